# Optimizing an MI355X kernel written in HIP

```python
import jax, jax.numpy as jnp
from jax import lax
import numpy as np

D_MODEL = 2048
BATCH = 1
SEQ = 8192
DEPTH = 1

CHUNK = 64
CONV_WIDTH = 1024
CONV_K = 3
SGU_WIDTH = 1024
SGU_HEADS = 8
SGU_HEAD_DIM = SGU_WIDTH // SGU_HEADS
SGU_BLOCK = 128
N_BRANCH = 2
IN_COLS = 3 * CONV_WIDTH + 2 * SGU_WIDTH + N_BRANCH * D_MODEL
N_GROUPS = 4
EXPERTS_PER_GROUP = 4
N_EXPERTS = N_GROUPS * EXPERTS_PER_GROUP
TOP_K_INNER = 2
D_EXPERT = D_MODEL // 4
EPS = 1e-6

kernel_name = 'hybrid_shortconv_sgu_hiermoe_block'


def rms_norm(x, g):
    xf = x.astype(jnp.float32)
    y = xf * lax.rsqrt(jnp.mean(xf * xf, axis=-1, keepdims=True) + EPS)
    return (y * g.astype(jnp.float32)).astype(x.dtype)


def layer_norm(x, g, b):
    xf = x.astype(jnp.float32)
    mu = jnp.mean(xf, axis=-1, keepdims=True)
    xc = xf - mu
    y = xc * lax.rsqrt(jnp.mean(xc * xc, axis=-1, keepdims=True) + EPS)
    return (y * g.astype(jnp.float32) + b.astype(jnp.float32)).astype(x.dtype)


def causal_depthwise_conv(z, w):
    c = z.shape[-1]
    return lax.conv_general_dilated(
        z, w[:, None, :].astype(z.dtype), window_strides=(1,),
        padding=[(CONV_K - 1, 0)], dimension_numbers=('NWC', 'WIO', 'NWC'),
        feature_group_count=c)


def short_conv_mixer(b_gate, c_gate, h_in, conv_w):
    return b_gate * causal_depthwise_conv(c_gate * h_in, conv_w)


def spatial_gating_mixer(z, ln_g, ln_b, w_s, b_s):
    bsz, s, _ = z.shape
    z = jax.nn.gelu(z)
    u, v = jnp.split(z, 2, axis=-1)
    v = layer_norm(v, ln_g, ln_b)
    chunk_id = jnp.arange(SGU_BLOCK) // CHUNK
    mask = chunk_id[None, :] <= chunk_id[:, None]
    w = jnp.where(mask[None], w_s, jnp.zeros_like(w_s)).astype(v.dtype)
    vb = v.reshape(bsz, s // SGU_BLOCK, SGU_BLOCK, SGU_HEADS, SGU_HEAD_DIM)
    vm = jnp.einsum('hij,bnjhc->bnihc', w, vb) + b_s.T.astype(v.dtype)[:, :, None]
    return u * vm.reshape(bsz, s, SGU_WIDTH)


def hierarchical_moe(x, w_rg, b_rg, w_re, b_re, w_gate, w_up, w_down):
    bsz, s, d = x.shape
    t = x.reshape(-1, d)
    tf = t.astype(jnp.float32)
    p_group = jax.nn.softmax(tf @ w_rg.astype(jnp.float32) + b_rg.astype(jnp.float32), axis=-1)
    pg, g_idx = lax.top_k(p_group, 1)
    oh_g = jax.nn.one_hot(g_idx[:, 0], N_GROUPS, dtype=jnp.float32)
    exp_logits = (tf @ w_re.astype(jnp.float32) + b_re.astype(jnp.float32)).reshape(-1, N_GROUPS, EXPERTS_PER_GROUP)
    sel_logits = jnp.einsum('tg,tge->te', oh_g, exp_logits)
    pe, e_idx = lax.top_k(jax.nn.softmax(sel_logits, axis=-1), TOP_K_INNER)
    pe = pe / jnp.sum(pe, axis=-1, keepdims=True)
    w_inner = jnp.einsum('tk,tke->te', pe, jax.nn.one_hot(e_idx, EXPERTS_PER_GROUP, dtype=jnp.float32))
    gate = ((pg * oh_g)[:, :, None] * w_inner[:, None, :]).reshape(-1, N_EXPERTS).astype(x.dtype)
    hid = jax.nn.silu(jnp.einsum('td,edf->tef', t, w_gate)) * jnp.einsum('td,edf->tef', t, w_up)
    y = jnp.einsum('tef,efd->td', hid * gate[:, :, None], w_down)
    return y.reshape(bsz, s, d)


def setup_inputs(seed: int = 0) -> dict:
    key = jax.random.key(seed)
    ks = jax.random.split(key, 20)
    f32 = jnp.float32
    nrm = lambda k, shape, scale: jax.random.normal(k, shape, f32) * scale
    L = DEPTH
    return {
        'x': jax.random.normal(ks[0], (BATCH, SEQ, D_MODEL), f32),
        'norm_mix_g': 1.0 + nrm(ks[1], (L, D_MODEL), 0.02),
        'w_in': nrm(ks[2], (L, D_MODEL, IN_COLS), D_MODEL ** -0.5),
        'conv_w': nrm(ks[3], (L, CONV_K, CONV_WIDTH), CONV_K ** -0.5),
        'sgu_ln_g': 1.0 + nrm(ks[4], (L, SGU_WIDTH), 0.02),
        'sgu_ln_b': nrm(ks[5], (L, SGU_WIDTH), 0.02),
        'sgu_w_s': nrm(ks[6], (L, SGU_HEADS, SGU_BLOCK, SGU_BLOCK), SGU_BLOCK ** -0.5),
        'sgu_b_s': 1.0 + nrm(ks[7], (L, SGU_HEADS, SGU_BLOCK), 0.02),
        'w_up_conv': nrm(ks[8], (L, CONV_WIDTH, D_MODEL), CONV_WIDTH ** -0.5),
        'w_up_sgu': nrm(ks[9], (L, SGU_WIDTH, D_MODEL), SGU_WIDTH ** -0.5),
        'w_out': nrm(ks[10], (L, D_MODEL, D_MODEL), D_MODEL ** -0.5),
        'norm_ffn_g': 1.0 + nrm(ks[11], (L, D_MODEL), 0.02),
        'w_router_group': nrm(ks[12], (L, D_MODEL, N_GROUPS), D_MODEL ** -0.5),
        'b_router_group': nrm(ks[13], (L, N_GROUPS), 0.01),
        'w_router_expert': nrm(ks[14], (L, D_MODEL, N_EXPERTS), D_MODEL ** -0.5),
        'b_router_expert': nrm(ks[15], (L, N_EXPERTS), 0.01),
        'w_exp_gate': nrm(ks[16], (L, N_EXPERTS, D_MODEL, D_EXPERT), D_MODEL ** -0.5),
        'w_exp_up': nrm(ks[17], (L, N_EXPERTS, D_MODEL, D_EXPERT), D_MODEL ** -0.5),
        'w_exp_down': nrm(ks[18], (L, N_EXPERTS, D_EXPERT, D_MODEL), D_EXPERT ** -0.5),
        'norm_final_g': 1.0 + nrm(ks[19], (D_MODEL,), 0.02),
    }


def reference(x, norm_mix_g, w_in, conv_w, sgu_ln_g, sgu_ln_b, sgu_w_s, sgu_b_s,
              w_up_conv, w_up_sgu, w_out, norm_ffn_g, w_router_group, b_router_group,
              w_router_expert, b_router_expert, w_exp_gate, w_exp_up, w_exp_down,
              norm_final_g):
    h = x
    splits = [CONV_WIDTH, 2 * CONV_WIDTH, 3 * CONV_WIDTH, 3 * CONV_WIDTH + 2 * SGU_WIDTH]
    for l in range(DEPTH):
        xn = rms_norm(h, norm_mix_g[l])
        proj = xn @ w_in[l]
        b_c, c_c, h_c, z_s, gate_logits = jnp.split(proj, splits, axis=-1)
        y_conv = short_conv_mixer(b_c, c_c, h_c, conv_w[l]) @ w_up_conv[l]
        y_sgu = spatial_gating_mixer(z_s, sgu_ln_g[l], sgu_ln_b[l], sgu_w_s[l], sgu_b_s[l]) @ w_up_sgu[l]
        g_conv, g_sgu = jnp.split(jax.nn.sigmoid(gate_logits), 2, axis=-1)
        h = h + (g_conv * y_conv + g_sgu * y_sgu) @ w_out[l]
        h = h + hierarchical_moe(rms_norm(h, norm_ffn_g[l]), w_router_group[l], b_router_group[l],
                                 w_router_expert[l], b_router_expert[l],
                                 w_exp_gate[l], w_exp_up[l], w_exp_down[l])
    return rms_norm(h, norm_final_g)
```

```cpp
#include <hip/hip_runtime.h>
#include <hip/hip_cooperative_groups.h>
#include <cstdio>
#include <cstdint>
namespace cg = cooperative_groups;

#ifndef ONE_LAUNCH
#define ONE_LAUNCH 0
#endif

#define LAS __attribute__((address_space(3)))
typedef unsigned short bf16_t;
typedef short bf16x8 __attribute__((ext_vector_type(8)));
typedef float f32x4 __attribute__((ext_vector_type(4)));
typedef float f32x2 __attribute__((ext_vector_type(2)));
typedef unsigned u32x4 __attribute__((ext_vector_type(4)));
typedef unsigned u32x2 __attribute__((ext_vector_type(2)));

constexpr int T = 8192, D = 2048, CW = 1024, SW = 1024, NIN = 9216, NE = 16, DE = 512;
constexpr float EPS = 1e-6f;
constexpr int NTHREADS = 512, NWAVES = 8;
constexpr int LDS_BYTES = 132 * 1024;
constexpr int HID_ROWS = 2 * T + NE * 256;

constexpr size_t MiB = 1024 * 1024;
constexpr size_t WS_CTL   = 0;
constexpr size_t WS_SMALL = 64 * 1024;
constexpr size_t SM_RSTD = 0, SM_ENT = 32 * 1024, SM_W = SM_ENT + (size_t)NE * T * 4, SM_END = SM_W + (size_t)NE * T * 4;
constexpr size_t WS_WR    = WS_SMALL + 2 * MiB;
constexpr size_t WS_WINT  = WS_WR + 256 * 1024;
constexpr size_t WS_WUPT  = WS_WINT + (size_t)NIN * D * 2;
constexpr size_t WS_WOUTT = WS_WUPT + (size_t)D * D * 2;
constexpr size_t WS_W1T   = WS_WOUTT + (size_t)D * D * 2;
constexpr size_t WS_W2T   = WS_W1T + (size_t)NE * 1024 * D * 2;
constexpr size_t WS_X     = WS_W2T + (size_t)NE * D * DE * 2;
constexpr size_t WS_P     = WS_X + (size_t)T * D * 2;
constexpr size_t P_BC = 0, P_P = P_BC + (size_t)T * CW * 2, P_U = P_P + (size_t)T * CW * 2, P_V = P_U + (size_t)T * SW * 2,
                 P_R = P_V + (size_t)T * SW * 2, P_S = P_R + (size_t)T * D * 2, P_END = P_S + (size_t)T * D * 2;
constexpr size_t WS_END   = WS_P + P_END;
constexpr size_t WS_MM  = WS_WINT;
constexpr size_t WS_H   = WS_P + P_BC;
constexpr size_t WS_A2  = WS_P + P_R;
constexpr size_t WS_HID = WS_P + P_S;
constexpr size_t WS_YK0 = WS_X;
constexpr size_t WS_YK1 = WS_WINT;
static_assert(SM_END <= 2 * MiB, "small region");
static_assert((size_t)HID_ROWS * DE * 2 <= (size_t)T * D * 2, "hid overlay");
static_assert((size_t)T * D * 4 <= P_R, "H overlay");

struct Params { const float* in[20]; float* out; unsigned char* ws; };

__device__ __forceinline__ unsigned cvt_pk_bf16(float lo, float hi) { unsigned r; asm("v_cvt_pk_bf16_f32 %0, %1, %2" : "=v"(r) : "v"(lo), "v"(hi)); return r; }
__device__ __forceinline__ float bf_lo(unsigned w) { return __uint_as_float(w << 16); }
__device__ __forceinline__ float bf_hi(unsigned w) { return __uint_as_float(w & 0xffff0000u); }
__device__ __forceinline__ float bf1(bf16_t b) { return __uint_as_float(((unsigned)b) << 16); }
__device__ __forceinline__ float wave_sum(float v) {
#pragma unroll
    for (int o = 1; o < 64; o <<= 1) v += __shfl_xor(v, o);
    return v;
}
__device__ __forceinline__ float fast_rcp(float x) { return __builtin_amdgcn_rcpf(x); }
__device__ __forceinline__ float fast_exp2(float x) { return __builtin_amdgcn_exp2f(x); }
__device__ __forceinline__ float sigmoid_f(float x) { return fast_rcp(1.0f + fast_exp2(-1.44269504f * x)); }
__device__ __forceinline__ float gelu_tanh(float x) {
    const float u = x + 0.044715f * x * x * x;
    return x * fast_rcp(1.0f + fast_exp2(-2.30220819f * u));
}
__host__ __device__ __forceinline__ int perm32(int rho) { const int n = rho >> 4, i = rho & 15; return 8 * (i >> 2) + 4 * n + (i & 3); }

struct Unit { int pm, pn, e, row0, nvalid; };
constexpr int NXCD = 8, WGM = 8;
struct DenseSched {
    const bf16_t* A; const bf16_t* Bt; int K; int nM, nN, nwg, G, c;
    __device__ __forceinline__ void init(const bf16_t* A_, const bf16_t* Bt_, int M, int N, int K_) { A = A_; Bt = Bt_; K = K_; nM = M / 256; nN = N / 256; nwg = nM * nN; G = gridDim.x; c = blockIdx.x; }
    __device__ __forceinline__ bool next(int i, Unit& u) const {
        const long L = (long)i * G + c; if (L >= nwg) return false;
        int wgid = (int)L; { const int q = nwg / NXCD, r = nwg % NXCD, xcd = wgid % NXCD, off = wgid / NXCD; wgid = (xcd < r ? xcd * (q + 1) : r * (q + 1) + (xcd - r) * q) + off; }
        const int nig = WGM * nN, gid = wgid / nig, fm = gid * WGM, gsz = (nM - fm) < WGM ? (nM - fm) : WGM;
        u.pm = fm + ((wgid % nig) % gsz); u.pn = (wgid % nig) / gsz; u.e = 0; u.row0 = u.pm * 256; u.nvalid = 256; return true;
    }
    __device__ __forceinline__ const char* a_base() const { return (const char*)A; }
    __device__ __forceinline__ unsigned a_off(const Unit& u, int r) const { return (unsigned)(u.row0 + r) * (unsigned)K * 2u; }
    __device__ __forceinline__ const char* b_base(const Unit& u) const { return (const char*)Bt + (size_t)u.pn * 256 * K * 2; }
};
template <bool GATHER, int NPN, int KK, int NROWS_E  >
struct MoeSched {
    const bf16_t* A; const bf16_t* Bt; const int* cnt; const int* ent; int G, c;
    __device__ __forceinline__ bool next(int i, Unit& u) const {
        int L = i * G + c; int hb = 0;
        for (int e = 0; e < NE; ++e) {
            const int n = __builtin_amdgcn_readfirstlane(cnt[e]); const int nt = (n + 255) >> 8;
            if (L < nt * NPN) { u.e = e; u.pm = L / NPN; u.pn = L % NPN; u.row0 = hb + u.pm * 256; u.nvalid = min(256, n - u.pm * 256); return true; }
            L -= nt * NPN; hb += nt * 256;
        }
        return false;
    }
    __device__ __forceinline__ const char* a_base() const { return (const char*)A; }
    __device__ __forceinline__ unsigned a_off(const Unit& u, int r) const {
        if (GATHER) { const int tok = (r < u.nvalid) ? (ent[u.e * T + u.pm * 256 + r] & 0xffff) : 0; return (unsigned)tok * (unsigned)KK * 2u; }
        return (unsigned)(u.row0 + r) * (unsigned)KK * 2u;
    }
    __device__ __forceinline__ const char* b_base(const Unit& u) const { return (const char*)Bt + ((size_t)u.e * NROWS_E + (size_t)u.pn * 256) * KK * 2; }
};

typedef f32x4 Acc[2][2][4][2];
__device__ __forceinline__ u32x4 pack8(f32x4 a, f32x4 b) { u32x4 w; w.x = cvt_pk_bf16(a[0], a[1]); w.y = cvt_pk_bf16(a[2], a[3]); w.z = cvt_pk_bf16(b[0], b[1]); w.w = cvt_pk_bf16(b[2], b[3]); return w; }
__device__ __forceinline__ void unpack8(u32x4 w, f32x4& a, f32x4& b) { a = (f32x4){bf_lo(w.x), bf_hi(w.x), bf_lo(w.y), bf_hi(w.y)}; b = (f32x4){bf_lo(w.z), bf_hi(w.z), bf_lo(w.w), bf_hi(w.w)}; }

struct EpiProj {
    static constexpr bool PERM = true; static constexpr int MIDK = 0;
    bf16_t *Bc, *P, *U, *V, *R, *S;
    __device__ __forceinline__ void mid(Acc&, const Unit&, int, int, int, int) const {}
    __device__ __forceinline__ void operator()(const Acc& acc, const Unit& u, int wr, int wc, int fr, int fq) const {
        const int pn = u.pn; const int rowb = u.row0 + wr * 64 + fr; const int cl = wc * 32 + 8 * fq;
#pragma unroll
        for (int ai = 0; ai < 2; ++ai)
#pragma unroll
            for (int m = 0; m < 4; ++m) {
                const size_t row = (size_t)(rowb + ai * 128 + m * 16);
                if (pn < 4) {
#pragma unroll
                    for (int bj = 0; bj < 2; ++bj) *(u32x4*)(Bc + row * CW + pn * 256 + bj * 128 + cl) = pack8(acc[ai][bj][m][0], acc[ai][bj][m][1]);
                } else if (pn < 12) {
                    *(u32x4*)(P + row * CW + (pn - 4) * 128 + cl) = pack8(acc[ai][0][m][0] * acc[ai][1][m][0], acc[ai][0][m][1] * acc[ai][1][m][1]);
                } else if (pn < 20) {
                    bf16_t* O = (pn < 16) ? (U + row * SW + (pn - 12) * 256) : (V + row * SW + (pn - 16) * 256);
#pragma unroll
                    for (int bj = 0; bj < 2; ++bj) { f32x4 a = acc[ai][bj][m][0], b = acc[ai][bj][m][1];
#pragma unroll
                        for (int j = 0; j < 4; ++j) { a[j] = gelu_tanh(a[j]); b[j] = gelu_tanh(b[j]); }
                        *(u32x4*)(O + bj * 128 + cl) = pack8(a, b); }
                } else {
                    f32x4 r0, r1, s0, s1;
#pragma unroll
                    for (int j = 0; j < 4; ++j) {
                        const float ec0 = fast_exp2(-1.44269504f * acc[ai][0][m][0][j]), es0 = fast_exp2(-1.44269504f * acc[ai][1][m][0][j]);
                        const float ec1 = fast_exp2(-1.44269504f * acc[ai][0][m][1][j]), es1 = fast_exp2(-1.44269504f * acc[ai][1][m][1][j]);
                        r0[j] = (1.0f + es0) * fast_rcp(1.0f + ec0); s0[j] = fast_rcp(1.0f + es0);
                        r1[j] = (1.0f + es1) * fast_rcp(1.0f + ec1); s1[j] = fast_rcp(1.0f + es1);
                    }
                    const size_t o = row * D + (pn - 20) * 128 + cl;
                    *(u32x4*)(R + o) = pack8(r0, r1); *(u32x4*)(S + o) = pack8(s0, s1);
                }
            }
    }
};
struct EpiUp {
    static constexpr bool PERM = true; static constexpr int MIDK = 1024;
    const bf16_t *R, *S; bf16_t* Mm;
    __device__ __forceinline__ void mid(Acc& acc, const Unit& u, int wr, int wc, int fr, int fq) const {
        const int rowb = u.row0 + wr * 64 + fr; const int cb = u.pn * 256 + wc * 32 + 8 * fq;
#pragma unroll
        for (int ai = 0; ai < 2; ++ai)
#pragma unroll
            for (int m = 0; m < 4; ++m)
#pragma unroll
                for (int bj = 0; bj < 2; ++bj) { f32x4 a, b; unpack8(*(const u32x4*)(R + (size_t)(rowb + ai * 128 + m * 16) * D + cb + bj * 128), a, b);
                    acc[ai][bj][m][0] *= a; acc[ai][bj][m][1] *= b; }
    }
    __device__ __forceinline__ void operator()(const Acc& acc, const Unit& u, int wr, int wc, int fr, int fq) const {
        const int rowb = u.row0 + wr * 64 + fr; const int cb = u.pn * 256 + wc * 32 + 8 * fq;
#pragma unroll
        for (int ai = 0; ai < 2; ++ai)
#pragma unroll
            for (int m = 0; m < 4; ++m)
#pragma unroll
                for (int bj = 0; bj < 2; ++bj) { const size_t o = (size_t)(rowb + ai * 128 + m * 16) * D + cb + bj * 128; f32x4 a, b; unpack8(*(const u32x4*)(S + o), a, b);
                    *(u32x4*)(Mm + o) = pack8(acc[ai][bj][m][0] * a, acc[ai][bj][m][1] * b); }
    }
};
struct EpiOut {
    static constexpr bool PERM = false; static constexpr int MIDK = 0;
    const float* x; const float* g; float* H; bf16_t* A2;
    __device__ __forceinline__ void mid(Acc&, const Unit&, int, int, int, int) const {}
    __device__ __forceinline__ void operator()(const Acc& acc, const Unit& u, int wr, int wc, int fr, int fq) const {
        const int rowb = u.row0 + wr * 64 + fr; const int cb = u.pn * 256 + wc * 32 + 4 * fq;
#pragma unroll
        for (int ai = 0; ai < 2; ++ai)
#pragma unroll
            for (int m = 0; m < 4; ++m)
#pragma unroll
                for (int bj = 0; bj < 2; ++bj)
#pragma unroll
                    for (int n = 0; n < 2; ++n) { const int col = cb + bj * 128 + n * 16; const size_t o = (size_t)(rowb + ai * 128 + m * 16) * D + col;
                        const f32x4 h = *(const f32x4*)(x + o) + acc[ai][bj][m][n]; *(f32x4*)(H + o) = h; const f32x4 gg = *(const f32x4*)(g + col);
                        u32x2 w; w.x = cvt_pk_bf16(h[0] * gg[0], h[1] * gg[1]); w.y = cvt_pk_bf16(h[2] * gg[2], h[3] * gg[3]); *(u32x2*)(A2 + o) = w; }
    }
};
struct EpiMoe1 {
    static constexpr bool PERM = true; static constexpr int MIDK = 0;
    const int* ent; const float* lw; const float* rstd; bf16_t* Hid;
    __device__ __forceinline__ void mid(Acc&, const Unit&, int, int, int, int) const {}
    __device__ __forceinline__ void operator()(const Acc& acc, const Unit& u, int wr, int wc, int fr, int fq) const {
        const int cl = u.pn * 128 + wc * 32 + 8 * fq;
#pragma unroll
        for (int ai = 0; ai < 2; ++ai)
#pragma unroll
            for (int m = 0; m < 4; ++m) {
                const int r = ai * 128 + wr * 64 + m * 16 + fr;
                if (r < u.nvalid) {
                    const int li = u.e * T + u.pm * 256 + r; const int tok = ent[li] & 0xffff; const float rs = rstd[tok], w = lw[li];
                    f32x4 o[2];
#pragma unroll
                    for (int n = 0; n < 2; ++n)
#pragma unroll
                        for (int j = 0; j < 4; ++j) { const float gt = acc[ai][0][m][n][j] * rs, up = acc[ai][1][m][n][j] * rs; o[n][j] = gt * sigmoid_f(gt) * up * w; }
                    *(u32x4*)(Hid + (size_t)(u.row0 + r) * DE + cl) = pack8(o[0], o[1]);
                }
            }
    }
};
struct EpiMoe2 {
    static constexpr bool PERM = true; static constexpr int MIDK = 0;
    const int* ent; bf16_t* Yk0; bf16_t* Yk1;
    __device__ __forceinline__ void mid(Acc&, const Unit&, int, int, int, int) const {}
    __device__ __forceinline__ void operator()(const Acc& acc, const Unit& u, int wr, int wc, int fr, int fq) const {
        const int cb = u.pn * 256 + wc * 32 + 8 * fq;
#pragma unroll
        for (int ai = 0; ai < 2; ++ai)
#pragma unroll
            for (int m = 0; m < 4; ++m) {
                const int r = ai * 128 + wr * 64 + m * 16 + fr;
                if (r < u.nvalid) {
                    const int en = ent[u.e * T + u.pm * 256 + r]; const int tok = en & 0xffff; bf16_t* Y = (en >> 16) ? Yk1 : Yk0;
#pragma unroll
                    for (int bj = 0; bj < 2; ++bj) *(u32x4*)(Y + (size_t)tok * D + cb + bj * 128) = pack8(acc[ai][bj][m][0], acc[ai][bj][m][1]);
                }
            }
    }
};

template <class Epi, class Sched>
__device__ __forceinline__ void gemm_simple(const Sched& S, const Epi& E, const int K) {
    const int tid = threadIdx.x, wid = __builtin_amdgcn_readfirstlane(tid >> 6), lane = tid & 63, wr = wid >> 2, wc = wid & 3, fr = lane & 15, fq = lane >> 4;
    Unit u;
    for (int ui = 0; S.next(ui, u); ++ui) {
        Acc acc;
#pragma unroll
        for (int a = 0; a < 2; ++a)
#pragma unroll
            for (int b = 0; b < 2; ++b)
#pragma unroll
                for (int m = 0; m < 4; ++m)
#pragma unroll
                    for (int n = 0; n < 2; ++n) acc[a][b][m][n] = (f32x4){0.f, 0.f, 0.f, 0.f};
        const char* ab = S.a_base(); const char* bb = S.b_base(u);
        unsigned aoff[2][4], boff[2][2];
#pragma unroll
        for (int ai = 0; ai < 2; ++ai)
#pragma unroll
            for (int m = 0; m < 4; ++m) aoff[ai][m] = S.a_off(u, ai * 128 + wr * 64 + m * 16 + fr) + fq * 16;
#pragma unroll
        for (int bj = 0; bj < 2; ++bj)
#pragma unroll
            for (int n = 0; n < 2; ++n) { const int rr = Epi::PERM ? perm32(n * 16 + fr) : (n * 16 + fr); boff[bj][n] = (unsigned)(bj * 128 + wc * 32 + rr) * (unsigned)K * 2u + fq * 16; }
        for (int k0 = 0; k0 < K; k0 += 32) {
            if (Epi::MIDK != 0 && k0 == Epi::MIDK) E.mid(acc, u, wr, wc, fr, fq);
            bf16x8 a[2][4], b[2][2];
#pragma unroll
            for (int ai = 0; ai < 2; ++ai)
#pragma unroll
                for (int m = 0; m < 4; ++m) a[ai][m] = *(const bf16x8*)(ab + aoff[ai][m] + k0 * 2);
#pragma unroll
            for (int bj = 0; bj < 2; ++bj)
#pragma unroll
                for (int n = 0; n < 2; ++n) b[bj][n] = *(const bf16x8*)(bb + boff[bj][n] + k0 * 2);
#pragma unroll
            for (int ai = 0; ai < 2; ++ai)
#pragma unroll
                for (int bj = 0; bj < 2; ++bj)
#pragma unroll
                    for (int m = 0; m < 4; ++m)
#pragma unroll
                        for (int n = 0; n < 2; ++n) acc[ai][bj][m][n] = __builtin_amdgcn_mfma_f32_16x16x32_bf16(b[bj][n], a[ai][m], acc[ai][bj][m][n], 0, 0, 0);
        }
        E(acc, u, wr, wc, fr, fq);
    }
}

__device__ __forceinline__ void tr_item(const float* W, int N, int k0, int ns, bf16_t* WT, int ldk, int nd, int kd, LAS float* scr, int lane) {
#pragma unroll 8
    for (int i = 0; i < 32; ++i) { const int kk = 2 * i + (lane >> 5); scr[kk * 33 + (lane & 31)] = W[(size_t)(k0 + kk) * N + ns + (lane & 31)]; }
    asm volatile("s_waitcnt lgkmcnt(0)" ::: "memory");
    const int c = lane & 7;
#pragma unroll
    for (int j = 0; j < 4; ++j) { const int n = (lane >> 3) + 8 * j; const LAS float* s = scr + (8 * c) * 33 + n;
        u32x4 o; o.x = cvt_pk_bf16(s[0 * 33], s[1 * 33]); o.y = cvt_pk_bf16(s[2 * 33], s[3 * 33]); o.z = cvt_pk_bf16(s[4 * 33], s[5 * 33]); o.w = cvt_pk_bf16(s[6 * 33], s[7 * 33]);
        *(u32x4*)(WT + (size_t)(nd + n) * ldk + kd + 8 * c) = o; }
    asm volatile("s_waitcnt lgkmcnt(0)" ::: "memory");
}
__device__ __forceinline__ int win_src_col(int nd) {
    if (nd < 1024) return nd;
    if (nd < 3072) { const int q = (nd - 1024) >> 8, r = (nd - 1024) & 255; return r < 128 ? (1024 + 128 * q + r) : (2048 + 128 * q + r - 128); }
    if (nd < 5120) return nd;
    { const int q = (nd - 5120) >> 8, r = (nd - 5120) & 255; return r < 128 ? (5120 + 128 * q + r) : (7168 + 128 * q + r - 128); }
}
__device__ __forceinline__ void phase0(const Params& p, LAS unsigned char* lds) {
    const int tid = threadIdx.x, wave = __builtin_amdgcn_readfirstlane(tid >> 6), lane = tid & 63;
    LAS float* scr = (LAS float*)(lds + wave * 8704);
    const int gw = blockIdx.x * NWAVES + wave, NGW = gridDim.x * NWAVES;
    unsigned char* ws = p.ws;
    constexpr int I_IN = 32 * 288, I_UP = 16 * 64, I_OUT = 32 * 64, I_G = 32 * 16 * NE, I_D = 8 * 64 * NE;
    constexpr int NITEMS = I_IN + 2 * I_UP + I_OUT + 2 * I_G + I_D;
    for (int it = gw; it < NITEMS; it += NGW) {
        int r = it;
        if (r < I_IN) { const int kb = r / 288, nb = r % 288; tr_item(p.in[2], NIN, kb * 64, win_src_col(nb * 32), (bf16_t*)(ws + WS_WINT), D, nb * 32, kb * 64, scr, lane); continue; } r -= I_IN;
        if (r < I_UP) { const int kb = r / 64, nb = r % 64; tr_item(p.in[8], D, kb * 64, nb * 32, (bf16_t*)(ws + WS_WUPT), 2048, nb * 32, kb * 64, scr, lane); continue; } r -= I_UP;
        if (r < I_UP) { const int kb = r / 64, nb = r % 64; tr_item(p.in[9], D, kb * 64, nb * 32, (bf16_t*)(ws + WS_WUPT), 2048, nb * 32, 1024 + kb * 64, scr, lane); continue; } r -= I_UP;
        if (r < I_OUT) { const int kb = r / 64, nb = r % 64; tr_item(p.in[10], D, kb * 64, nb * 32, (bf16_t*)(ws + WS_WOUTT), D, nb * 32, kb * 64, scr, lane); continue; } r -= I_OUT;
        if (r < 2 * I_G) { const int up = r >= I_G; if (up) r -= I_G; const int e = r / 512, q = r % 512, kb = q / 16, nb = q % 16;
            const int nd = 256 * (nb >> 2) + (nb & 3) * 32 + (up ? 128 : 0);
            tr_item(p.in[up ? 17 : 16] + (size_t)e * D * DE, DE, kb * 64, nb * 32, (bf16_t*)(ws + WS_W1T) + (size_t)e * 1024 * D, D, nd, kb * 64, scr, lane); continue; } r -= 2 * I_G;
        { const int e = r / 512, q = r % 512, kb = q / 64, nb = q % 64;
            tr_item(p.in[18] + (size_t)e * DE * D, D, kb * 64, nb * 32, (bf16_t*)(ws + WS_W2T) + (size_t)e * D * DE, DE, nb * 32, kb * 64, scr, lane); }
    }
    const float* x = p.in[0]; const float* g = p.in[1]; bf16_t* xn = (bf16_t*)(ws + WS_X);
    for (int m = gw; m < T; m += NGW) {
        const f32x4* xr = (const f32x4*)(x + (size_t)m * D) + lane; f32x4 v[8]; float s = 0.f;
#pragma unroll
        for (int j = 0; j < 8; ++j) { v[j] = xr[64 * j]; s += (v[j][0] * v[j][0] + v[j][1] * v[j][1]) + (v[j][2] * v[j][2] + v[j][3] * v[j][3]); }
        const float rs = 1.0f / sqrtf(wave_sum(s) * (1.0f / D) + EPS);
        u32x2* o = (u32x2*)(xn + (size_t)m * D) + lane;
#pragma unroll
        for (int j = 0; j < 8; ++j) { const f32x4 gg = *((const f32x4*)g + lane + 64 * j); u32x2 w; w.x = cvt_pk_bf16(v[j][0] * rs * gg[0], v[j][1] * rs * gg[1]); w.y = cvt_pk_bf16(v[j][2] * rs * gg[2], v[j][3] * rs * gg[3]); o[64 * j] = w; }
    }
    float* wr = (float*)(ws + WS_WR); const float* gf = p.in[11];
    for (int i = blockIdx.x * NTHREADS + tid; i < 20 * D; i += gridDim.x * NTHREADS) { const int j = i / D, d = i % D; wr[i] = gf[d] * (j < 4 ? p.in[12][d * 4 + j] : p.in[14][d * 16 + (j - 4)]); }
    if (blockIdx.x == 0 && tid < 64) ((int*)(ws + WS_CTL))[tid] = 0;
}

__device__ __forceinline__ void phase2_conv(const Params& p) {
    const bf16_t* Bc = (const bf16_t*)(p.ws + WS_P + P_BC); const bf16_t* P = (const bf16_t*)(p.ws + WS_P + P_P); bf16_t* Y = (bf16_t*)(p.ws + WS_X);
    const float* cw = p.in[3];
    for (int i = blockIdx.x * NTHREADS + threadIdx.x; i < T * (CW / 8); i += gridDim.x * NTHREADS) {
        const int t = i >> 7, c = (i & 127) * 8;
        f32x4 p0a, p0b, p1a, p1b, p2a, p2b, ba, bb;
        unpack8(*(const u32x4*)(P + (size_t)t * CW + c), p2a, p2b); unpack8(*(const u32x4*)(Bc + (size_t)t * CW + c), ba, bb);
        if (t >= 1) unpack8(*(const u32x4*)(P + (size_t)(t - 1) * CW + c), p1a, p1b); else { p1a = (f32x4){0, 0, 0, 0}; p1b = p1a; }
        if (t >= 2) unpack8(*(const u32x4*)(P + (size_t)(t - 2) * CW + c), p0a, p0b); else { p0a = (f32x4){0, 0, 0, 0}; p0b = p0a; }
        const f32x4 w0a = *(const f32x4*)(cw + c), w0b = *(const f32x4*)(cw + c + 4), w1a = *(const f32x4*)(cw + CW + c), w1b = *(const f32x4*)(cw + CW + c + 4),
                    w2a = *(const f32x4*)(cw + 2 * CW + c), w2b = *(const f32x4*)(cw + 2 * CW + c + 4);
        const f32x4 ya = ba * (w0a * p0a + w1a * p1a + w2a * p2a), yb = bb * (w0b * p0b + w1b * p1b + w2b * p2b);
        *(u32x4*)(Y + (size_t)t * 2048 + c) = pack8(ya, yb);
    }
}
__device__ __forceinline__ void phase2_sgu(const Params& p, LAS unsigned char* lds) {
    const int tid = threadIdx.x, wave = __builtin_amdgcn_readfirstlane(tid >> 6), lane = tid & 63;
    const bf16_t* U = (const bf16_t*)(p.ws + WS_P + P_U); const bf16_t* V = (const bf16_t*)(p.ws + WS_P + P_V); bf16_t* Y = (bf16_t*)(p.ws + WS_X);
    const float* lng = p.in[4]; const float* lnb = p.in[5]; const float* Ws = p.in[6]; const float* bs = p.in[7];
    LAS f32x2* st = (LAS f32x2*)lds;
    LAS float* vn = (LAS float*)(lds + 1024);
    for (int unit = blockIdx.x; unit < 64 * 8; unit += gridDim.x) {
        const int nb = unit >> 3, h = unit & 7, t0 = nb * 128, c0 = h * 128;
        __syncthreads();
        for (int jj = 0; jj < 16; ++jj) { const int j = wave * 16 + jj; const u32x4* vr = (const u32x4*)(V + (size_t)(t0 + j) * SW) + lane * 2;
            f32x4 a, b, c, d; unpack8(vr[0], a, b); unpack8(vr[1], c, d);
            float s = (a[0] + a[1] + a[2] + a[3]) + (b[0] + b[1] + b[2] + b[3]) + (c[0] + c[1] + c[2] + c[3]) + (d[0] + d[1] + d[2] + d[3]);
            const float mu = wave_sum(s) * (1.0f / SW);
            a -= mu; b -= mu; c -= mu; d -= mu;
            float q = (a[0] * a[0] + a[1] * a[1] + a[2] * a[2] + a[3] * a[3]) + (b[0] * b[0] + b[1] * b[1] + b[2] * b[2] + b[3] * b[3]) + (c[0] * c[0] + c[1] * c[1] + c[2] * c[2] + c[3] * c[3]) + (d[0] * d[0] + d[1] * d[1] + d[2] * d[2] + d[3] * d[3]);
            const float rs = 1.0f / sqrtf(wave_sum(q) * (1.0f / SW) + EPS);
            if (lane == 0) st[j] = (f32x2){mu, rs}; }
        __syncthreads();
        for (int q = tid; q < 128 * 16; q += NTHREADS) { const int j = q >> 4, c = (q & 15) * 8; const f32x2 s = st[j];
            f32x4 a, b; unpack8(*(const u32x4*)(V + (size_t)(t0 + j) * SW + c0 + c), a, b);
            const f32x4 g0 = *(const f32x4*)(lng + c0 + c), g1 = *(const f32x4*)(lng + c0 + c + 4), b0 = *(const f32x4*)(lnb + c0 + c), b1 = *(const f32x4*)(lnb + c0 + c + 4);
            a = (a - s.x) * s.y * g0 + b0; b = (b - s.x) * s.y * g1 + b1;
            *(LAS f32x4*)(vn + j * 128 + c) = a; *(LAS f32x4*)(vn + j * 128 + c + 4) = b; }
        __syncthreads();
        for (int ii = 0; ii < 16; ++ii) { const int i = wave * 16 + ii; const int jmax = (i < 64) ? 64 : 128; const float* wrow = Ws + ((size_t)h * 128 + i) * 128;
            float a0 = 0.f, a1 = 0.f;
            for (int j = 0; j < jmax; ++j) { const float w = wrow[j]; a0 += w * vn[j * 128 + lane]; a1 += w * vn[j * 128 + lane + 64]; }
            const float bb = bs[h * 128 + i]; const size_t t = (size_t)(t0 + i);
            const float u0 = bf1(U[t * SW + c0 + lane]), u1 = bf1(U[t * SW + c0 + lane + 64]);
            Y[t * 2048 + 1024 + c0 + lane] = (bf16_t)(cvt_pk_bf16(u0 * (a0 + bb), 0.f) & 0xffff); Y[t * 2048 + 1024 + c0 + lane + 64] = (bf16_t)(cvt_pk_bf16(u1 * (a1 + bb), 0.f) & 0xffff); }
    }
}

__device__ __forceinline__ void phase5_router(const Params& p, LAS unsigned char* lds) {
    const int tid = threadIdx.x, wave = __builtin_amdgcn_readfirstlane(tid >> 6), lane = tid & 63;
    const float* H = (const float*)(p.ws + WS_H); const float* wr = (const float*)(p.ws + WS_WR);
    float* rstd = (float*)(p.ws + WS_SMALL + SM_RSTD); int* ent = (int*)(p.ws + WS_SMALL + SM_ENT); float* lw = (float*)(p.ws + WS_SMALL + SM_W); int* cnt = (int*)(p.ws + WS_CTL);
    const float* brg = p.in[13]; const float* bre = p.in[15];
    LAS int* lcnt = (LAS int*)lds;
    LAS int* lbase = (LAS int*)(lds + 64);
    LAS int* le = (LAS int*)(lds + 128);
    LAS int* lp = (LAS int*)(lds + 128 + 256);
    LAS float* lwt = (LAS float*)(lds + 128 + 512);
    const int ngroups = T / 4, nrounds = (ngroups + gridDim.x * NWAVES - 1) / (gridDim.x * NWAVES);
    for (int rd = 0; rd < nrounds; ++rd) {
        const int grp = (rd * gridDim.x + blockIdx.x) * NWAVES + wave; const bool valid = grp < ngroups;
        if (tid < 16) lcnt[tid] = 0;
        __syncthreads();
        if (valid) {
            const int t0 = grp * 4;
            float acc[4][20]; float ss[4];
#pragma unroll
            for (int t = 0; t < 4; ++t) { ss[t] = 0.f;
#pragma unroll
                for (int j = 0; j < 20; ++j) acc[t][j] = 0.f; }
            for (int kc = 0; kc < 8; ++kc) {
                const int k = kc * 256 + lane * 4; f32x4 hv[4];
#pragma unroll
                for (int t = 0; t < 4; ++t) { hv[t] = *(const f32x4*)(H + (size_t)(t0 + t) * D + k); ss[t] += (hv[t][0] * hv[t][0] + hv[t][1] * hv[t][1]) + (hv[t][2] * hv[t][2] + hv[t][3] * hv[t][3]); }
#pragma unroll
                for (int j = 0; j < 20; ++j) { const f32x4 w = *(const f32x4*)(wr + (size_t)j * D + k);
#pragma unroll
                    for (int t = 0; t < 4; ++t) acc[t][j] += (hv[t][0] * w[0] + hv[t][1] * w[1]) + (hv[t][2] * w[2] + hv[t][3] * w[3]); }
            }
#pragma unroll
            for (int t = 0; t < 4; ++t) { ss[t] = wave_sum(ss[t]);
#pragma unroll
                for (int j = 0; j < 20; ++j) acc[t][j] = wave_sum(acc[t][j]); }
#pragma unroll
            for (int t = 0; t < 4; ++t) {
                const float rs = 1.0f / sqrtf(ss[t] * (1.0f / D) + EPS);
                float lg[4];
#pragma unroll
                for (int j = 0; j < 4; ++j) lg[j] = acc[t][j] * rs + brg[j];
                int gi = 0; float gm = lg[0];
#pragma unroll
                for (int j = 1; j < 4; ++j) if (lg[j] > gm) { gm = lg[j]; gi = j; }
                float den = 0.f;
#pragma unroll
                for (int j = 0; j < 4; ++j) den += __expf(lg[j] - gm);
                const float pg = 1.0f / den;
                float le4[4];
#pragma unroll
                for (int j = 0; j < 4; ++j) { const float v0 = acc[t][4 + j], v1 = acc[t][8 + j], v2 = acc[t][12 + j], v3 = acc[t][16 + j];
                    const float v = gi == 0 ? v0 : (gi == 1 ? v1 : (gi == 2 ? v2 : v3)); le4[j] = v * rs + bre[gi * 4 + j]; }
                int i1 = 0; float m1 = le4[0];
#pragma unroll
                for (int j = 1; j < 4; ++j) if (le4[j] > m1) { m1 = le4[j]; i1 = j; }
                int i2 = -1; float m2 = -3.0e38f;
#pragma unroll
                for (int j = 0; j < 4; ++j) if (j != i1 && le4[j] > m2) { m2 = le4[j]; i2 = j; }
                const float ex = __expf(m2 - m1); const float w1 = pg / (1.0f + ex), w2 = pg * ex / (1.0f + ex);
                if (lane == 0) {
                    rstd[t0 + t] = rs;
                    const int e1 = gi * 4 + i1, e2 = gi * 4 + i2; const int s = (wave * 4 + t) * 2;
                    le[s] = e1; le[s + 1] = e2; lwt[s] = w1; lwt[s + 1] = w2;
                    lp[s] = atomicAdd((int*)&lcnt[e1], 1); lp[s + 1] = atomicAdd((int*)&lcnt[e2], 1);
                }
            }
        }
        __syncthreads();
        if (tid < 16) { const int n = lcnt[tid]; lbase[tid] = n ? atomicAdd(&cnt[tid], n) : 0; }
        __syncthreads();
        if (valid && lane < 8) { const int s = wave * 8 + lane; const int e = le[s]; const int pos = lbase[e] + lp[s]; const int tok = grp * 4 + (lane >> 1);
            ent[e * T + pos] = tok | ((lane & 1) << 16); lw[e * T + pos] = lwt[s]; }
        __syncthreads();
    }
}

__device__ __forceinline__ void phase8_final(const Params& p) {
    const int tid = threadIdx.x, wave = __builtin_amdgcn_readfirstlane(tid >> 6), lane = tid & 63;
    const float* H = (const float*)(p.ws + WS_H); const bf16_t* Y0 = (const bf16_t*)(p.ws + WS_YK0); const bf16_t* Y1 = (const bf16_t*)(p.ws + WS_YK1); const float* g = p.in[19];
    const int gw = blockIdx.x * NWAVES + wave, NGW = gridDim.x * NWAVES;
    for (int m = gw; m < T; m += NGW) {
        f32x4 v[8]; float s = 0.f;
#pragma unroll
        for (int j = 0; j < 8; ++j) { const size_t o = (size_t)m * D + 4 * lane + 256 * j; v[j] = *(const f32x4*)(H + o);
            const u32x2 a = *(const u32x2*)(Y0 + o), b = *(const u32x2*)(Y1 + o);
            v[j][0] += bf_lo(a.x) + bf_lo(b.x); v[j][1] += bf_hi(a.x) + bf_hi(b.x); v[j][2] += bf_lo(a.y) + bf_lo(b.y); v[j][3] += bf_hi(a.y) + bf_hi(b.y);
            s += (v[j][0] * v[j][0] + v[j][1] * v[j][1]) + (v[j][2] * v[j][2] + v[j][3] * v[j][3]); }
        const float rs = 1.0f / sqrtf(wave_sum(s) * (1.0f / D) + EPS);
#pragma unroll
        for (int j = 0; j < 8; ++j) { const int c = 4 * lane + 256 * j; const f32x4 gg = *(const f32x4*)(g + c); *(f32x4*)(p.out + (size_t)m * D + c) = v[j] * rs * gg; }
    }
}

template <int PH> __device__ __forceinline__ void run_phase(const Params& p, LAS unsigned char* lds) {
    unsigned char* ws = p.ws;
    if constexpr (PH == 0) phase0(p, lds);
    if constexpr (PH == 1) { DenseSched S; S.init((const bf16_t*)(ws + WS_X), (const bf16_t*)(ws + WS_WINT), T, NIN, D);
        EpiProj E{(bf16_t*)(ws + WS_P + P_BC), (bf16_t*)(ws + WS_P + P_P), (bf16_t*)(ws + WS_P + P_U), (bf16_t*)(ws + WS_P + P_V), (bf16_t*)(ws + WS_P + P_R), (bf16_t*)(ws + WS_P + P_S)};
        gemm_simple(S, E, D); }
    if constexpr (PH == 2) { phase2_conv(p); phase2_sgu(p, lds); }
    if constexpr (PH == 3) { DenseSched S; S.init((const bf16_t*)(ws + WS_X), (const bf16_t*)(ws + WS_WUPT), T, D, 2048);
        EpiUp E{(const bf16_t*)(ws + WS_P + P_R), (const bf16_t*)(ws + WS_P + P_S), (bf16_t*)(ws + WS_MM)}; gemm_simple(S, E, 2048); }
    if constexpr (PH == 4) { DenseSched S; S.init((const bf16_t*)(ws + WS_MM), (const bf16_t*)(ws + WS_WOUTT), T, D, D);
        EpiOut E{p.in[0], p.in[11], (float*)(ws + WS_H), (bf16_t*)(ws + WS_A2)}; gemm_simple(S, E, D); }
    if constexpr (PH == 5) phase5_router(p, lds);
    if constexpr (PH == 6) { MoeSched<true, 4, D, 1024> S{(const bf16_t*)(ws + WS_A2), (const bf16_t*)(ws + WS_W1T), (const int*)(ws + WS_CTL), (const int*)(ws + WS_SMALL + SM_ENT), (int)gridDim.x, (int)blockIdx.x};
        EpiMoe1 E{(const int*)(ws + WS_SMALL + SM_ENT), (const float*)(ws + WS_SMALL + SM_W), (const float*)(ws + WS_SMALL + SM_RSTD), (bf16_t*)(ws + WS_HID)}; gemm_simple(S, E, D); }
    if constexpr (PH == 7) { MoeSched<false, 8, DE, D> S{(const bf16_t*)(ws + WS_HID), (const bf16_t*)(ws + WS_W2T), (const int*)(ws + WS_CTL), (const int*)(ws + WS_SMALL + SM_ENT), (int)gridDim.x, (int)blockIdx.x};
        EpiMoe2 E{(const int*)(ws + WS_SMALL + SM_ENT), (bf16_t*)(ws + WS_YK0), (bf16_t*)(ws + WS_YK1)}; gemm_simple(S, E, DE); }
    if constexpr (PH == 8) phase8_final(p);
}

template <int PH> __global__ void __launch_bounds__(NTHREADS, 2) k_phase(Params p) {
    extern __shared__ __attribute__((aligned(16))) unsigned char lds_raw[];
    run_phase<PH>(p, (LAS unsigned char*)lds_raw);
}

__global__ void __launch_bounds__(NTHREADS, 2) k_mega(Params p) {
    extern __shared__ __attribute__((aligned(16))) unsigned char lds_raw[];
    LAS unsigned char* lds = (LAS unsigned char*)lds_raw;
    cg::grid_group grid = cg::this_grid();
    run_phase<0>(p, lds); grid.sync();
    run_phase<1>(p, lds); grid.sync();
    run_phase<2>(p, lds); grid.sync();
    run_phase<3>(p, lds); grid.sync();
    run_phase<4>(p, lds); grid.sync();
    run_phase<5>(p, lds); grid.sync();
    run_phase<6>(p, lds); grid.sync();
    run_phase<7>(p, lds); grid.sync();
    run_phase<8>(p, lds);
}

template <int PH> static void launch_phase(const Params& p, int grid, hipStream_t stream) {
    static bool attr = false;
    if (!attr) { (void)hipFuncSetAttribute((const void*)k_phase<PH>, hipFuncAttributeMaxDynamicSharedMemorySize, LDS_BYTES); attr = true; }
    hipLaunchKernelGGL(k_phase<PH>, dim3(grid), dim3(NTHREADS), LDS_BYTES, stream, p);
}

extern "C" void kernel_launch(void* const* d_in, const int* in_sizes, int n_in, void* d_out, int out_size, void* d_ws, size_t ws_size, hipStream_t stream) {
    static int grid = 0;
    if (grid == 0) {
        if (n_in != 20 || out_size != T * D || ws_size < WS_END) { fprintf(stderr, "kernel_launch: unexpected shapes n_in %d out %d ws %zu (need %zu)\n", n_in, out_size, ws_size, (size_t)WS_END); grid = -1; return; }
        int dev = 0, cus = 0, per_cu = 0;
        (void)hipGetDevice(&dev); (void)hipDeviceGetAttribute(&cus, hipDeviceAttributeMultiprocessorCount, dev);
        (void)hipFuncSetAttribute((const void*)k_mega, hipFuncAttributeMaxDynamicSharedMemorySize, LDS_BYTES);
        (void)hipOccupancyMaxActiveBlocksPerMultiprocessor(&per_cu, (const void*)k_mega, NTHREADS, LDS_BYTES);
        if (per_cu < 1) { fprintf(stderr, "kernel_launch: occupancy query says %d blocks per CU\n", per_cu); per_cu = 1; }
        grid = cus * 1;
        (void)hipGetLastError();
    }
    if (grid < 0) return;
    Params p{};
    for (int i = 0; i < 20; ++i) p.in[i] = (const float*)d_in[i];
    p.out = (float*)d_out; p.ws = (unsigned char*)d_ws;
#if ONE_LAUNCH
    void* args[] = {&p};
    hipError_t e = hipLaunchCooperativeKernel((const void*)k_mega, dim3(grid), dim3(NTHREADS), args, LDS_BYTES, stream);
    if (e != hipSuccess) fprintf(stderr, "cooperative launch failed: %s (grid %d)\n", hipGetErrorString(e), grid);
#else
    launch_phase<0>(p, grid, stream); launch_phase<1>(p, grid, stream); launch_phase<2>(p, grid, stream); launch_phase<3>(p, grid, stream); launch_phase<4>(p, grid, stream);
    launch_phase<5>(p, grid, stream); launch_phase<6>(p, grid, stream); launch_phase<7>(p, grid, stream); launch_phase<8>(p, grid, stream);
#endif
}
```

```cpp
#include <hip/hip_runtime.h>
#include <hip/hip_cooperative_groups.h>
#include <cstdio>
#include <cstdint>
namespace cg = cooperative_groups;

#ifndef ONE_LAUNCH
#define ONE_LAUNCH 1
#endif

#define LAS __attribute__((address_space(3)))
typedef unsigned short bf16_t;
typedef short bf16x8 __attribute__((ext_vector_type(8)));
typedef float f32x4 __attribute__((ext_vector_type(4)));
typedef float f32x2 __attribute__((ext_vector_type(2)));
typedef unsigned u32x4 __attribute__((ext_vector_type(4)));
typedef unsigned u32x2 __attribute__((ext_vector_type(2)));

constexpr int T = 8192, D = 2048, CW = 1024, SW = 1024, NIN = 9216, NE = 16, DE = 512;
constexpr float EPS = 1e-6f;
constexpr int NTHREADS = 512, NWAVES = 8;
constexpr int LDS_BYTES = 132 * 1024;
constexpr int HID_ROWS = 2 * T + NE * 256;

constexpr size_t MiB = 1024 * 1024;
constexpr size_t WS_CTL   = 0;
constexpr size_t WS_SMALL = 64 * 1024;
constexpr size_t SM_RSTD = 0, SM_ENT = 32 * 1024, SM_W = SM_ENT + (size_t)NE * T * 4, SM_END = SM_W + (size_t)NE * T * 4;
constexpr size_t WS_WR    = WS_SMALL + 2 * MiB;
constexpr size_t WS_WINT  = WS_WR + 256 * 1024;
constexpr size_t WS_WUPT  = WS_WINT + (size_t)NIN * D * 2;
constexpr size_t WS_WOUTT = WS_WUPT + (size_t)D * D * 2;
constexpr size_t WS_W1T   = WS_WOUTT + (size_t)D * D * 2;
constexpr size_t WS_W2T   = WS_W1T + (size_t)NE * 1024 * D * 2;
constexpr size_t WS_X     = WS_W2T + (size_t)NE * D * DE * 2;
constexpr size_t WS_P     = WS_X + (size_t)T * D * 2;
constexpr size_t P_BC = 0, P_P = P_BC + (size_t)T * CW * 2, P_U = P_P + (size_t)T * CW * 2, P_V = P_U + (size_t)T * SW * 2,
                 P_R = P_V + (size_t)T * SW * 2, P_S = P_R + (size_t)T * D * 2, P_END = P_S + (size_t)T * D * 2;
constexpr size_t WS_END   = WS_P + P_END;
constexpr size_t WS_MM  = WS_WINT;
constexpr size_t WS_H   = WS_P + P_BC;
constexpr size_t WS_A2  = WS_P + P_R;
constexpr size_t WS_HID = WS_P + P_S;
constexpr size_t WS_YK0 = WS_X;
constexpr size_t WS_YK1 = WS_WINT;
static_assert(SM_END <= 2 * MiB, "small region");
static_assert((size_t)HID_ROWS * DE * 2 <= (size_t)T * D * 2, "hid overlay");
static_assert((size_t)T * D * 4 <= P_R, "H overlay");

struct Params { const float* in[20]; float* out; unsigned char* ws; };

__device__ __forceinline__ unsigned cvt_pk_bf16(float lo, float hi) { unsigned r; asm("v_cvt_pk_bf16_f32 %0, %1, %2" : "=v"(r) : "v"(lo), "v"(hi)); return r; }
__device__ __forceinline__ float bf_lo(unsigned w) { return __uint_as_float(w << 16); }
__device__ __forceinline__ float bf_hi(unsigned w) { return __uint_as_float(w & 0xffff0000u); }
__device__ __forceinline__ float bf1(bf16_t b) { return __uint_as_float(((unsigned)b) << 16); }
__device__ __forceinline__ float wave_sum(float v) {
#pragma unroll
    for (int o = 1; o < 64; o <<= 1) v += __shfl_xor(v, o);
    return v;
}
__device__ __forceinline__ float fast_rcp(float x) { return __builtin_amdgcn_rcpf(x); }
__device__ __forceinline__ float fast_exp2(float x) { return __builtin_amdgcn_exp2f(x); }
__device__ __forceinline__ float sigmoid_f(float x) { return fast_rcp(1.0f + fast_exp2(-1.44269504f * x)); }
__device__ __forceinline__ float gelu_tanh(float x) {
    const float u = x + 0.044715f * x * x * x;
    return x * fast_rcp(1.0f + fast_exp2(-2.30220819f * u));
}
__host__ __device__ __forceinline__ int perm32(int rho) { const int n = rho >> 4, i = rho & 15; return 8 * (i >> 2) + 4 * n + (i & 3); }

struct Unit { int pm, pn, e, row0, nvalid; };
constexpr int NXCD = 8, WGM = 8;
struct DenseSched {
    const bf16_t* A; const bf16_t* Bt; int K; int nM, nN, nwg, G, c;
    __device__ __forceinline__ void init(const bf16_t* A_, const bf16_t* Bt_, int M, int N, int K_) { A = A_; Bt = Bt_; K = K_; nM = M / 256; nN = N / 256; nwg = nM * nN; G = gridDim.x; c = blockIdx.x; }
    __device__ __forceinline__ bool next(int i, Unit& u) const {
        const long L = (long)i * G + c; if (L >= nwg) return false;
        int wgid = (int)L; { const int q = nwg / NXCD, r = nwg % NXCD, xcd = wgid % NXCD, off = wgid / NXCD; wgid = (xcd < r ? xcd * (q + 1) : r * (q + 1) + (xcd - r) * q) + off; }
        const int nig = WGM * nN, gid = wgid / nig, fm = gid * WGM, gsz = (nM - fm) < WGM ? (nM - fm) : WGM;
        u.pm = fm + ((wgid % nig) % gsz); u.pn = (wgid % nig) / gsz; u.e = 0; u.row0 = u.pm * 256; u.nvalid = 256; return true;
    }
    __device__ __forceinline__ const char* a_base() const { return (const char*)A; }
    __device__ __forceinline__ unsigned a_off(const Unit& u, int r) const { return (unsigned)(u.row0 + r) * (unsigned)K * 2u; }
    __device__ __forceinline__ const char* b_base(const Unit& u) const { return (const char*)Bt + (size_t)u.pn * 256 * K * 2; }
};
template <bool GATHER, int NPN, int KK, int NROWS_E  >
struct MoeSched {
    const bf16_t* A; const bf16_t* Bt; const int* cnt; const int* ent; int G, c;
    __device__ __forceinline__ bool next(int i, Unit& u) const {
        int L = i * G + c; int hb = 0;
        for (int e = 0; e < NE; ++e) {
            const int n = __builtin_amdgcn_readfirstlane(cnt[e]); const int nt = (n + 255) >> 8;
            if (L < nt * NPN) { u.e = e; u.pm = L / NPN; u.pn = L % NPN; u.row0 = hb + u.pm * 256; u.nvalid = min(256, n - u.pm * 256); return true; }
            L -= nt * NPN; hb += nt * 256;
        }
        return false;
    }
    __device__ __forceinline__ const char* a_base() const { return (const char*)A; }
    __device__ __forceinline__ unsigned a_off(const Unit& u, int r) const {
        if (GATHER) { const int tok = (r < u.nvalid) ? (ent[u.e * T + u.pm * 256 + r] & 0xffff) : 0; return (unsigned)tok * (unsigned)KK * 2u; }
        return (unsigned)(u.row0 + r) * (unsigned)KK * 2u;
    }
    __device__ __forceinline__ const char* b_base(const Unit& u) const { return (const char*)Bt + ((size_t)u.e * NROWS_E + (size_t)u.pn * 256) * KK * 2; }
};

typedef f32x4 Acc[2][2][4][2];
__device__ __forceinline__ u32x4 pack8(f32x4 a, f32x4 b) { u32x4 w; w.x = cvt_pk_bf16(a[0], a[1]); w.y = cvt_pk_bf16(a[2], a[3]); w.z = cvt_pk_bf16(b[0], b[1]); w.w = cvt_pk_bf16(b[2], b[3]); return w; }
__device__ __forceinline__ void unpack8(u32x4 w, f32x4& a, f32x4& b) { a = (f32x4){bf_lo(w.x), bf_hi(w.x), bf_lo(w.y), bf_hi(w.y)}; b = (f32x4){bf_lo(w.z), bf_hi(w.z), bf_lo(w.w), bf_hi(w.w)}; }

struct EpiProj {
    static constexpr bool PERM = true; static constexpr int MIDK = 0;
    bf16_t *Bc, *P, *U, *V, *R, *S;
    __device__ __forceinline__ void mid(Acc&, const Unit&, int, int, int, int) const {}
    __device__ __forceinline__ void operator()(const Acc& acc, const Unit& u, int wr, int wc, int fr, int fq) const {
        const int pn = u.pn; const int rowb = u.row0 + wr * 64 + fr; const int cl = wc * 32 + 8 * fq;
#pragma unroll
        for (int ai = 0; ai < 2; ++ai)
#pragma unroll
            for (int m = 0; m < 4; ++m) {
                const size_t row = (size_t)(rowb + ai * 128 + m * 16);
                if (pn < 4) {
#pragma unroll
                    for (int bj = 0; bj < 2; ++bj) *(u32x4*)(Bc + row * CW + pn * 256 + bj * 128 + cl) = pack8(acc[ai][bj][m][0], acc[ai][bj][m][1]);
                } else if (pn < 12) {
                    *(u32x4*)(P + row * CW + (pn - 4) * 128 + cl) = pack8(acc[ai][0][m][0] * acc[ai][1][m][0], acc[ai][0][m][1] * acc[ai][1][m][1]);
                } else if (pn < 20) {
                    bf16_t* O = (pn < 16) ? (U + row * SW + (pn - 12) * 256) : (V + row * SW + (pn - 16) * 256);
#pragma unroll
                    for (int bj = 0; bj < 2; ++bj) { f32x4 a = acc[ai][bj][m][0], b = acc[ai][bj][m][1];
#pragma unroll
                        for (int j = 0; j < 4; ++j) { a[j] = gelu_tanh(a[j]); b[j] = gelu_tanh(b[j]); }
                        *(u32x4*)(O + bj * 128 + cl) = pack8(a, b); }
                } else {
                    f32x4 r0, r1, s0, s1;
#pragma unroll
                    for (int j = 0; j < 4; ++j) {
                        const float ec0 = fast_exp2(-1.44269504f * acc[ai][0][m][0][j]), es0 = fast_exp2(-1.44269504f * acc[ai][1][m][0][j]);
                        const float ec1 = fast_exp2(-1.44269504f * acc[ai][0][m][1][j]), es1 = fast_exp2(-1.44269504f * acc[ai][1][m][1][j]);
                        r0[j] = (1.0f + es0) * fast_rcp(1.0f + ec0); s0[j] = fast_rcp(1.0f + es0);
                        r1[j] = (1.0f + es1) * fast_rcp(1.0f + ec1); s1[j] = fast_rcp(1.0f + es1);
                    }
                    const size_t o = row * D + (pn - 20) * 128 + cl;
                    *(u32x4*)(R + o) = pack8(r0, r1); *(u32x4*)(S + o) = pack8(s0, s1);
                }
            }
    }
};
struct EpiUp {
    static constexpr bool PERM = true; static constexpr int MIDK = 1024;
    const bf16_t *R, *S; bf16_t* Mm;
    __device__ __forceinline__ void mid(Acc& acc, const Unit& u, int wr, int wc, int fr, int fq) const {
        const int rowb = u.row0 + wr * 64 + fr; const int cb = u.pn * 256 + wc * 32 + 8 * fq;
#pragma unroll
        for (int ai = 0; ai < 2; ++ai)
#pragma unroll
            for (int m = 0; m < 4; ++m)
#pragma unroll
                for (int bj = 0; bj < 2; ++bj) { f32x4 a, b; unpack8(*(const u32x4*)(R + (size_t)(rowb + ai * 128 + m * 16) * D + cb + bj * 128), a, b);
                    acc[ai][bj][m][0] *= a; acc[ai][bj][m][1] *= b; }
    }
    __device__ __forceinline__ void operator()(const Acc& acc, const Unit& u, int wr, int wc, int fr, int fq) const {
        const int rowb = u.row0 + wr * 64 + fr; const int cb = u.pn * 256 + wc * 32 + 8 * fq;
#pragma unroll
        for (int ai = 0; ai < 2; ++ai)
#pragma unroll
            for (int m = 0; m < 4; ++m)
#pragma unroll
                for (int bj = 0; bj < 2; ++bj) { const size_t o = (size_t)(rowb + ai * 128 + m * 16) * D + cb + bj * 128; f32x4 a, b; unpack8(*(const u32x4*)(S + o), a, b);
                    *(u32x4*)(Mm + o) = pack8(acc[ai][bj][m][0] * a, acc[ai][bj][m][1] * b); }
    }
};
struct EpiOut {
    static constexpr bool PERM = false; static constexpr int MIDK = 0;
    const float* x; const float* g; float* H; bf16_t* A2;
    __device__ __forceinline__ void mid(Acc&, const Unit&, int, int, int, int) const {}
    __device__ __forceinline__ void operator()(const Acc& acc, const Unit& u, int wr, int wc, int fr, int fq) const {
        const int rowb = u.row0 + wr * 64 + fr; const int cb = u.pn * 256 + wc * 32 + 4 * fq;
#pragma unroll
        for (int ai = 0; ai < 2; ++ai)
#pragma unroll
            for (int m = 0; m < 4; ++m)
#pragma unroll
                for (int bj = 0; bj < 2; ++bj)
#pragma unroll
                    for (int n = 0; n < 2; ++n) { const int col = cb + bj * 128 + n * 16; const size_t o = (size_t)(rowb + ai * 128 + m * 16) * D + col;
                        const f32x4 h = *(const f32x4*)(x + o) + acc[ai][bj][m][n]; *(f32x4*)(H + o) = h; const f32x4 gg = *(const f32x4*)(g + col);
                        u32x2 w; w.x = cvt_pk_bf16(h[0] * gg[0], h[1] * gg[1]); w.y = cvt_pk_bf16(h[2] * gg[2], h[3] * gg[3]); *(u32x2*)(A2 + o) = w; }
    }
};
struct EpiMoe1 {
    static constexpr bool PERM = true; static constexpr int MIDK = 0;
    const int* ent; const float* lw; const float* rstd; bf16_t* Hid;
    __device__ __forceinline__ void mid(Acc&, const Unit&, int, int, int, int) const {}
    __device__ __forceinline__ void operator()(const Acc& acc, const Unit& u, int wr, int wc, int fr, int fq) const {
        const int cl = u.pn * 128 + wc * 32 + 8 * fq;
#pragma unroll
        for (int ai = 0; ai < 2; ++ai)
#pragma unroll
            for (int m = 0; m < 4; ++m) {
                const int r = ai * 128 + wr * 64 + m * 16 + fr;
                if (r < u.nvalid) {
                    const int li = u.e * T + u.pm * 256 + r; const int tok = ent[li] & 0xffff; const float rs = rstd[tok], w = lw[li];
                    f32x4 o[2];
#pragma unroll
                    for (int n = 0; n < 2; ++n)
#pragma unroll
                        for (int j = 0; j < 4; ++j) { const float gt = acc[ai][0][m][n][j] * rs, up = acc[ai][1][m][n][j] * rs; o[n][j] = gt * sigmoid_f(gt) * up * w; }
                    *(u32x4*)(Hid + (size_t)(u.row0 + r) * DE + cl) = pack8(o[0], o[1]);
                }
            }
    }
};
struct EpiMoe2 {
    static constexpr bool PERM = true; static constexpr int MIDK = 0;
    const int* ent; bf16_t* Yk0; bf16_t* Yk1;
    __device__ __forceinline__ void mid(Acc&, const Unit&, int, int, int, int) const {}
    __device__ __forceinline__ void operator()(const Acc& acc, const Unit& u, int wr, int wc, int fr, int fq) const {
        const int cb = u.pn * 256 + wc * 32 + 8 * fq;
#pragma unroll
        for (int ai = 0; ai < 2; ++ai)
#pragma unroll
            for (int m = 0; m < 4; ++m) {
                const int r = ai * 128 + wr * 64 + m * 16 + fr;
                if (r < u.nvalid) {
                    const int en = ent[u.e * T + u.pm * 256 + r]; const int tok = en & 0xffff; bf16_t* Y = (en >> 16) ? Yk1 : Yk0;
#pragma unroll
                    for (int bj = 0; bj < 2; ++bj) *(u32x4*)(Y + (size_t)tok * D + cb + bj * 128) = pack8(acc[ai][bj][m][0], acc[ai][bj][m][1]);
                }
            }
    }
};

template <class Epi, class Sched>
__device__ __forceinline__ void gemm_simple(const Sched& S, const Epi& E, const int K) {
    const int tid = threadIdx.x, wid = __builtin_amdgcn_readfirstlane(tid >> 6), lane = tid & 63, wr = wid >> 2, wc = wid & 3, fr = lane & 15, fq = lane >> 4;
    Unit u;
    for (int ui = 0; S.next(ui, u); ++ui) {
        Acc acc;
#pragma unroll
        for (int a = 0; a < 2; ++a)
#pragma unroll
            for (int b = 0; b < 2; ++b)
#pragma unroll
                for (int m = 0; m < 4; ++m)
#pragma unroll
                    for (int n = 0; n < 2; ++n) acc[a][b][m][n] = (f32x4){0.f, 0.f, 0.f, 0.f};
        const char* ab = S.a_base(); const char* bb = S.b_base(u);
        unsigned aoff[2][4], boff[2][2];
#pragma unroll
        for (int ai = 0; ai < 2; ++ai)
#pragma unroll
            for (int m = 0; m < 4; ++m) aoff[ai][m] = S.a_off(u, ai * 128 + wr * 64 + m * 16 + fr) + fq * 16;
#pragma unroll
        for (int bj = 0; bj < 2; ++bj)
#pragma unroll
            for (int n = 0; n < 2; ++n) { const int rr = Epi::PERM ? perm32(n * 16 + fr) : (n * 16 + fr); boff[bj][n] = (unsigned)(bj * 128 + wc * 32 + rr) * (unsigned)K * 2u + fq * 16; }
        for (int k0 = 0; k0 < K; k0 += 32) {
            if (Epi::MIDK != 0 && k0 == Epi::MIDK) E.mid(acc, u, wr, wc, fr, fq);
            bf16x8 a[2][4], b[2][2];
#pragma unroll
            for (int ai = 0; ai < 2; ++ai)
#pragma unroll
                for (int m = 0; m < 4; ++m) a[ai][m] = *(const bf16x8*)(ab + aoff[ai][m] + k0 * 2);
#pragma unroll
            for (int bj = 0; bj < 2; ++bj)
#pragma unroll
                for (int n = 0; n < 2; ++n) b[bj][n] = *(const bf16x8*)(bb + boff[bj][n] + k0 * 2);
#pragma unroll
            for (int ai = 0; ai < 2; ++ai)
#pragma unroll
                for (int bj = 0; bj < 2; ++bj)
#pragma unroll
                    for (int m = 0; m < 4; ++m)
#pragma unroll
                        for (int n = 0; n < 2; ++n) acc[ai][bj][m][n] = __builtin_amdgcn_mfma_f32_16x16x32_bf16(b[bj][n], a[ai][m], acc[ai][bj][m][n], 0, 0, 0);
        }
        E(acc, u, wr, wc, fr, fq);
    }
}

__device__ __forceinline__ void tr_item(const float* W, int N, int k0, int ns, bf16_t* WT, int ldk, int nd, int kd, LAS float* scr, int lane) {
#pragma unroll 8
    for (int i = 0; i < 32; ++i) { const int kk = 2 * i + (lane >> 5); scr[kk * 33 + (lane & 31)] = W[(size_t)(k0 + kk) * N + ns + (lane & 31)]; }
    asm volatile("s_waitcnt lgkmcnt(0)" ::: "memory");
    const int c = lane & 7;
#pragma unroll
    for (int j = 0; j < 4; ++j) { const int n = (lane >> 3) + 8 * j; const LAS float* s = scr + (8 * c) * 33 + n;
        u32x4 o; o.x = cvt_pk_bf16(s[0 * 33], s[1 * 33]); o.y = cvt_pk_bf16(s[2 * 33], s[3 * 33]); o.z = cvt_pk_bf16(s[4 * 33], s[5 * 33]); o.w = cvt_pk_bf16(s[6 * 33], s[7 * 33]);
        *(u32x4*)(WT + (size_t)(nd + n) * ldk + kd + 8 * c) = o; }
    asm volatile("s_waitcnt lgkmcnt(0)" ::: "memory");
}
__device__ __forceinline__ int win_src_col(int nd) {
    if (nd < 1024) return nd;
    if (nd < 3072) { const int q = (nd - 1024) >> 8, r = (nd - 1024) & 255; return r < 128 ? (1024 + 128 * q + r) : (2048 + 128 * q + r - 128); }
    if (nd < 5120) return nd;
    { const int q = (nd - 5120) >> 8, r = (nd - 5120) & 255; return r < 128 ? (5120 + 128 * q + r) : (7168 + 128 * q + r - 128); }
}
__device__ __forceinline__ void phase0(const Params& p, LAS unsigned char* lds) {
    const int tid = threadIdx.x, wave = __builtin_amdgcn_readfirstlane(tid >> 6), lane = tid & 63;
    LAS float* scr = (LAS float*)(lds + wave * 8704);
    const int gw = blockIdx.x * NWAVES + wave, NGW = gridDim.x * NWAVES;
    unsigned char* ws = p.ws;
    constexpr int I_IN = 32 * 288, I_UP = 16 * 64, I_OUT = 32 * 64, I_G = 32 * 16 * NE, I_D = 8 * 64 * NE;
    constexpr int NITEMS = I_IN + 2 * I_UP + I_OUT + 2 * I_G + I_D;
    for (int it = gw; it < NITEMS; it += NGW) {
        int r = it;
        if (r < I_IN) { const int kb = r / 288, nb = r % 288; tr_item(p.in[2], NIN, kb * 64, win_src_col(nb * 32), (bf16_t*)(ws + WS_WINT), D, nb * 32, kb * 64, scr, lane); continue; } r -= I_IN;
        if (r < I_UP) { const int kb = r / 64, nb = r % 64; tr_item(p.in[8], D, kb * 64, nb * 32, (bf16_t*)(ws + WS_WUPT), 2048, nb * 32, kb * 64, scr, lane); continue; } r -= I_UP;
        if (r < I_UP) { const int kb = r / 64, nb = r % 64; tr_item(p.in[9], D, kb * 64, nb * 32, (bf16_t*)(ws + WS_WUPT), 2048, nb * 32, 1024 + kb * 64, scr, lane); continue; } r -= I_UP;
        if (r < I_OUT) { const int kb = r / 64, nb = r % 64; tr_item(p.in[10], D, kb * 64, nb * 32, (bf16_t*)(ws + WS_WOUTT), D, nb * 32, kb * 64, scr, lane); continue; } r -= I_OUT;
        if (r < 2 * I_G) { const int up = r >= I_G; if (up) r -= I_G; const int e = r / 512, q = r % 512, kb = q / 16, nb = q % 16;
            const int nd = 256 * (nb >> 2) + (nb & 3) * 32 + (up ? 128 : 0);
            tr_item(p.in[up ? 17 : 16] + (size_t)e * D * DE, DE, kb * 64, nb * 32, (bf16_t*)(ws + WS_W1T) + (size_t)e * 1024 * D, D, nd, kb * 64, scr, lane); continue; } r -= 2 * I_G;
        { const int e = r / 512, q = r % 512, kb = q / 64, nb = q % 64;
            tr_item(p.in[18] + (size_t)e * DE * D, D, kb * 64, nb * 32, (bf16_t*)(ws + WS_W2T) + (size_t)e * D * DE, DE, nb * 32, kb * 64, scr, lane); }
    }
    const float* x = p.in[0]; const float* g = p.in[1]; bf16_t* xn = (bf16_t*)(ws + WS_X);
    for (int m = gw; m < T; m += NGW) {
        const f32x4* xr = (const f32x4*)(x + (size_t)m * D) + lane; f32x4 v[8]; float s = 0.f;
#pragma unroll
        for (int j = 0; j < 8; ++j) { v[j] = xr[64 * j]; s += (v[j][0] * v[j][0] + v[j][1] * v[j][1]) + (v[j][2] * v[j][2] + v[j][3] * v[j][3]); }
        const float rs = 1.0f / sqrtf(wave_sum(s) * (1.0f / D) + EPS);
        u32x2* o = (u32x2*)(xn + (size_t)m * D) + lane;
#pragma unroll
        for (int j = 0; j < 8; ++j) { const f32x4 gg = *((const f32x4*)g + lane + 64 * j); u32x2 w; w.x = cvt_pk_bf16(v[j][0] * rs * gg[0], v[j][1] * rs * gg[1]); w.y = cvt_pk_bf16(v[j][2] * rs * gg[2], v[j][3] * rs * gg[3]); o[64 * j] = w; }
    }
    float* wr = (float*)(ws + WS_WR); const float* gf = p.in[11];
    for (int i = blockIdx.x * NTHREADS + tid; i < 20 * D; i += gridDim.x * NTHREADS) { const int j = i / D, d = i % D; wr[i] = gf[d] * (j < 4 ? p.in[12][d * 4 + j] : p.in[14][d * 16 + (j - 4)]); }
    if (blockIdx.x == 0 && tid < 64) ((int*)(ws + WS_CTL))[tid] = 0;
}

__device__ __forceinline__ void phase2_conv(const Params& p) {
    const bf16_t* Bc = (const bf16_t*)(p.ws + WS_P + P_BC); const bf16_t* P = (const bf16_t*)(p.ws + WS_P + P_P); bf16_t* Y = (bf16_t*)(p.ws + WS_X);
    const float* cw = p.in[3];
    for (int i = blockIdx.x * NTHREADS + threadIdx.x; i < T * (CW / 8); i += gridDim.x * NTHREADS) {
        const int t = i >> 7, c = (i & 127) * 8;
        f32x4 p0a, p0b, p1a, p1b, p2a, p2b, ba, bb;
        unpack8(*(const u32x4*)(P + (size_t)t * CW + c), p2a, p2b); unpack8(*(const u32x4*)(Bc + (size_t)t * CW + c), ba, bb);
        if (t >= 1) unpack8(*(const u32x4*)(P + (size_t)(t - 1) * CW + c), p1a, p1b); else { p1a = (f32x4){0, 0, 0, 0}; p1b = p1a; }
        if (t >= 2) unpack8(*(const u32x4*)(P + (size_t)(t - 2) * CW + c), p0a, p0b); else { p0a = (f32x4){0, 0, 0, 0}; p0b = p0a; }
        const f32x4 w0a = *(const f32x4*)(cw + c), w0b = *(const f32x4*)(cw + c + 4), w1a = *(const f32x4*)(cw + CW + c), w1b = *(const f32x4*)(cw + CW + c + 4),
                    w2a = *(const f32x4*)(cw + 2 * CW + c), w2b = *(const f32x4*)(cw + 2 * CW + c + 4);
        const f32x4 ya = ba * (w0a * p0a + w1a * p1a + w2a * p2a), yb = bb * (w0b * p0b + w1b * p1b + w2b * p2b);
        *(u32x4*)(Y + (size_t)t * 2048 + c) = pack8(ya, yb);
    }
}
__device__ __forceinline__ void phase2_sgu(const Params& p, LAS unsigned char* lds) {
    const int tid = threadIdx.x, wave = __builtin_amdgcn_readfirstlane(tid >> 6), lane = tid & 63;
    const bf16_t* U = (const bf16_t*)(p.ws + WS_P + P_U); const bf16_t* V = (const bf16_t*)(p.ws + WS_P + P_V); bf16_t* Y = (bf16_t*)(p.ws + WS_X);
    const float* lng = p.in[4]; const float* lnb = p.in[5]; const float* Ws = p.in[6]; const float* bs = p.in[7];
    LAS f32x2* st = (LAS f32x2*)lds;
    LAS float* vn = (LAS float*)(lds + 1024);
    for (int unit = blockIdx.x; unit < 64 * 8; unit += gridDim.x) {
        const int nb = unit >> 3, h = unit & 7, t0 = nb * 128, c0 = h * 128;
        __syncthreads();
        for (int jj = 0; jj < 16; ++jj) { const int j = wave * 16 + jj; const u32x4* vr = (const u32x4*)(V + (size_t)(t0 + j) * SW) + lane * 2;
            f32x4 a, b, c, d; unpack8(vr[0], a, b); unpack8(vr[1], c, d);
            float s = (a[0] + a[1] + a[2] + a[3]) + (b[0] + b[1] + b[2] + b[3]) + (c[0] + c[1] + c[2] + c[3]) + (d[0] + d[1] + d[2] + d[3]);
            const float mu = wave_sum(s) * (1.0f / SW);
            a -= mu; b -= mu; c -= mu; d -= mu;
            float q = (a[0] * a[0] + a[1] * a[1] + a[2] * a[2] + a[3] * a[3]) + (b[0] * b[0] + b[1] * b[1] + b[2] * b[2] + b[3] * b[3]) + (c[0] * c[0] + c[1] * c[1] + c[2] * c[2] + c[3] * c[3]) + (d[0] * d[0] + d[1] * d[1] + d[2] * d[2] + d[3] * d[3]);
            const float rs = 1.0f / sqrtf(wave_sum(q) * (1.0f / SW) + EPS);
            if (lane == 0) st[j] = (f32x2){mu, rs}; }
        __syncthreads();
        for (int q = tid; q < 128 * 16; q += NTHREADS) { const int j = q >> 4, c = (q & 15) * 8; const f32x2 s = st[j];
            f32x4 a, b; unpack8(*(const u32x4*)(V + (size_t)(t0 + j) * SW + c0 + c), a, b);
            const f32x4 g0 = *(const f32x4*)(lng + c0 + c), g1 = *(const f32x4*)(lng + c0 + c + 4), b0 = *(const f32x4*)(lnb + c0 + c), b1 = *(const f32x4*)(lnb + c0 + c + 4);
            a = (a - s.x) * s.y * g0 + b0; b = (b - s.x) * s.y * g1 + b1;
            *(LAS f32x4*)(vn + j * 128 + c) = a; *(LAS f32x4*)(vn + j * 128 + c + 4) = b; }
        __syncthreads();
        for (int ii = 0; ii < 16; ++ii) { const int i = wave * 16 + ii; const int jmax = (i < 64) ? 64 : 128; const float* wrow = Ws + ((size_t)h * 128 + i) * 128;
            float a0 = 0.f, a1 = 0.f;
            for (int j = 0; j < jmax; ++j) { const float w = wrow[j]; a0 += w * vn[j * 128 + lane]; a1 += w * vn[j * 128 + lane + 64]; }
            const float bb = bs[h * 128 + i]; const size_t t = (size_t)(t0 + i);
            const float u0 = bf1(U[t * SW + c0 + lane]), u1 = bf1(U[t * SW + c0 + lane + 64]);
            Y[t * 2048 + 1024 + c0 + lane] = (bf16_t)(cvt_pk_bf16(u0 * (a0 + bb), 0.f) & 0xffff); Y[t * 2048 + 1024 + c0 + lane + 64] = (bf16_t)(cvt_pk_bf16(u1 * (a1 + bb), 0.f) & 0xffff); }
    }
}

__device__ __forceinline__ void phase5_router(const Params& p, LAS unsigned char* lds) {
    const int tid = threadIdx.x, wave = __builtin_amdgcn_readfirstlane(tid >> 6), lane = tid & 63;
    const float* H = (const float*)(p.ws + WS_H); const float* wr = (const float*)(p.ws + WS_WR);
    float* rstd = (float*)(p.ws + WS_SMALL + SM_RSTD); int* ent = (int*)(p.ws + WS_SMALL + SM_ENT); float* lw = (float*)(p.ws + WS_SMALL + SM_W); int* cnt = (int*)(p.ws + WS_CTL);
    const float* brg = p.in[13]; const float* bre = p.in[15];
    LAS int* lcnt = (LAS int*)lds;
    LAS int* lbase = (LAS int*)(lds + 64);
    LAS int* le = (LAS int*)(lds + 128);
    LAS int* lp = (LAS int*)(lds + 128 + 256);
    LAS float* lwt = (LAS float*)(lds + 128 + 512);
    const int ngroups = T / 4, nrounds = (ngroups + gridDim.x * NWAVES - 1) / (gridDim.x * NWAVES);
    for (int rd = 0; rd < nrounds; ++rd) {
        const int grp = (rd * gridDim.x + blockIdx.x) * NWAVES + wave; const bool valid = grp < ngroups;
        if (tid < 16) lcnt[tid] = 0;
        __syncthreads();
        if (valid) {
            const int t0 = grp * 4;
            float acc[4][20]; float ss[4];
#pragma unroll
            for (int t = 0; t < 4; ++t) { ss[t] = 0.f;
#pragma unroll
                for (int j = 0; j < 20; ++j) acc[t][j] = 0.f; }
            for (int kc = 0; kc < 8; ++kc) {
                const int k = kc * 256 + lane * 4; f32x4 hv[4];
#pragma unroll
                for (int t = 0; t < 4; ++t) { hv[t] = *(const f32x4*)(H + (size_t)(t0 + t) * D + k); ss[t] += (hv[t][0] * hv[t][0] + hv[t][1] * hv[t][1]) + (hv[t][2] * hv[t][2] + hv[t][3] * hv[t][3]); }
#pragma unroll
                for (int j = 0; j < 20; ++j) { const f32x4 w = *(const f32x4*)(wr + (size_t)j * D + k);
#pragma unroll
                    for (int t = 0; t < 4; ++t) acc[t][j] += (hv[t][0] * w[0] + hv[t][1] * w[1]) + (hv[t][2] * w[2] + hv[t][3] * w[3]); }
            }
#pragma unroll
            for (int t = 0; t < 4; ++t) { ss[t] = wave_sum(ss[t]);
#pragma unroll
                for (int j = 0; j < 20; ++j) acc[t][j] = wave_sum(acc[t][j]); }
#pragma unroll
            for (int t = 0; t < 4; ++t) {
                const float rs = 1.0f / sqrtf(ss[t] * (1.0f / D) + EPS);
                float lg[4];
#pragma unroll
                for (int j = 0; j < 4; ++j) lg[j] = acc[t][j] * rs + brg[j];
                int gi = 0; float gm = lg[0];
#pragma unroll
                for (int j = 1; j < 4; ++j) if (lg[j] > gm) { gm = lg[j]; gi = j; }
                float den = 0.f;
#pragma unroll
                for (int j = 0; j < 4; ++j) den += __expf(lg[j] - gm);
                const float pg = 1.0f / den;
                float le4[4];
#pragma unroll
                for (int j = 0; j < 4; ++j) { const float v0 = acc[t][4 + j], v1 = acc[t][8 + j], v2 = acc[t][12 + j], v3 = acc[t][16 + j];
                    const float v = gi == 0 ? v0 : (gi == 1 ? v1 : (gi == 2 ? v2 : v3)); le4[j] = v * rs + bre[gi * 4 + j]; }
                int i1 = 0; float m1 = le4[0];
#pragma unroll
                for (int j = 1; j < 4; ++j) if (le4[j] > m1) { m1 = le4[j]; i1 = j; }
                int i2 = -1; float m2 = -3.0e38f;
#pragma unroll
                for (int j = 0; j < 4; ++j) if (j != i1 && le4[j] > m2) { m2 = le4[j]; i2 = j; }
                const float ex = __expf(m2 - m1); const float w1 = pg / (1.0f + ex), w2 = pg * ex / (1.0f + ex);
                if (lane == 0) {
                    rstd[t0 + t] = rs;
                    const int e1 = gi * 4 + i1, e2 = gi * 4 + i2; const int s = (wave * 4 + t) * 2;
                    le[s] = e1; le[s + 1] = e2; lwt[s] = w1; lwt[s + 1] = w2;
                    lp[s] = atomicAdd((int*)&lcnt[e1], 1); lp[s + 1] = atomicAdd((int*)&lcnt[e2], 1);
                }
            }
        }
        __syncthreads();
        if (tid < 16) { const int n = lcnt[tid]; lbase[tid] = n ? atomicAdd(&cnt[tid], n) : 0; }
        __syncthreads();
        if (valid && lane < 8) { const int s = wave * 8 + lane; const int e = le[s]; const int pos = lbase[e] + lp[s]; const int tok = grp * 4 + (lane >> 1);
            ent[e * T + pos] = tok | ((lane & 1) << 16); lw[e * T + pos] = lwt[s]; }
        __syncthreads();
    }
}

__device__ __forceinline__ void phase8_final(const Params& p) {
    const int tid = threadIdx.x, wave = __builtin_amdgcn_readfirstlane(tid >> 6), lane = tid & 63;
    const float* H = (const float*)(p.ws + WS_H); const bf16_t* Y0 = (const bf16_t*)(p.ws + WS_YK0); const bf16_t* Y1 = (const bf16_t*)(p.ws + WS_YK1); const float* g = p.in[19];
    const int gw = blockIdx.x * NWAVES + wave, NGW = gridDim.x * NWAVES;
    for (int m = gw; m < T; m += NGW) {
        f32x4 v[8]; float s = 0.f;
#pragma unroll
        for (int j = 0; j < 8; ++j) { const size_t o = (size_t)m * D + 4 * lane + 256 * j; v[j] = *(const f32x4*)(H + o);
            const u32x2 a = *(const u32x2*)(Y0 + o), b = *(const u32x2*)(Y1 + o);
            v[j][0] += bf_lo(a.x) + bf_lo(b.x); v[j][1] += bf_hi(a.x) + bf_hi(b.x); v[j][2] += bf_lo(a.y) + bf_lo(b.y); v[j][3] += bf_hi(a.y) + bf_hi(b.y);
            s += (v[j][0] * v[j][0] + v[j][1] * v[j][1]) + (v[j][2] * v[j][2] + v[j][3] * v[j][3]); }
        const float rs = 1.0f / sqrtf(wave_sum(s) * (1.0f / D) + EPS);
#pragma unroll
        for (int j = 0; j < 8; ++j) { const int c = 4 * lane + 256 * j; const f32x4 gg = *(const f32x4*)(g + c); *(f32x4*)(p.out + (size_t)m * D + c) = v[j] * rs * gg; }
    }
}

template <int PH> __device__ __forceinline__ void run_phase(const Params& p, LAS unsigned char* lds) {
    unsigned char* ws = p.ws;
    if constexpr (PH == 0) phase0(p, lds);
    if constexpr (PH == 1) { DenseSched S; S.init((const bf16_t*)(ws + WS_X), (const bf16_t*)(ws + WS_WINT), T, NIN, D);
        EpiProj E{(bf16_t*)(ws + WS_P + P_BC), (bf16_t*)(ws + WS_P + P_P), (bf16_t*)(ws + WS_P + P_U), (bf16_t*)(ws + WS_P + P_V), (bf16_t*)(ws + WS_P + P_R), (bf16_t*)(ws + WS_P + P_S)};
        gemm_simple(S, E, D); }
    if constexpr (PH == 2) { phase2_conv(p); phase2_sgu(p, lds); }
    if constexpr (PH == 3) { DenseSched S; S.init((const bf16_t*)(ws + WS_X), (const bf16_t*)(ws + WS_WUPT), T, D, 2048);
        EpiUp E{(const bf16_t*)(ws + WS_P + P_R), (const bf16_t*)(ws + WS_P + P_S), (bf16_t*)(ws + WS_MM)}; gemm_simple(S, E, 2048); }
    if constexpr (PH == 4) { DenseSched S; S.init((const bf16_t*)(ws + WS_MM), (const bf16_t*)(ws + WS_WOUTT), T, D, D);
        EpiOut E{p.in[0], p.in[11], (float*)(ws + WS_H), (bf16_t*)(ws + WS_A2)}; gemm_simple(S, E, D); }
    if constexpr (PH == 5) phase5_router(p, lds);
    if constexpr (PH == 6) { MoeSched<true, 4, D, 1024> S{(const bf16_t*)(ws + WS_A2), (const bf16_t*)(ws + WS_W1T), (const int*)(ws + WS_CTL), (const int*)(ws + WS_SMALL + SM_ENT), (int)gridDim.x, (int)blockIdx.x};
        EpiMoe1 E{(const int*)(ws + WS_SMALL + SM_ENT), (const float*)(ws + WS_SMALL + SM_W), (const float*)(ws + WS_SMALL + SM_RSTD), (bf16_t*)(ws + WS_HID)}; gemm_simple(S, E, D); }
    if constexpr (PH == 7) { MoeSched<false, 8, DE, D> S{(const bf16_t*)(ws + WS_HID), (const bf16_t*)(ws + WS_W2T), (const int*)(ws + WS_CTL), (const int*)(ws + WS_SMALL + SM_ENT), (int)gridDim.x, (int)blockIdx.x};
        EpiMoe2 E{(const int*)(ws + WS_SMALL + SM_ENT), (bf16_t*)(ws + WS_YK0), (bf16_t*)(ws + WS_YK1)}; gemm_simple(S, E, DE); }
    if constexpr (PH == 8) phase8_final(p);
}

template <int PH> __global__ void __launch_bounds__(NTHREADS, 2) k_phase(Params p) {
    extern __shared__ __attribute__((aligned(16))) unsigned char lds_raw[];
    run_phase<PH>(p, (LAS unsigned char*)lds_raw);
}

__global__ void __launch_bounds__(NTHREADS, 2) k_mega(Params p) {
    extern __shared__ __attribute__((aligned(16))) unsigned char lds_raw[];
    LAS unsigned char* lds = (LAS unsigned char*)lds_raw;
    cg::grid_group grid = cg::this_grid();
    run_phase<0>(p, lds); grid.sync();
    run_phase<1>(p, lds); grid.sync();
    run_phase<2>(p, lds); grid.sync();
    run_phase<3>(p, lds); grid.sync();
    run_phase<4>(p, lds); grid.sync();
    run_phase<5>(p, lds); grid.sync();
    run_phase<6>(p, lds); grid.sync();
    run_phase<7>(p, lds); grid.sync();
    run_phase<8>(p, lds);
}

template <int PH> static void launch_phase(const Params& p, int grid, hipStream_t stream) {
    static bool attr = false;
    if (!attr) { (void)hipFuncSetAttribute((const void*)k_phase<PH>, hipFuncAttributeMaxDynamicSharedMemorySize, LDS_BYTES); attr = true; }
    hipLaunchKernelGGL(k_phase<PH>, dim3(grid), dim3(NTHREADS), LDS_BYTES, stream, p);
}

extern "C" void kernel_launch(void* const* d_in, const int* in_sizes, int n_in, void* d_out, int out_size, void* d_ws, size_t ws_size, hipStream_t stream) {
    static int grid = 0;
    if (grid == 0) {
        if (n_in != 20 || out_size != T * D || ws_size < WS_END) { fprintf(stderr, "kernel_launch: unexpected shapes n_in %d out %d ws %zu (need %zu)\n", n_in, out_size, ws_size, (size_t)WS_END); grid = -1; return; }
        int dev = 0, cus = 0, per_cu = 0;
        (void)hipGetDevice(&dev); (void)hipDeviceGetAttribute(&cus, hipDeviceAttributeMultiprocessorCount, dev);
        (void)hipFuncSetAttribute((const void*)k_mega, hipFuncAttributeMaxDynamicSharedMemorySize, LDS_BYTES);
        (void)hipOccupancyMaxActiveBlocksPerMultiprocessor(&per_cu, (const void*)k_mega, NTHREADS, LDS_BYTES);
        if (per_cu < 1) { fprintf(stderr, "kernel_launch: occupancy query says %d blocks per CU\n", per_cu); per_cu = 1; }
        grid = cus * 1;
        (void)hipGetLastError();
    }
    if (grid < 0) return;
    Params p{};
    for (int i = 0; i < 20; ++i) p.in[i] = (const float*)d_in[i];
    p.out = (float*)d_out; p.ws = (unsigned char*)d_ws;
#if ONE_LAUNCH
    void* args[] = {&p};
    hipError_t e = hipLaunchCooperativeKernel((const void*)k_mega, dim3(grid), dim3(NTHREADS), args, LDS_BYTES, stream);
    if (e != hipSuccess) fprintf(stderr, "cooperative launch failed: %s (grid %d)\n", hipGetErrorString(e), grid);
#else
    launch_phase<0>(p, grid, stream); launch_phase<1>(p, grid, stream); launch_phase<2>(p, grid, stream); launch_phase<3>(p, grid, stream); launch_phase<4>(p, grid, stream);
    launch_phase<5>(p, grid, stream); launch_phase<6>(p, grid, stream); launch_phase<7>(p, grid, stream); launch_phase<8>(p, grid, stream);
#endif
}
```

```cpp
#include <hip/hip_runtime.h>
#include <hip/hip_cooperative_groups.h>
#include <cstdio>
#include <cstdint>
namespace cg = cooperative_groups;

#ifndef ONE_LAUNCH
#define ONE_LAUNCH 1
#endif

#define LAS __attribute__((address_space(3)))
typedef unsigned short bf16_t;
typedef short bf16x8 __attribute__((ext_vector_type(8)));
typedef float f32x4 __attribute__((ext_vector_type(4)));
typedef float f32x2 __attribute__((ext_vector_type(2)));
typedef unsigned u32x4 __attribute__((ext_vector_type(4)));
typedef unsigned u32x2 __attribute__((ext_vector_type(2)));

constexpr int T = 8192, D = 2048, CW = 1024, SW = 1024, NIN = 9216, NE = 16, DE = 512;
constexpr float EPS = 1e-6f;
constexpr int NTHREADS = 512, NWAVES = 8;
constexpr int LDS_BYTES = 132 * 1024;
constexpr int HID_ROWS = 2 * T + NE * 256;

constexpr size_t MiB = 1024 * 1024;
constexpr size_t WS_CTL   = 0;
constexpr size_t WS_SMALL = 64 * 1024;
constexpr size_t SM_RSTD = 0, SM_ENT = 32 * 1024, SM_W = SM_ENT + (size_t)NE * T * 4, SM_END = SM_W + (size_t)NE * T * 4;
constexpr size_t WS_WR    = WS_SMALL + 2 * MiB;
constexpr size_t WS_WINT  = WS_WR + 256 * 1024;
constexpr size_t WS_WUPT  = WS_WINT + (size_t)NIN * D * 2;
constexpr size_t WS_WOUTT = WS_WUPT + (size_t)D * D * 2;
constexpr size_t WS_W1T   = WS_WOUTT + (size_t)D * D * 2;
constexpr size_t WS_W2T   = WS_W1T + (size_t)NE * 1024 * D * 2;
constexpr size_t WS_X     = WS_W2T + (size_t)NE * D * DE * 2;
constexpr size_t WS_P     = WS_X + (size_t)T * D * 2;
constexpr size_t P_BC = 0, P_P = P_BC + (size_t)T * CW * 2, P_U = P_P + (size_t)T * CW * 2, P_V = P_U + (size_t)T * SW * 2,
                 P_R = P_V + (size_t)T * SW * 2, P_S = P_R + (size_t)T * D * 2, P_END = P_S + (size_t)T * D * 2;
constexpr size_t WS_END   = WS_P + P_END;
constexpr size_t WS_MM  = WS_WINT;
constexpr size_t WS_H   = WS_P + P_BC;
constexpr size_t WS_A2  = WS_P + P_R;
constexpr size_t WS_HID = WS_P + P_S;
constexpr size_t WS_YK0 = WS_X;
constexpr size_t WS_YK1 = WS_WINT;
static_assert(SM_END <= 2 * MiB, "small region");
static_assert((size_t)HID_ROWS * DE * 2 <= (size_t)T * D * 2, "hid overlay");
static_assert((size_t)T * D * 4 <= P_R, "H overlay");

struct Params { const float* in[20]; float* out; unsigned char* ws; };

__device__ __forceinline__ unsigned cvt_pk_bf16(float lo, float hi) { unsigned r; asm("v_cvt_pk_bf16_f32 %0, %1, %2" : "=v"(r) : "v"(lo), "v"(hi)); return r; }
__device__ __forceinline__ float bf_lo(unsigned w) { return __uint_as_float(w << 16); }
__device__ __forceinline__ float bf_hi(unsigned w) { return __uint_as_float(w & 0xffff0000u); }
__device__ __forceinline__ float bf1(bf16_t b) { return __uint_as_float(((unsigned)b) << 16); }
__device__ __forceinline__ float wave_sum(float v) {
#pragma unroll
    for (int o = 1; o < 64; o <<= 1) v += __shfl_xor(v, o);
    return v;
}
__device__ __forceinline__ float fast_rcp(float x) { return __builtin_amdgcn_rcpf(x); }
__device__ __forceinline__ float fast_exp2(float x) { return __builtin_amdgcn_exp2f(x); }
__device__ __forceinline__ float sigmoid_f(float x) { return fast_rcp(1.0f + fast_exp2(-1.44269504f * x)); }
__device__ __forceinline__ float gelu_tanh(float x) {
    const float u = x + 0.044715f * x * x * x;
    return x * fast_rcp(1.0f + fast_exp2(-2.30220819f * u));
}
__host__ __device__ __forceinline__ int perm32(int rho) { const int n = rho >> 4, i = rho & 15; return 8 * (i >> 2) + 4 * n + (i & 3); }

struct Unit { int pm, pn, e, row0, nvalid; };
constexpr int NXCD = 8, WGM = 8;
struct DenseSched {
    const bf16_t* A; const bf16_t* Bt; int K; int nM, nN, nwg, G, c;
    __device__ __forceinline__ void init(const bf16_t* A_, const bf16_t* Bt_, int M, int N, int K_) { A = A_; Bt = Bt_; K = K_; nM = M / 256; nN = N / 256; nwg = nM * nN; G = gridDim.x; c = blockIdx.x; }
    __device__ __forceinline__ bool next(int i, Unit& u) const {
        const long L = (long)i * G + c; if (L >= nwg) return false;
        int wgid = (int)L; { const int q = nwg / NXCD, r = nwg % NXCD, xcd = wgid % NXCD, off = wgid / NXCD; wgid = (xcd < r ? xcd * (q + 1) : r * (q + 1) + (xcd - r) * q) + off; }
        const int nig = WGM * nN, gid = wgid / nig, fm = gid * WGM, gsz = (nM - fm) < WGM ? (nM - fm) : WGM;
        u.pm = fm + ((wgid % nig) % gsz); u.pn = (wgid % nig) / gsz; u.e = 0; u.row0 = u.pm * 256; u.nvalid = 256; return true;
    }
    __device__ __forceinline__ const char* a_base() const { return (const char*)A; }
    __device__ __forceinline__ unsigned a_off(const Unit& u, int r) const { return (unsigned)(u.row0 + r) * (unsigned)K * 2u; }
    __device__ __forceinline__ const char* b_base(const Unit& u) const { return (const char*)Bt + (size_t)u.pn * 256 * K * 2; }
};
template <bool GATHER, int NPN, int KK, int NROWS_E  >
struct MoeSched {
    const bf16_t* A; const bf16_t* Bt; const int* cnt; const int* ent; int G, c;
    __device__ __forceinline__ bool next(int i, Unit& u) const {
        int L = i * G + c; int hb = 0;
        for (int e = 0; e < NE; ++e) {
            const int n = __builtin_amdgcn_readfirstlane(cnt[e]); const int nt = (n + 255) >> 8;
            if (L < nt * NPN) { u.e = e; u.pm = L / NPN; u.pn = L % NPN; u.row0 = hb + u.pm * 256; u.nvalid = min(256, n - u.pm * 256); return true; }
            L -= nt * NPN; hb += nt * 256;
        }
        return false;
    }
    __device__ __forceinline__ const char* a_base() const { return (const char*)A; }
    __device__ __forceinline__ unsigned a_off(const Unit& u, int r) const {
        if (GATHER) { const int tok = (r < u.nvalid) ? (ent[u.e * T + u.pm * 256 + r] & 0xffff) : 0; return (unsigned)tok * (unsigned)KK * 2u; }
        return (unsigned)(u.row0 + r) * (unsigned)KK * 2u;
    }
    __device__ __forceinline__ const char* b_base(const Unit& u) const { return (const char*)Bt + ((size_t)u.e * NROWS_E + (size_t)u.pn * 256) * KK * 2; }
};

typedef f32x4 Acc[2][2][4][2];
__device__ __forceinline__ u32x4 pack8(f32x4 a, f32x4 b) { u32x4 w; w.x = cvt_pk_bf16(a[0], a[1]); w.y = cvt_pk_bf16(a[2], a[3]); w.z = cvt_pk_bf16(b[0], b[1]); w.w = cvt_pk_bf16(b[2], b[3]); return w; }
__device__ __forceinline__ void unpack8(u32x4 w, f32x4& a, f32x4& b) { a = (f32x4){bf_lo(w.x), bf_hi(w.x), bf_lo(w.y), bf_hi(w.y)}; b = (f32x4){bf_lo(w.z), bf_hi(w.z), bf_lo(w.w), bf_hi(w.w)}; }

struct EpiProj {
    static constexpr bool PERM = true; static constexpr int MIDK = 0;
    bf16_t *Bc, *P, *U, *V, *R, *S;
    __device__ __forceinline__ void mid(Acc&, const Unit&, int, int, int, int) const {}
    __device__ __forceinline__ void operator()(const Acc& acc, const Unit& u, int wr, int wc, int fr, int fq) const {
        const int pn = u.pn; const int rowb = u.row0 + wr * 64 + fr; const int cl = wc * 32 + 8 * fq;
#pragma unroll
        for (int ai = 0; ai < 2; ++ai)
#pragma unroll
            for (int m = 0; m < 4; ++m) {
                const size_t row = (size_t)(rowb + ai * 128 + m * 16);
                if (pn < 4) {
#pragma unroll
                    for (int bj = 0; bj < 2; ++bj) *(u32x4*)(Bc + row * CW + pn * 256 + bj * 128 + cl) = pack8(acc[ai][bj][m][0], acc[ai][bj][m][1]);
                } else if (pn < 12) {
                    *(u32x4*)(P + row * CW + (pn - 4) * 128 + cl) = pack8(acc[ai][0][m][0] * acc[ai][1][m][0], acc[ai][0][m][1] * acc[ai][1][m][1]);
                } else if (pn < 20) {
                    bf16_t* O = (pn < 16) ? (U + row * SW + (pn - 12) * 256) : (V + row * SW + (pn - 16) * 256);
#pragma unroll
                    for (int bj = 0; bj < 2; ++bj) { f32x4 a = acc[ai][bj][m][0], b = acc[ai][bj][m][1];
#pragma unroll
                        for (int j = 0; j < 4; ++j) { a[j] = gelu_tanh(a[j]); b[j] = gelu_tanh(b[j]); }
                        *(u32x4*)(O + bj * 128 + cl) = pack8(a, b); }
                } else {
                    f32x4 r0, r1, s0, s1;
#pragma unroll
                    for (int j = 0; j < 4; ++j) {
                        const float ec0 = fast_exp2(-1.44269504f * acc[ai][0][m][0][j]), es0 = fast_exp2(-1.44269504f * acc[ai][1][m][0][j]);
                        const float ec1 = fast_exp2(-1.44269504f * acc[ai][0][m][1][j]), es1 = fast_exp2(-1.44269504f * acc[ai][1][m][1][j]);
                        r0[j] = (1.0f + es0) * fast_rcp(1.0f + ec0); s0[j] = fast_rcp(1.0f + es0);
                        r1[j] = (1.0f + es1) * fast_rcp(1.0f + ec1); s1[j] = fast_rcp(1.0f + es1);
                    }
                    const size_t o = row * D + (pn - 20) * 128 + cl;
                    *(u32x4*)(R + o) = pack8(r0, r1); *(u32x4*)(S + o) = pack8(s0, s1);
                }
            }
    }
};
struct EpiUp {
    static constexpr bool PERM = true; static constexpr int MIDK = 1024;
    const bf16_t *R, *S; bf16_t* Mm;
    __device__ __forceinline__ void mid(Acc& acc, const Unit& u, int wr, int wc, int fr, int fq) const {
        int rowb = u.row0 + wr * 64 + fr; const int cb = u.pn * 256 + wc * 32 + 8 * fq;
        asm volatile("" : "+v"(rowb));
#pragma unroll
        for (int ai = 0; ai < 2; ++ai)
#pragma unroll
            for (int m = 0; m < 4; ++m)
#pragma unroll
                for (int bj = 0; bj < 2; ++bj) { f32x4 a, b; unpack8(*(const u32x4*)(R + (size_t)(rowb + ai * 128 + m * 16) * D + cb + bj * 128), a, b);
                    acc[ai][bj][m][0] *= a; acc[ai][bj][m][1] *= b; }
    }
    __device__ __forceinline__ void operator()(const Acc& acc, const Unit& u, int wr, int wc, int fr, int fq) const {
        const int rowb = u.row0 + wr * 64 + fr; const int cb = u.pn * 256 + wc * 32 + 8 * fq;
#pragma unroll
        for (int ai = 0; ai < 2; ++ai)
#pragma unroll
            for (int m = 0; m < 4; ++m)
#pragma unroll
                for (int bj = 0; bj < 2; ++bj) { const size_t o = (size_t)(rowb + ai * 128 + m * 16) * D + cb + bj * 128; f32x4 a, b; unpack8(*(const u32x4*)(S + o), a, b);
                    *(u32x4*)(Mm + o) = pack8(acc[ai][bj][m][0] * a, acc[ai][bj][m][1] * b); }
    }
};
struct EpiOut {
    static constexpr bool PERM = false; static constexpr int MIDK = 0;
    const float* x; const float* g; float* H; bf16_t* A2;
    __device__ __forceinline__ void mid(Acc&, const Unit&, int, int, int, int) const {}
    __device__ __forceinline__ void operator()(const Acc& acc, const Unit& u, int wr, int wc, int fr, int fq) const {
        const int rowb = u.row0 + wr * 64 + fr; const int cb = u.pn * 256 + wc * 32 + 4 * fq;
#pragma unroll
        for (int ai = 0; ai < 2; ++ai)
#pragma unroll
            for (int m = 0; m < 4; ++m)
#pragma unroll
                for (int bj = 0; bj < 2; ++bj)
#pragma unroll
                    for (int n = 0; n < 2; ++n) { const int col = cb + bj * 128 + n * 16; const size_t o = (size_t)(rowb + ai * 128 + m * 16) * D + col;
                        const f32x4 h = *(const f32x4*)(x + o) + acc[ai][bj][m][n]; *(f32x4*)(H + o) = h; const f32x4 gg = *(const f32x4*)(g + col);
                        u32x2 w; w.x = cvt_pk_bf16(h[0] * gg[0], h[1] * gg[1]); w.y = cvt_pk_bf16(h[2] * gg[2], h[3] * gg[3]); *(u32x2*)(A2 + o) = w; }
    }
};
struct EpiMoe1 {
    static constexpr bool PERM = true; static constexpr int MIDK = 0;
    const int* ent; const float* lw; const float* rstd; bf16_t* Hid;
    __device__ __forceinline__ void mid(Acc&, const Unit&, int, int, int, int) const {}
    __device__ __forceinline__ void operator()(const Acc& acc, const Unit& u, int wr, int wc, int fr, int fq) const {
        const int cl = u.pn * 128 + wc * 32 + 8 * fq;
#pragma unroll
        for (int ai = 0; ai < 2; ++ai)
#pragma unroll
            for (int m = 0; m < 4; ++m) {
                const int r = ai * 128 + wr * 64 + m * 16 + fr;
                if (r < u.nvalid) {
                    const int li = u.e * T + u.pm * 256 + r; const int tok = ent[li] & 0xffff; const float rs = rstd[tok], w = lw[li];
                    f32x4 o[2];
#pragma unroll
                    for (int n = 0; n < 2; ++n)
#pragma unroll
                        for (int j = 0; j < 4; ++j) { const float gt = acc[ai][0][m][n][j] * rs, up = acc[ai][1][m][n][j] * rs; o[n][j] = gt * sigmoid_f(gt) * up * w; }
                    *(u32x4*)(Hid + (size_t)(u.row0 + r) * DE + cl) = pack8(o[0], o[1]);
                }
            }
    }
};
struct EpiMoe2 {
    static constexpr bool PERM = true; static constexpr int MIDK = 0;
    const int* ent; bf16_t* Yk0; bf16_t* Yk1;
    __device__ __forceinline__ void mid(Acc&, const Unit&, int, int, int, int) const {}
    __device__ __forceinline__ void operator()(const Acc& acc, const Unit& u, int wr, int wc, int fr, int fq) const {
        const int cb = u.pn * 256 + wc * 32 + 8 * fq;
#pragma unroll
        for (int ai = 0; ai < 2; ++ai)
#pragma unroll
            for (int m = 0; m < 4; ++m) {
                const int r = ai * 128 + wr * 64 + m * 16 + fr;
                if (r < u.nvalid) {
                    const int en = ent[u.e * T + u.pm * 256 + r]; const int tok = en & 0xffff; bf16_t* Y = (en >> 16) ? Yk1 : Yk0;
#pragma unroll
                    for (int bj = 0; bj < 2; ++bj) *(u32x4*)(Y + (size_t)tok * D + cb + bj * 128) = pack8(acc[ai][bj][m][0], acc[ai][bj][m][1]);
                }
            }
    }
};

template <class Epi, class Sched>
__device__ __forceinline__ void gemm_simple(const Sched& S, const Epi& E, const int K) {
    const int tid = threadIdx.x, wid = __builtin_amdgcn_readfirstlane(tid >> 6), lane = tid & 63, wr = wid >> 2, wc = wid & 3, fr = lane & 15, fq = lane >> 4;
    Unit u;
    for (int ui = 0; S.next(ui, u); ++ui) {
        Acc acc;
#pragma unroll
        for (int a = 0; a < 2; ++a)
#pragma unroll
            for (int b = 0; b < 2; ++b)
#pragma unroll
                for (int m = 0; m < 4; ++m)
#pragma unroll
                    for (int n = 0; n < 2; ++n) acc[a][b][m][n] = (f32x4){0.f, 0.f, 0.f, 0.f};
        const char* ab = S.a_base(); const char* bb = S.b_base(u);
        unsigned aoff[2][4], boff[2][2];
#pragma unroll
        for (int ai = 0; ai < 2; ++ai)
#pragma unroll
            for (int m = 0; m < 4; ++m) aoff[ai][m] = S.a_off(u, ai * 128 + wr * 64 + m * 16 + fr) + fq * 16;
#pragma unroll
        for (int bj = 0; bj < 2; ++bj)
#pragma unroll
            for (int n = 0; n < 2; ++n) { const int rr = Epi::PERM ? perm32(n * 16 + fr) : (n * 16 + fr); boff[bj][n] = (unsigned)(bj * 128 + wc * 32 + rr) * (unsigned)K * 2u + fq * 16; }
        for (int k0 = 0; k0 < K; k0 += 32) {
            if (Epi::MIDK != 0 && k0 == Epi::MIDK) E.mid(acc, u, wr, wc, fr, fq);
            bf16x8 a[2][4], b[2][2];
#pragma unroll
            for (int ai = 0; ai < 2; ++ai)
#pragma unroll
                for (int m = 0; m < 4; ++m) a[ai][m] = *(const bf16x8*)(ab + aoff[ai][m] + k0 * 2);
#pragma unroll
            for (int bj = 0; bj < 2; ++bj)
#pragma unroll
                for (int n = 0; n < 2; ++n) b[bj][n] = *(const bf16x8*)(bb + boff[bj][n] + k0 * 2);
#pragma unroll
            for (int ai = 0; ai < 2; ++ai)
#pragma unroll
                for (int bj = 0; bj < 2; ++bj)
#pragma unroll
                    for (int m = 0; m < 4; ++m)
#pragma unroll
                        for (int n = 0; n < 2; ++n) acc[ai][bj][m][n] = __builtin_amdgcn_mfma_f32_16x16x32_bf16(b[bj][n], a[ai][m], acc[ai][bj][m][n], 0, 0, 0);
        }
        E(acc, u, wr, wc, fr, fq);
    }
}

constexpr int BK = 64, HALF = 128, HTB = HALF * BK * 2, STAGE_BYTES = 8 * HTB;
__host__ __device__ __forceinline__ int lds_byte(int r, int c) { const int st = (r >> 4) * 2 + (c >> 5), rr = r & 15, cc = c & 31, ob = rr * 64 + cc * 2; return st * 1024 + (ob ^ (((ob >> 9) & 1) << 5)); }
__host__ __device__ __forceinline__ void stage_rc(int b, int& R, int& C) { const int st = b / 1024, sb = b % 1024, swz = sb ^ (((sb >> 9) & 1) << 5); R = (st >> 1) * 16 + swz / 64; C = (st & 1) * 32 + (swz % 64) / 2; }

template <class Epi, class Sched>
__device__ __forceinline__ void gemm_fast(LAS unsigned char* lds, const Sched& S, const Epi& E, const int K) {
    const int tid = threadIdx.x, wid = __builtin_amdgcn_readfirstlane(tid >> 6), lane = tid & 63, wr = wid >> 2, wc = wid & 3, fr = lane & 15, fq = lane >> 4;
    const int nt = K / BK;
    int sR[2], sC[2]; unsigned voffB[2];
#pragma unroll
    for (int i = 0; i < 2; ++i) { stage_rc(tid * 16 + i * 8192, sR[i], sC[i]); const int Rb = Epi::PERM ? ((sR[i] & ~31) + perm32(sR[i] & 31)) : sR[i]; voffB[i] = (unsigned)(Rb * K + sC[i]) * 2u; }
    const size_t kstep = (size_t)(BK * 2);
    const size_t hstepB = (size_t)HALF * K * 2;
    const unsigned ldsw = (unsigned)wid * 1024u;
    const int aoff = lds_byte(wr * 64 + fr, fq * 8), boff = lds_byte(wc * 32 + fr, fq * 8);
#define PG8_SA(b, h) (((b) * 2 + (h)) * HTB)
#define PG8_SB(b, h) ((4 + (b) * 2 + (h)) * HTB)
#define PG8_STAGE(bufoff, gbase, voff) do { _Pragma("unroll") for (int _i = 0; _i < 2; ++_i) \
        __builtin_amdgcn_global_load_lds((const unsigned*)((const char*)(gbase) + (voff)[_i]), (LAS unsigned*)(lds + (bufoff) + ldsw + _i * 8192), 16, 0, 0); } while (0)
#define PG8_LDA(dst, b, h) do { _Pragma("unroll") for (int m = 0; m < 4; ++m) _Pragma("unroll") for (int k = 0; k < 2; ++k) dst[m][k] = *(const LAS bf16x8*)(lds + PG8_SA(b, h) + aoff + m * 2048 + k * 1024); } while (0)
#define PG8_LDB(dst, b, h) do { _Pragma("unroll") for (int n = 0; n < 2; ++n) _Pragma("unroll") for (int k = 0; k < 2; ++k) dst[n][k] = *(const LAS bf16x8*)(lds + PG8_SB(b, h) + boff + n * 2048 + k * 1024); } while (0)
#define PG8_MMA(ai, bj, At, Bt) do { __builtin_amdgcn_s_setprio(1); _Pragma("unroll") for (int m = 0; m < 4; ++m) _Pragma("unroll") for (int n = 0; n < 2; ++n) _Pragma("unroll") for (int k = 0; k < 2; ++k) \
        acc[ai][bj][m][n] = __builtin_amdgcn_mfma_f32_16x16x32_bf16(Bt[n][k], At[m][k], acc[ai][bj][m][n], 0, 0, 0); __builtin_amdgcn_s_setprio(0); } while (0)
#define PG8_WAIT_V(n) asm volatile("s_waitcnt vmcnt(" #n ")" ::: "memory")
#define PG8_WAIT_L(n) asm volatile("s_waitcnt lgkmcnt(" #n ")" ::: "memory")
#define PG8_BAR __builtin_amdgcn_s_barrier()
#define PG8_SCHED __builtin_amdgcn_sched_barrier(0)
    Unit cur, nxt; int ui = 0;
    if (!S.next(0, cur)) return;
    Acc acc;
#pragma unroll
    for (int a = 0; a < 2; ++a)
#pragma unroll
        for (int b = 0; b < 2; ++b)
#pragma unroll
            for (int m = 0; m < 4; ++m)
#pragma unroll
                for (int n = 0; n < 2; ++n) acc[a][b][m][n] = (f32x4){0.f, 0.f, 0.f, 0.f};
    bf16x8 At[4][2], B0[2][2], B1[2][2];
    unsigned va[2][2], vn[2][2];
#pragma unroll
    for (int h = 0; h < 2; ++h)
#pragma unroll
        for (int i = 0; i < 2; ++i) va[h][i] = S.a_off(cur, h * 128 + sR[i]) + (unsigned)sC[i] * 2u;
    const char* const A0 = S.a_base(); const char* cB = S.b_base(cur);
    PG8_STAGE(PG8_SB(0, 0), cB, voffB); PG8_STAGE(PG8_SB(0, 1), cB + hstepB, voffB); PG8_STAGE(PG8_SA(0, 0), A0, va[0]); PG8_STAGE(PG8_SA(0, 1), A0, va[1]);
    if (wr == 1) PG8_BAR;
    PG8_WAIT_V(2); PG8_BAR;
    PG8_STAGE(PG8_SB(1, 0), cB + kstep, voffB); PG8_STAGE(PG8_SA(1, 0), A0 + kstep, va[0]); PG8_STAGE(PG8_SB(1, 1), cB + hstepB + kstep, voffB);
    PG8_WAIT_V(6); PG8_BAR;
    for (;;) {
        const bool has_next = S.next(ui + 1, nxt);
        const char* nB = has_next ? S.b_base(nxt) : cB;
#pragma unroll
        for (int h = 0; h < 2; ++h)
#pragma unroll
            for (int i = 0; i < 2; ++i) vn[h][i] = has_next ? (S.a_off(nxt, h * 128 + sR[i]) + (unsigned)sC[i] * 2u) : va[h][i];
        for (int t = 0; t < nt; t += 2) {
            const bool last = (t == nt - 2);
            if (Epi::MIDK != 0 && t * BK == Epi::MIDK) { PG8_SCHED; E.mid(acc, cur, wr, wc, fr, fq); PG8_SCHED; }
            const char* a1 = A0 + (size_t)(t + 1) * kstep;
            const char* a2 = last ? A0 : A0 + (size_t)(t + 2) * kstep; const char* b2 = last ? nB : cB + (size_t)(t + 2) * kstep;
            const char* a3 = a2 + kstep; const char* b3 = b2 + kstep;
            unsigned v2[2][2];
#pragma unroll
            for (int h = 0; h < 2; ++h)
#pragma unroll
                for (int i = 0; i < 2; ++i) v2[h][i] = last ? vn[h][i] : va[h][i];
            PG8_LDB(B0, 0, 0); PG8_LDB(B1, 0, 1); PG8_SCHED; PG8_LDA(At, 0, 0); PG8_STAGE(PG8_SA(1, 1), a1, va[1]);
            PG8_WAIT_V(8); PG8_WAIT_L(0); PG8_BAR; PG8_MMA(0, 0, At, B0); PG8_MMA(0, 1, At, B1); PG8_BAR; PG8_SCHED;
            PG8_LDA(At, 0, 1); PG8_STAGE(PG8_SB(0, 0), b2, voffB); PG8_STAGE(PG8_SB(0, 1), b2 + hstepB, voffB); PG8_STAGE(PG8_SA(0, 0), a2, v2[0]);
            PG8_WAIT_V(8); PG8_WAIT_L(0); PG8_BAR; PG8_MMA(1, 0, At, B0); PG8_MMA(1, 1, At, B1); PG8_BAR; PG8_SCHED;
            PG8_LDB(B0, 1, 0); PG8_LDB(B1, 1, 1); PG8_SCHED; PG8_LDA(At, 1, 0); PG8_STAGE(PG8_SA(0, 1), a2, v2[1]);
            PG8_WAIT_V(8); PG8_WAIT_L(0); PG8_BAR; PG8_MMA(0, 0, At, B0); PG8_MMA(0, 1, At, B1); PG8_BAR; PG8_SCHED;
            PG8_LDA(At, 1, 1); PG8_STAGE(PG8_SB(1, 0), b3, voffB); PG8_STAGE(PG8_SB(1, 1), b3 + hstepB, voffB); PG8_STAGE(PG8_SA(1, 0), a3, v2[0]);
            PG8_WAIT_V(8); PG8_WAIT_L(0); PG8_BAR; PG8_MMA(1, 0, At, B0); PG8_MMA(1, 1, At, B1); PG8_BAR; PG8_SCHED;
        }
        if (wr == 0) PG8_BAR;
        E(acc, cur, wr, wc, fr, fq);
        if (!has_next) break;
#pragma unroll
        for (int a = 0; a < 2; ++a)
#pragma unroll
            for (int b = 0; b < 2; ++b)
#pragma unroll
                for (int m = 0; m < 4; ++m)
#pragma unroll
                    for (int n = 0; n < 2; ++n) acc[a][b][m][n] = (f32x4){0.f, 0.f, 0.f, 0.f};
        cur = nxt; cB = nB; ++ui;
#pragma unroll
        for (int h = 0; h < 2; ++h)
#pragma unroll
            for (int i = 0; i < 2; ++i) va[h][i] = vn[h][i];
        if (wr == 1) PG8_BAR;
    }
    PG8_WAIT_V(0);
    PG8_BAR;
#undef PG8_SA
#undef PG8_SB
#undef PG8_STAGE
#undef PG8_LDA
#undef PG8_LDB
#undef PG8_MMA
#undef PG8_WAIT_V
#undef PG8_WAIT_L
#undef PG8_BAR
#undef PG8_SCHED
}
#ifndef FAST_MASK
#define FAST_MASK 0x1f
#endif
template <int BIT, class Epi, class Sched>
__device__ __forceinline__ void gemm_run(LAS unsigned char* lds, const Sched& S, const Epi& E, const int K) {
    if constexpr ((FAST_MASK >> BIT) & 1) gemm_fast(lds, S, E, K); else gemm_simple(S, E, K);
}

__device__ __forceinline__ void tr_item(const float* W, int N, int k0, int ns, bf16_t* WT, int ldk, int nd, int kd, LAS float* scr, int lane) {
#pragma unroll 8
    for (int i = 0; i < 32; ++i) { const int kk = 2 * i + (lane >> 5); scr[kk * 33 + (lane & 31)] = W[(size_t)(k0 + kk) * N + ns + (lane & 31)]; }
    asm volatile("s_waitcnt lgkmcnt(0)" ::: "memory");
    const int c = lane & 7;
#pragma unroll
    for (int j = 0; j < 4; ++j) { const int n = (lane >> 3) + 8 * j; const LAS float* s = scr + (8 * c) * 33 + n;
        u32x4 o; o.x = cvt_pk_bf16(s[0 * 33], s[1 * 33]); o.y = cvt_pk_bf16(s[2 * 33], s[3 * 33]); o.z = cvt_pk_bf16(s[4 * 33], s[5 * 33]); o.w = cvt_pk_bf16(s[6 * 33], s[7 * 33]);
        *(u32x4*)(WT + (size_t)(nd + n) * ldk + kd + 8 * c) = o; }
    asm volatile("s_waitcnt lgkmcnt(0)" ::: "memory");
}
__device__ __forceinline__ int win_src_col(int nd) {
    if (nd < 1024) return nd;
    if (nd < 3072) { const int q = (nd - 1024) >> 8, r = (nd - 1024) & 255; return r < 128 ? (1024 + 128 * q + r) : (2048 + 128 * q + r - 128); }
    if (nd < 5120) return nd;
    { const int q = (nd - 5120) >> 8, r = (nd - 5120) & 255; return r < 128 ? (5120 + 128 * q + r) : (7168 + 128 * q + r - 128); }
}
__device__ __forceinline__ void phase0(const Params& p, LAS unsigned char* lds) {
    const int tid = threadIdx.x, wave = __builtin_amdgcn_readfirstlane(tid >> 6), lane = tid & 63;
    LAS float* scr = (LAS float*)(lds + wave * 8704);
    const int gw = blockIdx.x * NWAVES + wave, NGW = gridDim.x * NWAVES;
    unsigned char* ws = p.ws;
    constexpr int I_IN = 32 * 288, I_UP = 16 * 64, I_OUT = 32 * 64, I_G = 32 * 16 * NE, I_D = 8 * 64 * NE;
    constexpr int NITEMS = I_IN + 2 * I_UP + I_OUT + 2 * I_G + I_D;
    for (int it = gw; it < NITEMS; it += NGW) {
        int r = it;
        if (r < I_IN) { const int kb = r / 288, nb = r % 288; tr_item(p.in[2], NIN, kb * 64, win_src_col(nb * 32), (bf16_t*)(ws + WS_WINT), D, nb * 32, kb * 64, scr, lane); continue; } r -= I_IN;
        if (r < I_UP) { const int kb = r / 64, nb = r % 64; tr_item(p.in[8], D, kb * 64, nb * 32, (bf16_t*)(ws + WS_WUPT), 2048, nb * 32, kb * 64, scr, lane); continue; } r -= I_UP;
        if (r < I_UP) { const int kb = r / 64, nb = r % 64; tr_item(p.in[9], D, kb * 64, nb * 32, (bf16_t*)(ws + WS_WUPT), 2048, nb * 32, 1024 + kb * 64, scr, lane); continue; } r -= I_UP;
        if (r < I_OUT) { const int kb = r / 64, nb = r % 64; tr_item(p.in[10], D, kb * 64, nb * 32, (bf16_t*)(ws + WS_WOUTT), D, nb * 32, kb * 64, scr, lane); continue; } r -= I_OUT;
        if (r < 2 * I_G) { const int up = r >= I_G; if (up) r -= I_G; const int e = r / 512, q = r % 512, kb = q / 16, nb = q % 16;
            const int nd = 256 * (nb >> 2) + (nb & 3) * 32 + (up ? 128 : 0);
            tr_item(p.in[up ? 17 : 16] + (size_t)e * D * DE, DE, kb * 64, nb * 32, (bf16_t*)(ws + WS_W1T) + (size_t)e * 1024 * D, D, nd, kb * 64, scr, lane); continue; } r -= 2 * I_G;
        { const int e = r / 512, q = r % 512, kb = q / 64, nb = q % 64;
            tr_item(p.in[18] + (size_t)e * DE * D, D, kb * 64, nb * 32, (bf16_t*)(ws + WS_W2T) + (size_t)e * D * DE, DE, nb * 32, kb * 64, scr, lane); }
    }
    const float* x = p.in[0]; const float* g = p.in[1]; bf16_t* xn = (bf16_t*)(ws + WS_X);
    for (int m = gw; m < T; m += NGW) {
        const f32x4* xr = (const f32x4*)(x + (size_t)m * D) + lane; f32x4 v[8]; float s = 0.f;
#pragma unroll
        for (int j = 0; j < 8; ++j) { v[j] = xr[64 * j]; s += (v[j][0] * v[j][0] + v[j][1] * v[j][1]) + (v[j][2] * v[j][2] + v[j][3] * v[j][3]); }
        const float rs = 1.0f / sqrtf(wave_sum(s) * (1.0f / D) + EPS);
        u32x2* o = (u32x2*)(xn + (size_t)m * D) + lane;
#pragma unroll
        for (int j = 0; j < 8; ++j) { const f32x4 gg = *((const f32x4*)g + lane + 64 * j); u32x2 w; w.x = cvt_pk_bf16(v[j][0] * rs * gg[0], v[j][1] * rs * gg[1]); w.y = cvt_pk_bf16(v[j][2] * rs * gg[2], v[j][3] * rs * gg[3]); o[64 * j] = w; }
    }
    float* wr = (float*)(ws + WS_WR); const float* gf = p.in[11];
    for (int i = blockIdx.x * NTHREADS + tid; i < 20 * D; i += gridDim.x * NTHREADS) { const int j = i / D, d = i % D; wr[i] = gf[d] * (j < 4 ? p.in[12][d * 4 + j] : p.in[14][d * 16 + (j - 4)]); }
    if (blockIdx.x == 0 && tid < 64) ((int*)(ws + WS_CTL))[tid] = 0;
}

__device__ __forceinline__ void phase2_conv(const Params& p) {
    const bf16_t* Bc = (const bf16_t*)(p.ws + WS_P + P_BC); const bf16_t* P = (const bf16_t*)(p.ws + WS_P + P_P); bf16_t* Y = (bf16_t*)(p.ws + WS_X);
    const float* cw = p.in[3];
    for (int i = blockIdx.x * NTHREADS + threadIdx.x; i < T * (CW / 8); i += gridDim.x * NTHREADS) {
        const int t = i >> 7, c = (i & 127) * 8;
        f32x4 p0a, p0b, p1a, p1b, p2a, p2b, ba, bb;
        unpack8(*(const u32x4*)(P + (size_t)t * CW + c), p2a, p2b); unpack8(*(const u32x4*)(Bc + (size_t)t * CW + c), ba, bb);
        if (t >= 1) unpack8(*(const u32x4*)(P + (size_t)(t - 1) * CW + c), p1a, p1b); else { p1a = (f32x4){0, 0, 0, 0}; p1b = p1a; }
        if (t >= 2) unpack8(*(const u32x4*)(P + (size_t)(t - 2) * CW + c), p0a, p0b); else { p0a = (f32x4){0, 0, 0, 0}; p0b = p0a; }
        const f32x4 w0a = *(const f32x4*)(cw + c), w0b = *(const f32x4*)(cw + c + 4), w1a = *(const f32x4*)(cw + CW + c), w1b = *(const f32x4*)(cw + CW + c + 4),
                    w2a = *(const f32x4*)(cw + 2 * CW + c), w2b = *(const f32x4*)(cw + 2 * CW + c + 4);
        const f32x4 ya = ba * (w0a * p0a + w1a * p1a + w2a * p2a), yb = bb * (w0b * p0b + w1b * p1b + w2b * p2b);
        *(u32x4*)(Y + (size_t)t * 2048 + c) = pack8(ya, yb);
    }
}
__device__ __forceinline__ void phase2_sgu(const Params& p, LAS unsigned char* lds) {
    const int tid = threadIdx.x, wave = __builtin_amdgcn_readfirstlane(tid >> 6), lane = tid & 63;
    const bf16_t* U = (const bf16_t*)(p.ws + WS_P + P_U); const bf16_t* V = (const bf16_t*)(p.ws + WS_P + P_V); bf16_t* Y = (bf16_t*)(p.ws + WS_X);
    const float* lng = p.in[4]; const float* lnb = p.in[5]; const float* Ws = p.in[6]; const float* bs = p.in[7];
    LAS f32x2* st = (LAS f32x2*)lds;
    LAS float* vn = (LAS float*)(lds + 1024);
    for (int unit = blockIdx.x; unit < 64 * 8; unit += gridDim.x) {
        const int nb = unit >> 3, h = unit & 7, t0 = nb * 128, c0 = h * 128;
        __syncthreads();
        for (int jj = 0; jj < 16; ++jj) { const int j = wave * 16 + jj; const u32x4* vr = (const u32x4*)(V + (size_t)(t0 + j) * SW) + lane * 2;
            f32x4 a, b, c, d; unpack8(vr[0], a, b); unpack8(vr[1], c, d);
            float s = (a[0] + a[1] + a[2] + a[3]) + (b[0] + b[1] + b[2] + b[3]) + (c[0] + c[1] + c[2] + c[3]) + (d[0] + d[1] + d[2] + d[3]);
            const float mu = wave_sum(s) * (1.0f / SW);
            a -= mu; b -= mu; c -= mu; d -= mu;
            float q = (a[0] * a[0] + a[1] * a[1] + a[2] * a[2] + a[3] * a[3]) + (b[0] * b[0] + b[1] * b[1] + b[2] * b[2] + b[3] * b[3]) + (c[0] * c[0] + c[1] * c[1] + c[2] * c[2] + c[3] * c[3]) + (d[0] * d[0] + d[1] * d[1] + d[2] * d[2] + d[3] * d[3]);
            const float rs = 1.0f / sqrtf(wave_sum(q) * (1.0f / SW) + EPS);
            if (lane == 0) st[j] = (f32x2){mu, rs}; }
        __syncthreads();
        for (int q = tid; q < 128 * 16; q += NTHREADS) { const int j = q >> 4, c = (q & 15) * 8; const f32x2 s = st[j];
            f32x4 a, b; unpack8(*(const u32x4*)(V + (size_t)(t0 + j) * SW + c0 + c), a, b);
            const f32x4 g0 = *(const f32x4*)(lng + c0 + c), g1 = *(const f32x4*)(lng + c0 + c + 4), b0 = *(const f32x4*)(lnb + c0 + c), b1 = *(const f32x4*)(lnb + c0 + c + 4);
            a = (a - s.x) * s.y * g0 + b0; b = (b - s.x) * s.y * g1 + b1;
            *(LAS f32x4*)(vn + j * 128 + c) = a; *(LAS f32x4*)(vn + j * 128 + c + 4) = b; }
        __syncthreads();
        for (int ii = 0; ii < 16; ++ii) { const int i = wave * 16 + ii; const int jmax = (i < 64) ? 64 : 128; const float* wrow = Ws + ((size_t)h * 128 + i) * 128;
            float a0 = 0.f, a1 = 0.f;
            for (int j = 0; j < jmax; ++j) { const float w = wrow[j]; a0 += w * vn[j * 128 + lane]; a1 += w * vn[j * 128 + lane + 64]; }
            const float bb = bs[h * 128 + i]; const size_t t = (size_t)(t0 + i);
            const float u0 = bf1(U[t * SW + c0 + lane]), u1 = bf1(U[t * SW + c0 + lane + 64]);
            Y[t * 2048 + 1024 + c0 + lane] = (bf16_t)(cvt_pk_bf16(u0 * (a0 + bb), 0.f) & 0xffff); Y[t * 2048 + 1024 + c0 + lane + 64] = (bf16_t)(cvt_pk_bf16(u1 * (a1 + bb), 0.f) & 0xffff); }
    }
}

__device__ __forceinline__ void phase5_router(const Params& p, LAS unsigned char* lds) {
    const int tid = threadIdx.x, wave = __builtin_amdgcn_readfirstlane(tid >> 6), lane = tid & 63;
    const float* H = (const float*)(p.ws + WS_H); const float* wr = (const float*)(p.ws + WS_WR);
    float* rstd = (float*)(p.ws + WS_SMALL + SM_RSTD); int* ent = (int*)(p.ws + WS_SMALL + SM_ENT); float* lw = (float*)(p.ws + WS_SMALL + SM_W); int* cnt = (int*)(p.ws + WS_CTL);
    const float* brg = p.in[13]; const float* bre = p.in[15];
    LAS int* lcnt = (LAS int*)lds;
    LAS int* lbase = (LAS int*)(lds + 64);
    LAS int* le = (LAS int*)(lds + 128);
    LAS int* lp = (LAS int*)(lds + 128 + 256);
    LAS float* lwt = (LAS float*)(lds + 128 + 512);
    const int ngroups = T / 4, nrounds = (ngroups + gridDim.x * NWAVES - 1) / (gridDim.x * NWAVES);
    for (int rd = 0; rd < nrounds; ++rd) {
        const int grp = (rd * gridDim.x + blockIdx.x) * NWAVES + wave; const bool valid = grp < ngroups;
        if (tid < 16) lcnt[tid] = 0;
        __syncthreads();
        if (valid) {
            const int t0 = grp * 4;
            float acc[4][20]; float ss[4];
#pragma unroll
            for (int t = 0; t < 4; ++t) { ss[t] = 0.f;
#pragma unroll
                for (int j = 0; j < 20; ++j) acc[t][j] = 0.f; }
            for (int kc = 0; kc < 8; ++kc) {
                const int k = kc * 256 + lane * 4; f32x4 hv[4];
#pragma unroll
                for (int t = 0; t < 4; ++t) { hv[t] = *(const f32x4*)(H + (size_t)(t0 + t) * D + k); ss[t] += (hv[t][0] * hv[t][0] + hv[t][1] * hv[t][1]) + (hv[t][2] * hv[t][2] + hv[t][3] * hv[t][3]); }
#pragma unroll
                for (int j = 0; j < 20; ++j) { const f32x4 w = *(const f32x4*)(wr + (size_t)j * D + k);
#pragma unroll
                    for (int t = 0; t < 4; ++t) acc[t][j] += (hv[t][0] * w[0] + hv[t][1] * w[1]) + (hv[t][2] * w[2] + hv[t][3] * w[3]); }
            }
#pragma unroll
            for (int t = 0; t < 4; ++t) { ss[t] = wave_sum(ss[t]);
#pragma unroll
                for (int j = 0; j < 20; ++j) acc[t][j] = wave_sum(acc[t][j]); }
#pragma unroll
            for (int t = 0; t < 4; ++t) {
                const float rs = 1.0f / sqrtf(ss[t] * (1.0f / D) + EPS);
                float lg[4];
#pragma unroll
                for (int j = 0; j < 4; ++j) lg[j] = acc[t][j] * rs + brg[j];
                int gi = 0; float gm = lg[0];
#pragma unroll
                for (int j = 1; j < 4; ++j) if (lg[j] > gm) { gm = lg[j]; gi = j; }
                float den = 0.f;
#pragma unroll
                for (int j = 0; j < 4; ++j) den += __expf(lg[j] - gm);
                const float pg = 1.0f / den;
                float le4[4];
#pragma unroll
                for (int j = 0; j < 4; ++j) { const float v0 = acc[t][4 + j], v1 = acc[t][8 + j], v2 = acc[t][12 + j], v3 = acc[t][16 + j];
                    const float v = gi == 0 ? v0 : (gi == 1 ? v1 : (gi == 2 ? v2 : v3)); le4[j] = v * rs + bre[gi * 4 + j]; }
                int i1 = 0; float m1 = le4[0];
#pragma unroll
                for (int j = 1; j < 4; ++j) if (le4[j] > m1) { m1 = le4[j]; i1 = j; }
                int i2 = -1; float m2 = -3.0e38f;
#pragma unroll
                for (int j = 0; j < 4; ++j) if (j != i1 && le4[j] > m2) { m2 = le4[j]; i2 = j; }
                const float ex = __expf(m2 - m1); const float w1 = pg / (1.0f + ex), w2 = pg * ex / (1.0f + ex);
                if (lane == 0) {
                    rstd[t0 + t] = rs;
                    const int e1 = gi * 4 + i1, e2 = gi * 4 + i2; const int s = (wave * 4 + t) * 2;
                    le[s] = e1; le[s + 1] = e2; lwt[s] = w1; lwt[s + 1] = w2;
                    lp[s] = atomicAdd((int*)&lcnt[e1], 1); lp[s + 1] = atomicAdd((int*)&lcnt[e2], 1);
                }
            }
        }
        __syncthreads();
        if (tid < 16) { const int n = lcnt[tid]; lbase[tid] = n ? atomicAdd(&cnt[tid], n) : 0; }
        __syncthreads();
        if (valid && lane < 8) { const int s = wave * 8 + lane; const int e = le[s]; const int pos = lbase[e] + lp[s]; const int tok = grp * 4 + (lane >> 1);
            ent[e * T + pos] = tok | ((lane & 1) << 16); lw[e * T + pos] = lwt[s]; }
        __syncthreads();
    }
}

__device__ __forceinline__ void phase8_final(const Params& p) {
    const int tid = threadIdx.x, wave = __builtin_amdgcn_readfirstlane(tid >> 6), lane = tid & 63;
    const float* H = (const float*)(p.ws + WS_H); const bf16_t* Y0 = (const bf16_t*)(p.ws + WS_YK0); const bf16_t* Y1 = (const bf16_t*)(p.ws + WS_YK1); const float* g = p.in[19];
    const int gw = blockIdx.x * NWAVES + wave, NGW = gridDim.x * NWAVES;
    for (int m = gw; m < T; m += NGW) {
        f32x4 v[8]; float s = 0.f;
#pragma unroll
        for (int j = 0; j < 8; ++j) { const size_t o = (size_t)m * D + 4 * lane + 256 * j; v[j] = *(const f32x4*)(H + o);
            const u32x2 a = *(const u32x2*)(Y0 + o), b = *(const u32x2*)(Y1 + o);
            v[j][0] += bf_lo(a.x) + bf_lo(b.x); v[j][1] += bf_hi(a.x) + bf_hi(b.x); v[j][2] += bf_lo(a.y) + bf_lo(b.y); v[j][3] += bf_hi(a.y) + bf_hi(b.y);
            s += (v[j][0] * v[j][0] + v[j][1] * v[j][1]) + (v[j][2] * v[j][2] + v[j][3] * v[j][3]); }
        const float rs = 1.0f / sqrtf(wave_sum(s) * (1.0f / D) + EPS);
#pragma unroll
        for (int j = 0; j < 8; ++j) { const int c = 4 * lane + 256 * j; const f32x4 gg = *(const f32x4*)(g + c); *(f32x4*)(p.out + (size_t)m * D + c) = v[j] * rs * gg; }
    }
}

template <int PH> __device__ __forceinline__ void run_phase(const Params& p, LAS unsigned char* lds) {
    unsigned char* ws = p.ws;
    if constexpr (PH == 0) phase0(p, lds);
    if constexpr (PH == 1) { DenseSched S; S.init((const bf16_t*)(ws + WS_X), (const bf16_t*)(ws + WS_WINT), T, NIN, D);
        EpiProj E{(bf16_t*)(ws + WS_P + P_BC), (bf16_t*)(ws + WS_P + P_P), (bf16_t*)(ws + WS_P + P_U), (bf16_t*)(ws + WS_P + P_V), (bf16_t*)(ws + WS_P + P_R), (bf16_t*)(ws + WS_P + P_S)};
        gemm_run<0>(lds, S, E, D); }
    if constexpr (PH == 2) { phase2_conv(p); phase2_sgu(p, lds); }
    if constexpr (PH == 3) { DenseSched S; S.init((const bf16_t*)(ws + WS_X), (const bf16_t*)(ws + WS_WUPT), T, D, 2048);
        EpiUp E{(const bf16_t*)(ws + WS_P + P_R), (const bf16_t*)(ws + WS_P + P_S), (bf16_t*)(ws + WS_MM)}; gemm_run<1>(lds, S, E, 2048); }
    if constexpr (PH == 4) { DenseSched S; S.init((const bf16_t*)(ws + WS_MM), (const bf16_t*)(ws + WS_WOUTT), T, D, D);
        EpiOut E{p.in[0], p.in[11], (float*)(ws + WS_H), (bf16_t*)(ws + WS_A2)}; gemm_run<2>(lds, S, E, D); }
    if constexpr (PH == 5) phase5_router(p, lds);
    if constexpr (PH == 6) { MoeSched<true, 4, D, 1024> S{(const bf16_t*)(ws + WS_A2), (const bf16_t*)(ws + WS_W1T), (const int*)(ws + WS_CTL), (const int*)(ws + WS_SMALL + SM_ENT), (int)gridDim.x, (int)blockIdx.x};
        EpiMoe1 E{(const int*)(ws + WS_SMALL + SM_ENT), (const float*)(ws + WS_SMALL + SM_W), (const float*)(ws + WS_SMALL + SM_RSTD), (bf16_t*)(ws + WS_HID)}; gemm_run<3>(lds, S, E, D); }
    if constexpr (PH == 7) { MoeSched<false, 8, DE, D> S{(const bf16_t*)(ws + WS_HID), (const bf16_t*)(ws + WS_W2T), (const int*)(ws + WS_CTL), (const int*)(ws + WS_SMALL + SM_ENT), (int)gridDim.x, (int)blockIdx.x};
        EpiMoe2 E{(const int*)(ws + WS_SMALL + SM_ENT), (bf16_t*)(ws + WS_YK0), (bf16_t*)(ws + WS_YK1)}; gemm_run<4>(lds, S, E, DE); }
    if constexpr (PH == 8) phase8_final(p);
}

template <int PH> __global__ void __launch_bounds__(NTHREADS, 2) k_phase(Params p) {
    extern __shared__ __attribute__((aligned(16))) unsigned char lds_raw[];
    run_phase<PH>(p, (LAS unsigned char*)lds_raw);
}

__global__ void __launch_bounds__(NTHREADS, 2) k_mega(Params p) {
    extern __shared__ __attribute__((aligned(16))) unsigned char lds_raw[];
    LAS unsigned char* lds = (LAS unsigned char*)lds_raw;
    cg::grid_group grid = cg::this_grid();
    run_phase<0>(p, lds); grid.sync();
    run_phase<1>(p, lds); grid.sync();
    run_phase<2>(p, lds); grid.sync();
    run_phase<3>(p, lds); grid.sync();
    run_phase<4>(p, lds); grid.sync();
    run_phase<5>(p, lds); grid.sync();
    run_phase<6>(p, lds); grid.sync();
    run_phase<7>(p, lds); grid.sync();
    run_phase<8>(p, lds);
}

template <int PH> static void launch_phase(const Params& p, int grid, hipStream_t stream) {
    static bool attr = false;
    if (!attr) { (void)hipFuncSetAttribute((const void*)k_phase<PH>, hipFuncAttributeMaxDynamicSharedMemorySize, LDS_BYTES); attr = true; }
    hipLaunchKernelGGL(k_phase<PH>, dim3(grid), dim3(NTHREADS), LDS_BYTES, stream, p);
}

extern "C" void kernel_launch(void* const* d_in, const int* in_sizes, int n_in, void* d_out, int out_size, void* d_ws, size_t ws_size, hipStream_t stream) {
    static int grid = 0;
    if (grid == 0) {
        if (n_in != 20 || out_size != T * D || ws_size < WS_END) { fprintf(stderr, "kernel_launch: unexpected shapes n_in %d out %d ws %zu (need %zu)\n", n_in, out_size, ws_size, (size_t)WS_END); grid = -1; return; }
        int dev = 0, cus = 0, per_cu = 0;
        (void)hipGetDevice(&dev); (void)hipDeviceGetAttribute(&cus, hipDeviceAttributeMultiprocessorCount, dev);
        (void)hipFuncSetAttribute((const void*)k_mega, hipFuncAttributeMaxDynamicSharedMemorySize, LDS_BYTES);
        (void)hipOccupancyMaxActiveBlocksPerMultiprocessor(&per_cu, (const void*)k_mega, NTHREADS, LDS_BYTES);
        if (per_cu < 1) { fprintf(stderr, "kernel_launch: occupancy query says %d blocks per CU\n", per_cu); per_cu = 1; }
        grid = cus * 1;
        (void)hipGetLastError();
    }
    if (grid < 0) return;
    Params p{};
    for (int i = 0; i < 20; ++i) p.in[i] = (const float*)d_in[i];
    p.out = (float*)d_out; p.ws = (unsigned char*)d_ws;
#if ONE_LAUNCH
    void* args[] = {&p};
    hipError_t e = hipLaunchCooperativeKernel((const void*)k_mega, dim3(grid), dim3(NTHREADS), args, LDS_BYTES, stream);
    if (e != hipSuccess) fprintf(stderr, "cooperative launch failed: %s (grid %d)\n", hipGetErrorString(e), grid);
#else
    launch_phase<0>(p, grid, stream); launch_phase<1>(p, grid, stream); launch_phase<2>(p, grid, stream); launch_phase<3>(p, grid, stream); launch_phase<4>(p, grid, stream);
    launch_phase<5>(p, grid, stream); launch_phase<6>(p, grid, stream); launch_phase<7>(p, grid, stream); launch_phase<8>(p, grid, stream);
#endif
}
```

```cpp
#include <hip/hip_runtime.h>
#include <hip/hip_cooperative_groups.h>
#include <cstdio>
#include <cstdint>
namespace cg = cooperative_groups;

#ifndef ONE_LAUNCH
#define ONE_LAUNCH 1
#endif

#define LAS __attribute__((address_space(3)))
typedef unsigned short bf16_t;
typedef short bf16x8 __attribute__((ext_vector_type(8)));
typedef float f32x4 __attribute__((ext_vector_type(4)));
typedef float f32x2 __attribute__((ext_vector_type(2)));
typedef unsigned u32x4 __attribute__((ext_vector_type(4)));
typedef unsigned u32x2 __attribute__((ext_vector_type(2)));

constexpr int T = 8192, D = 2048, CW = 1024, SW = 1024, NIN = 9216, NE = 16, DE = 512;
constexpr float EPS = 1e-6f;
constexpr int NTHREADS = 512, NWAVES = 8;
constexpr int LDS_BYTES = 132 * 1024;
constexpr int HID_ROWS = 2 * T + NE * 256;

constexpr size_t MiB = 1024 * 1024;
constexpr size_t WS_CTL   = 0;
constexpr size_t WS_BAR   = 4096;
constexpr size_t WS_SMALL = 64 * 1024;
constexpr size_t SM_RSTD = 0, SM_ENT = 32 * 1024, SM_W = SM_ENT + (size_t)NE * T * 4, SM_END = SM_W + (size_t)NE * T * 4;
constexpr size_t WS_WR    = WS_SMALL + 2 * MiB;
constexpr size_t WS_WINT  = WS_WR + 256 * 1024;
constexpr size_t WS_WUPT  = WS_WINT + (size_t)NIN * D * 2;
constexpr size_t WS_WOUTT = WS_WUPT + (size_t)D * D * 2;
constexpr size_t WS_W1T   = WS_WOUTT + (size_t)D * D * 2;
constexpr size_t WS_W2T   = WS_W1T + (size_t)NE * 1024 * D * 2;
constexpr size_t WS_X     = WS_W2T + (size_t)NE * D * DE * 2;
constexpr size_t WS_P     = WS_X + (size_t)T * D * 2;
constexpr size_t P_BC = 0, P_P = P_BC + (size_t)T * CW * 2, P_U = P_P + (size_t)T * CW * 2, P_V = P_U + (size_t)T * SW * 2,
                 P_R = P_V + (size_t)T * SW * 2, P_S = P_R + (size_t)T * D * 2, P_END = P_S + (size_t)T * D * 2;
constexpr size_t WS_END   = WS_P + P_END;
constexpr size_t WS_MM  = WS_WINT;
constexpr size_t WS_H   = WS_P + P_BC;
constexpr size_t WS_A2  = WS_P + P_R;
constexpr size_t WS_HID = WS_P + P_S;
constexpr size_t WS_YK0 = WS_X;
constexpr size_t WS_YK1 = WS_WINT;
static_assert(SM_END <= 2 * MiB, "small region");
static_assert((size_t)HID_ROWS * DE * 2 <= (size_t)T * D * 2, "hid overlay");
static_assert((size_t)T * D * 4 <= P_R, "H overlay");

struct Params { const float* in[20]; float* out; unsigned char* ws; };

__device__ __forceinline__ unsigned cvt_pk_bf16(float lo, float hi) { unsigned r; asm("v_cvt_pk_bf16_f32 %0, %1, %2" : "=v"(r) : "v"(lo), "v"(hi)); return r; }
__device__ __forceinline__ float bf_lo(unsigned w) { return __uint_as_float(w << 16); }
__device__ __forceinline__ float bf_hi(unsigned w) { return __uint_as_float(w & 0xffff0000u); }
__device__ __forceinline__ float bf1(bf16_t b) { return __uint_as_float(((unsigned)b) << 16); }
__device__ __forceinline__ float wave_sum(float v) {
#pragma unroll
    for (int o = 1; o < 64; o <<= 1) v += __shfl_xor(v, o);
    return v;
}
__device__ __forceinline__ float fast_rcp(float x) { return __builtin_amdgcn_rcpf(x); }
__device__ __forceinline__ float fast_exp2(float x) { return __builtin_amdgcn_exp2f(x); }
__device__ __forceinline__ float sigmoid_f(float x) { return fast_rcp(1.0f + fast_exp2(-1.44269504f * x)); }
__device__ __forceinline__ float gelu_tanh(float x) {
    const float u = x + 0.044715f * x * x * x;
    return x * fast_rcp(1.0f + fast_exp2(-2.30220819f * u));
}
__host__ __device__ __forceinline__ int perm32(int rho) { const int n = rho >> 4, i = rho & 15; return 8 * (i >> 2) + 4 * n + (i & 3); }

struct Unit { int pm, pn, e, row0, nvalid; };
constexpr int NXCD = 8, WGM = 8;
struct DenseSched {
    const bf16_t* A; const bf16_t* Bt; int K; int nM, nN, nwg, G, c;
    __device__ __forceinline__ void init(const bf16_t* A_, const bf16_t* Bt_, int M, int N, int K_) { A = A_; Bt = Bt_; K = K_; nM = M / 256; nN = N / 256; nwg = nM * nN; G = gridDim.x; c = blockIdx.x; }
    __device__ __forceinline__ bool next(int i, Unit& u) const {
        const long L = (long)i * G + c; if (L >= nwg) return false;
        int wgid = (int)L; { const int q = nwg / NXCD, r = nwg % NXCD, xcd = wgid % NXCD, off = wgid / NXCD; wgid = (xcd < r ? xcd * (q + 1) : r * (q + 1) + (xcd - r) * q) + off; }
        const int nig = WGM * nN, gid = wgid / nig, fm = gid * WGM, gsz = (nM - fm) < WGM ? (nM - fm) : WGM;
        u.pm = fm + ((wgid % nig) % gsz); u.pn = (wgid % nig) / gsz; u.e = 0; u.row0 = u.pm * 256; u.nvalid = 256; return true;
    }
    __device__ __forceinline__ const char* a_base() const { return (const char*)A; }
    __device__ __forceinline__ unsigned a_off(const Unit& u, int r) const { return (unsigned)(u.row0 + r) * (unsigned)K * 2u; }
    __device__ __forceinline__ const char* b_base(const Unit& u) const { return (const char*)Bt + (size_t)u.pn * 256 * K * 2; }
};
template <bool GATHER, int NPN, int KK, int NROWS_E  >
struct MoeSched {
    const bf16_t* A; const bf16_t* Bt; const int* cnt; const int* ent; int G, c;
    __device__ __forceinline__ bool next(int i, Unit& u) const {
        int L = i * G + c; int hb = 0;
        for (int e = 0; e < NE; ++e) {
            const int n = __builtin_amdgcn_readfirstlane(cnt[e]); const int nt = (n + 255) >> 8;
            if (L < nt * NPN) { u.e = e; u.pm = L / NPN; u.pn = L % NPN; u.row0 = hb + u.pm * 256; u.nvalid = min(256, n - u.pm * 256); return true; }
            L -= nt * NPN; hb += nt * 256;
        }
        return false;
    }
    __device__ __forceinline__ const char* a_base() const { return (const char*)A; }
    __device__ __forceinline__ unsigned a_off(const Unit& u, int r) const {
        if (GATHER) { const int tok = (r < u.nvalid) ? (ent[u.e * T + u.pm * 256 + r] & 0xffff) : 0; return (unsigned)tok * (unsigned)KK * 2u; }
        return (unsigned)(u.row0 + r) * (unsigned)KK * 2u;
    }
    __device__ __forceinline__ const char* b_base(const Unit& u) const { return (const char*)Bt + ((size_t)u.e * NROWS_E + (size_t)u.pn * 256) * KK * 2; }
};

typedef f32x4 Acc[2][2][4][2];
__device__ __forceinline__ u32x4 pack8(f32x4 a, f32x4 b) { u32x4 w; w.x = cvt_pk_bf16(a[0], a[1]); w.y = cvt_pk_bf16(a[2], a[3]); w.z = cvt_pk_bf16(b[0], b[1]); w.w = cvt_pk_bf16(b[2], b[3]); return w; }
__device__ __forceinline__ void unpack8(u32x4 w, f32x4& a, f32x4& b) { a = (f32x4){bf_lo(w.x), bf_hi(w.x), bf_lo(w.y), bf_hi(w.y)}; b = (f32x4){bf_lo(w.z), bf_hi(w.z), bf_lo(w.w), bf_hi(w.w)}; }

struct EpiProj {
    static constexpr bool PERM = true; static constexpr int MIDK = 0;
    bf16_t *Bc, *P, *U, *V, *R, *S;
    __device__ __forceinline__ void mid(Acc&, const Unit&, int, int, int, int) const {}
    __device__ __forceinline__ void operator()(const Acc& acc, const Unit& u, int wr, int wc, int fr, int fq) const {
        const int pn = u.pn; const int rowb = u.row0 + wr * 64 + fr; const int cl = wc * 32 + 8 * fq;
#pragma unroll
        for (int ai = 0; ai < 2; ++ai)
#pragma unroll
            for (int m = 0; m < 4; ++m) {
                const size_t row = (size_t)(rowb + ai * 128 + m * 16);
                if (pn < 4) {
#pragma unroll
                    for (int bj = 0; bj < 2; ++bj) *(u32x4*)(Bc + row * CW + pn * 256 + bj * 128 + cl) = pack8(acc[ai][bj][m][0], acc[ai][bj][m][1]);
                } else if (pn < 12) {
                    *(u32x4*)(P + row * CW + (pn - 4) * 128 + cl) = pack8(acc[ai][0][m][0] * acc[ai][1][m][0], acc[ai][0][m][1] * acc[ai][1][m][1]);
                } else if (pn < 20) {
                    bf16_t* O = (pn < 16) ? (U + row * SW + (pn - 12) * 256) : (V + row * SW + (pn - 16) * 256);
#pragma unroll
                    for (int bj = 0; bj < 2; ++bj) { f32x4 a = acc[ai][bj][m][0], b = acc[ai][bj][m][1];
#pragma unroll
                        for (int j = 0; j < 4; ++j) { a[j] = gelu_tanh(a[j]); b[j] = gelu_tanh(b[j]); }
                        *(u32x4*)(O + bj * 128 + cl) = pack8(a, b); }
                } else {
                    f32x4 r0, r1, s0, s1;
#pragma unroll
                    for (int j = 0; j < 4; ++j) {
                        const float ec0 = fast_exp2(-1.44269504f * acc[ai][0][m][0][j]), es0 = fast_exp2(-1.44269504f * acc[ai][1][m][0][j]);
                        const float ec1 = fast_exp2(-1.44269504f * acc[ai][0][m][1][j]), es1 = fast_exp2(-1.44269504f * acc[ai][1][m][1][j]);
                        r0[j] = (1.0f + es0) * fast_rcp(1.0f + ec0); s0[j] = fast_rcp(1.0f + es0);
                        r1[j] = (1.0f + es1) * fast_rcp(1.0f + ec1); s1[j] = fast_rcp(1.0f + es1);
                    }
                    const size_t o = row * D + (pn - 20) * 128 + cl;
                    *(u32x4*)(R + o) = pack8(r0, r1); *(u32x4*)(S + o) = pack8(s0, s1);
                }
            }
    }
};
struct EpiUp {
    static constexpr bool PERM = true; static constexpr int MIDK = 1024;
    const bf16_t *R, *S; bf16_t* Mm;
    __device__ __forceinline__ void mid(Acc& acc, const Unit& u, int wr, int wc, int fr, int fq) const {
        int rowb = u.row0 + wr * 64 + fr; const int cb = u.pn * 256 + wc * 32 + 8 * fq;
        asm volatile("" : "+v"(rowb));
#pragma unroll
        for (int ai = 0; ai < 2; ++ai)
#pragma unroll
            for (int m = 0; m < 4; ++m)
#pragma unroll
                for (int bj = 0; bj < 2; ++bj) { f32x4 a, b; unpack8(*(const u32x4*)(R + (size_t)(rowb + ai * 128 + m * 16) * D + cb + bj * 128), a, b);
                    acc[ai][bj][m][0] *= a; acc[ai][bj][m][1] *= b; }
    }
    __device__ __forceinline__ void operator()(const Acc& acc, const Unit& u, int wr, int wc, int fr, int fq) const {
        const int rowb = u.row0 + wr * 64 + fr; const int cb = u.pn * 256 + wc * 32 + 8 * fq;
#pragma unroll
        for (int ai = 0; ai < 2; ++ai)
#pragma unroll
            for (int m = 0; m < 4; ++m)
#pragma unroll
                for (int bj = 0; bj < 2; ++bj) { const size_t o = (size_t)(rowb + ai * 128 + m * 16) * D + cb + bj * 128; f32x4 a, b; unpack8(*(const u32x4*)(S + o), a, b);
                    *(u32x4*)(Mm + o) = pack8(acc[ai][bj][m][0] * a, acc[ai][bj][m][1] * b); }
    }
};
struct EpiOut {
    static constexpr bool PERM = false; static constexpr int MIDK = 0;
    const float* x; const float* g; float* H; bf16_t* A2;
    __device__ __forceinline__ void mid(Acc&, const Unit&, int, int, int, int) const {}
    __device__ __forceinline__ void operator()(const Acc& acc, const Unit& u, int wr, int wc, int fr, int fq) const {
        const int rowb = u.row0 + wr * 64 + fr; const int cb = u.pn * 256 + wc * 32 + 4 * fq;
#pragma unroll
        for (int ai = 0; ai < 2; ++ai)
#pragma unroll
            for (int m = 0; m < 4; ++m)
#pragma unroll
                for (int bj = 0; bj < 2; ++bj)
#pragma unroll
                    for (int n = 0; n < 2; ++n) { const int col = cb + bj * 128 + n * 16; const size_t o = (size_t)(rowb + ai * 128 + m * 16) * D + col;
                        const f32x4 h = *(const f32x4*)(x + o) + acc[ai][bj][m][n]; *(f32x4*)(H + o) = h; const f32x4 gg = *(const f32x4*)(g + col);
                        u32x2 w; w.x = cvt_pk_bf16(h[0] * gg[0], h[1] * gg[1]); w.y = cvt_pk_bf16(h[2] * gg[2], h[3] * gg[3]); *(u32x2*)(A2 + o) = w; }
    }
};
struct EpiMoe1 {
    static constexpr bool PERM = true; static constexpr int MIDK = 0;
    const int* ent; const float* lw; const float* rstd; bf16_t* Hid;
    __device__ __forceinline__ void mid(Acc&, const Unit&, int, int, int, int) const {}
    __device__ __forceinline__ void operator()(const Acc& acc, const Unit& u, int wr, int wc, int fr, int fq) const {
        const int cl = u.pn * 128 + wc * 32 + 8 * fq;
#pragma unroll
        for (int ai = 0; ai < 2; ++ai)
#pragma unroll
            for (int m = 0; m < 4; ++m) {
                const int r = ai * 128 + wr * 64 + m * 16 + fr;
                if (r < u.nvalid) {
                    const int li = u.e * T + u.pm * 256 + r; const int tok = ent[li] & 0xffff; const float rs = rstd[tok], w = lw[li];
                    f32x4 o[2];
#pragma unroll
                    for (int n = 0; n < 2; ++n)
#pragma unroll
                        for (int j = 0; j < 4; ++j) { const float gt = acc[ai][0][m][n][j] * rs, up = acc[ai][1][m][n][j] * rs; o[n][j] = gt * sigmoid_f(gt) * up * w; }
                    *(u32x4*)(Hid + (size_t)(u.row0 + r) * DE + cl) = pack8(o[0], o[1]);
                }
            }
    }
};
struct EpiMoe2 {
    static constexpr bool PERM = true; static constexpr int MIDK = 0;
    const int* ent; bf16_t* Yk0; bf16_t* Yk1;
    __device__ __forceinline__ void mid(Acc&, const Unit&, int, int, int, int) const {}
    __device__ __forceinline__ void operator()(const Acc& acc, const Unit& u, int wr, int wc, int fr, int fq) const {
        const int cb = u.pn * 256 + wc * 32 + 8 * fq;
#pragma unroll
        for (int ai = 0; ai < 2; ++ai)
#pragma unroll
            for (int m = 0; m < 4; ++m) {
                const int r = ai * 128 + wr * 64 + m * 16 + fr;
                if (r < u.nvalid) {
                    const int en = ent[u.e * T + u.pm * 256 + r]; const int tok = en & 0xffff; bf16_t* Y = (en >> 16) ? Yk1 : Yk0;
#pragma unroll
                    for (int bj = 0; bj < 2; ++bj) *(u32x4*)(Y + (size_t)tok * D + cb + bj * 128) = pack8(acc[ai][bj][m][0], acc[ai][bj][m][1]);
                }
            }
    }
};

template <class Epi, class Sched>
__device__ __forceinline__ void gemm_simple(const Sched& S, const Epi& E, const int K) {
    const int tid = threadIdx.x, wid = __builtin_amdgcn_readfirstlane(tid >> 6), lane = tid & 63, wr = wid >> 2, wc = wid & 3, fr = lane & 15, fq = lane >> 4;
    Unit u;
    for (int ui = 0; S.next(ui, u); ++ui) {
        Acc acc;
#pragma unroll
        for (int a = 0; a < 2; ++a)
#pragma unroll
            for (int b = 0; b < 2; ++b)
#pragma unroll
                for (int m = 0; m < 4; ++m)
#pragma unroll
                    for (int n = 0; n < 2; ++n) acc[a][b][m][n] = (f32x4){0.f, 0.f, 0.f, 0.f};
        const char* ab = S.a_base(); const char* bb = S.b_base(u);
        unsigned aoff[2][4], boff[2][2];
#pragma unroll
        for (int ai = 0; ai < 2; ++ai)
#pragma unroll
            for (int m = 0; m < 4; ++m) aoff[ai][m] = S.a_off(u, ai * 128 + wr * 64 + m * 16 + fr) + fq * 16;
#pragma unroll
        for (int bj = 0; bj < 2; ++bj)
#pragma unroll
            for (int n = 0; n < 2; ++n) { const int rr = Epi::PERM ? perm32(n * 16 + fr) : (n * 16 + fr); boff[bj][n] = (unsigned)(bj * 128 + wc * 32 + rr) * (unsigned)K * 2u + fq * 16; }
        for (int k0 = 0; k0 < K; k0 += 32) {
            if (Epi::MIDK != 0 && k0 == Epi::MIDK) E.mid(acc, u, wr, wc, fr, fq);
            bf16x8 a[2][4], b[2][2];
#pragma unroll
            for (int ai = 0; ai < 2; ++ai)
#pragma unroll
                for (int m = 0; m < 4; ++m) a[ai][m] = *(const bf16x8*)(ab + aoff[ai][m] + k0 * 2);
#pragma unroll
            for (int bj = 0; bj < 2; ++bj)
#pragma unroll
                for (int n = 0; n < 2; ++n) b[bj][n] = *(const bf16x8*)(bb + boff[bj][n] + k0 * 2);
#pragma unroll
            for (int ai = 0; ai < 2; ++ai)
#pragma unroll
                for (int bj = 0; bj < 2; ++bj)
#pragma unroll
                    for (int m = 0; m < 4; ++m)
#pragma unroll
                        for (int n = 0; n < 2; ++n) acc[ai][bj][m][n] = __builtin_amdgcn_mfma_f32_16x16x32_bf16(b[bj][n], a[ai][m], acc[ai][bj][m][n], 0, 0, 0);
        }
        E(acc, u, wr, wc, fr, fq);
    }
}

constexpr int BK = 64, HALF = 128, HTB = HALF * BK * 2, STAGE_BYTES = 8 * HTB;
__host__ __device__ __forceinline__ int lds_byte(int r, int c) { const int st = (r >> 4) * 2 + (c >> 5), rr = r & 15, cc = c & 31, ob = rr * 64 + cc * 2; return st * 1024 + (ob ^ (((ob >> 9) & 1) << 5)); }
__host__ __device__ __forceinline__ void stage_rc(int b, int& R, int& C) { const int st = b / 1024, sb = b % 1024, swz = sb ^ (((sb >> 9) & 1) << 5); R = (st >> 1) * 16 + swz / 64; C = (st & 1) * 32 + (swz % 64) / 2; }

template <class Epi, class Sched>
__device__ __forceinline__ void gemm_fast(LAS unsigned char* lds, const Sched& S, const Epi& E, const int K) {
    const int tid = threadIdx.x, wid = __builtin_amdgcn_readfirstlane(tid >> 6), lane = tid & 63, wr = wid >> 2, wc = wid & 3, fr = lane & 15, fq = lane >> 4;
    const int nt = K / BK;
    int sR[2], sC[2]; unsigned voffB[2];
#pragma unroll
    for (int i = 0; i < 2; ++i) { stage_rc(tid * 16 + i * 8192, sR[i], sC[i]); const int Rb = Epi::PERM ? ((sR[i] & ~31) + perm32(sR[i] & 31)) : sR[i]; voffB[i] = (unsigned)(Rb * K + sC[i]) * 2u; }
    const size_t kstep = (size_t)(BK * 2);
    const size_t hstepB = (size_t)HALF * K * 2;
    const unsigned ldsw = (unsigned)wid * 1024u;
    const int aoff = lds_byte(wr * 64 + fr, fq * 8), boff = lds_byte(wc * 32 + fr, fq * 8);
#define PG8_SA(b, h) (((b) * 2 + (h)) * HTB)
#define PG8_SB(b, h) ((4 + (b) * 2 + (h)) * HTB)
#define PG8_STAGE(bufoff, gbase, voff) do { _Pragma("unroll") for (int _i = 0; _i < 2; ++_i) \
        __builtin_amdgcn_global_load_lds((const unsigned*)((const char*)(gbase) + (voff)[_i]), (LAS unsigned*)(lds + (bufoff) + ldsw + _i * 8192), 16, 0, 0); } while (0)
#define PG8_LDA(dst, b, h) do { _Pragma("unroll") for (int m = 0; m < 4; ++m) _Pragma("unroll") for (int k = 0; k < 2; ++k) dst[m][k] = *(const LAS bf16x8*)(lds + PG8_SA(b, h) + aoff + m * 2048 + k * 1024); } while (0)
#define PG8_LDB(dst, b, h) do { _Pragma("unroll") for (int n = 0; n < 2; ++n) _Pragma("unroll") for (int k = 0; k < 2; ++k) dst[n][k] = *(const LAS bf16x8*)(lds + PG8_SB(b, h) + boff + n * 2048 + k * 1024); } while (0)
#define PG8_MMA(ai, bj, At, Bt) do { __builtin_amdgcn_s_setprio(1); _Pragma("unroll") for (int m = 0; m < 4; ++m) _Pragma("unroll") for (int n = 0; n < 2; ++n) _Pragma("unroll") for (int k = 0; k < 2; ++k) \
        acc[ai][bj][m][n] = __builtin_amdgcn_mfma_f32_16x16x32_bf16(Bt[n][k], At[m][k], acc[ai][bj][m][n], 0, 0, 0); __builtin_amdgcn_s_setprio(0); } while (0)
#define PG8_WAIT_V(n) asm volatile("s_waitcnt vmcnt(" #n ")" ::: "memory")
#define PG8_WAIT_L(n) asm volatile("s_waitcnt lgkmcnt(" #n ")" ::: "memory")
#define PG8_BAR __builtin_amdgcn_s_barrier()
#define PG8_SCHED __builtin_amdgcn_sched_barrier(0)
    Unit cur, nxt; int ui = 0;
    if (!S.next(0, cur)) return;
    Acc acc;
#pragma unroll
    for (int a = 0; a < 2; ++a)
#pragma unroll
        for (int b = 0; b < 2; ++b)
#pragma unroll
            for (int m = 0; m < 4; ++m)
#pragma unroll
                for (int n = 0; n < 2; ++n) acc[a][b][m][n] = (f32x4){0.f, 0.f, 0.f, 0.f};
    bf16x8 At[4][2], B0[2][2], B1[2][2];
    unsigned va[2][2], vn[2][2];
#pragma unroll
    for (int h = 0; h < 2; ++h)
#pragma unroll
        for (int i = 0; i < 2; ++i) va[h][i] = S.a_off(cur, h * 128 + sR[i]) + (unsigned)sC[i] * 2u;
    const char* const A0 = S.a_base(); const char* cB = S.b_base(cur);
    PG8_STAGE(PG8_SB(0, 0), cB, voffB); PG8_STAGE(PG8_SB(0, 1), cB + hstepB, voffB); PG8_STAGE(PG8_SA(0, 0), A0, va[0]); PG8_STAGE(PG8_SA(0, 1), A0, va[1]);
    if (wr == 1) PG8_BAR;
    PG8_WAIT_V(2); PG8_BAR;
    PG8_STAGE(PG8_SB(1, 0), cB + kstep, voffB); PG8_STAGE(PG8_SA(1, 0), A0 + kstep, va[0]); PG8_STAGE(PG8_SB(1, 1), cB + hstepB + kstep, voffB);
    PG8_WAIT_V(6); PG8_BAR;
    for (;;) {
        const bool has_next = S.next(ui + 1, nxt);
        const char* nB = has_next ? S.b_base(nxt) : cB;
#pragma unroll
        for (int h = 0; h < 2; ++h)
#pragma unroll
            for (int i = 0; i < 2; ++i) vn[h][i] = has_next ? (S.a_off(nxt, h * 128 + sR[i]) + (unsigned)sC[i] * 2u) : va[h][i];
        for (int t = 0; t < nt; t += 2) {
            const bool last = (t == nt - 2);
            if (Epi::MIDK != 0 && t * BK == Epi::MIDK) { PG8_SCHED; E.mid(acc, cur, wr, wc, fr, fq); PG8_SCHED; }
            const char* a1 = A0 + (size_t)(t + 1) * kstep;
            const char* a2 = last ? A0 : A0 + (size_t)(t + 2) * kstep; const char* b2 = last ? nB : cB + (size_t)(t + 2) * kstep;
            const char* a3 = a2 + kstep; const char* b3 = b2 + kstep;
            unsigned v2[2][2];
#pragma unroll
            for (int h = 0; h < 2; ++h)
#pragma unroll
                for (int i = 0; i < 2; ++i) v2[h][i] = last ? vn[h][i] : va[h][i];
            PG8_LDB(B0, 0, 0); PG8_LDB(B1, 0, 1); PG8_SCHED; PG8_LDA(At, 0, 0); PG8_STAGE(PG8_SA(1, 1), a1, va[1]);
            PG8_WAIT_V(8); PG8_WAIT_L(0); PG8_BAR; PG8_MMA(0, 0, At, B0); PG8_MMA(0, 1, At, B1); PG8_BAR; PG8_SCHED;
            PG8_LDA(At, 0, 1); PG8_STAGE(PG8_SB(0, 0), b2, voffB); PG8_STAGE(PG8_SB(0, 1), b2 + hstepB, voffB); PG8_STAGE(PG8_SA(0, 0), a2, v2[0]);
            PG8_WAIT_V(8); PG8_WAIT_L(0); PG8_BAR; PG8_MMA(1, 0, At, B0); PG8_MMA(1, 1, At, B1); PG8_BAR; PG8_SCHED;
            PG8_LDB(B0, 1, 0); PG8_LDB(B1, 1, 1); PG8_SCHED; PG8_LDA(At, 1, 0); PG8_STAGE(PG8_SA(0, 1), a2, v2[1]);
            PG8_WAIT_V(8); PG8_WAIT_L(0); PG8_BAR; PG8_MMA(0, 0, At, B0); PG8_MMA(0, 1, At, B1); PG8_BAR; PG8_SCHED;
            PG8_LDA(At, 1, 1); PG8_STAGE(PG8_SB(1, 0), b3, voffB); PG8_STAGE(PG8_SB(1, 1), b3 + hstepB, voffB); PG8_STAGE(PG8_SA(1, 0), a3, v2[0]);
            PG8_WAIT_V(8); PG8_WAIT_L(0); PG8_BAR; PG8_MMA(1, 0, At, B0); PG8_MMA(1, 1, At, B1); PG8_BAR; PG8_SCHED;
        }
        if (wr == 0) PG8_BAR;
        E(acc, cur, wr, wc, fr, fq);
        if (!has_next) break;
#pragma unroll
        for (int a = 0; a < 2; ++a)
#pragma unroll
            for (int b = 0; b < 2; ++b)
#pragma unroll
                for (int m = 0; m < 4; ++m)
#pragma unroll
                    for (int n = 0; n < 2; ++n) acc[a][b][m][n] = (f32x4){0.f, 0.f, 0.f, 0.f};
        cur = nxt; cB = nB; ++ui;
#pragma unroll
        for (int h = 0; h < 2; ++h)
#pragma unroll
            for (int i = 0; i < 2; ++i) va[h][i] = vn[h][i];
        if (wr == 1) PG8_BAR;
    }
    PG8_WAIT_V(0);
    PG8_BAR;
#undef PG8_SA
#undef PG8_SB
#undef PG8_STAGE
#undef PG8_LDA
#undef PG8_LDB
#undef PG8_MMA
#undef PG8_WAIT_V
#undef PG8_WAIT_L
#undef PG8_BAR
#undef PG8_SCHED
}
#ifndef FAST_MASK
#define FAST_MASK 0x1f
#endif
template <int BIT, class Epi, class Sched>
__device__ __forceinline__ void gemm_run(LAS unsigned char* lds, const Sched& S, const Epi& E, const int K) {
    if constexpr ((FAST_MASK >> BIT) & 1) gemm_fast(lds, S, E, K); else gemm_simple(S, E, K);
}

__device__ __forceinline__ void tr_item(const float* W, int N, int k0, int ns, bf16_t* WT, int ldk, int nd, int kd, LAS float* scr, int lane) {
#pragma unroll 8
    for (int i = 0; i < 32; ++i) { const int kk = 2 * i + (lane >> 5); scr[kk * 33 + (lane & 31)] = W[(size_t)(k0 + kk) * N + ns + (lane & 31)]; }
    asm volatile("s_waitcnt lgkmcnt(0)" ::: "memory");
    const int c = lane & 7;
#pragma unroll
    for (int j = 0; j < 4; ++j) { const int n = (lane >> 3) + 8 * j; const LAS float* s = scr + (8 * c) * 33 + n;
        u32x4 o; o.x = cvt_pk_bf16(s[0 * 33], s[1 * 33]); o.y = cvt_pk_bf16(s[2 * 33], s[3 * 33]); o.z = cvt_pk_bf16(s[4 * 33], s[5 * 33]); o.w = cvt_pk_bf16(s[6 * 33], s[7 * 33]);
        *(u32x4*)(WT + (size_t)(nd + n) * ldk + kd + 8 * c) = o; }
    asm volatile("s_waitcnt lgkmcnt(0)" ::: "memory");
}
__device__ __forceinline__ int win_src_col(int nd) {
    if (nd < 1024) return nd;
    if (nd < 3072) { const int q = (nd - 1024) >> 8, r = (nd - 1024) & 255; return r < 128 ? (1024 + 128 * q + r) : (2048 + 128 * q + r - 128); }
    if (nd < 5120) return nd;
    { const int q = (nd - 5120) >> 8, r = (nd - 5120) & 255; return r < 128 ? (5120 + 128 * q + r) : (7168 + 128 * q + r - 128); }
}
__device__ __forceinline__ void phase0(const Params& p, LAS unsigned char* lds) {
    const int tid = threadIdx.x, wave = __builtin_amdgcn_readfirstlane(tid >> 6), lane = tid & 63;
    LAS float* scr = (LAS float*)(lds + wave * 8704);
    const int gw = blockIdx.x * NWAVES + wave, NGW = gridDim.x * NWAVES;
    unsigned char* ws = p.ws;
    constexpr int I_IN = 32 * 288, I_UP = 16 * 64, I_OUT = 32 * 64, I_G = 32 * 16 * NE, I_D = 8 * 64 * NE;
    constexpr int NITEMS = I_IN + 2 * I_UP + I_OUT + 2 * I_G + I_D;
    for (int it = gw; it < NITEMS; it += NGW) {
        int r = it;
        if (r < I_IN) { const int kb = r / 288, nb = r % 288; tr_item(p.in[2], NIN, kb * 64, win_src_col(nb * 32), (bf16_t*)(ws + WS_WINT), D, nb * 32, kb * 64, scr, lane); continue; } r -= I_IN;
        if (r < I_UP) { const int kb = r / 64, nb = r % 64; tr_item(p.in[8], D, kb * 64, nb * 32, (bf16_t*)(ws + WS_WUPT), 2048, nb * 32, kb * 64, scr, lane); continue; } r -= I_UP;
        if (r < I_UP) { const int kb = r / 64, nb = r % 64; tr_item(p.in[9], D, kb * 64, nb * 32, (bf16_t*)(ws + WS_WUPT), 2048, nb * 32, 1024 + kb * 64, scr, lane); continue; } r -= I_UP;
        if (r < I_OUT) { const int kb = r / 64, nb = r % 64; tr_item(p.in[10], D, kb * 64, nb * 32, (bf16_t*)(ws + WS_WOUTT), D, nb * 32, kb * 64, scr, lane); continue; } r -= I_OUT;
        if (r < 2 * I_G) { const int up = r >= I_G; if (up) r -= I_G; const int e = r / 512, q = r % 512, kb = q / 16, nb = q % 16;
            const int nd = 256 * (nb >> 2) + (nb & 3) * 32 + (up ? 128 : 0);
            tr_item(p.in[up ? 17 : 16] + (size_t)e * D * DE, DE, kb * 64, nb * 32, (bf16_t*)(ws + WS_W1T) + (size_t)e * 1024 * D, D, nd, kb * 64, scr, lane); continue; } r -= 2 * I_G;
        { const int e = r / 512, q = r % 512, kb = q / 64, nb = q % 64;
            tr_item(p.in[18] + (size_t)e * DE * D, D, kb * 64, nb * 32, (bf16_t*)(ws + WS_W2T) + (size_t)e * D * DE, DE, nb * 32, kb * 64, scr, lane); }
    }
    const float* x = p.in[0]; const float* g = p.in[1]; bf16_t* xn = (bf16_t*)(ws + WS_X);
    for (int m = gw; m < T; m += NGW) {
        const f32x4* xr = (const f32x4*)(x + (size_t)m * D) + lane; f32x4 v[8]; float s = 0.f;
#pragma unroll
        for (int j = 0; j < 8; ++j) { v[j] = xr[64 * j]; s += (v[j][0] * v[j][0] + v[j][1] * v[j][1]) + (v[j][2] * v[j][2] + v[j][3] * v[j][3]); }
        const float rs = 1.0f / sqrtf(wave_sum(s) * (1.0f / D) + EPS);
        u32x2* o = (u32x2*)(xn + (size_t)m * D) + lane;
#pragma unroll
        for (int j = 0; j < 8; ++j) { const f32x4 gg = *((const f32x4*)g + lane + 64 * j); u32x2 w; w.x = cvt_pk_bf16(v[j][0] * rs * gg[0], v[j][1] * rs * gg[1]); w.y = cvt_pk_bf16(v[j][2] * rs * gg[2], v[j][3] * rs * gg[3]); o[64 * j] = w; }
    }
    float* wr = (float*)(ws + WS_WR); const float* gf = p.in[11];
    for (int i = blockIdx.x * NTHREADS + tid; i < 20 * D; i += gridDim.x * NTHREADS) { const int j = i / D, d = i % D; wr[i] = gf[d] * (j < 4 ? p.in[12][d * 4 + j] : p.in[14][d * 16 + (j - 4)]); }
    if (blockIdx.x == 0 && tid < 64) ((int*)(ws + WS_CTL))[tid] = 0;
}

__device__ __forceinline__ void phase2_conv(const Params& p) {
    const bf16_t* Bc = (const bf16_t*)(p.ws + WS_P + P_BC); const bf16_t* P = (const bf16_t*)(p.ws + WS_P + P_P); bf16_t* Y = (bf16_t*)(p.ws + WS_X);
    const float* cw = p.in[3];
    for (int i = blockIdx.x * NTHREADS + threadIdx.x; i < T * (CW / 8); i += gridDim.x * NTHREADS) {
        const int t = i >> 7, c = (i & 127) * 8;
        f32x4 p0a, p0b, p1a, p1b, p2a, p2b, ba, bb;
        unpack8(*(const u32x4*)(P + (size_t)t * CW + c), p2a, p2b); unpack8(*(const u32x4*)(Bc + (size_t)t * CW + c), ba, bb);
        if (t >= 1) unpack8(*(const u32x4*)(P + (size_t)(t - 1) * CW + c), p1a, p1b); else { p1a = (f32x4){0, 0, 0, 0}; p1b = p1a; }
        if (t >= 2) unpack8(*(const u32x4*)(P + (size_t)(t - 2) * CW + c), p0a, p0b); else { p0a = (f32x4){0, 0, 0, 0}; p0b = p0a; }
        const f32x4 w0a = *(const f32x4*)(cw + c), w0b = *(const f32x4*)(cw + c + 4), w1a = *(const f32x4*)(cw + CW + c), w1b = *(const f32x4*)(cw + CW + c + 4),
                    w2a = *(const f32x4*)(cw + 2 * CW + c), w2b = *(const f32x4*)(cw + 2 * CW + c + 4);
        const f32x4 ya = ba * (w0a * p0a + w1a * p1a + w2a * p2a), yb = bb * (w0b * p0b + w1b * p1b + w2b * p2b);
        *(u32x4*)(Y + (size_t)t * 2048 + c) = pack8(ya, yb);
    }
}
__device__ __forceinline__ void phase2_sgu(const Params& p, LAS unsigned char* lds) {
    const int tid = threadIdx.x, wave = __builtin_amdgcn_readfirstlane(tid >> 6), lane = tid & 63;
    const bf16_t* U = (const bf16_t*)(p.ws + WS_P + P_U); const bf16_t* V = (const bf16_t*)(p.ws + WS_P + P_V); bf16_t* Y = (bf16_t*)(p.ws + WS_X);
    const float* lng = p.in[4]; const float* lnb = p.in[5]; const float* Ws = p.in[6]; const float* bs = p.in[7];
    LAS f32x2* st = (LAS f32x2*)lds;
    LAS float* vn = (LAS float*)(lds + 1024);
    for (int unit = blockIdx.x; unit < 64 * 8; unit += gridDim.x) {
        const int nb = unit >> 3, h = unit & 7, t0 = nb * 128, c0 = h * 128;
        __syncthreads();
        for (int jj = 0; jj < 16; ++jj) { const int j = wave * 16 + jj; const u32x4* vr = (const u32x4*)(V + (size_t)(t0 + j) * SW) + lane * 2;
            f32x4 a, b, c, d; unpack8(vr[0], a, b); unpack8(vr[1], c, d);
            float s = (a[0] + a[1] + a[2] + a[3]) + (b[0] + b[1] + b[2] + b[3]) + (c[0] + c[1] + c[2] + c[3]) + (d[0] + d[1] + d[2] + d[3]);
            const float mu = wave_sum(s) * (1.0f / SW);
            a -= mu; b -= mu; c -= mu; d -= mu;
            float q = (a[0] * a[0] + a[1] * a[1] + a[2] * a[2] + a[3] * a[3]) + (b[0] * b[0] + b[1] * b[1] + b[2] * b[2] + b[3] * b[3]) + (c[0] * c[0] + c[1] * c[1] + c[2] * c[2] + c[3] * c[3]) + (d[0] * d[0] + d[1] * d[1] + d[2] * d[2] + d[3] * d[3]);
            const float rs = 1.0f / sqrtf(wave_sum(q) * (1.0f / SW) + EPS);
            if (lane == 0) st[j] = (f32x2){mu, rs}; }
        __syncthreads();
        for (int q = tid; q < 128 * 16; q += NTHREADS) { const int j = q >> 4, c = (q & 15) * 8; const f32x2 s = st[j];
            f32x4 a, b; unpack8(*(const u32x4*)(V + (size_t)(t0 + j) * SW + c0 + c), a, b);
            const f32x4 g0 = *(const f32x4*)(lng + c0 + c), g1 = *(const f32x4*)(lng + c0 + c + 4), b0 = *(const f32x4*)(lnb + c0 + c), b1 = *(const f32x4*)(lnb + c0 + c + 4);
            a = (a - s.x) * s.y * g0 + b0; b = (b - s.x) * s.y * g1 + b1;
            *(LAS f32x4*)(vn + j * 128 + c) = a; *(LAS f32x4*)(vn + j * 128 + c + 4) = b; }
        __syncthreads();
        for (int ii = 0; ii < 16; ++ii) { const int i = wave * 16 + ii; const int jmax = (i < 64) ? 64 : 128; const float* wrow = Ws + ((size_t)h * 128 + i) * 128;
            float a0 = 0.f, a1 = 0.f;
            for (int j = 0; j < jmax; ++j) { const float w = wrow[j]; a0 += w * vn[j * 128 + lane]; a1 += w * vn[j * 128 + lane + 64]; }
            const float bb = bs[h * 128 + i]; const size_t t = (size_t)(t0 + i);
            const float u0 = bf1(U[t * SW + c0 + lane]), u1 = bf1(U[t * SW + c0 + lane + 64]);
            Y[t * 2048 + 1024 + c0 + lane] = (bf16_t)(cvt_pk_bf16(u0 * (a0 + bb), 0.f) & 0xffff); Y[t * 2048 + 1024 + c0 + lane + 64] = (bf16_t)(cvt_pk_bf16(u1 * (a1 + bb), 0.f) & 0xffff); }
    }
}

__device__ __forceinline__ void phase5_router(const Params& p, LAS unsigned char* lds) {
    const int tid = threadIdx.x, wave = __builtin_amdgcn_readfirstlane(tid >> 6), lane = tid & 63;
    const float* H = (const float*)(p.ws + WS_H); const float* wr = (const float*)(p.ws + WS_WR);
    float* rstd = (float*)(p.ws + WS_SMALL + SM_RSTD); int* ent = (int*)(p.ws + WS_SMALL + SM_ENT); float* lw = (float*)(p.ws + WS_SMALL + SM_W); int* cnt = (int*)(p.ws + WS_CTL);
    const float* brg = p.in[13]; const float* bre = p.in[15];
    LAS int* lcnt = (LAS int*)lds;
    LAS int* lbase = (LAS int*)(lds + 64);
    LAS int* le = (LAS int*)(lds + 128);
    LAS int* lp = (LAS int*)(lds + 128 + 256);
    LAS float* lwt = (LAS float*)(lds + 128 + 512);
    const int ngroups = T / 4, nrounds = (ngroups + gridDim.x * NWAVES - 1) / (gridDim.x * NWAVES);
    for (int rd = 0; rd < nrounds; ++rd) {
        const int grp = (rd * gridDim.x + blockIdx.x) * NWAVES + wave; const bool valid = grp < ngroups;
        if (tid < 16) lcnt[tid] = 0;
        __syncthreads();
        if (valid) {
            const int t0 = grp * 4;
            float acc[4][20]; float ss[4];
#pragma unroll
            for (int t = 0; t < 4; ++t) { ss[t] = 0.f;
#pragma unroll
                for (int j = 0; j < 20; ++j) acc[t][j] = 0.f; }
            for (int kc = 0; kc < 8; ++kc) {
                const int k = kc * 256 + lane * 4; f32x4 hv[4];
#pragma unroll
                for (int t = 0; t < 4; ++t) { hv[t] = *(const f32x4*)(H + (size_t)(t0 + t) * D + k); ss[t] += (hv[t][0] * hv[t][0] + hv[t][1] * hv[t][1]) + (hv[t][2] * hv[t][2] + hv[t][3] * hv[t][3]); }
#pragma unroll
                for (int j = 0; j < 20; ++j) { const f32x4 w = *(const f32x4*)(wr + (size_t)j * D + k);
#pragma unroll
                    for (int t = 0; t < 4; ++t) acc[t][j] += (hv[t][0] * w[0] + hv[t][1] * w[1]) + (hv[t][2] * w[2] + hv[t][3] * w[3]); }
            }
#pragma unroll
            for (int t = 0; t < 4; ++t) { ss[t] = wave_sum(ss[t]);
#pragma unroll
                for (int j = 0; j < 20; ++j) acc[t][j] = wave_sum(acc[t][j]); }
#pragma unroll
            for (int t = 0; t < 4; ++t) {
                const float rs = 1.0f / sqrtf(ss[t] * (1.0f / D) + EPS);
                float lg[4];
#pragma unroll
                for (int j = 0; j < 4; ++j) lg[j] = acc[t][j] * rs + brg[j];
                int gi = 0; float gm = lg[0];
#pragma unroll
                for (int j = 1; j < 4; ++j) if (lg[j] > gm) { gm = lg[j]; gi = j; }
                float den = 0.f;
#pragma unroll
                for (int j = 0; j < 4; ++j) den += __expf(lg[j] - gm);
                const float pg = 1.0f / den;
                float le4[4];
#pragma unroll
                for (int j = 0; j < 4; ++j) { const float v0 = acc[t][4 + j], v1 = acc[t][8 + j], v2 = acc[t][12 + j], v3 = acc[t][16 + j];
                    const float v = gi == 0 ? v0 : (gi == 1 ? v1 : (gi == 2 ? v2 : v3)); le4[j] = v * rs + bre[gi * 4 + j]; }
                int i1 = 0; float m1 = le4[0];
#pragma unroll
                for (int j = 1; j < 4; ++j) if (le4[j] > m1) { m1 = le4[j]; i1 = j; }
                int i2 = -1; float m2 = -3.0e38f;
#pragma unroll
                for (int j = 0; j < 4; ++j) if (j != i1 && le4[j] > m2) { m2 = le4[j]; i2 = j; }
                const float ex = __expf(m2 - m1); const float w1 = pg / (1.0f + ex), w2 = pg * ex / (1.0f + ex);
                if (lane == 0) {
                    rstd[t0 + t] = rs;
                    const int e1 = gi * 4 + i1, e2 = gi * 4 + i2; const int s = (wave * 4 + t) * 2;
                    le[s] = e1; le[s + 1] = e2; lwt[s] = w1; lwt[s + 1] = w2;
                    lp[s] = atomicAdd((int*)&lcnt[e1], 1); lp[s + 1] = atomicAdd((int*)&lcnt[e2], 1);
                }
            }
        }
        __syncthreads();
        if (tid < 16) { const int n = lcnt[tid]; lbase[tid] = n ? atomicAdd(&cnt[tid], n) : 0; }
        __syncthreads();
        if (valid && lane < 8) { const int s = wave * 8 + lane; const int e = le[s]; const int pos = lbase[e] + lp[s]; const int tok = grp * 4 + (lane >> 1);
            ent[e * T + pos] = tok | ((lane & 1) << 16); lw[e * T + pos] = lwt[s]; }
        __syncthreads();
    }
}

__device__ __forceinline__ void phase8_final(const Params& p) {
    const int tid = threadIdx.x, wave = __builtin_amdgcn_readfirstlane(tid >> 6), lane = tid & 63;
    const float* H = (const float*)(p.ws + WS_H); const bf16_t* Y0 = (const bf16_t*)(p.ws + WS_YK0); const bf16_t* Y1 = (const bf16_t*)(p.ws + WS_YK1); const float* g = p.in[19];
    const int gw = blockIdx.x * NWAVES + wave, NGW = gridDim.x * NWAVES;
    for (int m = gw; m < T; m += NGW) {
        f32x4 v[8]; float s = 0.f;
#pragma unroll
        for (int j = 0; j < 8; ++j) { const size_t o = (size_t)m * D + 4 * lane + 256 * j; v[j] = *(const f32x4*)(H + o);
            const u32x2 a = *(const u32x2*)(Y0 + o), b = *(const u32x2*)(Y1 + o);
            v[j][0] += bf_lo(a.x) + bf_lo(b.x); v[j][1] += bf_hi(a.x) + bf_hi(b.x); v[j][2] += bf_lo(a.y) + bf_lo(b.y); v[j][3] += bf_hi(a.y) + bf_hi(b.y);
            s += (v[j][0] * v[j][0] + v[j][1] * v[j][1]) + (v[j][2] * v[j][2] + v[j][3] * v[j][3]); }
        const float rs = 1.0f / sqrtf(wave_sum(s) * (1.0f / D) + EPS);
#pragma unroll
        for (int j = 0; j < 8; ++j) { const int c = 4 * lane + 256 * j; const f32x4 gg = *(const f32x4*)(g + c); *(f32x4*)(p.out + (size_t)m * D + c) = v[j] * rs * gg; }
    }
}

#define XB_TMO      128
#define XB_XCNT(j)  (256  + 64 * (j))
#define XB_XSUB(j)  (1280 + 64 * (j))
#define XB_XGEN(j)  (2304 + 64 * (j))
#define XB_TOP      3328
#define XB_TOPGEN   3392
#define XCD_BAR_WORDS 3456
#define XB_SPIN_CAP (1u << 18)
__device__ __forceinline__ unsigned xb_ld(unsigned* p)              { return __hip_atomic_load(p, __ATOMIC_RELAXED, __HIP_MEMORY_SCOPE_AGENT); }
__device__ __forceinline__ unsigned xb_add(unsigned* p, unsigned v) { return __hip_atomic_fetch_add(p, v, __ATOMIC_RELAXED, __HIP_MEMORY_SCOPE_AGENT); }
__device__ __forceinline__ unsigned xb_xcc_id() { return (unsigned)__builtin_amdgcn_s_getreg((3 << 11) | 20) & 0xFu; }
#define XB_SPIN(cond, bar) do { unsigned _sp = 0; while (cond) { __builtin_amdgcn_s_sleep(1); \
    if ((++_sp & 255u) == 0u) { if (xb_ld(&(bar)[XB_TMO])) break; if (_sp > XB_SPIN_CAP) { atomicAdd(&(bar)[XB_TMO], 1u); break; } } } } while (0)
struct XcdBarrier { unsigned* bar; unsigned x; volatile LAS unsigned* st; };
__device__ __forceinline__ XcdBarrier xcd_barrier_post(unsigned* bar, volatile LAS unsigned* st) {
    XcdBarrier b; b.bar = bar; b.x = xb_xcc_id(); b.st = st;
    if (threadIdx.x == 0) (void)xb_add(&bar[XB_XCNT(b.x)], 1u);
    return b;
}
__device__ __forceinline__ void xcd_barrier_complete(unsigned* bar, unsigned x, unsigned& nloc, unsigned& nx) {
    const unsigned G = gridDim.x * gridDim.y * gridDim.z;
    unsigned sum, cnt, mine, sp = 0u;
    for (;;) {
        sum = 0u; cnt = 0u; mine = 0u;
#pragma unroll
        for (unsigned j = 0; j < 16; ++j) { const unsigned c = xb_ld(&bar[XB_XCNT(j)]); sum += c; cnt += (c > 0u) ? 1u : 0u; mine = (j == x) ? c : mine; }
        if (sum == G) break;
        __builtin_amdgcn_s_sleep(1);
        if ((++sp & 255u) == 0u) { if (xb_ld(&bar[XB_TMO])) break; if (sp > XB_SPIN_CAP) { atomicAdd(&bar[XB_TMO], 1u); break; } }
    }
    nloc = mine > 0u ? mine : 1u; nx = cnt > 0u ? cnt : 1u;
}
__device__ __forceinline__ void xcd_barrier(const XcdBarrier& b) {
    asm volatile("s_waitcnt vmcnt(0)" ::: "memory");
    __syncthreads();
    if (threadIdx.x == 0) {
        unsigned* bar = b.bar;
        __builtin_amdgcn_s_waitcnt(0);
        unsigned nloc = b.st[0], nx = b.st[1];
        if (nloc == 0u) { xcd_barrier_complete(bar, b.x, nloc, nx); b.st[0] = nloc; b.st[1] = nx; }
        const unsigned old = xb_add(&bar[XB_XSUB(b.x)], 1u);
        const unsigned gen = old / nloc;
        if (old + 1u == (gen + 1u) * nloc) {
            __builtin_amdgcn_fence(__ATOMIC_RELEASE, "agent");
            asm volatile("s_waitcnt vmcnt(0)" ::: "memory");
            const unsigned og = xb_add(&bar[XB_TOP], 1u);
            const unsigned tg = og / nx;
            if (og + 1u == (tg + 1u) * nx) xb_add(&bar[XB_TOPGEN], 1u);
            else XB_SPIN(xb_ld(&bar[XB_TOPGEN]) == tg, bar);
            __builtin_amdgcn_fence(__ATOMIC_ACQUIRE, "agent");
            xb_add(&bar[XB_XGEN(b.x)], 1u);
            asm volatile("s_waitcnt vmcnt(0)" ::: "memory");
        } else {
            XB_SPIN(xb_ld(&bar[XB_XGEN(b.x)]) == gen, bar);
            __builtin_amdgcn_fence(__ATOMIC_ACQUIRE, "agent");
            asm volatile("s_waitcnt vmcnt(0)" ::: "memory");
        }
    }
    __syncthreads();
}

template <int PH> __device__ __forceinline__ void run_phase(const Params& p, LAS unsigned char* lds) {
    unsigned char* ws = p.ws;
    if constexpr (PH == 0) phase0(p, lds);
    if constexpr (PH == 1) { DenseSched S; S.init((const bf16_t*)(ws + WS_X), (const bf16_t*)(ws + WS_WINT), T, NIN, D);
        EpiProj E{(bf16_t*)(ws + WS_P + P_BC), (bf16_t*)(ws + WS_P + P_P), (bf16_t*)(ws + WS_P + P_U), (bf16_t*)(ws + WS_P + P_V), (bf16_t*)(ws + WS_P + P_R), (bf16_t*)(ws + WS_P + P_S)};
        gemm_run<0>(lds, S, E, D); }
    if constexpr (PH == 2) { phase2_conv(p); phase2_sgu(p, lds); }
    if constexpr (PH == 3) { DenseSched S; S.init((const bf16_t*)(ws + WS_X), (const bf16_t*)(ws + WS_WUPT), T, D, 2048);
        EpiUp E{(const bf16_t*)(ws + WS_P + P_R), (const bf16_t*)(ws + WS_P + P_S), (bf16_t*)(ws + WS_MM)}; gemm_run<1>(lds, S, E, 2048); }
    if constexpr (PH == 4) { DenseSched S; S.init((const bf16_t*)(ws + WS_MM), (const bf16_t*)(ws + WS_WOUTT), T, D, D);
        EpiOut E{p.in[0], p.in[11], (float*)(ws + WS_H), (bf16_t*)(ws + WS_A2)}; gemm_run<2>(lds, S, E, D); }
    if constexpr (PH == 5) phase5_router(p, lds);
    if constexpr (PH == 6) { MoeSched<true, 4, D, 1024> S{(const bf16_t*)(ws + WS_A2), (const bf16_t*)(ws + WS_W1T), (const int*)(ws + WS_CTL), (const int*)(ws + WS_SMALL + SM_ENT), (int)gridDim.x, (int)blockIdx.x};
        EpiMoe1 E{(const int*)(ws + WS_SMALL + SM_ENT), (const float*)(ws + WS_SMALL + SM_W), (const float*)(ws + WS_SMALL + SM_RSTD), (bf16_t*)(ws + WS_HID)}; gemm_run<3>(lds, S, E, D); }
    if constexpr (PH == 7) { MoeSched<false, 8, DE, D> S{(const bf16_t*)(ws + WS_HID), (const bf16_t*)(ws + WS_W2T), (const int*)(ws + WS_CTL), (const int*)(ws + WS_SMALL + SM_ENT), (int)gridDim.x, (int)blockIdx.x};
        EpiMoe2 E{(const int*)(ws + WS_SMALL + SM_ENT), (bf16_t*)(ws + WS_YK0), (bf16_t*)(ws + WS_YK1)}; gemm_run<4>(lds, S, E, DE); }
    if constexpr (PH == 8) phase8_final(p);
}

template <int PH> __global__ void __launch_bounds__(NTHREADS, 2) k_phase(Params p) {
    extern __shared__ __attribute__((aligned(16))) unsigned char lds_raw[];
    run_phase<PH>(p, (LAS unsigned char*)lds_raw);
}

#ifndef PROBE_DUP
#define PROBE_DUP 0
#endif
#ifndef PROBE_SYNCS
#define PROBE_SYNCS 0
#endif
#define DUP(k) ((PROBE_DUP >> (k)) & 1)
__global__ void __launch_bounds__(NTHREADS, 2) k_mega(Params p) {
    extern __shared__ __attribute__((aligned(16))) unsigned char lds_raw[];
    LAS unsigned char* lds = (LAS unsigned char*)lds_raw;
    cg::grid_group grid = cg::this_grid();
    volatile LAS unsigned* xbst = (volatile LAS unsigned*)(lds + 131072 + 1024);
    if (threadIdx.x < 4) xbst[threadIdx.x] = 0u;
    __syncthreads();
    const XcdBarrier bar = xcd_barrier_post((unsigned*)(p.ws + WS_BAR), xbst);
#define GSYNC() xcd_barrier(bar)
    run_phase<0>(p, lds); grid.sync();
    if (DUP(0)) { run_phase<0>(p, lds); GSYNC(); }
    run_phase<1>(p, lds); GSYNC();
    if (DUP(1)) { run_phase<1>(p, lds); GSYNC(); }
    run_phase<2>(p, lds); GSYNC();
    if (DUP(2)) { run_phase<2>(p, lds); GSYNC(); }
    run_phase<3>(p, lds); GSYNC();
    if (DUP(3)) { run_phase<3>(p, lds); GSYNC(); }
    run_phase<4>(p, lds); GSYNC();
    if (DUP(4)) { run_phase<4>(p, lds); GSYNC(); }
    run_phase<5>(p, lds); GSYNC();
    if (DUP(5)) { if (blockIdx.x == 0 && threadIdx.x < 64) ((int*)(p.ws + WS_CTL))[threadIdx.x] = 0; GSYNC(); run_phase<5>(p, lds); GSYNC(); }
    run_phase<6>(p, lds); GSYNC();
    if (DUP(6)) { run_phase<6>(p, lds); GSYNC(); }
    run_phase<7>(p, lds); GSYNC();
    if (DUP(7)) { run_phase<7>(p, lds); GSYNC(); }
    for (int i = 0; i < PROBE_SYNCS; ++i) GSYNC();
    run_phase<8>(p, lds);
    if (DUP(8)) { GSYNC(); run_phase<8>(p, lds); }
}

template <int PH> static void launch_phase(const Params& p, int grid, hipStream_t stream) {
    static bool attr = false;
    if (!attr) { (void)hipFuncSetAttribute((const void*)k_phase<PH>, hipFuncAttributeMaxDynamicSharedMemorySize, LDS_BYTES); attr = true; }
    hipLaunchKernelGGL(k_phase<PH>, dim3(grid), dim3(NTHREADS), LDS_BYTES, stream, p);
}

extern "C" void kernel_launch(void* const* d_in, const int* in_sizes, int n_in, void* d_out, int out_size, void* d_ws, size_t ws_size, hipStream_t stream) {
    static int grid = 0;
    if (grid == 0) {
        if (n_in != 20 || out_size != T * D || ws_size < WS_END) { fprintf(stderr, "kernel_launch: unexpected shapes n_in %d out %d ws %zu (need %zu)\n", n_in, out_size, ws_size, (size_t)WS_END); grid = -1; return; }
        int dev = 0, cus = 0, per_cu = 0;
        (void)hipGetDevice(&dev); (void)hipDeviceGetAttribute(&cus, hipDeviceAttributeMultiprocessorCount, dev);
        (void)hipFuncSetAttribute((const void*)k_mega, hipFuncAttributeMaxDynamicSharedMemorySize, LDS_BYTES);
        (void)hipOccupancyMaxActiveBlocksPerMultiprocessor(&per_cu, (const void*)k_mega, NTHREADS, LDS_BYTES);
        if (per_cu < 1) { fprintf(stderr, "kernel_launch: occupancy query says %d blocks per CU\n", per_cu); per_cu = 1; }
        grid = cus * 1;
        (void)hipGetLastError();
    }
    if (grid < 0) return;
    Params p{};
    for (int i = 0; i < 20; ++i) p.in[i] = (const float*)d_in[i];
    p.out = (float*)d_out; p.ws = (unsigned char*)d_ws;
    (void)hipMemsetAsync((char*)d_ws + WS_CTL, 0, 64 * 1024, stream);
#if ONE_LAUNCH
    void* args[] = {&p};
    hipError_t e = hipLaunchCooperativeKernel((const void*)k_mega, dim3(grid), dim3(NTHREADS), args, LDS_BYTES, stream);
    if (e != hipSuccess) fprintf(stderr, "cooperative launch failed: %s (grid %d)\n", hipGetErrorString(e), grid);
#else
    launch_phase<0>(p, grid, stream); launch_phase<1>(p, grid, stream); launch_phase<2>(p, grid, stream); launch_phase<3>(p, grid, stream); launch_phase<4>(p, grid, stream);
    launch_phase<5>(p, grid, stream); launch_phase<6>(p, grid, stream); launch_phase<7>(p, grid, stream); launch_phase<8>(p, grid, stream);
#endif
}
```

```cpp
#include <hip/hip_runtime.h>
#include <hip/hip_cooperative_groups.h>
#include <cstdio>
#include <cstdint>
namespace cg = cooperative_groups;

#ifndef ONE_LAUNCH
#define ONE_LAUNCH 1
#endif

#define LAS __attribute__((address_space(3)))
typedef unsigned short bf16_t;
typedef short bf16x8 __attribute__((ext_vector_type(8)));
typedef float f32x4 __attribute__((ext_vector_type(4)));
typedef float f32x2 __attribute__((ext_vector_type(2)));
typedef unsigned u32x4 __attribute__((ext_vector_type(4)));
typedef unsigned u32x2 __attribute__((ext_vector_type(2)));

constexpr int T = 8192, D = 2048, CW = 1024, SW = 1024, NIN = 9216, NE = 16, DE = 512;
constexpr float EPS = 1e-6f;
constexpr int NTHREADS = 512, NWAVES = 8;
constexpr int LDS_BYTES = 132 * 1024;
constexpr int HID_ROWS = 2 * T + NE * 256;

constexpr size_t MiB = 1024 * 1024;
constexpr size_t WS_CTL   = 0;
constexpr size_t WS_BAR   = 4096;
constexpr size_t WS_SMALL = 64 * 1024;
constexpr size_t SM_RSTD = 0, SM_ENT = 32 * 1024, SM_W = SM_ENT + (size_t)NE * T * 4, SM_END = SM_W + (size_t)NE * T * 4;
constexpr size_t WS_WR    = WS_SMALL + 2 * MiB;
constexpr size_t WS_WMB   = WS_WR + 256 * 1024;
constexpr size_t WS_WINT  = WS_WMB + 256 * 1024;
constexpr size_t WS_WUPT  = WS_WINT + (size_t)NIN * D * 2;
constexpr size_t WS_WOUTT = WS_WUPT + (size_t)D * D * 2;
constexpr size_t WS_W1T   = WS_WOUTT + (size_t)D * D * 2;
constexpr size_t WS_W2T   = WS_W1T + (size_t)NE * 1024 * D * 2;
constexpr size_t WS_X     = WS_W2T + (size_t)NE * D * DE * 2;
constexpr size_t WS_P     = WS_X + (size_t)T * D * 2;
constexpr size_t P_BC = 0, P_P = P_BC + (size_t)T * CW * 2, P_U = P_P + (size_t)T * CW * 2, P_V = P_U + (size_t)T * SW * 2,
                 P_R = P_V + (size_t)T * SW * 2, P_S = P_R + (size_t)T * D * 2, P_END = P_S + (size_t)T * D * 2;
constexpr size_t WS_END   = WS_P + P_END;
constexpr size_t WS_MM  = WS_WINT;
constexpr size_t WS_H   = WS_P + P_BC;
constexpr size_t WS_A2  = WS_P + P_R;
constexpr size_t WS_HID = WS_P + P_S;
constexpr size_t WS_YK0 = WS_X;
constexpr size_t WS_YK1 = WS_WINT;
static_assert(SM_END <= 2 * MiB, "small region");
static_assert((size_t)HID_ROWS * DE * 2 <= (size_t)T * D * 2, "hid overlay");
static_assert((size_t)T * D * 4 <= P_R, "H overlay");

struct Params { const float* in[20]; float* out; unsigned char* ws; };

__device__ __forceinline__ unsigned cvt_pk_bf16(float lo, float hi) { unsigned r; asm("v_cvt_pk_bf16_f32 %0, %1, %2" : "=v"(r) : "v"(lo), "v"(hi)); return r; }
__device__ __forceinline__ float bf_lo(unsigned w) { return __uint_as_float(w << 16); }
__device__ __forceinline__ float bf_hi(unsigned w) { return __uint_as_float(w & 0xffff0000u); }
__device__ __forceinline__ float bf1(bf16_t b) { return __uint_as_float(((unsigned)b) << 16); }
__device__ __forceinline__ float wave_sum(float v) {
#pragma unroll
    for (int o = 1; o < 64; o <<= 1) v += __shfl_xor(v, o);
    return v;
}
__device__ __forceinline__ float fast_rcp(float x) { return __builtin_amdgcn_rcpf(x); }
__device__ __forceinline__ float fast_exp2(float x) { return __builtin_amdgcn_exp2f(x); }
__device__ __forceinline__ float sigmoid_f(float x) { return fast_rcp(1.0f + fast_exp2(-1.44269504f * x)); }
__device__ __forceinline__ float gelu_tanh(float x) {
    const float u = x + 0.044715f * x * x * x;
    return x * fast_rcp(1.0f + fast_exp2(-2.30220819f * u));
}
__host__ __device__ __forceinline__ int perm32(int rho) { const int n = rho >> 4, i = rho & 15; return 8 * (i >> 2) + 4 * n + (i & 3); }

struct Unit { int pm, pn, e, row0, nvalid; };
constexpr int NXCD = 8, WGM = 8;
struct DenseSched {
    const bf16_t* A; const bf16_t* Bt; int K; int nM, nN, nwg, G, c;
    __device__ __forceinline__ void init(const bf16_t* A_, const bf16_t* Bt_, int M, int N, int K_) { A = A_; Bt = Bt_; K = K_; nM = M / 256; nN = N / 256; nwg = nM * nN; G = gridDim.x; c = blockIdx.x; }
    __device__ __forceinline__ bool next(int i, Unit& u) const {
        const long L = (long)i * G + c; if (L >= nwg) return false;
        int wgid = (int)L; { const int q = nwg / NXCD, r = nwg % NXCD, xcd = wgid % NXCD, off = wgid / NXCD; wgid = (xcd < r ? xcd * (q + 1) : r * (q + 1) + (xcd - r) * q) + off; }
        const int nig = WGM * nN, gid = wgid / nig, fm = gid * WGM, gsz = (nM - fm) < WGM ? (nM - fm) : WGM;
        u.pm = fm + ((wgid % nig) % gsz); u.pn = (wgid % nig) / gsz; u.e = 0; u.row0 = u.pm * 256; u.nvalid = 256; return true;
    }
    __device__ __forceinline__ const char* a_base() const { return (const char*)A; }
    __device__ __forceinline__ unsigned a_off(const Unit& u, int r) const { return (unsigned)(u.row0 + r) * (unsigned)K * 2u; }
    __device__ __forceinline__ const char* b_base(const Unit& u) const { return (const char*)Bt + (size_t)u.pn * 256 * K * 2; }
};
template <bool GATHER, int NPN, int KK, int NROWS_E  >
struct MoeSched {
    const bf16_t* A; const bf16_t* Bt; const int* cnt; const int* ent; int G, c;
    __device__ __forceinline__ bool next(int i, Unit& u) const {
        int L = i * G + c; int hb = 0;
        for (int e = 0; e < NE; ++e) {
            const int n = __builtin_amdgcn_readfirstlane(cnt[e]); const int nt = (n + 255) >> 8;
            if (L < nt * NPN) { u.e = e; u.pm = L / NPN; u.pn = L % NPN; u.row0 = hb + u.pm * 256; u.nvalid = min(256, n - u.pm * 256); return true; }
            L -= nt * NPN; hb += nt * 256;
        }
        return false;
    }
    __device__ __forceinline__ const char* a_base() const { return (const char*)A; }
    __device__ __forceinline__ unsigned a_off(const Unit& u, int r) const {
        if (GATHER) { const int tok = (r < u.nvalid) ? (ent[u.e * T + u.pm * 256 + r] & 0xffff) : 0; return (unsigned)tok * (unsigned)KK * 2u; }
        return (unsigned)(u.row0 + r) * (unsigned)KK * 2u;
    }
    __device__ __forceinline__ const char* b_base(const Unit& u) const { return (const char*)Bt + ((size_t)u.e * NROWS_E + (size_t)u.pn * 256) * KK * 2; }
};

typedef f32x4 Acc[2][2][4][2];
__device__ __forceinline__ u32x4 pack8(f32x4 a, f32x4 b) { u32x4 w; w.x = cvt_pk_bf16(a[0], a[1]); w.y = cvt_pk_bf16(a[2], a[3]); w.z = cvt_pk_bf16(b[0], b[1]); w.w = cvt_pk_bf16(b[2], b[3]); return w; }
__device__ __forceinline__ void unpack8(u32x4 w, f32x4& a, f32x4& b) { a = (f32x4){bf_lo(w.x), bf_hi(w.x), bf_lo(w.y), bf_hi(w.y)}; b = (f32x4){bf_lo(w.z), bf_hi(w.z), bf_lo(w.w), bf_hi(w.w)}; }

struct EpiProj {
    static constexpr bool PERM = true; static constexpr int MIDK = 0;
    bf16_t *Bc, *P, *U, *V, *R, *S;
    __device__ __forceinline__ void mid(Acc&, const Unit&, int, int, int, int) const {}
    __device__ __forceinline__ void operator()(const Acc& acc, const Unit& u, int wr, int wc, int fr, int fq) const {
        const int pn = u.pn; const int rowb = u.row0 + wr * 64 + fr; const int cl = wc * 32 + 8 * fq;
#pragma unroll
        for (int ai = 0; ai < 2; ++ai)
#pragma unroll
            for (int m = 0; m < 4; ++m) {
                const size_t row = (size_t)(rowb + ai * 128 + m * 16);
                if (pn < 4) {
#pragma unroll
                    for (int bj = 0; bj < 2; ++bj) *(u32x4*)(Bc + row * CW + pn * 256 + bj * 128 + cl) = pack8(acc[ai][bj][m][0], acc[ai][bj][m][1]);
                } else if (pn < 12) {
                    *(u32x4*)(P + row * CW + (pn - 4) * 128 + cl) = pack8(acc[ai][0][m][0] * acc[ai][1][m][0], acc[ai][0][m][1] * acc[ai][1][m][1]);
                } else if (pn < 20) {
                    bf16_t* O = (pn < 16) ? (U + row * SW + (pn - 12) * 256) : (V + row * SW + (pn - 16) * 256);
#pragma unroll
                    for (int bj = 0; bj < 2; ++bj) { f32x4 a = acc[ai][bj][m][0], b = acc[ai][bj][m][1];
#pragma unroll
                        for (int j = 0; j < 4; ++j) { a[j] = gelu_tanh(a[j]); b[j] = gelu_tanh(b[j]); }
                        *(u32x4*)(O + bj * 128 + cl) = pack8(a, b); }
                } else {
                    f32x4 r0, r1, s0, s1;
#pragma unroll
                    for (int j = 0; j < 4; ++j) {
                        const float ec0 = fast_exp2(-1.44269504f * acc[ai][0][m][0][j]), es0 = fast_exp2(-1.44269504f * acc[ai][1][m][0][j]);
                        const float ec1 = fast_exp2(-1.44269504f * acc[ai][0][m][1][j]), es1 = fast_exp2(-1.44269504f * acc[ai][1][m][1][j]);
                        r0[j] = (1.0f + es0) * fast_rcp(1.0f + ec0); s0[j] = fast_rcp(1.0f + es0);
                        r1[j] = (1.0f + es1) * fast_rcp(1.0f + ec1); s1[j] = fast_rcp(1.0f + es1);
                    }
                    const size_t o = row * D + (pn - 20) * 128 + cl;
                    *(u32x4*)(R + o) = pack8(r0, r1); *(u32x4*)(S + o) = pack8(s0, s1);
                }
            }
    }
};
struct EpiUp {
    static constexpr bool PERM = true; static constexpr int MIDK = 1024;
    const bf16_t *R, *S; bf16_t* Mm;
    __device__ __forceinline__ void mid(Acc& acc, const Unit& u, int wr, int wc, int fr, int fq) const {
        int rowb = u.row0 + wr * 64 + fr; const int cb = u.pn * 256 + wc * 32 + 8 * fq;
        asm volatile("" : "+v"(rowb));
#pragma unroll
        for (int ai = 0; ai < 2; ++ai)
#pragma unroll
            for (int m = 0; m < 4; ++m)
#pragma unroll
                for (int bj = 0; bj < 2; ++bj) { f32x4 a, b; unpack8(*(const u32x4*)(R + (size_t)(rowb + ai * 128 + m * 16) * D + cb + bj * 128), a, b);
                    acc[ai][bj][m][0] *= a; acc[ai][bj][m][1] *= b; }
    }
    __device__ __forceinline__ void operator()(const Acc& acc, const Unit& u, int wr, int wc, int fr, int fq) const {
        const int rowb = u.row0 + wr * 64 + fr; const int cb = u.pn * 256 + wc * 32 + 8 * fq;
#pragma unroll
        for (int ai = 0; ai < 2; ++ai)
#pragma unroll
            for (int m = 0; m < 4; ++m)
#pragma unroll
                for (int bj = 0; bj < 2; ++bj) { const size_t o = (size_t)(rowb + ai * 128 + m * 16) * D + cb + bj * 128; f32x4 a, b; unpack8(*(const u32x4*)(S + o), a, b);
                    *(u32x4*)(Mm + o) = pack8(acc[ai][bj][m][0] * a, acc[ai][bj][m][1] * b); }
    }
};
struct EpiOut {
    static constexpr bool PERM = false; static constexpr int MIDK = 0;
    const float* x; const float* g; float* H; bf16_t* A2;
    __device__ __forceinline__ void mid(Acc&, const Unit&, int, int, int, int) const {}
    __device__ __forceinline__ void operator()(const Acc& acc, const Unit& u, int wr, int wc, int fr, int fq) const {
        const int rowb = u.row0 + wr * 64 + fr; const int cb = u.pn * 256 + wc * 32 + 4 * fq;
#pragma unroll
        for (int ai = 0; ai < 2; ++ai)
#pragma unroll
            for (int m = 0; m < 4; ++m)
#pragma unroll
                for (int bj = 0; bj < 2; ++bj)
#pragma unroll
                    for (int n = 0; n < 2; ++n) { const int col = cb + bj * 128 + n * 16; const size_t o = (size_t)(rowb + ai * 128 + m * 16) * D + col;
                        const f32x4 h = *(const f32x4*)(x + o) + acc[ai][bj][m][n]; *(f32x4*)(H + o) = h; const f32x4 gg = *(const f32x4*)(g + col);
                        u32x2 w; w.x = cvt_pk_bf16(h[0] * gg[0], h[1] * gg[1]); w.y = cvt_pk_bf16(h[2] * gg[2], h[3] * gg[3]); *(u32x2*)(A2 + o) = w; }
    }
};
struct EpiMoe1 {
    static constexpr bool PERM = true; static constexpr int MIDK = 0;
    const int* ent; const float* lw; const float* rstd; bf16_t* Hid;
    __device__ __forceinline__ void mid(Acc&, const Unit&, int, int, int, int) const {}
    __device__ __forceinline__ void operator()(const Acc& acc, const Unit& u, int wr, int wc, int fr, int fq) const {
        const int cl = u.pn * 128 + wc * 32 + 8 * fq;
#pragma unroll
        for (int ai = 0; ai < 2; ++ai)
#pragma unroll
            for (int m = 0; m < 4; ++m) {
                const int r = ai * 128 + wr * 64 + m * 16 + fr;
                if (r < u.nvalid) {
                    const int li = u.e * T + u.pm * 256 + r; const int tok = ent[li] & 0xffff; const float rs = rstd[tok], w = lw[li];
                    f32x4 o[2];
#pragma unroll
                    for (int n = 0; n < 2; ++n)
#pragma unroll
                        for (int j = 0; j < 4; ++j) { const float gt = acc[ai][0][m][n][j] * rs, up = acc[ai][1][m][n][j] * rs; o[n][j] = gt * sigmoid_f(gt) * up * w; }
                    *(u32x4*)(Hid + (size_t)(u.row0 + r) * DE + cl) = pack8(o[0], o[1]);
                }
            }
    }
};
struct EpiMoe2 {
    static constexpr bool PERM = true; static constexpr int MIDK = 0;
    const int* ent; bf16_t* Yk0; bf16_t* Yk1;
    __device__ __forceinline__ void mid(Acc&, const Unit&, int, int, int, int) const {}
    __device__ __forceinline__ void operator()(const Acc& acc, const Unit& u, int wr, int wc, int fr, int fq) const {
        const int cb = u.pn * 256 + wc * 32 + 8 * fq;
#pragma unroll
        for (int ai = 0; ai < 2; ++ai)
#pragma unroll
            for (int m = 0; m < 4; ++m) {
                const int r = ai * 128 + wr * 64 + m * 16 + fr;
                if (r < u.nvalid) {
                    const int en = ent[u.e * T + u.pm * 256 + r]; const int tok = en & 0xffff; bf16_t* Y = (en >> 16) ? Yk1 : Yk0;
#pragma unroll
                    for (int bj = 0; bj < 2; ++bj) *(u32x4*)(Y + (size_t)tok * D + cb + bj * 128) = pack8(acc[ai][bj][m][0], acc[ai][bj][m][1]);
                }
            }
    }
};

template <class Epi, class Sched>
__device__ __forceinline__ void gemm_simple(const Sched& S, const Epi& E, const int K) {
    const int tid = threadIdx.x, wid = __builtin_amdgcn_readfirstlane(tid >> 6), lane = tid & 63, wr = wid >> 2, wc = wid & 3, fr = lane & 15, fq = lane >> 4;
    Unit u;
    for (int ui = 0; S.next(ui, u); ++ui) {
        Acc acc;
#pragma unroll
        for (int a = 0; a < 2; ++a)
#pragma unroll
            for (int b = 0; b < 2; ++b)
#pragma unroll
                for (int m = 0; m < 4; ++m)
#pragma unroll
                    for (int n = 0; n < 2; ++n) acc[a][b][m][n] = (f32x4){0.f, 0.f, 0.f, 0.f};
        const char* ab = S.a_base(); const char* bb = S.b_base(u);
        unsigned aoff[2][4], boff[2][2];
#pragma unroll
        for (int ai = 0; ai < 2; ++ai)
#pragma unroll
            for (int m = 0; m < 4; ++m) aoff[ai][m] = S.a_off(u, ai * 128 + wr * 64 + m * 16 + fr) + fq * 16;
#pragma unroll
        for (int bj = 0; bj < 2; ++bj)
#pragma unroll
            for (int n = 0; n < 2; ++n) { const int rr = Epi::PERM ? perm32(n * 16 + fr) : (n * 16 + fr); boff[bj][n] = (unsigned)(bj * 128 + wc * 32 + rr) * (unsigned)K * 2u + fq * 16; }
        for (int k0 = 0; k0 < K; k0 += 32) {
            if (Epi::MIDK != 0 && k0 == Epi::MIDK) E.mid(acc, u, wr, wc, fr, fq);
            bf16x8 a[2][4], b[2][2];
#pragma unroll
            for (int ai = 0; ai < 2; ++ai)
#pragma unroll
                for (int m = 0; m < 4; ++m) a[ai][m] = *(const bf16x8*)(ab + aoff[ai][m] + k0 * 2);
#pragma unroll
            for (int bj = 0; bj < 2; ++bj)
#pragma unroll
                for (int n = 0; n < 2; ++n) b[bj][n] = *(const bf16x8*)(bb + boff[bj][n] + k0 * 2);
#pragma unroll
            for (int ai = 0; ai < 2; ++ai)
#pragma unroll
                for (int bj = 0; bj < 2; ++bj)
#pragma unroll
                    for (int m = 0; m < 4; ++m)
#pragma unroll
                        for (int n = 0; n < 2; ++n) acc[ai][bj][m][n] = __builtin_amdgcn_mfma_f32_16x16x32_bf16(b[bj][n], a[ai][m], acc[ai][bj][m][n], 0, 0, 0);
        }
        E(acc, u, wr, wc, fr, fq);
    }
}

constexpr int BK = 64, HALF = 128, HTB = HALF * BK * 2, STAGE_BYTES = 8 * HTB;
__host__ __device__ __forceinline__ int lds_byte(int r, int c) { const int st = (r >> 4) * 2 + (c >> 5), rr = r & 15, cc = c & 31, ob = rr * 64 + cc * 2; return st * 1024 + (ob ^ (((ob >> 9) & 1) << 5)); }
__host__ __device__ __forceinline__ void stage_rc(int b, int& R, int& C) { const int st = b / 1024, sb = b % 1024, swz = sb ^ (((sb >> 9) & 1) << 5); R = (st >> 1) * 16 + swz / 64; C = (st & 1) * 32 + (swz % 64) / 2; }

template <class Epi, class Sched>
__device__ __forceinline__ void gemm_fast(LAS unsigned char* lds, const Sched& S, const Epi& E, const int K) {
    const int tid = threadIdx.x, wid = __builtin_amdgcn_readfirstlane(tid >> 6), lane = tid & 63, wr = wid >> 2, wc = wid & 3, fr = lane & 15, fq = lane >> 4;
    const int nt = K / BK;
    int sR[2], sC[2]; unsigned voffB[2];
#pragma unroll
    for (int i = 0; i < 2; ++i) { stage_rc(tid * 16 + i * 8192, sR[i], sC[i]); const int Rb = Epi::PERM ? ((sR[i] & ~31) + perm32(sR[i] & 31)) : sR[i]; voffB[i] = (unsigned)(Rb * K + sC[i]) * 2u; }
    const size_t kstep = (size_t)(BK * 2);
    const size_t hstepB = (size_t)HALF * K * 2;
    const unsigned ldsw = (unsigned)wid * 1024u;
    const int aoff = lds_byte(wr * 64 + fr, fq * 8), boff = lds_byte(wc * 32 + fr, fq * 8);
#define PG8_SA(b, h) (((b) * 2 + (h)) * HTB)
#define PG8_SB(b, h) ((4 + (b) * 2 + (h)) * HTB)
#define PG8_STAGE(bufoff, gbase, voff) do { _Pragma("unroll") for (int _i = 0; _i < 2; ++_i) \
        __builtin_amdgcn_global_load_lds((const unsigned*)((const char*)(gbase) + (voff)[_i]), (LAS unsigned*)(lds + (bufoff) + ldsw + _i * 8192), 16, 0, 0); } while (0)
#define PG8_LDA(dst, b, h) do { _Pragma("unroll") for (int m = 0; m < 4; ++m) _Pragma("unroll") for (int k = 0; k < 2; ++k) dst[m][k] = *(const LAS bf16x8*)(lds + PG8_SA(b, h) + aoff + m * 2048 + k * 1024); } while (0)
#define PG8_LDB(dst, b, h) do { _Pragma("unroll") for (int n = 0; n < 2; ++n) _Pragma("unroll") for (int k = 0; k < 2; ++k) dst[n][k] = *(const LAS bf16x8*)(lds + PG8_SB(b, h) + boff + n * 2048 + k * 1024); } while (0)
#define PG8_MMA(ai, bj, At, Bt) do { __builtin_amdgcn_s_setprio(1); _Pragma("unroll") for (int m = 0; m < 4; ++m) _Pragma("unroll") for (int n = 0; n < 2; ++n) _Pragma("unroll") for (int k = 0; k < 2; ++k) \
        acc[ai][bj][m][n] = __builtin_amdgcn_mfma_f32_16x16x32_bf16(Bt[n][k], At[m][k], acc[ai][bj][m][n], 0, 0, 0); __builtin_amdgcn_s_setprio(0); } while (0)
#define PG8_WAIT_V(n) asm volatile("s_waitcnt vmcnt(" #n ")" ::: "memory")
#define PG8_WAIT_L(n) asm volatile("s_waitcnt lgkmcnt(" #n ")" ::: "memory")
#define PG8_BAR __builtin_amdgcn_s_barrier()
#define PG8_SCHED __builtin_amdgcn_sched_barrier(0)
    Unit cur, nxt; int ui = 0;
    if (!S.next(0, cur)) return;
    Acc acc;
#pragma unroll
    for (int a = 0; a < 2; ++a)
#pragma unroll
        for (int b = 0; b < 2; ++b)
#pragma unroll
            for (int m = 0; m < 4; ++m)
#pragma unroll
                for (int n = 0; n < 2; ++n) acc[a][b][m][n] = (f32x4){0.f, 0.f, 0.f, 0.f};
    bf16x8 At[4][2], B0[2][2], B1[2][2];
    unsigned va[2][2], vn[2][2];
#pragma unroll
    for (int h = 0; h < 2; ++h)
#pragma unroll
        for (int i = 0; i < 2; ++i) va[h][i] = S.a_off(cur, h * 128 + sR[i]) + (unsigned)sC[i] * 2u;
    const char* const A0 = S.a_base(); const char* cB = S.b_base(cur);
    PG8_STAGE(PG8_SB(0, 0), cB, voffB); PG8_STAGE(PG8_SB(0, 1), cB + hstepB, voffB); PG8_STAGE(PG8_SA(0, 0), A0, va[0]); PG8_STAGE(PG8_SA(0, 1), A0, va[1]);
    if (wr == 1) PG8_BAR;
    PG8_WAIT_V(2); PG8_BAR;
    PG8_STAGE(PG8_SB(1, 0), cB + kstep, voffB); PG8_STAGE(PG8_SA(1, 0), A0 + kstep, va[0]); PG8_STAGE(PG8_SB(1, 1), cB + hstepB + kstep, voffB);
    PG8_WAIT_V(6); PG8_BAR;
    for (;;) {
        const bool has_next = S.next(ui + 1, nxt);
        const char* nB = has_next ? S.b_base(nxt) : cB;
#pragma unroll
        for (int h = 0; h < 2; ++h)
#pragma unroll
            for (int i = 0; i < 2; ++i) vn[h][i] = has_next ? (S.a_off(nxt, h * 128 + sR[i]) + (unsigned)sC[i] * 2u) : va[h][i];
        for (int t = 0; t < nt; t += 2) {
            const bool last = (t == nt - 2);
            if (Epi::MIDK != 0 && t * BK == Epi::MIDK) { PG8_SCHED; E.mid(acc, cur, wr, wc, fr, fq); PG8_SCHED; }
            const char* a1 = A0 + (size_t)(t + 1) * kstep;
            const char* a2 = last ? A0 : A0 + (size_t)(t + 2) * kstep; const char* b2 = last ? nB : cB + (size_t)(t + 2) * kstep;
            const char* a3 = a2 + kstep; const char* b3 = b2 + kstep;
            unsigned v2[2][2];
#pragma unroll
            for (int h = 0; h < 2; ++h)
#pragma unroll
                for (int i = 0; i < 2; ++i) v2[h][i] = last ? vn[h][i] : va[h][i];
            PG8_LDB(B0, 0, 0); PG8_LDB(B1, 0, 1); PG8_SCHED; PG8_LDA(At, 0, 0); PG8_STAGE(PG8_SA(1, 1), a1, va[1]);
            PG8_WAIT_V(8); PG8_WAIT_L(0); PG8_BAR; PG8_MMA(0, 0, At, B0); PG8_MMA(0, 1, At, B1); PG8_BAR; PG8_SCHED;
            PG8_LDA(At, 0, 1); PG8_STAGE(PG8_SB(0, 0), b2, voffB); PG8_STAGE(PG8_SB(0, 1), b2 + hstepB, voffB); PG8_STAGE(PG8_SA(0, 0), a2, v2[0]);
            PG8_WAIT_V(8); PG8_WAIT_L(0); PG8_BAR; PG8_MMA(1, 0, At, B0); PG8_MMA(1, 1, At, B1); PG8_BAR; PG8_SCHED;
            PG8_LDB(B0, 1, 0); PG8_LDB(B1, 1, 1); PG8_SCHED; PG8_LDA(At, 1, 0); PG8_STAGE(PG8_SA(0, 1), a2, v2[1]);
            PG8_WAIT_V(8); PG8_WAIT_L(0); PG8_BAR; PG8_MMA(0, 0, At, B0); PG8_MMA(0, 1, At, B1); PG8_BAR; PG8_SCHED;
            PG8_LDA(At, 1, 1); PG8_STAGE(PG8_SB(1, 0), b3, voffB); PG8_STAGE(PG8_SB(1, 1), b3 + hstepB, voffB); PG8_STAGE(PG8_SA(1, 0), a3, v2[0]);
            PG8_WAIT_V(8); PG8_WAIT_L(0); PG8_BAR; PG8_MMA(1, 0, At, B0); PG8_MMA(1, 1, At, B1); PG8_BAR; PG8_SCHED;
        }
        if (wr == 0) PG8_BAR;
        E(acc, cur, wr, wc, fr, fq);
        if (!has_next) break;
#pragma unroll
        for (int a = 0; a < 2; ++a)
#pragma unroll
            for (int b = 0; b < 2; ++b)
#pragma unroll
                for (int m = 0; m < 4; ++m)
#pragma unroll
                    for (int n = 0; n < 2; ++n) acc[a][b][m][n] = (f32x4){0.f, 0.f, 0.f, 0.f};
        cur = nxt; cB = nB; ++ui;
#pragma unroll
        for (int h = 0; h < 2; ++h)
#pragma unroll
            for (int i = 0; i < 2; ++i) va[h][i] = vn[h][i];
        if (wr == 1) PG8_BAR;
    }
    PG8_WAIT_V(0);
    PG8_BAR;
#undef PG8_SA
#undef PG8_SB
#undef PG8_STAGE
#undef PG8_LDA
#undef PG8_LDB
#undef PG8_MMA
#undef PG8_WAIT_V
#undef PG8_WAIT_L
#undef PG8_BAR
#undef PG8_SCHED
}
#ifndef FAST_MASK
#define FAST_MASK 0x1f
#endif
template <int BIT, class Epi, class Sched>
__device__ __forceinline__ void gemm_run(LAS unsigned char* lds, const Sched& S, const Epi& E, const int K) {
    if constexpr ((FAST_MASK >> BIT) & 1) gemm_fast(lds, S, E, K); else gemm_simple(S, E, K);
}

__device__ __forceinline__ void tr_item(const float* W, int N, int k0, int ns, bf16_t* WT, int ldk, int nd, int kd, LAS float* scr, int lane) {
#pragma unroll 8
    for (int i = 0; i < 32; ++i) { const int kk = 2 * i + (lane >> 5); scr[kk * 33 + (lane & 31)] = W[(size_t)(k0 + kk) * N + ns + (lane & 31)]; }
    asm volatile("s_waitcnt lgkmcnt(0)" ::: "memory");
    const int c = lane & 7;
#pragma unroll
    for (int j = 0; j < 4; ++j) { const int n = (lane >> 3) + 8 * j; const LAS float* s = scr + (8 * c) * 33 + n;
        u32x4 o; o.x = cvt_pk_bf16(s[0 * 33], s[1 * 33]); o.y = cvt_pk_bf16(s[2 * 33], s[3 * 33]); o.z = cvt_pk_bf16(s[4 * 33], s[5 * 33]); o.w = cvt_pk_bf16(s[6 * 33], s[7 * 33]);
        *(u32x4*)(WT + (size_t)(nd + n) * ldk + kd + 8 * c) = o; }
    asm volatile("s_waitcnt lgkmcnt(0)" ::: "memory");
}
__device__ __forceinline__ int win_src_col(int nd) {
    if (nd < 1024) return nd;
    if (nd < 3072) { const int q = (nd - 1024) >> 8, r = (nd - 1024) & 255; return r < 128 ? (1024 + 128 * q + r) : (2048 + 128 * q + r - 128); }
    if (nd < 5120) return nd;
    { const int q = (nd - 5120) >> 8, r = (nd - 5120) & 255; return r < 128 ? (5120 + 128 * q + r) : (7168 + 128 * q + r - 128); }
}
__device__ __forceinline__ void phase0(const Params& p, LAS unsigned char* lds) {
    const int tid = threadIdx.x, wave = __builtin_amdgcn_readfirstlane(tid >> 6), lane = tid & 63;
    LAS float* scr = (LAS float*)(lds + wave * 8704);
    const int gw = blockIdx.x * NWAVES + wave, NGW = gridDim.x * NWAVES;
    unsigned char* ws = p.ws;
    constexpr int I_IN = 32 * 288, I_UP = 16 * 64, I_OUT = 32 * 64, I_G = 32 * 16 * NE, I_D = 8 * 64 * NE;
    constexpr int NITEMS = I_IN + 2 * I_UP + I_OUT + 2 * I_G + I_D;
    for (int it = gw; it < NITEMS; it += NGW) {
        int r = it;
        if (r < I_IN) { const int kb = r / 288, nb = r % 288; tr_item(p.in[2], NIN, kb * 64, win_src_col(nb * 32), (bf16_t*)(ws + WS_WINT), D, nb * 32, kb * 64, scr, lane); continue; } r -= I_IN;
        if (r < I_UP) { const int kb = r / 64, nb = r % 64; tr_item(p.in[8], D, kb * 64, nb * 32, (bf16_t*)(ws + WS_WUPT), 2048, nb * 32, kb * 64, scr, lane); continue; } r -= I_UP;
        if (r < I_UP) { const int kb = r / 64, nb = r % 64; tr_item(p.in[9], D, kb * 64, nb * 32, (bf16_t*)(ws + WS_WUPT), 2048, nb * 32, 1024 + kb * 64, scr, lane); continue; } r -= I_UP;
        if (r < I_OUT) { const int kb = r / 64, nb = r % 64; tr_item(p.in[10], D, kb * 64, nb * 32, (bf16_t*)(ws + WS_WOUTT), D, nb * 32, kb * 64, scr, lane); continue; } r -= I_OUT;
        if (r < 2 * I_G) { const int up = r >= I_G; if (up) r -= I_G; const int e = r / 512, q = r % 512, kb = q / 16, nb = q % 16;
            const int nd = 256 * (nb >> 2) + (nb & 3) * 32 + (up ? 128 : 0);
            tr_item(p.in[up ? 17 : 16] + (size_t)e * D * DE, DE, kb * 64, nb * 32, (bf16_t*)(ws + WS_W1T) + (size_t)e * 1024 * D, D, nd, kb * 64, scr, lane); continue; } r -= 2 * I_G;
        { const int e = r / 512, q = r % 512, kb = q / 64, nb = q % 64;
            tr_item(p.in[18] + (size_t)e * DE * D, D, kb * 64, nb * 32, (bf16_t*)(ws + WS_W2T) + (size_t)e * D * DE, DE, nb * 32, kb * 64, scr, lane); }
    }
    const float* x = p.in[0]; const float* g = p.in[1]; bf16_t* xn = (bf16_t*)(ws + WS_X);
    for (int m = gw; m < T; m += NGW) {
        const f32x4* xr = (const f32x4*)(x + (size_t)m * D) + lane; f32x4 v[8]; float s = 0.f;
#pragma unroll
        for (int j = 0; j < 8; ++j) { v[j] = xr[64 * j]; s += (v[j][0] * v[j][0] + v[j][1] * v[j][1]) + (v[j][2] * v[j][2] + v[j][3] * v[j][3]); }
        const float rs = 1.0f / sqrtf(wave_sum(s) * (1.0f / D) + EPS);
        u32x2* o = (u32x2*)(xn + (size_t)m * D) + lane;
#pragma unroll
        for (int j = 0; j < 8; ++j) { const f32x4 gg = *((const f32x4*)g + lane + 64 * j); u32x2 w; w.x = cvt_pk_bf16(v[j][0] * rs * gg[0], v[j][1] * rs * gg[1]); w.y = cvt_pk_bf16(v[j][2] * rs * gg[2], v[j][3] * rs * gg[3]); o[64 * j] = w; }
    }
    float* wr = (float*)(ws + WS_WR); const float* gf = p.in[11];
    for (int i = blockIdx.x * NTHREADS + tid; i < 20 * D; i += gridDim.x * NTHREADS) { const int j = i / D, d = i % D; wr[i] = gf[d] * (j < 4 ? p.in[12][d * 4 + j] : p.in[14][d * 16 + (j - 4)]); }
    { bf16_t* wmb = (bf16_t*)(ws + WS_WMB); const float* wsrc = p.in[6];
      for (int i = blockIdx.x * NTHREADS + tid; i < 8 * 128 * 128 / 2; i += gridDim.x * NTHREADS) { const int e0 = 2 * i, r = (e0 >> 7) & 127, c = e0 & 127; const bool ok = (r >= 64) || (c < 64);
          ((unsigned*)wmb)[i] = ok ? cvt_pk_bf16(wsrc[e0], wsrc[e0 + 1]) : 0u; } }
    if (blockIdx.x == 0 && tid < 64) ((int*)(ws + WS_CTL))[tid] = 0;
}

__device__ __forceinline__ void phase2_conv(const Params& p) {
    const bf16_t* Bc = (const bf16_t*)(p.ws + WS_P + P_BC); const bf16_t* P = (const bf16_t*)(p.ws + WS_P + P_P); bf16_t* Y = (bf16_t*)(p.ws + WS_X);
    const float* cw = p.in[3];
    for (int i = blockIdx.x * NTHREADS + threadIdx.x; i < T * (CW / 8); i += gridDim.x * NTHREADS) {
        const int t = i >> 7, c = (i & 127) * 8;
        f32x4 p0a, p0b, p1a, p1b, p2a, p2b, ba, bb;
        unpack8(*(const u32x4*)(P + (size_t)t * CW + c), p2a, p2b); unpack8(*(const u32x4*)(Bc + (size_t)t * CW + c), ba, bb);
        if (t >= 1) unpack8(*(const u32x4*)(P + (size_t)(t - 1) * CW + c), p1a, p1b); else { p1a = (f32x4){0, 0, 0, 0}; p1b = p1a; }
        if (t >= 2) unpack8(*(const u32x4*)(P + (size_t)(t - 2) * CW + c), p0a, p0b); else { p0a = (f32x4){0, 0, 0, 0}; p0b = p0a; }
        const f32x4 w0a = *(const f32x4*)(cw + c), w0b = *(const f32x4*)(cw + c + 4), w1a = *(const f32x4*)(cw + CW + c), w1b = *(const f32x4*)(cw + CW + c + 4),
                    w2a = *(const f32x4*)(cw + 2 * CW + c), w2b = *(const f32x4*)(cw + 2 * CW + c + 4);
        const f32x4 ya = ba * (w0a * p0a + w1a * p1a + w2a * p2a), yb = bb * (w0b * p0b + w1b * p1b + w2b * p2b);
        *(u32x4*)(Y + (size_t)t * 2048 + c) = pack8(ya, yb);
    }
}
__device__ __forceinline__ void phase2_sgu(const Params& p, LAS unsigned char* lds) {
    const int tid = threadIdx.x, wave = __builtin_amdgcn_readfirstlane(tid >> 6), lane = tid & 63, fr = lane & 15, fq = lane >> 4;
    const bf16_t* U = (const bf16_t*)(p.ws + WS_P + P_U); const bf16_t* V = (const bf16_t*)(p.ws + WS_P + P_V); bf16_t* Y = (bf16_t*)(p.ws + WS_X);
    const bf16_t* WmB = (const bf16_t*)(p.ws + WS_WMB);
    const float* lng = p.in[4]; const float* lnb = p.in[5]; const float* bs = p.in[7];
    LAS f32x2* st = (LAS f32x2*)lds;
    LAS unsigned char* vT = lds + 1024;
    constexpr int VP = 272;
    for (int unit = blockIdx.x; unit < 64 * 8; unit += gridDim.x) {
        const int nb = unit >> 3, h = unit & 7, t0 = nb * 128, c0 = h * 128;
        __syncthreads();
        for (int jj = 0; jj < 16; ++jj) { const int j = wave * 16 + jj; const u32x4* vr = (const u32x4*)(V + (size_t)(t0 + j) * SW) + lane * 2;
            f32x4 a, b, c, d; unpack8(vr[0], a, b); unpack8(vr[1], c, d);
            float s = (a[0] + a[1] + a[2] + a[3]) + (b[0] + b[1] + b[2] + b[3]) + (c[0] + c[1] + c[2] + c[3]) + (d[0] + d[1] + d[2] + d[3]);
            const float mu = wave_sum(s) * (1.0f / SW);
            a -= mu; b -= mu; c -= mu; d -= mu;
            float q = (a[0] * a[0] + a[1] * a[1] + a[2] * a[2] + a[3] * a[3]) + (b[0] * b[0] + b[1] * b[1] + b[2] * b[2] + b[3] * b[3]) + (c[0] * c[0] + c[1] * c[1] + c[2] * c[2] + c[3] * c[3]) + (d[0] * d[0] + d[1] * d[1] + d[2] * d[2] + d[3] * d[3]);
            const float rs = 1.0f / sqrtf(wave_sum(q) * (1.0f / SW) + EPS);
            if (lane == 0) st[j] = (f32x2){mu, rs}; }
        __syncthreads();
        if (tid < 256) {
            const int jb = tid >> 4, cb = tid & 15, j0 = jb * 8, cc0 = cb * 8;
            const f32x4 g0 = *(const f32x4*)(lng + c0 + cc0), g1 = *(const f32x4*)(lng + c0 + cc0 + 4), b0 = *(const f32x4*)(lnb + c0 + cc0), b1 = *(const f32x4*)(lnb + c0 + cc0 + 4);
            f32x4 lo[8], hi[8];
#pragma unroll
            for (int r = 0; r < 8; ++r) { const f32x2 s = st[j0 + r]; f32x4 a, b; unpack8(*(const u32x4*)(V + (size_t)(t0 + j0 + r) * SW + c0 + cc0), a, b);
                lo[r] = (a - s.x) * s.y * g0 + b0; hi[r] = (b - s.x) * s.y * g1 + b1; }
#pragma unroll
            for (int cc = 0; cc < 4; ++cc) { u32x4 o;
                o.x = cvt_pk_bf16(lo[0][cc], lo[1][cc]); o.y = cvt_pk_bf16(lo[2][cc], lo[3][cc]); o.z = cvt_pk_bf16(lo[4][cc], lo[5][cc]); o.w = cvt_pk_bf16(lo[6][cc], lo[7][cc]);
                *(LAS u32x4*)(vT + (cc0 + cc) * VP + j0 * 2) = o;
                o.x = cvt_pk_bf16(hi[0][cc], hi[1][cc]); o.y = cvt_pk_bf16(hi[2][cc], hi[3][cc]); o.z = cvt_pk_bf16(hi[4][cc], hi[5][cc]); o.w = cvt_pk_bf16(hi[6][cc], hi[7][cc]);
                *(LAS u32x4*)(vT + (cc0 + 4 + cc) * VP + j0 * 2) = o; }
        }
        __syncthreads();
        bf16x8 wf[4];
#pragma unroll
        for (int ks = 0; ks < 4; ++ks) wf[ks] = *(const bf16x8*)(WmB + ((size_t)h * 128 + wave * 16 + fr) * 128 + ks * 32 + fq * 8);
        f32x4 acc[8];
#pragma unroll
        for (int nk = 0; nk < 8; ++nk) { acc[nk] = (f32x4){0.f, 0.f, 0.f, 0.f};
#pragma unroll
            for (int ks = 0; ks < 4; ++ks) { const bf16x8 vf = *(const LAS bf16x8*)(vT + (nk * 16 + fr) * VP + (ks * 32 + fq * 8) * 2);
                acc[nk] = __builtin_amdgcn_mfma_f32_16x16x32_bf16(vf, wf[ks], acc[nk], 0, 0, 0); } }
        { const int i = wave * 16 + fr; const float bb = bs[h * 128 + i]; const size_t t = (size_t)(t0 + i);
#pragma unroll
          for (int nk = 0; nk < 8; ++nk) { const int c = c0 + nk * 16 + 4 * fq; const u32x2 uu = *(const u32x2*)(U + t * SW + c);
              u32x2 o; o.x = cvt_pk_bf16(bf_lo(uu.x) * (acc[nk][0] + bb), bf_hi(uu.x) * (acc[nk][1] + bb)); o.y = cvt_pk_bf16(bf_lo(uu.y) * (acc[nk][2] + bb), bf_hi(uu.y) * (acc[nk][3] + bb));
              *(u32x2*)(Y + t * 2048 + 1024 + c) = o; } }
    }
}

__device__ __forceinline__ void phase5_router(const Params& p, LAS unsigned char* lds) {
    const int tid = threadIdx.x, wave = __builtin_amdgcn_readfirstlane(tid >> 6), lane = tid & 63;
    const float* H = (const float*)(p.ws + WS_H); const float* wr = (const float*)(p.ws + WS_WR);
    float* rstd = (float*)(p.ws + WS_SMALL + SM_RSTD); int* ent = (int*)(p.ws + WS_SMALL + SM_ENT); float* lw = (float*)(p.ws + WS_SMALL + SM_W); int* cnt = (int*)(p.ws + WS_CTL);
    const float* brg = p.in[13]; const float* bre = p.in[15];
    LAS int* lcnt = (LAS int*)lds;
    LAS int* lbase = (LAS int*)(lds + 64);
    LAS int* le = (LAS int*)(lds + 128);
    LAS int* lp = (LAS int*)(lds + 128 + 256);
    LAS float* lwt = (LAS float*)(lds + 128 + 512);
    const int ngroups = T / 4, nrounds = (ngroups + gridDim.x * NWAVES - 1) / (gridDim.x * NWAVES);
    for (int rd = 0; rd < nrounds; ++rd) {
        const int grp = (rd * gridDim.x + blockIdx.x) * NWAVES + wave; const bool valid = grp < ngroups;
        if (tid < 16) lcnt[tid] = 0;
        __syncthreads();
        if (valid) {
            const int t0 = grp * 4;
            float acc[4][20]; float ss[4];
#pragma unroll
            for (int t = 0; t < 4; ++t) { ss[t] = 0.f;
#pragma unroll
                for (int j = 0; j < 20; ++j) acc[t][j] = 0.f; }
            for (int kc = 0; kc < 8; ++kc) {
                const int k = kc * 256 + lane * 4; f32x4 hv[4];
#pragma unroll
                for (int t = 0; t < 4; ++t) { hv[t] = *(const f32x4*)(H + (size_t)(t0 + t) * D + k); ss[t] += (hv[t][0] * hv[t][0] + hv[t][1] * hv[t][1]) + (hv[t][2] * hv[t][2] + hv[t][3] * hv[t][3]); }
#pragma unroll
                for (int j = 0; j < 20; ++j) { const f32x4 w = *(const f32x4*)(wr + (size_t)j * D + k);
#pragma unroll
                    for (int t = 0; t < 4; ++t) acc[t][j] += (hv[t][0] * w[0] + hv[t][1] * w[1]) + (hv[t][2] * w[2] + hv[t][3] * w[3]); }
            }
#pragma unroll
            for (int t = 0; t < 4; ++t) { ss[t] = wave_sum(ss[t]);
#pragma unroll
                for (int j = 0; j < 20; ++j) acc[t][j] = wave_sum(acc[t][j]); }
#pragma unroll
            for (int t = 0; t < 4; ++t) {
                const float rs = 1.0f / sqrtf(ss[t] * (1.0f / D) + EPS);
                float lg[4];
#pragma unroll
                for (int j = 0; j < 4; ++j) lg[j] = acc[t][j] * rs + brg[j];
                int gi = 0; float gm = lg[0];
#pragma unroll
                for (int j = 1; j < 4; ++j) if (lg[j] > gm) { gm = lg[j]; gi = j; }
                float den = 0.f;
#pragma unroll
                for (int j = 0; j < 4; ++j) den += __expf(lg[j] - gm);
                const float pg = 1.0f / den;
                float le4[4];
#pragma unroll
                for (int j = 0; j < 4; ++j) { const float v0 = acc[t][4 + j], v1 = acc[t][8 + j], v2 = acc[t][12 + j], v3 = acc[t][16 + j];
                    const float v = gi == 0 ? v0 : (gi == 1 ? v1 : (gi == 2 ? v2 : v3)); le4[j] = v * rs + bre[gi * 4 + j]; }
                int i1 = 0; float m1 = le4[0];
#pragma unroll
                for (int j = 1; j < 4; ++j) if (le4[j] > m1) { m1 = le4[j]; i1 = j; }
                int i2 = -1; float m2 = -3.0e38f;
#pragma unroll
                for (int j = 0; j < 4; ++j) if (j != i1 && le4[j] > m2) { m2 = le4[j]; i2 = j; }
                const float ex = __expf(m2 - m1); const float w1 = pg / (1.0f + ex), w2 = pg * ex / (1.0f + ex);
                if (lane == 0) {
                    rstd[t0 + t] = rs;
                    const int e1 = gi * 4 + i1, e2 = gi * 4 + i2; const int s = (wave * 4 + t) * 2;
                    le[s] = e1; le[s + 1] = e2; lwt[s] = w1; lwt[s + 1] = w2;
                    lp[s] = atomicAdd((int*)&lcnt[e1], 1); lp[s + 1] = atomicAdd((int*)&lcnt[e2], 1);
                }
            }
        }
        __syncthreads();
        if (tid < 16) { const int n = lcnt[tid]; lbase[tid] = n ? atomicAdd(&cnt[tid], n) : 0; }
        __syncthreads();
        if (valid && lane < 8) { const int s = wave * 8 + lane; const int e = le[s]; const int pos = lbase[e] + lp[s]; const int tok = grp * 4 + (lane >> 1);
            ent[e * T + pos] = tok | ((lane & 1) << 16); lw[e * T + pos] = lwt[s]; }
        __syncthreads();
    }
}

__device__ __forceinline__ void phase8_final(const Params& p) {
    const int tid = threadIdx.x, wave = __builtin_amdgcn_readfirstlane(tid >> 6), lane = tid & 63;
    const float* H = (const float*)(p.ws + WS_H); const bf16_t* Y0 = (const bf16_t*)(p.ws + WS_YK0); const bf16_t* Y1 = (const bf16_t*)(p.ws + WS_YK1); const float* g = p.in[19];
    const int gw = blockIdx.x * NWAVES + wave, NGW = gridDim.x * NWAVES;
    for (int m = gw; m < T; m += NGW) {
        f32x4 v[8]; float s = 0.f;
#pragma unroll
        for (int j = 0; j < 8; ++j) { const size_t o = (size_t)m * D + 4 * lane + 256 * j; v[j] = *(const f32x4*)(H + o);
            const u32x2 a = *(const u32x2*)(Y0 + o), b = *(const u32x2*)(Y1 + o);
            v[j][0] += bf_lo(a.x) + bf_lo(b.x); v[j][1] += bf_hi(a.x) + bf_hi(b.x); v[j][2] += bf_lo(a.y) + bf_lo(b.y); v[j][3] += bf_hi(a.y) + bf_hi(b.y);
            s += (v[j][0] * v[j][0] + v[j][1] * v[j][1]) + (v[j][2] * v[j][2] + v[j][3] * v[j][3]); }
        const float rs = 1.0f / sqrtf(wave_sum(s) * (1.0f / D) + EPS);
#pragma unroll
        for (int j = 0; j < 8; ++j) { const int c = 4 * lane + 256 * j; const f32x4 gg = *(const f32x4*)(g + c); *(f32x4*)(p.out + (size_t)m * D + c) = v[j] * rs * gg; }
    }
}

#define XB_TMO      128
#define XB_XCNT(j)  (256  + 64 * (j))
#define XB_XSUB(j)  (1280 + 64 * (j))
#define XB_XGEN(j)  (2304 + 64 * (j))
#define XB_TOP      3328
#define XB_TOPGEN   3392
#define XCD_BAR_WORDS 3456
#define XB_SPIN_CAP (1u << 18)
__device__ __forceinline__ unsigned xb_ld(unsigned* p)              { return __hip_atomic_load(p, __ATOMIC_RELAXED, __HIP_MEMORY_SCOPE_AGENT); }
__device__ __forceinline__ unsigned xb_add(unsigned* p, unsigned v) { return __hip_atomic_fetch_add(p, v, __ATOMIC_RELAXED, __HIP_MEMORY_SCOPE_AGENT); }
__device__ __forceinline__ unsigned xb_xcc_id() { return (unsigned)__builtin_amdgcn_s_getreg((3 << 11) | 20) & 0xFu; }
#define XB_SPIN(cond, bar) do { unsigned _sp = 0; while (cond) { __builtin_amdgcn_s_sleep(1); \
    if ((++_sp & 255u) == 0u) { if (xb_ld(&(bar)[XB_TMO])) break; if (_sp > XB_SPIN_CAP) { atomicAdd(&(bar)[XB_TMO], 1u); break; } } } } while (0)
struct XcdBarrier { unsigned* bar; unsigned x; volatile LAS unsigned* st; };
__device__ __forceinline__ XcdBarrier xcd_barrier_post(unsigned* bar, volatile LAS unsigned* st) {
    XcdBarrier b; b.bar = bar; b.x = xb_xcc_id(); b.st = st;
    if (threadIdx.x == 0) (void)xb_add(&bar[XB_XCNT(b.x)], 1u);
    return b;
}
__device__ __forceinline__ void xcd_barrier_complete(unsigned* bar, unsigned x, unsigned& nloc, unsigned& nx) {
    const unsigned G = gridDim.x * gridDim.y * gridDim.z;
    unsigned sum, cnt, mine, sp = 0u;
    for (;;) {
        sum = 0u; cnt = 0u; mine = 0u;
#pragma unroll
        for (unsigned j = 0; j < 16; ++j) { const unsigned c = xb_ld(&bar[XB_XCNT(j)]); sum += c; cnt += (c > 0u) ? 1u : 0u; mine = (j == x) ? c : mine; }
        if (sum == G) break;
        __builtin_amdgcn_s_sleep(1);
        if ((++sp & 255u) == 0u) { if (xb_ld(&bar[XB_TMO])) break; if (sp > XB_SPIN_CAP) { atomicAdd(&bar[XB_TMO], 1u); break; } }
    }
    nloc = mine > 0u ? mine : 1u; nx = cnt > 0u ? cnt : 1u;
}
__device__ __forceinline__ void xcd_barrier(const XcdBarrier& b) {
    asm volatile("s_waitcnt vmcnt(0)" ::: "memory");
    __syncthreads();
    if (threadIdx.x == 0) {
        unsigned* bar = b.bar;
        __builtin_amdgcn_s_waitcnt(0);
        unsigned nloc = b.st[0], nx = b.st[1];
        if (nloc == 0u) { xcd_barrier_complete(bar, b.x, nloc, nx); b.st[0] = nloc; b.st[1] = nx; }
        const unsigned old = xb_add(&bar[XB_XSUB(b.x)], 1u);
        const unsigned gen = old / nloc;
        if (old + 1u == (gen + 1u) * nloc) {
            __builtin_amdgcn_fence(__ATOMIC_RELEASE, "agent");
            asm volatile("s_waitcnt vmcnt(0)" ::: "memory");
            const unsigned og = xb_add(&bar[XB_TOP], 1u);
            const unsigned tg = og / nx;
            if (og + 1u == (tg + 1u) * nx) xb_add(&bar[XB_TOPGEN], 1u);
            else XB_SPIN(xb_ld(&bar[XB_TOPGEN]) == tg, bar);
            __builtin_amdgcn_fence(__ATOMIC_ACQUIRE, "agent");
            xb_add(&bar[XB_XGEN(b.x)], 1u);
            asm volatile("s_waitcnt vmcnt(0)" ::: "memory");
        } else {
            XB_SPIN(xb_ld(&bar[XB_XGEN(b.x)]) == gen, bar);
            __builtin_amdgcn_fence(__ATOMIC_ACQUIRE, "agent");
            asm volatile("s_waitcnt vmcnt(0)" ::: "memory");
        }
    }
    __syncthreads();
}

template <int PH> __device__ __forceinline__ void run_phase(const Params& p, LAS unsigned char* lds) {
    unsigned char* ws = p.ws;
    if constexpr (PH == 0) phase0(p, lds);
    if constexpr (PH == 1) { DenseSched S; S.init((const bf16_t*)(ws + WS_X), (const bf16_t*)(ws + WS_WINT), T, NIN, D);
        EpiProj E{(bf16_t*)(ws + WS_P + P_BC), (bf16_t*)(ws + WS_P + P_P), (bf16_t*)(ws + WS_P + P_U), (bf16_t*)(ws + WS_P + P_V), (bf16_t*)(ws + WS_P + P_R), (bf16_t*)(ws + WS_P + P_S)};
        gemm_run<0>(lds, S, E, D); }
    if constexpr (PH == 2) { phase2_conv(p); phase2_sgu(p, lds); }
    if constexpr (PH == 3) { DenseSched S; S.init((const bf16_t*)(ws + WS_X), (const bf16_t*)(ws + WS_WUPT), T, D, 2048);
        EpiUp E{(const bf16_t*)(ws + WS_P + P_R), (const bf16_t*)(ws + WS_P + P_S), (bf16_t*)(ws + WS_MM)}; gemm_run<1>(lds, S, E, 2048); }
    if constexpr (PH == 4) { DenseSched S; S.init((const bf16_t*)(ws + WS_MM), (const bf16_t*)(ws + WS_WOUTT), T, D, D);
        EpiOut E{p.in[0], p.in[11], (float*)(ws + WS_H), (bf16_t*)(ws + WS_A2)}; gemm_run<2>(lds, S, E, D); }
    if constexpr (PH == 5) phase5_router(p, lds);
    if constexpr (PH == 6) { MoeSched<true, 4, D, 1024> S{(const bf16_t*)(ws + WS_A2), (const bf16_t*)(ws + WS_W1T), (const int*)(ws + WS_CTL), (const int*)(ws + WS_SMALL + SM_ENT), (int)gridDim.x, (int)blockIdx.x};
        EpiMoe1 E{(const int*)(ws + WS_SMALL + SM_ENT), (const float*)(ws + WS_SMALL + SM_W), (const float*)(ws + WS_SMALL + SM_RSTD), (bf16_t*)(ws + WS_HID)}; gemm_run<3>(lds, S, E, D); }
    if constexpr (PH == 7) { MoeSched<false, 8, DE, D> S{(const bf16_t*)(ws + WS_HID), (const bf16_t*)(ws + WS_W2T), (const int*)(ws + WS_CTL), (const int*)(ws + WS_SMALL + SM_ENT), (int)gridDim.x, (int)blockIdx.x};
        EpiMoe2 E{(const int*)(ws + WS_SMALL + SM_ENT), (bf16_t*)(ws + WS_YK0), (bf16_t*)(ws + WS_YK1)}; gemm_run<4>(lds, S, E, DE); }
    if constexpr (PH == 8) phase8_final(p);
}

template <int PH> __global__ void __launch_bounds__(NTHREADS, 2) k_phase(Params p) {
    extern __shared__ __attribute__((aligned(16))) unsigned char lds_raw[];
    run_phase<PH>(p, (LAS unsigned char*)lds_raw);
}

#ifndef PROBE_DUP
#define PROBE_DUP 0
#endif
#ifndef PROBE_SYNCS
#define PROBE_SYNCS 0
#endif
#define DUP(k) ((PROBE_DUP >> (k)) & 1)
__global__ void __launch_bounds__(NTHREADS, 2) k_mega(Params p) {
    extern __shared__ __attribute__((aligned(16))) unsigned char lds_raw[];
    LAS unsigned char* lds = (LAS unsigned char*)lds_raw;
    cg::grid_group grid = cg::this_grid();
    volatile LAS unsigned* xbst = (volatile LAS unsigned*)(lds + 131072 + 1024);
    if (threadIdx.x < 4) xbst[threadIdx.x] = 0u;
    __syncthreads();
    const XcdBarrier bar = xcd_barrier_post((unsigned*)(p.ws + WS_BAR), xbst);
#define GSYNC() xcd_barrier(bar)
    run_phase<0>(p, lds); grid.sync();
    if (DUP(0)) { run_phase<0>(p, lds); GSYNC(); }
    run_phase<1>(p, lds); GSYNC();
    if (DUP(1)) { run_phase<1>(p, lds); GSYNC(); }
    run_phase<2>(p, lds); GSYNC();
    if (DUP(2)) { run_phase<2>(p, lds); GSYNC(); }
    run_phase<3>(p, lds); GSYNC();
    if (DUP(3)) { run_phase<3>(p, lds); GSYNC(); }
    run_phase<4>(p, lds); GSYNC();
    if (DUP(4)) { run_phase<4>(p, lds); GSYNC(); }
    run_phase<5>(p, lds); GSYNC();
    if (DUP(5)) { if (blockIdx.x == 0 && threadIdx.x < 64) ((int*)(p.ws + WS_CTL))[threadIdx.x] = 0; GSYNC(); run_phase<5>(p, lds); GSYNC(); }
    run_phase<6>(p, lds); GSYNC();
    if (DUP(6)) { run_phase<6>(p, lds); GSYNC(); }
    run_phase<7>(p, lds); GSYNC();
    if (DUP(7)) { run_phase<7>(p, lds); GSYNC(); }
    for (int i = 0; i < PROBE_SYNCS; ++i) GSYNC();
    run_phase<8>(p, lds);
    if (DUP(8)) { GSYNC(); run_phase<8>(p, lds); }
}

template <int PH> static void launch_phase(const Params& p, int grid, hipStream_t stream) {
    static bool attr = false;
    if (!attr) { (void)hipFuncSetAttribute((const void*)k_phase<PH>, hipFuncAttributeMaxDynamicSharedMemorySize, LDS_BYTES); attr = true; }
    hipLaunchKernelGGL(k_phase<PH>, dim3(grid), dim3(NTHREADS), LDS_BYTES, stream, p);
}

extern "C" void kernel_launch(void* const* d_in, const int* in_sizes, int n_in, void* d_out, int out_size, void* d_ws, size_t ws_size, hipStream_t stream) {
    static int grid = 0;
    if (grid == 0) {
        if (n_in != 20 || out_size != T * D || ws_size < WS_END) { fprintf(stderr, "kernel_launch: unexpected shapes n_in %d out %d ws %zu (need %zu)\n", n_in, out_size, ws_size, (size_t)WS_END); grid = -1; return; }
        int dev = 0, cus = 0, per_cu = 0;
        (void)hipGetDevice(&dev); (void)hipDeviceGetAttribute(&cus, hipDeviceAttributeMultiprocessorCount, dev);
        (void)hipFuncSetAttribute((const void*)k_mega, hipFuncAttributeMaxDynamicSharedMemorySize, LDS_BYTES);
        (void)hipOccupancyMaxActiveBlocksPerMultiprocessor(&per_cu, (const void*)k_mega, NTHREADS, LDS_BYTES);
        if (per_cu < 1) { fprintf(stderr, "kernel_launch: occupancy query says %d blocks per CU\n", per_cu); per_cu = 1; }
        grid = cus * 1;
        (void)hipGetLastError();
    }
    if (grid < 0) return;
    Params p{};
    for (int i = 0; i < 20; ++i) p.in[i] = (const float*)d_in[i];
    p.out = (float*)d_out; p.ws = (unsigned char*)d_ws;
    (void)hipMemsetAsync((char*)d_ws + WS_CTL, 0, 64 * 1024, stream);
#if ONE_LAUNCH
    void* args[] = {&p};
    hipError_t e = hipLaunchCooperativeKernel((const void*)k_mega, dim3(grid), dim3(NTHREADS), args, LDS_BYTES, stream);
    if (e != hipSuccess) fprintf(stderr, "cooperative launch failed: %s (grid %d)\n", hipGetErrorString(e), grid);
#else
    launch_phase<0>(p, grid, stream); launch_phase<1>(p, grid, stream); launch_phase<2>(p, grid, stream); launch_phase<3>(p, grid, stream); launch_phase<4>(p, grid, stream);
    launch_phase<5>(p, grid, stream); launch_phase<6>(p, grid, stream); launch_phase<7>(p, grid, stream); launch_phase<8>(p, grid, stream);
#endif
}
```

```cpp
#include <hip/hip_runtime.h>
#include <hip/hip_cooperative_groups.h>
#include <cstdio>
#include <cstdint>
namespace cg = cooperative_groups;

#ifndef ONE_LAUNCH
#define ONE_LAUNCH 1
#endif

#define LAS __attribute__((address_space(3)))
typedef unsigned short bf16_t;
typedef short bf16x8 __attribute__((ext_vector_type(8)));
typedef float f32x4 __attribute__((ext_vector_type(4)));
typedef float f32x2 __attribute__((ext_vector_type(2)));
typedef unsigned u32x4 __attribute__((ext_vector_type(4)));
typedef unsigned u32x2 __attribute__((ext_vector_type(2)));

constexpr int T = 8192, D = 2048, CW = 1024, SW = 1024, NIN = 9216, NE = 16, DE = 512;
constexpr float EPS = 1e-6f;
constexpr int NTHREADS = 512, NWAVES = 8;
constexpr int LDS_BYTES = 140 * 1024;
constexpr int HID_ROWS = 2 * T + NE * 256;

constexpr size_t MiB = 1024 * 1024;
constexpr size_t WS_CTL   = 0;
constexpr size_t WS_BAR   = 4096;
constexpr size_t WS_SMALL = 64 * 1024;
constexpr size_t SM_RSTD = 0, SM_ENT = 32 * 1024, SM_W = SM_ENT + (size_t)NE * T * 4, SM_END = SM_W + (size_t)NE * T * 4;
constexpr size_t WS_WR    = WS_SMALL + 2 * MiB;
constexpr size_t WS_WMB   = WS_WR + 256 * 1024;
constexpr size_t WS_WINT  = WS_WMB + 256 * 1024;
constexpr size_t WS_WUPT  = WS_WINT + (size_t)NIN * D * 2;
constexpr size_t WS_WOUTT = WS_WUPT + (size_t)D * D * 2;
constexpr size_t WS_W1T   = WS_WOUTT + (size_t)D * D * 2;
constexpr size_t WS_W2T   = WS_W1T + (size_t)NE * 1024 * D * 2;
constexpr size_t WS_X     = WS_W2T + (size_t)NE * D * DE * 2;
constexpr size_t WS_P     = WS_X + (size_t)T * D * 2;
constexpr size_t P_BC = 0, P_P = P_BC + (size_t)T * CW * 2, P_U = P_P + (size_t)T * CW * 2, P_V = P_U + (size_t)T * SW * 2,
                 P_R = P_V + (size_t)T * SW * 2, P_S = P_R + (size_t)T * D * 2, P_END = P_S + (size_t)T * D * 2;
constexpr size_t WS_END   = WS_P + P_END;
constexpr size_t WS_MM  = WS_WINT;
constexpr size_t WS_H   = WS_P + P_BC;
constexpr size_t WS_A2  = WS_P + P_R;
constexpr size_t WS_HID = WS_P + P_S;
constexpr size_t WS_YK0 = WS_X;
constexpr size_t WS_YK1 = WS_WINT;
static_assert(SM_END <= 2 * MiB, "small region");
static_assert((size_t)HID_ROWS * DE * 2 <= (size_t)T * D * 2, "hid overlay");
static_assert((size_t)T * D * 4 <= P_R, "H overlay");

struct Params { const float* in[20]; float* out; unsigned char* ws; };

__device__ __forceinline__ unsigned cvt_pk_bf16(float lo, float hi) { unsigned r; asm("v_cvt_pk_bf16_f32 %0, %1, %2" : "=v"(r) : "v"(lo), "v"(hi)); return r; }
__device__ __forceinline__ float bf_lo(unsigned w) { return __uint_as_float(w << 16); }
__device__ __forceinline__ float bf_hi(unsigned w) { return __uint_as_float(w & 0xffff0000u); }
__device__ __forceinline__ float bf1(bf16_t b) { return __uint_as_float(((unsigned)b) << 16); }
__device__ __forceinline__ float wave_sum(float v) {
#pragma unroll
    for (int o = 1; o < 64; o <<= 1) v += __shfl_xor(v, o);
    return v;
}
__device__ __forceinline__ float fast_rcp(float x) { return __builtin_amdgcn_rcpf(x); }
__device__ __forceinline__ float fast_exp2(float x) { return __builtin_amdgcn_exp2f(x); }
__device__ __forceinline__ float sigmoid_f(float x) { return fast_rcp(1.0f + fast_exp2(-1.44269504f * x)); }
__device__ __forceinline__ float gelu_tanh(float x) {
    const float u = x + 0.044715f * x * x * x;
    return x * fast_rcp(1.0f + fast_exp2(-2.30220819f * u));
}
__device__ __forceinline__ int opaque_tid() { int t = threadIdx.x; asm volatile("" : "+v"(t)); return t; }
__host__ __device__ __forceinline__ int perm32(int rho) { const int n = rho >> 4, i = rho & 15; return 8 * (i >> 2) + 4 * n + (i & 3); }

struct Unit { int pm, pn, e, row0, nvalid; };
constexpr int NXCD = 8, WGM = 8;
struct DenseSched {
    const bf16_t* A; const bf16_t* Bt; int K; int nM, nN, nwg, G, c;
    __device__ __forceinline__ void init(const bf16_t* A_, const bf16_t* Bt_, int M, int N, int K_) { A = A_; Bt = Bt_; K = K_; nM = M / 256; nN = N / 256; nwg = nM * nN; G = gridDim.x; c = blockIdx.x; }
    __device__ __forceinline__ bool next(int i, Unit& u) const {
        const long L = (long)i * G + c; if (L >= nwg) return false;
        int wgid = (int)L; { const int q = nwg / NXCD, r = nwg % NXCD, xcd = wgid % NXCD, off = wgid / NXCD; wgid = (xcd < r ? xcd * (q + 1) : r * (q + 1) + (xcd - r) * q) + off; }
        const int nig = WGM * nN, gid = wgid / nig, fm = gid * WGM, gsz = (nM - fm) < WGM ? (nM - fm) : WGM;
        u.pm = fm + ((wgid % nig) % gsz); u.pn = (wgid % nig) / gsz; u.e = 0; u.row0 = u.pm * 256; u.nvalid = 256; return true;
    }
    __device__ __forceinline__ const char* a_base() const { return (const char*)A; }
    __device__ __forceinline__ unsigned a_off(const Unit& u, int r) const { return (unsigned)(u.row0 + r) * (unsigned)K * 2u; }
    __device__ __forceinline__ const char* b_base(const Unit& u) const { return (const char*)Bt + (size_t)u.pn * 256 * K * 2; }
};
template <bool GATHER, int NPN, int KK, int NROWS_E  >
struct MoeSched {
    const bf16_t* A; const bf16_t* Bt; const int* cnt; const int* ent; int G, c;
    __device__ __forceinline__ bool next(int i, Unit& u) const {
        int L = i * G + c; int hb = 0;
        for (int e = 0; e < NE; ++e) {
            const int n = __builtin_amdgcn_readfirstlane(cnt[e]); const int nt = (n + 255) >> 8;
            if (L < nt * NPN) { u.e = e; u.pm = L / NPN; u.pn = L % NPN; u.row0 = hb + u.pm * 256; u.nvalid = min(256, n - u.pm * 256); return true; }
            L -= nt * NPN; hb += nt * 256;
        }
        return false;
    }
    __device__ __forceinline__ const char* a_base() const { return (const char*)A; }
    __device__ __forceinline__ unsigned a_off(const Unit& u, int r) const {
        if (GATHER) { const int tok = (r < u.nvalid) ? (ent[u.e * T + u.pm * 256 + r] & 0xffff) : 0; return (unsigned)tok * (unsigned)KK * 2u; }
        return (unsigned)(u.row0 + r) * (unsigned)KK * 2u;
    }
    __device__ __forceinline__ const char* b_base(const Unit& u) const { return (const char*)Bt + ((size_t)u.e * NROWS_E + (size_t)u.pn * 256) * KK * 2; }
};

typedef f32x4 Acc[2][2][4][2];
__device__ __forceinline__ u32x4 pack8(f32x4 a, f32x4 b) { u32x4 w; w.x = cvt_pk_bf16(a[0], a[1]); w.y = cvt_pk_bf16(a[2], a[3]); w.z = cvt_pk_bf16(b[0], b[1]); w.w = cvt_pk_bf16(b[2], b[3]); return w; }
__device__ __forceinline__ void unpack8(u32x4 w, f32x4& a, f32x4& b) { a = (f32x4){bf_lo(w.x), bf_hi(w.x), bf_lo(w.y), bf_hi(w.y)}; b = (f32x4){bf_lo(w.z), bf_hi(w.z), bf_lo(w.w), bf_hi(w.w)}; }

struct EpiProj {
    static constexpr bool PERM = true; static constexpr int MIDK = 0;
    bf16_t *Bc, *P, *U, *V, *R, *S;
    __device__ __forceinline__ void mid(Acc&, const Unit&, int, int, int, int) const {}
    __device__ __forceinline__ void operator()(const Acc& acc, const Unit& u, int wr, int wc, int fr, int fq) const {
        const int pn = u.pn; const int rowb = u.row0 + wr * 64 + fr; const int cl = wc * 32 + 8 * fq;
#pragma unroll
        for (int ai = 0; ai < 2; ++ai)
#pragma unroll
            for (int m = 0; m < 4; ++m) {
                const size_t row = (size_t)(rowb + ai * 128 + m * 16);
                if (pn < 4) {
#pragma unroll
                    for (int bj = 0; bj < 2; ++bj) *(u32x4*)(Bc + row * CW + pn * 256 + bj * 128 + cl) = pack8(acc[ai][bj][m][0], acc[ai][bj][m][1]);
                } else if (pn < 12) {
                    *(u32x4*)(P + row * CW + (pn - 4) * 128 + cl) = pack8(acc[ai][0][m][0] * acc[ai][1][m][0], acc[ai][0][m][1] * acc[ai][1][m][1]);
                } else if (pn < 20) {
                    bf16_t* O = (pn < 16) ? (U + row * SW + (pn - 12) * 256) : (V + row * SW + (pn - 16) * 256);
#pragma unroll
                    for (int bj = 0; bj < 2; ++bj) { f32x4 a = acc[ai][bj][m][0], b = acc[ai][bj][m][1];
#pragma unroll
                        for (int j = 0; j < 4; ++j) { a[j] = gelu_tanh(a[j]); b[j] = gelu_tanh(b[j]); }
                        *(u32x4*)(O + bj * 128 + cl) = pack8(a, b); }
                } else {
                    f32x4 r0, r1, s0, s1;
#pragma unroll
                    for (int j = 0; j < 4; ++j) {
                        const float ec0 = fast_exp2(-1.44269504f * acc[ai][0][m][0][j]), es0 = fast_exp2(-1.44269504f * acc[ai][1][m][0][j]);
                        const float ec1 = fast_exp2(-1.44269504f * acc[ai][0][m][1][j]), es1 = fast_exp2(-1.44269504f * acc[ai][1][m][1][j]);
                        r0[j] = (1.0f + es0) * fast_rcp(1.0f + ec0); s0[j] = fast_rcp(1.0f + es0);
                        r1[j] = (1.0f + es1) * fast_rcp(1.0f + ec1); s1[j] = fast_rcp(1.0f + es1);
                    }
                    const size_t o = row * D + (pn - 20) * 128 + cl;
                    *(u32x4*)(R + o) = pack8(r0, r1); *(u32x4*)(S + o) = pack8(s0, s1);
                }
            }
    }
};
struct EpiUp {
    static constexpr bool PERM = true; static constexpr int MIDK = 1024;
    const bf16_t *R, *S; bf16_t* Mm;
    __device__ __forceinline__ void mid(Acc& acc, const Unit& u, int wr, int wc, int fr, int fq) const {
        int rowb = u.row0 + wr * 64 + fr; const int cb = u.pn * 256 + wc * 32 + 8 * fq;
        asm volatile("" : "+v"(rowb));
#pragma unroll
        for (int ai = 0; ai < 2; ++ai)
#pragma unroll
            for (int m = 0; m < 4; ++m)
#pragma unroll
                for (int bj = 0; bj < 2; ++bj) { f32x4 a, b; unpack8(*(const u32x4*)(R + (size_t)(rowb + ai * 128 + m * 16) * D + cb + bj * 128), a, b);
                    acc[ai][bj][m][0] *= a; acc[ai][bj][m][1] *= b; }
    }
    __device__ __forceinline__ void operator()(const Acc& acc, const Unit& u, int wr, int wc, int fr, int fq) const {
        const int rowb = u.row0 + wr * 64 + fr; const int cb = u.pn * 256 + wc * 32 + 8 * fq;
#pragma unroll
        for (int ai = 0; ai < 2; ++ai)
#pragma unroll
            for (int m = 0; m < 4; ++m)
#pragma unroll
                for (int bj = 0; bj < 2; ++bj) { const size_t o = (size_t)(rowb + ai * 128 + m * 16) * D + cb + bj * 128; f32x4 a, b; unpack8(*(const u32x4*)(S + o), a, b);
                    *(u32x4*)(Mm + o) = pack8(acc[ai][bj][m][0] * a, acc[ai][bj][m][1] * b); }
    }
};
struct EpiOut {
    static constexpr bool PERM = true; static constexpr int MIDK = 0;
    const float* x; bf16_t* A2;
    __device__ __forceinline__ void mid(Acc&, const Unit&, int, int, int, int) const {}
    __device__ __forceinline__ void operator()(const Acc& acc, const Unit& u, int wr, int wc, int fr, int fq) const {
        const int rowb = u.row0 + wr * 64 + fr; const int cb = u.pn * 256 + wc * 32 + 8 * fq;
#pragma unroll
        for (int ai = 0; ai < 2; ++ai)
#pragma unroll
            for (int m = 0; m < 4; ++m)
#pragma unroll
                for (int bj = 0; bj < 2; ++bj) { const size_t o = (size_t)(rowb + ai * 128 + m * 16) * D + cb + bj * 128;
                    const f32x4 h0 = *(const f32x4*)(x + o) + acc[ai][bj][m][0], h1 = *(const f32x4*)(x + o + 4) + acc[ai][bj][m][1];
                    *(u32x4*)(A2 + o) = pack8(h0, h1); }
    }
};
struct EpiMoe1 {
    static constexpr bool PERM = true; static constexpr int MIDK = 0;
    const int* ent; const float* lw; const float* rstd; bf16_t* Hid;
    __device__ __forceinline__ void mid(Acc&, const Unit&, int, int, int, int) const {}
    __device__ __forceinline__ void operator()(const Acc& acc, const Unit& u, int wr, int wc, int fr, int fq) const {
        const int cl = u.pn * 128 + wc * 32 + 8 * fq;
#pragma unroll
        for (int ai = 0; ai < 2; ++ai)
#pragma unroll
            for (int m = 0; m < 4; ++m) {
                const int r = ai * 128 + wr * 64 + m * 16 + fr;
                if (r < u.nvalid) {
                    const int li = u.e * T + u.pm * 256 + r; const int tok = ent[li] & 0xffff; const float rs = rstd[tok], w = lw[li];
                    f32x4 o[2];
#pragma unroll
                    for (int n = 0; n < 2; ++n)
#pragma unroll
                        for (int j = 0; j < 4; ++j) { const float gt = acc[ai][0][m][n][j] * rs, up = acc[ai][1][m][n][j] * rs; o[n][j] = gt * sigmoid_f(gt) * up * w; }
                    *(u32x4*)(Hid + (size_t)(u.row0 + r) * DE + cl) = pack8(o[0], o[1]);
                }
            }
    }
};
struct EpiMoe2 {
    static constexpr bool PERM = true; static constexpr int MIDK = 0;
    const int* ent; bf16_t* Yk0; bf16_t* Yk1;
    __device__ __forceinline__ void mid(Acc&, const Unit&, int, int, int, int) const {}
    __device__ __forceinline__ void operator()(const Acc& acc, const Unit& u, int wr, int wc, int fr, int fq) const {
        const int cb = u.pn * 256 + wc * 32 + 8 * fq;
#pragma unroll
        for (int ai = 0; ai < 2; ++ai)
#pragma unroll
            for (int m = 0; m < 4; ++m) {
                const int r = ai * 128 + wr * 64 + m * 16 + fr;
                if (r < u.nvalid) {
                    const int en = ent[u.e * T + u.pm * 256 + r]; const int tok = en & 0xffff; bf16_t* Y = (en >> 16) ? Yk1 : Yk0;
#pragma unroll
                    for (int bj = 0; bj < 2; ++bj) *(u32x4*)(Y + (size_t)tok * D + cb + bj * 128) = pack8(acc[ai][bj][m][0], acc[ai][bj][m][1]);
                }
            }
    }
};

template <class Epi, class Sched>
__device__ __forceinline__ void gemm_simple(const Sched& S, const Epi& E, const int K) {
    const int tid = opaque_tid(), wid = __builtin_amdgcn_readfirstlane(tid >> 6), lane = tid & 63, wr = wid >> 2, wc = wid & 3, fr = lane & 15, fq = lane >> 4;
    Unit u;
    for (int ui = 0; S.next(ui, u); ++ui) {
        Acc acc;
#pragma unroll
        for (int a = 0; a < 2; ++a)
#pragma unroll
            for (int b = 0; b < 2; ++b)
#pragma unroll
                for (int m = 0; m < 4; ++m)
#pragma unroll
                    for (int n = 0; n < 2; ++n) acc[a][b][m][n] = (f32x4){0.f, 0.f, 0.f, 0.f};
        const char* ab = S.a_base(); const char* bb = S.b_base(u);
        unsigned aoff[2][4], boff[2][2];
#pragma unroll
        for (int ai = 0; ai < 2; ++ai)
#pragma unroll
            for (int m = 0; m < 4; ++m) aoff[ai][m] = S.a_off(u, ai * 128 + wr * 64 + m * 16 + fr) + fq * 16;
#pragma unroll
        for (int bj = 0; bj < 2; ++bj)
#pragma unroll
            for (int n = 0; n < 2; ++n) { const int rr = Epi::PERM ? perm32(n * 16 + fr) : (n * 16 + fr); boff[bj][n] = (unsigned)(bj * 128 + wc * 32 + rr) * (unsigned)K * 2u + fq * 16; }
        for (int k0 = 0; k0 < K; k0 += 32) {
            if (Epi::MIDK != 0 && k0 == Epi::MIDK) E.mid(acc, u, wr, wc, fr, fq);
            bf16x8 a[2][4], b[2][2];
#pragma unroll
            for (int ai = 0; ai < 2; ++ai)
#pragma unroll
                for (int m = 0; m < 4; ++m) a[ai][m] = *(const bf16x8*)(ab + aoff[ai][m] + k0 * 2);
#pragma unroll
            for (int bj = 0; bj < 2; ++bj)
#pragma unroll
                for (int n = 0; n < 2; ++n) b[bj][n] = *(const bf16x8*)(bb + boff[bj][n] + k0 * 2);
#pragma unroll
            for (int ai = 0; ai < 2; ++ai)
#pragma unroll
                for (int bj = 0; bj < 2; ++bj)
#pragma unroll
                    for (int m = 0; m < 4; ++m)
#pragma unroll
                        for (int n = 0; n < 2; ++n) acc[ai][bj][m][n] = __builtin_amdgcn_mfma_f32_16x16x32_bf16(b[bj][n], a[ai][m], acc[ai][bj][m][n], 0, 0, 0);
        }
        E(acc, u, wr, wc, fr, fq);
    }
}

constexpr int BK = 64, HALF = 128, HTB = HALF * BK * 2, STAGE_BYTES = 8 * HTB;
__host__ __device__ __forceinline__ int lds_byte(int r, int c) { const int st = (r >> 4) * 2 + (c >> 5), rr = r & 15, cc = c & 31, ob = rr * 64 + cc * 2; return st * 1024 + (ob ^ (((ob >> 9) & 1) << 5)); }
__host__ __device__ __forceinline__ void stage_rc(int b, int& R, int& C) { const int st = b / 1024, sb = b % 1024, swz = sb ^ (((sb >> 9) & 1) << 5); R = (st >> 1) * 16 + swz / 64; C = (st & 1) * 32 + (swz % 64) / 2; }

template <class Epi, class Sched>
__device__ __forceinline__ void gemm_fast(LAS unsigned char* lds, const Sched& S, const Epi& E, const int K) {
    const int tid = opaque_tid(), wid = __builtin_amdgcn_readfirstlane(tid >> 6), lane = tid & 63, wr = wid >> 2, wc = wid & 3, fr = lane & 15, fq = lane >> 4;
    const int nt = K / BK;
    int sR[2], sC[2]; unsigned voffB[2];
#pragma unroll
    for (int i = 0; i < 2; ++i) { stage_rc(tid * 16 + i * 8192, sR[i], sC[i]); const int Rb = Epi::PERM ? ((sR[i] & ~31) + perm32(sR[i] & 31)) : sR[i]; voffB[i] = (unsigned)(Rb * K + sC[i]) * 2u; }
    const size_t kstep = (size_t)(BK * 2);
    const size_t hstepB = (size_t)HALF * K * 2;
    const unsigned ldsw = (unsigned)wid * 1024u;
    const int aoff = lds_byte(wr * 64 + fr, fq * 8), boff = lds_byte(wc * 32 + fr, fq * 8);
#define PG8_SA(b, h) (((b) * 2 + (h)) * HTB)
#define PG8_SB(b, h) ((4 + (b) * 2 + (h)) * HTB)
#define PG8_STAGE(bufoff, gbase, voff) do { _Pragma("unroll") for (int _i = 0; _i < 2; ++_i) \
        __builtin_amdgcn_global_load_lds((const unsigned*)((const char*)(gbase) + (voff)[_i]), (LAS unsigned*)(lds + (bufoff) + ldsw + _i * 8192), 16, 0, 0); } while (0)
#define PG8_LDA(dst, b, h) do { _Pragma("unroll") for (int m = 0; m < 4; ++m) _Pragma("unroll") for (int k = 0; k < 2; ++k) dst[m][k] = *(const LAS bf16x8*)(lds + PG8_SA(b, h) + aoff + m * 2048 + k * 1024); } while (0)
#define PG8_LDB(dst, b, h) do { _Pragma("unroll") for (int n = 0; n < 2; ++n) _Pragma("unroll") for (int k = 0; k < 2; ++k) dst[n][k] = *(const LAS bf16x8*)(lds + PG8_SB(b, h) + boff + n * 2048 + k * 1024); } while (0)
#define PG8_MMA(ai, bj, At, Bt) do { __builtin_amdgcn_s_setprio(1); _Pragma("unroll") for (int m = 0; m < 4; ++m) _Pragma("unroll") for (int n = 0; n < 2; ++n) _Pragma("unroll") for (int k = 0; k < 2; ++k) \
        acc[ai][bj][m][n] = __builtin_amdgcn_mfma_f32_16x16x32_bf16(Bt[n][k], At[m][k], acc[ai][bj][m][n], 0, 0, 0); __builtin_amdgcn_s_setprio(0); } while (0)
#define PG8_WAIT_V(n) asm volatile("s_waitcnt vmcnt(" #n ")" ::: "memory")
#define PG8_WAIT_L(n) asm volatile("s_waitcnt lgkmcnt(" #n ")" ::: "memory")
#define PG8_BAR __builtin_amdgcn_s_barrier()
#define PG8_SCHED __builtin_amdgcn_sched_barrier(0)
    Unit cur, nxt; int ui = 0;
    if (!S.next(0, cur)) return;
    Acc acc;
#pragma unroll
    for (int a = 0; a < 2; ++a)
#pragma unroll
        for (int b = 0; b < 2; ++b)
#pragma unroll
            for (int m = 0; m < 4; ++m)
#pragma unroll
                for (int n = 0; n < 2; ++n) acc[a][b][m][n] = (f32x4){0.f, 0.f, 0.f, 0.f};
    bf16x8 At[4][2], B0[2][2], B1[2][2];
    unsigned va[2][2], vn[2][2];
#pragma unroll
    for (int h = 0; h < 2; ++h)
#pragma unroll
        for (int i = 0; i < 2; ++i) va[h][i] = S.a_off(cur, h * 128 + sR[i]) + (unsigned)sC[i] * 2u;
    const char* const A0 = S.a_base(); const char* cB = S.b_base(cur);
    PG8_STAGE(PG8_SB(0, 0), cB, voffB); PG8_STAGE(PG8_SB(0, 1), cB + hstepB, voffB); PG8_STAGE(PG8_SA(0, 0), A0, va[0]); PG8_STAGE(PG8_SA(0, 1), A0, va[1]);
    if (wr == 1) PG8_BAR;
    PG8_WAIT_V(2); PG8_BAR;
    PG8_STAGE(PG8_SB(1, 0), cB + kstep, voffB); PG8_STAGE(PG8_SA(1, 0), A0 + kstep, va[0]); PG8_STAGE(PG8_SB(1, 1), cB + hstepB + kstep, voffB);
    PG8_WAIT_V(6); PG8_BAR;
    for (;;) {
        const bool has_next = S.next(ui + 1, nxt);
        const char* nB = has_next ? S.b_base(nxt) : cB;
#pragma unroll
        for (int h = 0; h < 2; ++h)
#pragma unroll
            for (int i = 0; i < 2; ++i) vn[h][i] = has_next ? (S.a_off(nxt, h * 128 + sR[i]) + (unsigned)sC[i] * 2u) : va[h][i];
        for (int t = 0; t < nt; t += 2) {
            const bool last = (t == nt - 2);
            if (Epi::MIDK != 0 && t * BK == Epi::MIDK) { PG8_SCHED; E.mid(acc, cur, wr, wc, fr, fq); PG8_SCHED; }
            const char* a1 = A0 + (size_t)(t + 1) * kstep;
            const char* a2 = last ? A0 : A0 + (size_t)(t + 2) * kstep; const char* b2 = last ? nB : cB + (size_t)(t + 2) * kstep;
            const char* a3 = a2 + kstep; const char* b3 = b2 + kstep;
            unsigned v2[2][2];
#pragma unroll
            for (int h = 0; h < 2; ++h)
#pragma unroll
                for (int i = 0; i < 2; ++i) v2[h][i] = last ? vn[h][i] : va[h][i];
            PG8_LDB(B0, 0, 0); PG8_LDB(B1, 0, 1); PG8_SCHED; PG8_LDA(At, 0, 0); PG8_STAGE(PG8_SA(1, 1), a1, va[1]);
            PG8_WAIT_V(8); PG8_WAIT_L(0); PG8_BAR; PG8_MMA(0, 0, At, B0); PG8_MMA(0, 1, At, B1); PG8_BAR; PG8_SCHED;
            PG8_LDA(At, 0, 1); PG8_STAGE(PG8_SB(0, 0), b2, voffB); PG8_STAGE(PG8_SB(0, 1), b2 + hstepB, voffB); PG8_STAGE(PG8_SA(0, 0), a2, v2[0]);
            PG8_WAIT_V(8); PG8_WAIT_L(0); PG8_BAR; PG8_MMA(1, 0, At, B0); PG8_MMA(1, 1, At, B1); PG8_BAR; PG8_SCHED;
            PG8_LDB(B0, 1, 0); PG8_LDB(B1, 1, 1); PG8_SCHED; PG8_LDA(At, 1, 0); PG8_STAGE(PG8_SA(0, 1), a2, v2[1]);
            PG8_WAIT_V(8); PG8_WAIT_L(0); PG8_BAR; PG8_MMA(0, 0, At, B0); PG8_MMA(0, 1, At, B1); PG8_BAR; PG8_SCHED;
            PG8_LDA(At, 1, 1); PG8_STAGE(PG8_SB(1, 0), b3, voffB); PG8_STAGE(PG8_SB(1, 1), b3 + hstepB, voffB); PG8_STAGE(PG8_SA(1, 0), a3, v2[0]);
            PG8_WAIT_V(8); PG8_WAIT_L(0); PG8_BAR; PG8_MMA(1, 0, At, B0); PG8_MMA(1, 1, At, B1); PG8_BAR; PG8_SCHED;
        }
        if (wr == 0) PG8_BAR;
        E(acc, cur, wr, wc, fr, fq);
        if (!has_next) break;
#pragma unroll
        for (int a = 0; a < 2; ++a)
#pragma unroll
            for (int b = 0; b < 2; ++b)
#pragma unroll
                for (int m = 0; m < 4; ++m)
#pragma unroll
                    for (int n = 0; n < 2; ++n) acc[a][b][m][n] = (f32x4){0.f, 0.f, 0.f, 0.f};
        cur = nxt; cB = nB; ++ui;
#pragma unroll
        for (int h = 0; h < 2; ++h)
#pragma unroll
            for (int i = 0; i < 2; ++i) va[h][i] = vn[h][i];
        if (wr == 1) PG8_BAR;
    }
    PG8_WAIT_V(0);
    PG8_BAR;
#undef PG8_SA
#undef PG8_SB
#undef PG8_STAGE
#undef PG8_LDA
#undef PG8_LDB
#undef PG8_MMA
#undef PG8_WAIT_V
#undef PG8_WAIT_L
#undef PG8_BAR
#undef PG8_SCHED
}
#ifndef FAST_MASK
#define FAST_MASK 0x1f
#endif
template <int BIT, class Epi, class Sched>
__device__ __forceinline__ void gemm_run(LAS unsigned char* lds, const Sched& S, const Epi& E, const int K) {
    if constexpr ((FAST_MASK >> BIT) & 1) gemm_fast(lds, S, E, K); else gemm_simple(S, E, K);
}

__device__ __forceinline__ void tr_item64(const float* W, int N, int k0, int ns, bf16_t* WT, int ldk, int nd, int kd, LAS float* scr, int lane, const float* kscale) {
    { const int r4 = lane >> 4, c4 = (lane & 15) * 4; f32x4 v[16];
#pragma unroll
      for (int i = 0; i < 16; ++i) v[i] = *(const f32x4*)(W + (size_t)(k0 + 4 * i + r4) * N + ns + c4);
#pragma unroll
      for (int i = 0; i < 16; ++i) { LAS float* d = scr + (4 * i + r4) * 65 + c4; d[0] = v[i][0]; d[1] = v[i][1]; d[2] = v[i][2]; d[3] = v[i][3]; } }
    const int c = lane & 7;
    f32x4 s0 = (f32x4){1.f, 1.f, 1.f, 1.f}, s1 = s0;
    if (kscale) { s0 = *(const f32x4*)(kscale + k0 + 8 * c); s1 = *(const f32x4*)(kscale + k0 + 8 * c + 4); }
    asm volatile("s_waitcnt lgkmcnt(0)" ::: "memory");
#pragma unroll
    for (int j = 0; j < 8; ++j) { const int n = (lane >> 3) + 8 * j; const LAS float* s = scr + (8 * c) * 65 + n;
        u32x4 o; o.x = cvt_pk_bf16(s[0 * 65] * s0[0], s[1 * 65] * s0[1]); o.y = cvt_pk_bf16(s[2 * 65] * s0[2], s[3 * 65] * s0[3]);
        o.z = cvt_pk_bf16(s[4 * 65] * s1[0], s[5 * 65] * s1[1]); o.w = cvt_pk_bf16(s[6 * 65] * s1[2], s[7 * 65] * s1[3]);
        *(u32x4*)(WT + (size_t)(nd + n) * ldk + kd + 8 * c) = o; }
    asm volatile("s_waitcnt lgkmcnt(0)" ::: "memory");
}
constexpr int TRS = 64 * 65 * 4;
static_assert(8 * TRS <= LDS_BYTES - 64, "transpose scratch vs barrier words");
template <int WHICH>
__device__ __forceinline__ void convert_tail(const Params& p, LAS unsigned char* lds, int nunits) {
    const int tid = opaque_tid(), wave = __builtin_amdgcn_readfirstlane(tid >> 6), lane = tid & 63;
    const int G = gridDim.x, rounds = (nunits + G - 1) / G, nfull = nunits - (rounds - 1) * G;
    int idle_idx, n_idle;
    if (nfull >= G || nunits == 0) { idle_idx = blockIdx.x; n_idle = G; } else { idle_idx = (int)blockIdx.x - nfull; n_idle = G - nfull; }
    if (idle_idx < 0) return;
    LAS float* scr = (LAS float*)(lds + wave * TRS);
    constexpr int NIT = WHICH == 0 ? 8192 : 4096;
    for (int r = idle_idx * NWAVES + wave; r < NIT; r += n_idle * NWAVES) {
        if (WHICH == 0) { const int up = r >> 12, qq = r & 4095, e = qq >> 8, kb = (qq & 255) >> 3, nb = qq & 7; const int nd = 256 * (nb >> 1) + (nb & 1) * 64 + (up ? 128 : 0);
            tr_item64(p.in[up ? 17 : 16] + (size_t)e * D * DE, DE, kb * 64, nb * 64, (bf16_t*)(p.ws + WS_W1T) + (size_t)e * 1024 * D, D, nd, kb * 64, scr, lane, p.in[11]); }
        else { const int e = r >> 8, kb = (r & 255) >> 5, nb = r & 31;
            tr_item64(p.in[18] + (size_t)e * DE * D, D, kb * 64, nb * 64, (bf16_t*)(p.ws + WS_W2T) + (size_t)e * D * DE, DE, nb * 64, kb * 64, scr, lane, nullptr); }
    }
}
__device__ __forceinline__ int win_src_col(int nd) {
    if (nd < 1024) return nd;
    if (nd < 3072) { const int q = (nd - 1024) >> 8, r = (nd - 1024) & 255; return r < 128 ? (1024 + 128 * q + r) : (2048 + 128 * q + r - 128); }
    if (nd < 5120) return nd;
    { const int q = (nd - 5120) >> 8, r = (nd - 5120) & 255; return r < 128 ? (5120 + 128 * q + r) : (7168 + 128 * q + r - 128); }
}
__device__ __forceinline__ void phase0(const Params& p, LAS unsigned char* lds) {
    const int tid = opaque_tid(), wave = __builtin_amdgcn_readfirstlane(tid >> 6), lane = tid & 63;
    LAS float* scr = (LAS float*)(lds + wave * TRS);
    const int gw = blockIdx.x * NWAVES + wave, NGW = gridDim.x * NWAVES;
    unsigned char* ws = p.ws;
    constexpr int I_IN = 32 * 144, I_UP = 16 * 32, I_OUT = 32 * 32;
    constexpr int NITEMS = I_IN + 2 * I_UP + I_OUT;
    for (int it = gw; it < NITEMS; it += NGW) {
        int r = it;
        if (r < I_IN) { const int kb = r / 144, nb = r % 144; tr_item64(p.in[2], NIN, kb * 64, win_src_col(nb * 64), (bf16_t*)(ws + WS_WINT), D, nb * 64, kb * 64, scr, lane, nullptr); continue; } r -= I_IN;
        if (r < I_UP) { const int kb = r / 32, nb = r % 32; tr_item64(p.in[8], D, kb * 64, nb * 64, (bf16_t*)(ws + WS_WUPT), 2048, nb * 64, kb * 64, scr, lane, nullptr); continue; } r -= I_UP;
        if (r < I_UP) { const int kb = r / 32, nb = r % 32; tr_item64(p.in[9], D, kb * 64, nb * 64, (bf16_t*)(ws + WS_WUPT), 2048, nb * 64, 1024 + kb * 64, scr, lane, nullptr); continue; } r -= I_UP;
        { const int kb = r / 32, nb = r % 32; tr_item64(p.in[10], D, kb * 64, nb * 64, (bf16_t*)(ws + WS_WOUTT), D, nb * 64, kb * 64, scr, lane, nullptr); }
    }
    const float* x = p.in[0]; const float* g = p.in[1]; bf16_t* xn = (bf16_t*)(ws + WS_X);
    for (int m = gw; m < T; m += NGW) {
        const f32x4* xr = (const f32x4*)(x + (size_t)m * D) + lane; f32x4 v[8]; float s = 0.f;
#pragma unroll
        for (int j = 0; j < 8; ++j) { v[j] = xr[64 * j]; s += (v[j][0] * v[j][0] + v[j][1] * v[j][1]) + (v[j][2] * v[j][2] + v[j][3] * v[j][3]); }
        const float rs = 1.0f / sqrtf(wave_sum(s) * (1.0f / D) + EPS);
        u32x2* o = (u32x2*)(xn + (size_t)m * D) + lane;
#pragma unroll
        for (int j = 0; j < 8; ++j) { const f32x4 gg = *((const f32x4*)g + lane + 64 * j); u32x2 w; w.x = cvt_pk_bf16(v[j][0] * rs * gg[0], v[j][1] * rs * gg[1]); w.y = cvt_pk_bf16(v[j][2] * rs * gg[2], v[j][3] * rs * gg[3]); o[64 * j] = w; }
    }
    { bf16_t* wr = (bf16_t*)(ws + WS_WR); const float* gf = p.in[11];
      for (int i = blockIdx.x * NTHREADS + tid; i < 32 * D; i += gridDim.x * NTHREADS) { const int j = i / D, d = i % D; unsigned hi = 0, lo = 0;
          if (j < 20) { const float v = gf[d] * (j < 4 ? p.in[12][d * 4 + j] : p.in[14][d * 16 + (j - 4)]); hi = cvt_pk_bf16(v, 0.f) & 0xffffu; lo = cvt_pk_bf16(v - __uint_as_float(hi << 16), 0.f) & 0xffffu; }
          wr[(size_t)j * D + d] = (bf16_t)hi; wr[(size_t)(32 + j) * D + d] = (bf16_t)lo; } }
    { bf16_t* wmb = (bf16_t*)(ws + WS_WMB); const float* wsrc = p.in[6];
      for (int i = blockIdx.x * NTHREADS + tid; i < 8 * 128 * 128 / 2; i += gridDim.x * NTHREADS) { const int e0 = 2 * i, r = (e0 >> 7) & 127, c = e0 & 127; const bool ok = (r >= 64) || (c < 64);
          ((unsigned*)wmb)[i] = ok ? cvt_pk_bf16(wsrc[e0], wsrc[e0 + 1]) : 0u; } }
    if (blockIdx.x == 0 && tid < 64) ((int*)(ws + WS_CTL))[tid] = 0;
}

__device__ __forceinline__ void phase2_conv(const Params& p) {
    const bf16_t* Bc = (const bf16_t*)(p.ws + WS_P + P_BC); const bf16_t* P = (const bf16_t*)(p.ws + WS_P + P_P); bf16_t* Y = (bf16_t*)(p.ws + WS_X);
    const float* cw = p.in[3];
    for (int i = blockIdx.x * NTHREADS + opaque_tid(); i < T * (CW / 8); i += gridDim.x * NTHREADS) {
        const int t = i >> 7, c = (i & 127) * 8;
        f32x4 p0a, p0b, p1a, p1b, p2a, p2b, ba, bb;
        unpack8(*(const u32x4*)(P + (size_t)t * CW + c), p2a, p2b); unpack8(*(const u32x4*)(Bc + (size_t)t * CW + c), ba, bb);
        if (t >= 1) unpack8(*(const u32x4*)(P + (size_t)(t - 1) * CW + c), p1a, p1b); else { p1a = (f32x4){0, 0, 0, 0}; p1b = p1a; }
        if (t >= 2) unpack8(*(const u32x4*)(P + (size_t)(t - 2) * CW + c), p0a, p0b); else { p0a = (f32x4){0, 0, 0, 0}; p0b = p0a; }
        const f32x4 w0a = *(const f32x4*)(cw + c), w0b = *(const f32x4*)(cw + c + 4), w1a = *(const f32x4*)(cw + CW + c), w1b = *(const f32x4*)(cw + CW + c + 4),
                    w2a = *(const f32x4*)(cw + 2 * CW + c), w2b = *(const f32x4*)(cw + 2 * CW + c + 4);
        const f32x4 ya = ba * (w0a * p0a + w1a * p1a + w2a * p2a), yb = bb * (w0b * p0b + w1b * p1b + w2b * p2b);
        *(u32x4*)(Y + (size_t)t * 2048 + c) = pack8(ya, yb);
    }
}
__device__ __forceinline__ void phase2_sgu(const Params& p, LAS unsigned char* lds) {
    const int tid = opaque_tid(), wave = __builtin_amdgcn_readfirstlane(tid >> 6), lane = tid & 63, fr = lane & 15, fq = lane >> 4;
    const bf16_t* U = (const bf16_t*)(p.ws + WS_P + P_U); const bf16_t* V = (const bf16_t*)(p.ws + WS_P + P_V); bf16_t* Y = (bf16_t*)(p.ws + WS_X);
    const bf16_t* WmB = (const bf16_t*)(p.ws + WS_WMB);
    const float* lng = p.in[4]; const float* lnb = p.in[5]; const float* bs = p.in[7];
    LAS f32x2* st = (LAS f32x2*)lds;
    LAS unsigned char* vT = lds + 1024;
    constexpr int VP = 272;
    for (int unit = blockIdx.x; unit < 64 * 8; unit += gridDim.x) {
        const int nb = unit >> 3, h = unit & 7, t0 = nb * 128, c0 = h * 128;
        __syncthreads();
        for (int jj = 0; jj < 16; ++jj) { const int j = wave * 16 + jj; const u32x4* vr = (const u32x4*)(V + (size_t)(t0 + j) * SW) + lane * 2;
            f32x4 a, b, c, d; unpack8(vr[0], a, b); unpack8(vr[1], c, d);
            float s = (a[0] + a[1] + a[2] + a[3]) + (b[0] + b[1] + b[2] + b[3]) + (c[0] + c[1] + c[2] + c[3]) + (d[0] + d[1] + d[2] + d[3]);
            const float mu = wave_sum(s) * (1.0f / SW);
            a -= mu; b -= mu; c -= mu; d -= mu;
            float q = (a[0] * a[0] + a[1] * a[1] + a[2] * a[2] + a[3] * a[3]) + (b[0] * b[0] + b[1] * b[1] + b[2] * b[2] + b[3] * b[3]) + (c[0] * c[0] + c[1] * c[1] + c[2] * c[2] + c[3] * c[3]) + (d[0] * d[0] + d[1] * d[1] + d[2] * d[2] + d[3] * d[3]);
            const float rs = 1.0f / sqrtf(wave_sum(q) * (1.0f / SW) + EPS);
            if (lane == 0) st[j] = (f32x2){mu, rs}; }
        __syncthreads();
        if (tid < 256) {
            const int jb = tid >> 4, cb = tid & 15, j0 = jb * 8, cc0 = cb * 8;
            const f32x4 g0 = *(const f32x4*)(lng + c0 + cc0), g1 = *(const f32x4*)(lng + c0 + cc0 + 4), b0 = *(const f32x4*)(lnb + c0 + cc0), b1 = *(const f32x4*)(lnb + c0 + cc0 + 4);
            f32x4 lo[8], hi[8];
#pragma unroll
            for (int r = 0; r < 8; ++r) { const f32x2 s = st[j0 + r]; f32x4 a, b; unpack8(*(const u32x4*)(V + (size_t)(t0 + j0 + r) * SW + c0 + cc0), a, b);
                lo[r] = (a - s.x) * s.y * g0 + b0; hi[r] = (b - s.x) * s.y * g1 + b1; }
#pragma unroll
            for (int cc = 0; cc < 4; ++cc) { u32x4 o;
                o.x = cvt_pk_bf16(lo[0][cc], lo[1][cc]); o.y = cvt_pk_bf16(lo[2][cc], lo[3][cc]); o.z = cvt_pk_bf16(lo[4][cc], lo[5][cc]); o.w = cvt_pk_bf16(lo[6][cc], lo[7][cc]);
                *(LAS u32x4*)(vT + (cc0 + cc) * VP + j0 * 2) = o;
                o.x = cvt_pk_bf16(hi[0][cc], hi[1][cc]); o.y = cvt_pk_bf16(hi[2][cc], hi[3][cc]); o.z = cvt_pk_bf16(hi[4][cc], hi[5][cc]); o.w = cvt_pk_bf16(hi[6][cc], hi[7][cc]);
                *(LAS u32x4*)(vT + (cc0 + 4 + cc) * VP + j0 * 2) = o; }
        }
        __syncthreads();
        bf16x8 wf[4];
#pragma unroll
        for (int ks = 0; ks < 4; ++ks) wf[ks] = *(const bf16x8*)(WmB + ((size_t)h * 128 + wave * 16 + fr) * 128 + ks * 32 + fq * 8);
        f32x4 acc[8];
#pragma unroll
        for (int nk = 0; nk < 8; ++nk) { acc[nk] = (f32x4){0.f, 0.f, 0.f, 0.f};
#pragma unroll
            for (int ks = 0; ks < 4; ++ks) { const bf16x8 vf = *(const LAS bf16x8*)(vT + (nk * 16 + fr) * VP + (ks * 32 + fq * 8) * 2);
                acc[nk] = __builtin_amdgcn_mfma_f32_16x16x32_bf16(vf, wf[ks], acc[nk], 0, 0, 0); } }
        { const int i = wave * 16 + fr; const float bb = bs[h * 128 + i]; const size_t t = (size_t)(t0 + i);
#pragma unroll
          for (int nk = 0; nk < 8; ++nk) { const int c = c0 + nk * 16 + 4 * fq; const u32x2 uu = *(const u32x2*)(U + t * SW + c);
              u32x2 o; o.x = cvt_pk_bf16(bf_lo(uu.x) * (acc[nk][0] + bb), bf_hi(uu.x) * (acc[nk][1] + bb)); o.y = cvt_pk_bf16(bf_lo(uu.y) * (acc[nk][2] + bb), bf_hi(uu.y) * (acc[nk][3] + bb));
              *(u32x2*)(Y + t * 2048 + 1024 + c) = o; } }
    }
}

__device__ __forceinline__ void phase5_router(const Params& p, LAS unsigned char* lds) {
    const int tid = opaque_tid(), wave = __builtin_amdgcn_readfirstlane(tid >> 6), lane = tid & 63, fr = lane & 15, fq = lane >> 4;
    const bf16_t* A2 = (const bf16_t*)(p.ws + WS_A2); const bf16_t* wr = (const bf16_t*)(p.ws + WS_WR);
    float* rstd = (float*)(p.ws + WS_SMALL + SM_RSTD); int* ent = (int*)(p.ws + WS_SMALL + SM_ENT); float* lw = (float*)(p.ws + WS_SMALL + SM_W); int* cnt = (int*)(p.ws + WS_CTL);
    const float* brg = p.in[13]; const float* bre = p.in[15];
    LAS float* part = (LAS float*)lds;
    LAS float* pss  = (LAS float*)(lds + 65536);
    LAS float* lg   = (LAS float*)(lds + 65536 + 1024);
    LAS float* lss  = (LAS float*)(lds + 65536 + 1024 + 2560);
    LAS int* lcnt  = (LAS int*)(lds + 70000);
    LAS int* lbase = (LAS int*)(lds + 70000 + 64);
    LAS int* le    = (LAS int*)(lds + 70000 + 128);
    LAS int* lp    = (LAS int*)(lds + 70000 + 128 + 256);
    LAS float* lwt = (LAS float*)(lds + 70000 + 128 + 512);
    for (int tile = blockIdx.x; tile < T / 32; tile += gridDim.x) {
        const int tok0 = tile * 32;
        __syncthreads();
        if (tid < 16) lcnt[tid] = 0;
        f32x4 acc[2][4]; float ss[2] = {0.f, 0.f};
#pragma unroll
        for (int m = 0; m < 2; ++m)
#pragma unroll
            for (int n = 0; n < 4; ++n) acc[m][n] = (f32x4){0.f, 0.f, 0.f, 0.f};
#pragma unroll 2
        for (int ks = 0; ks < 8; ++ks) {
            const int k = wave * 256 + ks * 32 + fq * 8;
            bf16x8 af[2], bfr[4];
#pragma unroll
            for (int m = 0; m < 2; ++m) af[m] = *(const bf16x8*)(A2 + (size_t)(tok0 + 16 * m + fr) * D + k);
#pragma unroll
            for (int n = 0; n < 4; ++n) bfr[n] = *(const bf16x8*)(wr + (size_t)(16 * n + fr) * D + k);
#pragma unroll
            for (int m = 0; m < 2; ++m) {
#pragma unroll
                for (int j = 0; j < 8; ++j) { const float v = bf1((bf16_t)af[m][j]); ss[m] += v * v; }
#pragma unroll
                for (int n = 0; n < 4; ++n) acc[m][n] = __builtin_amdgcn_mfma_f32_16x16x32_bf16(bfr[n], af[m], acc[m][n], 0, 0, 0);
            }
        }
#pragma unroll
        for (int m = 0; m < 2; ++m) { ss[m] += __shfl_xor(ss[m], 16); ss[m] += __shfl_xor(ss[m], 32);
            if (fq == 0) pss[wave * 32 + 16 * m + fr] = ss[m];
#pragma unroll
            for (int n = 0; n < 4; ++n) *(LAS f32x4*)(part + (wave * 32 + 16 * m + fr) * 64 + 16 * n + 4 * fq) = acc[m][n]; }
        __syncthreads();
        for (int i = tid; i < 32 * 20; i += NTHREADS) { const int t = i / 20, j = i % 20; float s = 0.f;
#pragma unroll
            for (int w = 0; w < 8; ++w) s += part[(w * 32 + t) * 64 + j] + part[(w * 32 + t) * 64 + 32 + j];
            lg[t * 20 + j] = s; }
        if (tid < 32) { float s = 0.f;
#pragma unroll
            for (int w = 0; w < 8; ++w) s += pss[w * 32 + tid];
            lss[tid] = s; }
        __syncthreads();
        if (tid < 32) {
            const int t = tid; const float rs = 1.0f / sqrtf(lss[t] * (1.0f / D) + EPS);
            float g4[4];
#pragma unroll
            for (int j = 0; j < 4; ++j) g4[j] = lg[t * 20 + j] * rs + brg[j];
            int gi = 0; float gm = g4[0];
#pragma unroll
            for (int j = 1; j < 4; ++j) if (g4[j] > gm) { gm = g4[j]; gi = j; }
            float den = 0.f;
#pragma unroll
            for (int j = 0; j < 4; ++j) den += __expf(g4[j] - gm);
            const float pg = 1.0f / den;
            float le4[4];
#pragma unroll
            for (int j = 0; j < 4; ++j) le4[j] = lg[t * 20 + 4 + gi * 4 + j] * rs + bre[gi * 4 + j];
            int i1 = 0; float m1 = le4[0];
#pragma unroll
            for (int j = 1; j < 4; ++j) if (le4[j] > m1) { m1 = le4[j]; i1 = j; }
            int i2 = -1; float m2 = -3.0e38f;
#pragma unroll
            for (int j = 0; j < 4; ++j) if (j != i1 && le4[j] > m2) { m2 = le4[j]; i2 = j; }
            const float ex = __expf(m2 - m1); const float w1 = pg / (1.0f + ex), w2 = pg * ex / (1.0f + ex);
            rstd[tok0 + t] = rs;
            const int e1 = gi * 4 + i1, e2 = gi * 4 + i2;
            le[2 * t] = e1; le[2 * t + 1] = e2; lwt[2 * t] = w1; lwt[2 * t + 1] = w2;
            lp[2 * t] = atomicAdd((int*)&lcnt[e1], 1); lp[2 * t + 1] = atomicAdd((int*)&lcnt[e2], 1);
        }
        __syncthreads();
        if (tid < 16) { const int n = lcnt[tid]; lbase[tid] = n ? atomicAdd(&cnt[tid], n) : 0; }
        __syncthreads();
        if (tid < 64) { const int e = le[tid]; const int pos = lbase[e] + lp[tid]; ent[e * T + pos] = (tok0 + (tid >> 1)) | ((tid & 1) << 16); lw[e * T + pos] = lwt[tid]; }
    }
}

__device__ __forceinline__ void phase8_final(const Params& p) {
    const int tid = opaque_tid(), wave = __builtin_amdgcn_readfirstlane(tid >> 6), lane = tid & 63;
    const bf16_t* A2 = (const bf16_t*)(p.ws + WS_A2); const bf16_t* Y0 = (const bf16_t*)(p.ws + WS_YK0); const bf16_t* Y1 = (const bf16_t*)(p.ws + WS_YK1); const float* g = p.in[19];
    const int gw = blockIdx.x * NWAVES + wave, NGW = gridDim.x * NWAVES;
    for (int m = gw; m < T; m += NGW) {
        f32x4 v[8]; float s = 0.f;
#pragma unroll
        for (int j = 0; j < 8; ++j) { const size_t o = (size_t)m * D + 4 * lane + 256 * j;
            const u32x2 hh = *(const u32x2*)(A2 + o), a = *(const u32x2*)(Y0 + o), b = *(const u32x2*)(Y1 + o);
            v[j][0] = bf_lo(hh.x) + (bf_lo(a.x) + bf_lo(b.x)); v[j][1] = bf_hi(hh.x) + (bf_hi(a.x) + bf_hi(b.x)); v[j][2] = bf_lo(hh.y) + (bf_lo(a.y) + bf_lo(b.y)); v[j][3] = bf_hi(hh.y) + (bf_hi(a.y) + bf_hi(b.y));
            s += (v[j][0] * v[j][0] + v[j][1] * v[j][1]) + (v[j][2] * v[j][2] + v[j][3] * v[j][3]); }
        const float rs = 1.0f / sqrtf(wave_sum(s) * (1.0f / D) + EPS);
#pragma unroll
        for (int j = 0; j < 8; ++j) { const int c = 4 * lane + 256 * j; const f32x4 gg = *(const f32x4*)(g + c); *(f32x4*)(p.out + (size_t)m * D + c) = v[j] * rs * gg; }
    }
}

#define XB_TMO      128
#define XB_XCNT(j)  (256  + 64 * (j))
#define XB_XSUB(j)  (1280 + 64 * (j))
#define XB_XGEN(j)  (2304 + 64 * (j))
#define XB_TOP      3328
#define XB_TOPGEN   3392
#define XCD_BAR_WORDS 3456
#define XB_SPIN_CAP (1u << 18)
__device__ __forceinline__ unsigned xb_ld(unsigned* p)              { return __hip_atomic_load(p, __ATOMIC_RELAXED, __HIP_MEMORY_SCOPE_AGENT); }
__device__ __forceinline__ unsigned xb_add(unsigned* p, unsigned v) { return __hip_atomic_fetch_add(p, v, __ATOMIC_RELAXED, __HIP_MEMORY_SCOPE_AGENT); }
__device__ __forceinline__ unsigned xb_xcc_id() { return (unsigned)__builtin_amdgcn_s_getreg((3 << 11) | 20) & 0xFu; }
#define XB_SPIN(cond, bar) do { unsigned _sp = 0; while (cond) { __builtin_amdgcn_s_sleep(1); \
    if ((++_sp & 255u) == 0u) { if (xb_ld(&(bar)[XB_TMO])) break; if (_sp > XB_SPIN_CAP) { atomicAdd(&(bar)[XB_TMO], 1u); break; } } } } while (0)
struct XcdBarrier { unsigned* bar; unsigned x; volatile LAS unsigned* st; };
__device__ __forceinline__ XcdBarrier xcd_barrier_post(unsigned* bar, volatile LAS unsigned* st) {
    XcdBarrier b; b.bar = bar; b.x = xb_xcc_id(); b.st = st;
    if (threadIdx.x == 0) (void)xb_add(&bar[XB_XCNT(b.x)], 1u);
    return b;
}
__device__ __forceinline__ void xcd_barrier_complete(unsigned* bar, unsigned x, unsigned& nloc, unsigned& nx) {
    const unsigned G = gridDim.x * gridDim.y * gridDim.z;
    unsigned sum, cnt, mine, sp = 0u;
    for (;;) {
        sum = 0u; cnt = 0u; mine = 0u;
#pragma unroll
        for (unsigned j = 0; j < 16; ++j) { const unsigned c = xb_ld(&bar[XB_XCNT(j)]); sum += c; cnt += (c > 0u) ? 1u : 0u; mine = (j == x) ? c : mine; }
        if (sum == G) break;
        __builtin_amdgcn_s_sleep(1);
        if ((++sp & 255u) == 0u) { if (xb_ld(&bar[XB_TMO])) break; if (sp > XB_SPIN_CAP) { atomicAdd(&bar[XB_TMO], 1u); break; } }
    }
    nloc = mine > 0u ? mine : 1u; nx = cnt > 0u ? cnt : 1u;
}
__device__ __forceinline__ void xcd_barrier(const XcdBarrier& b) {
    asm volatile("s_waitcnt vmcnt(0)" ::: "memory");
    __syncthreads();
    if (threadIdx.x == 0) {
        unsigned* bar = b.bar;
        __builtin_amdgcn_s_waitcnt(0);
        unsigned nloc = b.st[0], nx = b.st[1];
        if (nloc == 0u) { xcd_barrier_complete(bar, b.x, nloc, nx); b.st[0] = nloc; b.st[1] = nx; }
        const unsigned old = xb_add(&bar[XB_XSUB(b.x)], 1u);
        const unsigned gen = old / nloc;
        if (old + 1u == (gen + 1u) * nloc) {
            __builtin_amdgcn_fence(__ATOMIC_RELEASE, "agent");
            asm volatile("s_waitcnt vmcnt(0)" ::: "memory");
            const unsigned og = xb_add(&bar[XB_TOP], 1u);
            const unsigned tg = og / nx;
            if (og + 1u == (tg + 1u) * nx) xb_add(&bar[XB_TOPGEN], 1u);
            else XB_SPIN(xb_ld(&bar[XB_TOPGEN]) == tg, bar);
            __builtin_amdgcn_fence(__ATOMIC_ACQUIRE, "agent");
            xb_add(&bar[XB_XGEN(b.x)], 1u);
            asm volatile("s_waitcnt vmcnt(0)" ::: "memory");
        } else {
            XB_SPIN(xb_ld(&bar[XB_XGEN(b.x)]) == gen, bar);
            __builtin_amdgcn_fence(__ATOMIC_ACQUIRE, "agent");
            asm volatile("s_waitcnt vmcnt(0)" ::: "memory");
        }
    }
    __syncthreads();
}

template <int PH> __device__ __forceinline__ void run_phase(const Params& p, LAS unsigned char* lds) {
    unsigned char* ws = p.ws;
    if constexpr (PH == 0) phase0(p, lds);
    if constexpr (PH == 1) { DenseSched S; S.init((const bf16_t*)(ws + WS_X), (const bf16_t*)(ws + WS_WINT), T, NIN, D);
        EpiProj E{(bf16_t*)(ws + WS_P + P_BC), (bf16_t*)(ws + WS_P + P_P), (bf16_t*)(ws + WS_P + P_U), (bf16_t*)(ws + WS_P + P_V), (bf16_t*)(ws + WS_P + P_R), (bf16_t*)(ws + WS_P + P_S)};
        gemm_run<0>(lds, S, E, D); convert_tail<0>(p, lds, (T / 256) * (NIN / 256)); }
    if constexpr (PH == 2) { phase2_conv(p); phase2_sgu(p, lds); }
    if constexpr (PH == 3) { DenseSched S; S.init((const bf16_t*)(ws + WS_X), (const bf16_t*)(ws + WS_WUPT), T, D, 2048);
        EpiUp E{(const bf16_t*)(ws + WS_P + P_R), (const bf16_t*)(ws + WS_P + P_S), (bf16_t*)(ws + WS_MM)}; gemm_run<1>(lds, S, E, 2048); }
    if constexpr (PH == 4) { DenseSched S; S.init((const bf16_t*)(ws + WS_MM), (const bf16_t*)(ws + WS_WOUTT), T, D, D);
        EpiOut E{p.in[0], (bf16_t*)(ws + WS_A2)}; gemm_run<2>(lds, S, E, D); }
    if constexpr (PH == 5) phase5_router(p, lds);
    if constexpr (PH == 6) { MoeSched<true, 4, D, 1024> S{(const bf16_t*)(ws + WS_A2), (const bf16_t*)(ws + WS_W1T), (const int*)(ws + WS_CTL), (const int*)(ws + WS_SMALL + SM_ENT), (int)gridDim.x, (int)blockIdx.x};
        EpiMoe1 E{(const int*)(ws + WS_SMALL + SM_ENT), (const float*)(ws + WS_SMALL + SM_W), (const float*)(ws + WS_SMALL + SM_RSTD), (bf16_t*)(ws + WS_HID)}; gemm_run<3>(lds, S, E, D); int nu = 0; for (int e = 0; e < NE; ++e) nu += ((__builtin_amdgcn_readfirstlane(S.cnt[e]) + 255) >> 8) * 4; convert_tail<1>(p, lds, nu); }
    if constexpr (PH == 7) { MoeSched<false, 8, DE, D> S{(const bf16_t*)(ws + WS_HID), (const bf16_t*)(ws + WS_W2T), (const int*)(ws + WS_CTL), (const int*)(ws + WS_SMALL + SM_ENT), (int)gridDim.x, (int)blockIdx.x};
        EpiMoe2 E{(const int*)(ws + WS_SMALL + SM_ENT), (bf16_t*)(ws + WS_YK0), (bf16_t*)(ws + WS_YK1)}; gemm_run<4>(lds, S, E, DE); }
    if constexpr (PH == 8) phase8_final(p);
}

template <int PH> __global__ void __launch_bounds__(NTHREADS, 2) k_phase(Params p) {
    extern __shared__ __attribute__((aligned(16))) unsigned char lds_raw[];
    run_phase<PH>(p, (LAS unsigned char*)lds_raw);
}

#ifndef PROBE_DUP
#define PROBE_DUP 0
#endif
#ifndef PROBE_SYNCS
#define PROBE_SYNCS 0
#endif
#define DUP(k) ((PROBE_DUP >> (k)) & 1)
typedef const __attribute__((address_space(4))) Params* KParamsPtr;
__device__ __forceinline__ Params load_params() {
    Params r{};
#if defined(__HIP_DEVICE_COMPILE__)
    unsigned long long v = (unsigned long long)__builtin_amdgcn_kernarg_segment_ptr(); asm volatile("" : "+s"(v));
    const __attribute__((address_space(4))) unsigned long long* q = (const __attribute__((address_space(4))) unsigned long long*)v;
#pragma unroll
    for (int i = 0; i < 20; ++i) r.in[i] = (const float*)(const __attribute__((address_space(1))) float*)q[i];
    r.out = (float*)(__attribute__((address_space(1))) float*)q[20]; r.ws = (unsigned char*)(__attribute__((address_space(1))) unsigned char*)q[21];
#endif
    return r;
}
#define RUN(k) do { const Params pk = load_params(); run_phase<k>(pk, lds); } while (0)
__global__ void __launch_bounds__(NTHREADS, 2) k_mega(Params p) {
    extern __shared__ __attribute__((aligned(16))) unsigned char lds_raw[];
    LAS unsigned char* lds = (LAS unsigned char*)lds_raw;
    cg::grid_group grid = cg::this_grid();
    volatile LAS unsigned* xbst = (volatile LAS unsigned*)(lds + LDS_BYTES - 64);
    if (threadIdx.x < 4) xbst[threadIdx.x] = 0u;
    __syncthreads();
    const XcdBarrier bar = xcd_barrier_post((unsigned*)(p.ws + WS_BAR), xbst);
#define GSYNC() xcd_barrier(bar)
    RUN(0); grid.sync();
    if (DUP(0)) { RUN(0); GSYNC(); }
    RUN(1); GSYNC();
    if (DUP(1)) { RUN(1); GSYNC(); }
    RUN(2); GSYNC();
    if (DUP(2)) { RUN(2); GSYNC(); }
    RUN(3); GSYNC();
    if (DUP(3)) { RUN(3); GSYNC(); }
    RUN(4); GSYNC();
    if (DUP(4)) { RUN(4); GSYNC(); }
    RUN(5); GSYNC();
    if (DUP(5)) { if (blockIdx.x == 0 && threadIdx.x < 16) ((int*)(load_params().ws + WS_CTL))[threadIdx.x] = 0; GSYNC(); RUN(5); GSYNC(); }
    RUN(6); GSYNC();
    if (DUP(6)) { RUN(6); GSYNC(); }
    RUN(7); GSYNC();
    if (DUP(7)) { RUN(7); GSYNC(); }
    for (int i = 0; i < PROBE_SYNCS; ++i) GSYNC();
    RUN(8);
    if (DUP(8)) { GSYNC(); RUN(8); }
}

template <int PH> static void launch_phase(const Params& p, int grid, hipStream_t stream) {
    static bool attr = false;
    if (!attr) { (void)hipFuncSetAttribute((const void*)k_phase<PH>, hipFuncAttributeMaxDynamicSharedMemorySize, LDS_BYTES); attr = true; }
    hipLaunchKernelGGL(k_phase<PH>, dim3(grid), dim3(NTHREADS), LDS_BYTES, stream, p);
}

extern "C" void kernel_launch(void* const* d_in, const int* in_sizes, int n_in, void* d_out, int out_size, void* d_ws, size_t ws_size, hipStream_t stream) {
    static int grid = 0;
    if (grid == 0) {
        if (n_in != 20 || out_size != T * D || ws_size < WS_END) { fprintf(stderr, "kernel_launch: unexpected shapes n_in %d out %d ws %zu (need %zu)\n", n_in, out_size, ws_size, (size_t)WS_END); grid = -1; return; }
        int dev = 0, cus = 0, per_cu = 0;
        (void)hipGetDevice(&dev); (void)hipDeviceGetAttribute(&cus, hipDeviceAttributeMultiprocessorCount, dev);
        (void)hipFuncSetAttribute((const void*)k_mega, hipFuncAttributeMaxDynamicSharedMemorySize, LDS_BYTES);
        (void)hipOccupancyMaxActiveBlocksPerMultiprocessor(&per_cu, (const void*)k_mega, NTHREADS, LDS_BYTES);
        if (per_cu < 1) { fprintf(stderr, "kernel_launch: occupancy query says %d blocks per CU\n", per_cu); per_cu = 1; }
        grid = cus * 1;
        (void)hipGetLastError();
    }
    if (grid < 0) return;
    Params p{};
    for (int i = 0; i < 20; ++i) p.in[i] = (const float*)d_in[i];
    p.out = (float*)d_out; p.ws = (unsigned char*)d_ws;
    (void)hipMemsetAsync((char*)d_ws + WS_CTL, 0, 64 * 1024, stream);
#if ONE_LAUNCH
    void* args[] = {&p};
    hipError_t e = hipLaunchCooperativeKernel((const void*)k_mega, dim3(grid), dim3(NTHREADS), args, LDS_BYTES, stream);
    if (e != hipSuccess) fprintf(stderr, "cooperative launch failed: %s (grid %d)\n", hipGetErrorString(e), grid);
#else
    launch_phase<0>(p, grid, stream); launch_phase<1>(p, grid, stream); launch_phase<2>(p, grid, stream); launch_phase<3>(p, grid, stream); launch_phase<4>(p, grid, stream);
    launch_phase<5>(p, grid, stream); launch_phase<6>(p, grid, stream); launch_phase<7>(p, grid, stream); launch_phase<8>(p, grid, stream);
#endif
}
```

```cpp
#include <hip/hip_runtime.h>
#include <hip/hip_cooperative_groups.h>
#include <cstdio>
#include <cstdint>
namespace cg = cooperative_groups;

#ifndef ONE_LAUNCH
#define ONE_LAUNCH 1
#endif

#define LAS __attribute__((address_space(3)))
typedef unsigned short bf16_t;
typedef short bf16x8 __attribute__((ext_vector_type(8)));
typedef float f32x4 __attribute__((ext_vector_type(4)));
typedef float f32x2 __attribute__((ext_vector_type(2)));
typedef unsigned u32x4 __attribute__((ext_vector_type(4)));
typedef unsigned u32x2 __attribute__((ext_vector_type(2)));

constexpr int T = 8192, D = 2048, CW = 1024, SW = 1024, NIN = 9216, NE = 16, DE = 512;
constexpr float EPS = 1e-6f;
constexpr int NTHREADS = 512, NWAVES = 8;
constexpr int LDS_BYTES = 140 * 1024;
constexpr int HID_ROWS = 2 * T + NE * 256;

constexpr size_t MiB = 1024 * 1024;
constexpr size_t WS_CTL   = 0;
constexpr size_t WS_BAR   = 4096;
constexpr size_t WS_SMALL = 64 * 1024;
constexpr size_t SM_RSTD = 0, SM_ENT = 32 * 1024, SM_W = SM_ENT + (size_t)NE * T * 4, SM_END = SM_W + (size_t)NE * T * 4;
constexpr size_t WS_WR    = WS_SMALL + 2 * MiB;
constexpr size_t WS_WMB   = WS_WR + 256 * 1024;
constexpr size_t WS_WINT  = WS_WMB + 256 * 1024;
constexpr size_t WS_WUPT  = WS_WINT + (size_t)NIN * D * 2;
constexpr size_t WS_WOUTT = WS_WUPT + (size_t)D * D * 2;
constexpr size_t WS_W1T   = WS_WOUTT + (size_t)D * D * 2;
constexpr size_t WS_W2T   = WS_W1T + (size_t)NE * 1024 * D * 2;
constexpr size_t WS_X     = WS_W2T + (size_t)NE * D * DE * 2;
constexpr size_t WS_P     = WS_X + (size_t)T * D * 2;
constexpr size_t P_BC = 0, P_P = P_BC + (size_t)T * CW * 2, P_U = P_P + (size_t)T * CW * 2, P_V = P_U + (size_t)T * SW * 2,
                 P_R = P_V + (size_t)T * SW * 2, P_S = P_R + (size_t)T * D * 2, P_END = P_S + (size_t)T * D * 2;
constexpr size_t WS_END   = WS_P + P_END;
constexpr size_t WS_MM  = WS_WINT;
constexpr size_t WS_H   = WS_P + P_BC;
constexpr size_t WS_A2  = WS_P + P_R;
constexpr size_t WS_HID = WS_P + P_S;
constexpr size_t WS_YK0 = WS_X;
constexpr size_t WS_YK1 = WS_WINT;
static_assert(SM_END <= 2 * MiB, "small region");
static_assert((size_t)HID_ROWS * DE * 2 <= (size_t)T * D * 2, "hid overlay");
static_assert((size_t)T * D * 4 <= P_R, "H overlay");

struct Params { const float* in[20]; float* out; unsigned char* ws; };

__device__ __forceinline__ unsigned cvt_pk_bf16(float lo, float hi) { unsigned r; asm("v_cvt_pk_bf16_f32 %0, %1, %2" : "=v"(r) : "v"(lo), "v"(hi)); return r; }
__device__ __forceinline__ float bf_lo(unsigned w) { return __uint_as_float(w << 16); }
__device__ __forceinline__ float bf_hi(unsigned w) { return __uint_as_float(w & 0xffff0000u); }
__device__ __forceinline__ float bf1(bf16_t b) { return __uint_as_float(((unsigned)b) << 16); }
__device__ __forceinline__ float wave_sum(float v) {
#pragma unroll
    for (int o = 1; o < 64; o <<= 1) v += __shfl_xor(v, o);
    return v;
}
__device__ __forceinline__ float fast_rcp(float x) { return __builtin_amdgcn_rcpf(x); }
__device__ __forceinline__ float fast_exp2(float x) { return __builtin_amdgcn_exp2f(x); }
__device__ __forceinline__ float sigmoid_f(float x) { return fast_rcp(1.0f + fast_exp2(-1.44269504f * x)); }
__device__ __forceinline__ float gelu_tanh(float x) {
    const float u = x + 0.044715f * x * x * x;
    return x * fast_rcp(1.0f + fast_exp2(-2.30220819f * u));
}
__device__ __forceinline__ int opaque_tid() { int t = threadIdx.x; asm volatile("" : "+v"(t)); return t; }
__host__ __device__ __forceinline__ int perm32(int rho) { const int n = rho >> 4, i = rho & 15; return 8 * (i >> 2) + 4 * n + (i & 3); }

struct Unit { int pm, pn, e, row0, nvalid; };
constexpr int NXCD = 8, WGM = 8;
struct DenseSched {
    const bf16_t* A; const bf16_t* Bt; int K; int nM, nN, nwg, G, c;
    __device__ __forceinline__ void init(const bf16_t* A_, const bf16_t* Bt_, int M, int N, int K_) { A = A_; Bt = Bt_; K = K_; nM = M / 256; nN = N / 256; nwg = nM * nN; G = gridDim.x; c = blockIdx.x; }
    __device__ __forceinline__ bool next(int i, Unit& u) const {
        const long L = (long)i * G + c; if (L >= nwg) return false;
        int wgid = (int)L; { const int q = nwg / NXCD, r = nwg % NXCD, xcd = wgid % NXCD, off = wgid / NXCD; wgid = (xcd < r ? xcd * (q + 1) : r * (q + 1) + (xcd - r) * q) + off; }
        const int nig = WGM * nN, gid = wgid / nig, fm = gid * WGM, gsz = (nM - fm) < WGM ? (nM - fm) : WGM;
        u.pm = fm + ((wgid % nig) % gsz); u.pn = (wgid % nig) / gsz; u.e = 0; u.row0 = u.pm * 256; u.nvalid = 256; return true;
    }
    __device__ __forceinline__ const char* a_base() const { return (const char*)A; }
    __device__ __forceinline__ unsigned a_off(const Unit& u, int r) const { return (unsigned)(u.row0 + r) * (unsigned)K * 2u; }
    __device__ __forceinline__ const char* b_base(const Unit& u) const { return (const char*)Bt + (size_t)u.pn * 256 * K * 2; }
};
template <bool GATHER, int NPN, int KK, int NROWS_E  >
struct MoeSched {
    const bf16_t* A; const bf16_t* Bt; const int* cnt; const int* ent; int G, c;
    __device__ __forceinline__ bool next(int i, Unit& u) const {
        int L = i * G + c; int hb = 0;
        for (int e = 0; e < NE; ++e) {
            const int n = __builtin_amdgcn_readfirstlane(cnt[e]); const int nt = (n + 255) >> 8;
            if (L < nt * NPN) { u.e = e; u.pm = L / NPN; u.pn = L % NPN; u.row0 = hb + u.pm * 256; u.nvalid = min(256, n - u.pm * 256); return true; }
            L -= nt * NPN; hb += nt * 256;
        }
        return false;
    }
    __device__ __forceinline__ const char* a_base() const { return (const char*)A; }
    __device__ __forceinline__ unsigned a_off(const Unit& u, int r) const {
        if (GATHER) { const int tok = (r < u.nvalid) ? (ent[u.e * T + u.pm * 256 + r] & 0xffff) : 0; return (unsigned)tok * (unsigned)KK * 2u; }
        return (unsigned)(u.row0 + r) * (unsigned)KK * 2u;
    }
    __device__ __forceinline__ const char* b_base(const Unit& u) const { return (const char*)Bt + ((size_t)u.e * NROWS_E + (size_t)u.pn * 256) * KK * 2; }
};

typedef f32x4 Acc[2][2][4][2];
__device__ __forceinline__ u32x4 pack8(f32x4 a, f32x4 b) { u32x4 w; w.x = cvt_pk_bf16(a[0], a[1]); w.y = cvt_pk_bf16(a[2], a[3]); w.z = cvt_pk_bf16(b[0], b[1]); w.w = cvt_pk_bf16(b[2], b[3]); return w; }
__device__ __forceinline__ void unpack8(u32x4 w, f32x4& a, f32x4& b) { a = (f32x4){bf_lo(w.x), bf_hi(w.x), bf_lo(w.y), bf_hi(w.y)}; b = (f32x4){bf_lo(w.z), bf_hi(w.z), bf_lo(w.w), bf_hi(w.w)}; }

struct EpiProj {
    static constexpr bool PERM = true; static constexpr int MIDK = 0;
    bf16_t *Bc, *P, *U, *V, *R, *S;
    __device__ __forceinline__ void mid(Acc&, const Unit&, int, int, int, int) const {}
    __device__ __forceinline__ void operator()(const Acc& acc, const Unit& u, int wr, int wc, int fr, int fq) const {
        const int pn = u.pn; const int rowb = u.row0 + wr * 64 + fr; const int cl = wc * 32 + 8 * fq;
#pragma unroll
        for (int ai = 0; ai < 2; ++ai)
#pragma unroll
            for (int m = 0; m < 4; ++m) {
                const size_t row = (size_t)(rowb + ai * 128 + m * 16);
                if (pn < 4) {
#pragma unroll
                    for (int bj = 0; bj < 2; ++bj) *(u32x4*)(Bc + row * CW + pn * 256 + bj * 128 + cl) = pack8(acc[ai][bj][m][0], acc[ai][bj][m][1]);
                } else if (pn < 12) {
                    *(u32x4*)(P + row * CW + (pn - 4) * 128 + cl) = pack8(acc[ai][0][m][0] * acc[ai][1][m][0], acc[ai][0][m][1] * acc[ai][1][m][1]);
                } else if (pn < 20) {
                    bf16_t* O = (pn < 16) ? (U + row * SW + (pn - 12) * 256) : (V + row * SW + (pn - 16) * 256);
#pragma unroll
                    for (int bj = 0; bj < 2; ++bj) { f32x4 a = acc[ai][bj][m][0], b = acc[ai][bj][m][1];
#pragma unroll
                        for (int j = 0; j < 4; ++j) { a[j] = gelu_tanh(a[j]); b[j] = gelu_tanh(b[j]); }
                        *(u32x4*)(O + bj * 128 + cl) = pack8(a, b); }
                } else {
                    f32x4 r0, r1, s0, s1;
#pragma unroll
                    for (int j = 0; j < 4; ++j) {
                        const float ec0 = fast_exp2(-1.44269504f * acc[ai][0][m][0][j]), es0 = fast_exp2(-1.44269504f * acc[ai][1][m][0][j]);
                        const float ec1 = fast_exp2(-1.44269504f * acc[ai][0][m][1][j]), es1 = fast_exp2(-1.44269504f * acc[ai][1][m][1][j]);
                        r0[j] = (1.0f + es0) * fast_rcp(1.0f + ec0); s0[j] = fast_rcp(1.0f + es0);
                        r1[j] = (1.0f + es1) * fast_rcp(1.0f + ec1); s1[j] = fast_rcp(1.0f + es1);
                    }
                    const size_t o = row * D + (pn - 20) * 128 + cl;
                    *(u32x4*)(R + o) = pack8(r0, r1); *(u32x4*)(S + o) = pack8(s0, s1);
                }
            }
    }
};
struct EpiUp {
    static constexpr bool PERM = true; static constexpr int MIDK = 1024;
    const bf16_t *R, *S; bf16_t* Mm;
    __device__ __forceinline__ void mid(Acc& acc, const Unit& u, int wr, int wc, int fr, int fq) const {
        int rowb = u.row0 + wr * 64 + fr; const int cb = u.pn * 256 + wc * 32 + 8 * fq;
        asm volatile("" : "+v"(rowb));
#pragma unroll
        for (int ai = 0; ai < 2; ++ai)
#pragma unroll
            for (int m = 0; m < 4; ++m)
#pragma unroll
                for (int bj = 0; bj < 2; ++bj) { f32x4 a, b; unpack8(*(const u32x4*)(R + (size_t)(rowb + ai * 128 + m * 16) * D + cb + bj * 128), a, b);
                    acc[ai][bj][m][0] *= a; acc[ai][bj][m][1] *= b; }
    }
    __device__ __forceinline__ void operator()(const Acc& acc, const Unit& u, int wr, int wc, int fr, int fq) const {
        const int rowb = u.row0 + wr * 64 + fr; const int cb = u.pn * 256 + wc * 32 + 8 * fq;
#pragma unroll
        for (int ai = 0; ai < 2; ++ai)
#pragma unroll
            for (int m = 0; m < 4; ++m)
#pragma unroll
                for (int bj = 0; bj < 2; ++bj) { const size_t o = (size_t)(rowb + ai * 128 + m * 16) * D + cb + bj * 128; f32x4 a, b; unpack8(*(const u32x4*)(S + o), a, b);
                    *(u32x4*)(Mm + o) = pack8(acc[ai][bj][m][0] * a, acc[ai][bj][m][1] * b); }
    }
};
struct EpiOut {
    static constexpr bool PERM = true; static constexpr int MIDK = 0;
    const float* x; bf16_t* A2;
    __device__ __forceinline__ void mid(Acc&, const Unit&, int, int, int, int) const {}
    __device__ __forceinline__ void operator()(const Acc& acc, const Unit& u, int wr, int wc, int fr, int fq) const {
        const int rowb = u.row0 + wr * 64 + fr; const int cb = u.pn * 256 + wc * 32 + 8 * fq;
#pragma unroll
        for (int ai = 0; ai < 2; ++ai)
#pragma unroll
            for (int m = 0; m < 4; ++m)
#pragma unroll
                for (int bj = 0; bj < 2; ++bj) { const size_t o = (size_t)(rowb + ai * 128 + m * 16) * D + cb + bj * 128;
                    const f32x4 h0 = *(const f32x4*)(x + o) + acc[ai][bj][m][0], h1 = *(const f32x4*)(x + o + 4) + acc[ai][bj][m][1];
                    *(u32x4*)(A2 + o) = pack8(h0, h1); }
    }
};
struct EpiMoe1 {
    static constexpr bool PERM = true; static constexpr int MIDK = 0;
    const int* ent; const float* lw; const float* rstd; bf16_t* Hid;
    __device__ __forceinline__ void mid(Acc&, const Unit&, int, int, int, int) const {}
    __device__ __forceinline__ void operator()(const Acc& acc, const Unit& u, int wr, int wc, int fr, int fq) const {
        const int cl = u.pn * 128 + wc * 32 + 8 * fq;
#pragma unroll
        for (int ai = 0; ai < 2; ++ai)
#pragma unroll
            for (int m = 0; m < 4; ++m) {
                const int r = ai * 128 + wr * 64 + m * 16 + fr;
                if (r < u.nvalid) {
                    const int li = u.e * T + u.pm * 256 + r; const int tok = ent[li] & 0xffff; const float rs = rstd[tok], w = lw[li];
                    f32x4 o[2];
#pragma unroll
                    for (int n = 0; n < 2; ++n)
#pragma unroll
                        for (int j = 0; j < 4; ++j) { const float gt = acc[ai][0][m][n][j] * rs, up = acc[ai][1][m][n][j] * rs; o[n][j] = gt * sigmoid_f(gt) * up * w; }
                    *(u32x4*)(Hid + (size_t)(u.row0 + r) * DE + cl) = pack8(o[0], o[1]);
                }
            }
    }
};
struct EpiMoe2 {
    static constexpr bool PERM = true; static constexpr int MIDK = 0;
    const int* ent; bf16_t* Yk0; bf16_t* Yk1;
    __device__ __forceinline__ void mid(Acc&, const Unit&, int, int, int, int) const {}
    __device__ __forceinline__ void operator()(const Acc& acc, const Unit& u, int wr, int wc, int fr, int fq) const {
        const int cb = u.pn * 256 + wc * 32 + 8 * fq;
#pragma unroll
        for (int ai = 0; ai < 2; ++ai)
#pragma unroll
            for (int m = 0; m < 4; ++m) {
                const int r = ai * 128 + wr * 64 + m * 16 + fr;
                if (r < u.nvalid) {
                    const int en = ent[u.e * T + u.pm * 256 + r]; const int tok = en & 0xffff; bf16_t* Y = (en >> 16) ? Yk1 : Yk0;
#pragma unroll
                    for (int bj = 0; bj < 2; ++bj) *(u32x4*)(Y + (size_t)tok * D + cb + bj * 128) = pack8(acc[ai][bj][m][0], acc[ai][bj][m][1]);
                }
            }
    }
};

template <class Epi, class Sched>
__device__ __forceinline__ void gemm_simple(const Sched& S, const Epi& E, const int K) {
    const int tid = opaque_tid(), wid = __builtin_amdgcn_readfirstlane(tid >> 6), lane = tid & 63, wr = wid >> 2, wc = wid & 3, fr = lane & 15, fq = lane >> 4;
    Unit u;
    for (int ui = 0; S.next(ui, u); ++ui) {
        Acc acc;
#pragma unroll
        for (int a = 0; a < 2; ++a)
#pragma unroll
            for (int b = 0; b < 2; ++b)
#pragma unroll
                for (int m = 0; m < 4; ++m)
#pragma unroll
                    for (int n = 0; n < 2; ++n) acc[a][b][m][n] = (f32x4){0.f, 0.f, 0.f, 0.f};
        const char* ab = S.a_base(); const char* bb = S.b_base(u);
        unsigned aoff[2][4], boff[2][2];
#pragma unroll
        for (int ai = 0; ai < 2; ++ai)
#pragma unroll
            for (int m = 0; m < 4; ++m) aoff[ai][m] = S.a_off(u, ai * 128 + wr * 64 + m * 16 + fr) + fq * 16;
#pragma unroll
        for (int bj = 0; bj < 2; ++bj)
#pragma unroll
            for (int n = 0; n < 2; ++n) { const int rr = Epi::PERM ? perm32(n * 16 + fr) : (n * 16 + fr); boff[bj][n] = (unsigned)(bj * 128 + wc * 32 + rr) * (unsigned)K * 2u + fq * 16; }
        for (int k0 = 0; k0 < K; k0 += 32) {
            if (Epi::MIDK != 0 && k0 == Epi::MIDK) E.mid(acc, u, wr, wc, fr, fq);
            bf16x8 a[2][4], b[2][2];
#pragma unroll
            for (int ai = 0; ai < 2; ++ai)
#pragma unroll
                for (int m = 0; m < 4; ++m) a[ai][m] = *(const bf16x8*)(ab + aoff[ai][m] + k0 * 2);
#pragma unroll
            for (int bj = 0; bj < 2; ++bj)
#pragma unroll
                for (int n = 0; n < 2; ++n) b[bj][n] = *(const bf16x8*)(bb + boff[bj][n] + k0 * 2);
#pragma unroll
            for (int ai = 0; ai < 2; ++ai)
#pragma unroll
                for (int bj = 0; bj < 2; ++bj)
#pragma unroll
                    for (int m = 0; m < 4; ++m)
#pragma unroll
                        for (int n = 0; n < 2; ++n) acc[ai][bj][m][n] = __builtin_amdgcn_mfma_f32_16x16x32_bf16(b[bj][n], a[ai][m], acc[ai][bj][m][n], 0, 0, 0);
        }
        E(acc, u, wr, wc, fr, fq);
    }
}

constexpr int BK = 64, HALF = 128, HTB = HALF * BK * 2, STAGE_BYTES = 8 * HTB;
__host__ __device__ __forceinline__ int lds_byte(int r, int c) { const int st = (r >> 4) * 2 + (c >> 5), rr = r & 15, cc = c & 31, ob = rr * 64 + cc * 2; return st * 1024 + (ob ^ (((ob >> 9) & 1) << 5)); }
__host__ __device__ __forceinline__ void stage_rc(int b, int& R, int& C) { const int st = b / 1024, sb = b % 1024, swz = sb ^ (((sb >> 9) & 1) << 5); R = (st >> 1) * 16 + swz / 64; C = (st & 1) * 32 + (swz % 64) / 2; }

template <class Epi, class Sched>
__device__ __forceinline__ void gemm_fast(LAS unsigned char* lds, const Sched& S, const Epi& E, const int K) {
    const int tid = opaque_tid(), wid = __builtin_amdgcn_readfirstlane(tid >> 6), lane = tid & 63, wr = wid >> 2, wc = wid & 3, fr = lane & 15, fq = lane >> 4;
    const int nt = K / BK;
    int sR[2], sC[2]; unsigned voffB[2];
#pragma unroll
    for (int i = 0; i < 2; ++i) { stage_rc(tid * 16 + i * 8192, sR[i], sC[i]); const int Rb = Epi::PERM ? ((sR[i] & ~31) + perm32(sR[i] & 31)) : sR[i]; voffB[i] = (unsigned)(Rb * K + sC[i]) * 2u; }
    const size_t kstep = (size_t)(BK * 2);
    const size_t hstepB = (size_t)HALF * K * 2;
    const unsigned ldsw = (unsigned)wid * 1024u;
    const int aoff = lds_byte(wr * 64 + fr, fq * 8), boff = lds_byte(wc * 32 + fr, fq * 8);
#define PG8_SA(b, h) (((b) * 2 + (h)) * HTB)
#define PG8_SB(b, h) ((4 + (b) * 2 + (h)) * HTB)
#define PG8_STAGE(bufoff, gbase, voff) do { _Pragma("unroll") for (int _i = 0; _i < 2; ++_i) \
        __builtin_amdgcn_global_load_lds((const unsigned*)((const char*)(gbase) + (voff)[_i]), (LAS unsigned*)(lds + (bufoff) + ldsw + _i * 8192), 16, 0, 0); } while (0)
#define PG8_LDA(dst, b, h) do { _Pragma("unroll") for (int m = 0; m < 4; ++m) _Pragma("unroll") for (int k = 0; k < 2; ++k) dst[m][k] = *(const LAS bf16x8*)(lds + PG8_SA(b, h) + aoff + m * 2048 + k * 1024); } while (0)
#define PG8_LDB(dst, b, h) do { _Pragma("unroll") for (int n = 0; n < 2; ++n) _Pragma("unroll") for (int k = 0; k < 2; ++k) dst[n][k] = *(const LAS bf16x8*)(lds + PG8_SB(b, h) + boff + n * 2048 + k * 1024); } while (0)
#define PG8_MMA(ai, bj, At, Bt) do { __builtin_amdgcn_s_setprio(1); _Pragma("unroll") for (int m = 0; m < 4; ++m) _Pragma("unroll") for (int n = 0; n < 2; ++n) _Pragma("unroll") for (int k = 0; k < 2; ++k) \
        acc[ai][bj][m][n] = __builtin_amdgcn_mfma_f32_16x16x32_bf16(Bt[n][k], At[m][k], acc[ai][bj][m][n], 0, 0, 0); __builtin_amdgcn_s_setprio(0); } while (0)
#define PG8_WAIT_V(n) asm volatile("s_waitcnt vmcnt(" #n ")" ::: "memory")
#define PG8_WAIT_L(n) asm volatile("s_waitcnt lgkmcnt(" #n ")" ::: "memory")
#define PG8_BAR __builtin_amdgcn_s_barrier()
#define PG8_SCHED __builtin_amdgcn_sched_barrier(0)
    Unit cur, nxt; int ui = 0;
    if (!S.next(0, cur)) return;
    Acc acc;
#pragma unroll
    for (int a = 0; a < 2; ++a)
#pragma unroll
        for (int b = 0; b < 2; ++b)
#pragma unroll
            for (int m = 0; m < 4; ++m)
#pragma unroll
                for (int n = 0; n < 2; ++n) acc[a][b][m][n] = (f32x4){0.f, 0.f, 0.f, 0.f};
    bf16x8 At[4][2], B0[2][2], B1[2][2];
    unsigned va[2][2], vn[2][2];
#pragma unroll
    for (int h = 0; h < 2; ++h)
#pragma unroll
        for (int i = 0; i < 2; ++i) va[h][i] = S.a_off(cur, h * 128 + sR[i]) + (unsigned)sC[i] * 2u;
    const char* const A0 = S.a_base(); const char* cB = S.b_base(cur);
    PG8_STAGE(PG8_SB(0, 0), cB, voffB); PG8_STAGE(PG8_SB(0, 1), cB + hstepB, voffB); PG8_STAGE(PG8_SA(0, 0), A0, va[0]); PG8_STAGE(PG8_SA(0, 1), A0, va[1]);
    if (wr == 1) PG8_BAR;
    PG8_WAIT_V(2); PG8_BAR;
    PG8_STAGE(PG8_SB(1, 0), cB + kstep, voffB); PG8_STAGE(PG8_SA(1, 0), A0 + kstep, va[0]); PG8_STAGE(PG8_SB(1, 1), cB + hstepB + kstep, voffB);
    PG8_WAIT_V(6); PG8_BAR;
    for (;;) {
        const bool has_next = S.next(ui + 1, nxt);
        const char* nB = has_next ? S.b_base(nxt) : cB;
#pragma unroll
        for (int h = 0; h < 2; ++h)
#pragma unroll
            for (int i = 0; i < 2; ++i) vn[h][i] = has_next ? (S.a_off(nxt, h * 128 + sR[i]) + (unsigned)sC[i] * 2u) : va[h][i];
        for (int t = 0; t < nt; t += 2) {
            const bool last = (t == nt - 2);
            if (Epi::MIDK != 0 && t * BK == Epi::MIDK) { PG8_SCHED; E.mid(acc, cur, wr, wc, fr, fq); PG8_SCHED; }
            const char* a1 = A0 + (size_t)(t + 1) * kstep;
            const char* a2 = last ? A0 : A0 + (size_t)(t + 2) * kstep; const char* b2 = last ? nB : cB + (size_t)(t + 2) * kstep;
            const char* a3 = a2 + kstep; const char* b3 = b2 + kstep;
            unsigned v2[2][2];
#pragma unroll
            for (int h = 0; h < 2; ++h)
#pragma unroll
                for (int i = 0; i < 2; ++i) v2[h][i] = last ? vn[h][i] : va[h][i];
            PG8_LDB(B0, 0, 0); PG8_LDB(B1, 0, 1); PG8_SCHED; PG8_LDA(At, 0, 0); PG8_STAGE(PG8_SA(1, 1), a1, va[1]);
            PG8_WAIT_V(8); PG8_WAIT_L(0); PG8_BAR; PG8_MMA(0, 0, At, B0); PG8_MMA(0, 1, At, B1); PG8_BAR; PG8_SCHED;
            PG8_LDA(At, 0, 1); PG8_STAGE(PG8_SB(0, 0), b2, voffB); PG8_STAGE(PG8_SB(0, 1), b2 + hstepB, voffB); PG8_STAGE(PG8_SA(0, 0), a2, v2[0]);
            PG8_WAIT_V(8); PG8_WAIT_L(0); PG8_BAR; PG8_MMA(1, 0, At, B0); PG8_MMA(1, 1, At, B1); PG8_BAR; PG8_SCHED;
            PG8_LDB(B0, 1, 0); PG8_LDB(B1, 1, 1); PG8_SCHED; PG8_LDA(At, 1, 0); PG8_STAGE(PG8_SA(0, 1), a2, v2[1]);
            PG8_WAIT_V(8); PG8_WAIT_L(0); PG8_BAR; PG8_MMA(0, 0, At, B0); PG8_MMA(0, 1, At, B1); PG8_BAR; PG8_SCHED;
            PG8_LDA(At, 1, 1); PG8_STAGE(PG8_SB(1, 0), b3, voffB); PG8_STAGE(PG8_SB(1, 1), b3 + hstepB, voffB); PG8_STAGE(PG8_SA(1, 0), a3, v2[0]);
            PG8_WAIT_V(8); PG8_WAIT_L(0); PG8_BAR; PG8_MMA(1, 0, At, B0); PG8_MMA(1, 1, At, B1); PG8_BAR; PG8_SCHED;
        }
        if (wr == 0) PG8_BAR;
        E(acc, cur, wr, wc, fr, fq);
        if (!has_next) break;
#pragma unroll
        for (int a = 0; a < 2; ++a)
#pragma unroll
            for (int b = 0; b < 2; ++b)
#pragma unroll
                for (int m = 0; m < 4; ++m)
#pragma unroll
                    for (int n = 0; n < 2; ++n) acc[a][b][m][n] = (f32x4){0.f, 0.f, 0.f, 0.f};
        cur = nxt; cB = nB; ++ui;
#pragma unroll
        for (int h = 0; h < 2; ++h)
#pragma unroll
            for (int i = 0; i < 2; ++i) va[h][i] = vn[h][i];
        if (wr == 1) PG8_BAR;
    }
    PG8_WAIT_V(0);
    PG8_BAR;
#undef PG8_SA
#undef PG8_SB
#undef PG8_STAGE
#undef PG8_LDA
#undef PG8_LDB
#undef PG8_MMA
#undef PG8_WAIT_V
#undef PG8_WAIT_L
#undef PG8_BAR
#undef PG8_SCHED
}
#ifndef FAST_MASK
#define FAST_MASK 0x1f
#endif
template <int BIT, class Epi, class Sched>
__device__ __forceinline__ void gemm_run(LAS unsigned char* lds, const Sched& S, const Epi& E, const int K) {
    if constexpr ((FAST_MASK >> BIT) & 1) gemm_fast(lds, S, E, K); else gemm_simple(S, E, K);
}

__device__ __forceinline__ void tr_item64(const float* W, int N, int k0, int ns, bf16_t* WT, int ldk, int nd, int kd, LAS float* scr, int lane, const float* kscale) {
    { const int r4 = lane >> 4, c4 = (lane & 15) * 4; f32x4 v[16];
#pragma unroll
      for (int i = 0; i < 16; ++i) v[i] = *(const f32x4*)(W + (size_t)(k0 + 4 * i + r4) * N + ns + c4);
#pragma unroll
      for (int i = 0; i < 16; ++i) { LAS float* d = scr + (4 * i + r4) * 65 + c4; d[0] = v[i][0]; d[1] = v[i][1]; d[2] = v[i][2]; d[3] = v[i][3]; } }
    const int c = lane & 7;
    f32x4 s0 = (f32x4){1.f, 1.f, 1.f, 1.f}, s1 = s0;
    if (kscale) { s0 = *(const f32x4*)(kscale + k0 + 8 * c); s1 = *(const f32x4*)(kscale + k0 + 8 * c + 4); }
    asm volatile("s_waitcnt lgkmcnt(0)" ::: "memory");
#pragma unroll
    for (int j = 0; j < 8; ++j) { const int n = (lane >> 3) + 8 * j; const LAS float* s = scr + (8 * c) * 65 + n;
        u32x4 o; o.x = cvt_pk_bf16(s[0 * 65] * s0[0], s[1 * 65] * s0[1]); o.y = cvt_pk_bf16(s[2 * 65] * s0[2], s[3 * 65] * s0[3]);
        o.z = cvt_pk_bf16(s[4 * 65] * s1[0], s[5 * 65] * s1[1]); o.w = cvt_pk_bf16(s[6 * 65] * s1[2], s[7 * 65] * s1[3]);
        *(u32x4*)(WT + (size_t)(nd + n) * ldk + kd + 8 * c) = o; }
    asm volatile("s_waitcnt lgkmcnt(0)" ::: "memory");
}
constexpr int TRS = 64 * 65 * 4;
static_assert(8 * TRS <= LDS_BYTES - 64, "transpose scratch vs barrier words");
template <int WHICH>
__device__ __forceinline__ void convert_tail(const Params& p, LAS unsigned char* lds, int nunits) {
    const int tid = opaque_tid(), wave = __builtin_amdgcn_readfirstlane(tid >> 6), lane = tid & 63;
    const int G = gridDim.x, rounds = (nunits + G - 1) / G, nfull = nunits - (rounds - 1) * G;
    int idle_idx, n_idle;
    if (nfull >= G || nunits == 0) { idle_idx = blockIdx.x; n_idle = G; } else { idle_idx = (int)blockIdx.x - nfull; n_idle = G - nfull; }
    if (idle_idx < 0) return;
    LAS float* scr = (LAS float*)(lds + wave * TRS);
    constexpr int NIT = WHICH == 0 ? 8192 : 4096;
    for (int r = idle_idx * NWAVES + wave; r < NIT; r += n_idle * NWAVES) {
        if (WHICH == 0) { const int up = r >> 12, qq = r & 4095, e = qq >> 8, kb = (qq & 255) >> 3, nb = qq & 7; const int nd = 256 * (nb >> 1) + (nb & 1) * 64 + (up ? 128 : 0);
            tr_item64(p.in[up ? 17 : 16] + (size_t)e * D * DE, DE, kb * 64, nb * 64, (bf16_t*)(p.ws + WS_W1T) + (size_t)e * 1024 * D, D, nd, kb * 64, scr, lane, p.in[11]); }
        else { const int e = r >> 8, kb = (r & 255) >> 5, nb = r & 31;
            tr_item64(p.in[18] + (size_t)e * DE * D, D, kb * 64, nb * 64, (bf16_t*)(p.ws + WS_W2T) + (size_t)e * D * DE, DE, nb * 64, kb * 64, scr, lane, nullptr); }
    }
}
__device__ __forceinline__ int win_src_col(int nd) {
    if (nd < 1024) return nd;
    if (nd < 3072) { const int q = (nd - 1024) >> 8, r = (nd - 1024) & 255; return r < 128 ? (1024 + 128 * q + r) : (2048 + 128 * q + r - 128); }
    if (nd < 5120) return nd;
    { const int q = (nd - 5120) >> 8, r = (nd - 5120) & 255; return r < 128 ? (5120 + 128 * q + r) : (7168 + 128 * q + r - 128); }
}
__device__ __forceinline__ void phase0(const Params& p, LAS unsigned char* lds) {
    const int tid = opaque_tid(), wave = __builtin_amdgcn_readfirstlane(tid >> 6), lane = tid & 63;
    LAS float* scr = (LAS float*)(lds + wave * TRS);
    const int gw = blockIdx.x * NWAVES + wave, NGW = gridDim.x * NWAVES;
    unsigned char* ws = p.ws;
    constexpr int I_IN = 32 * 144, I_UP = 16 * 32, I_OUT = 32 * 32;
    constexpr int NITEMS = I_IN + 2 * I_UP + I_OUT;
    for (int it = gw; it < NITEMS; it += NGW) {
        int r = it;
        if (r < I_IN) { const int kb = r / 144, nb = r % 144; tr_item64(p.in[2], NIN, kb * 64, win_src_col(nb * 64), (bf16_t*)(ws + WS_WINT), D, nb * 64, kb * 64, scr, lane, nullptr); continue; } r -= I_IN;
        if (r < I_UP) { const int kb = r / 32, nb = r % 32; tr_item64(p.in[8], D, kb * 64, nb * 64, (bf16_t*)(ws + WS_WUPT), 2048, nb * 64, kb * 64, scr, lane, nullptr); continue; } r -= I_UP;
        if (r < I_UP) { const int kb = r / 32, nb = r % 32; tr_item64(p.in[9], D, kb * 64, nb * 64, (bf16_t*)(ws + WS_WUPT), 2048, nb * 64, 1024 + kb * 64, scr, lane, nullptr); continue; } r -= I_UP;
        { const int kb = r / 32, nb = r % 32; tr_item64(p.in[10], D, kb * 64, nb * 64, (bf16_t*)(ws + WS_WOUTT), D, nb * 64, kb * 64, scr, lane, nullptr); }
    }
    const float* x = p.in[0]; const float* g = p.in[1]; bf16_t* xn = (bf16_t*)(ws + WS_X);
    for (int m = gw; m < T; m += NGW) {
        const f32x4* xr = (const f32x4*)(x + (size_t)m * D) + lane; f32x4 v[8]; float s = 0.f;
#pragma unroll
        for (int j = 0; j < 8; ++j) { v[j] = xr[64 * j]; s += (v[j][0] * v[j][0] + v[j][1] * v[j][1]) + (v[j][2] * v[j][2] + v[j][3] * v[j][3]); }
        const float rs = 1.0f / sqrtf(wave_sum(s) * (1.0f / D) + EPS);
        u32x2* o = (u32x2*)(xn + (size_t)m * D) + lane;
#pragma unroll
        for (int j = 0; j < 8; ++j) { const f32x4 gg = *((const f32x4*)g + lane + 64 * j); u32x2 w; w.x = cvt_pk_bf16(v[j][0] * rs * gg[0], v[j][1] * rs * gg[1]); w.y = cvt_pk_bf16(v[j][2] * rs * gg[2], v[j][3] * rs * gg[3]); o[64 * j] = w; }
    }
    { bf16_t* wr = (bf16_t*)(ws + WS_WR); const float* gf = p.in[11];
      for (int i = blockIdx.x * NTHREADS + tid; i < 32 * D; i += gridDim.x * NTHREADS) { const int j = i / D, d = i % D; unsigned hi = 0, lo = 0;
          if (j < 20) { const float v = gf[d] * (j < 4 ? p.in[12][d * 4 + j] : p.in[14][d * 16 + (j - 4)]); hi = cvt_pk_bf16(v, 0.f) & 0xffffu; lo = cvt_pk_bf16(v - __uint_as_float(hi << 16), 0.f) & 0xffffu; }
          wr[(size_t)j * D + d] = (bf16_t)hi; wr[(size_t)(32 + j) * D + d] = (bf16_t)lo; } }
    { bf16_t* wmb = (bf16_t*)(ws + WS_WMB); const float* wsrc = p.in[6];
      for (int i = blockIdx.x * NTHREADS + tid; i < 8 * 128 * 128 / 2; i += gridDim.x * NTHREADS) { const int e0 = 2 * i, r = (e0 >> 7) & 127, c = e0 & 127; const bool ok = (r >= 64) || (c < 64);
          ((unsigned*)wmb)[i] = ok ? cvt_pk_bf16(wsrc[e0], wsrc[e0 + 1]) : 0u; } }
    if (blockIdx.x == 0 && tid < 64) ((int*)(ws + WS_CTL))[tid] = 0;
}

__device__ __forceinline__ void phase2_conv(const Params& p) {
    const bf16_t* Bc = (const bf16_t*)(p.ws + WS_P + P_BC); const bf16_t* P = (const bf16_t*)(p.ws + WS_P + P_P); bf16_t* Y = (bf16_t*)(p.ws + WS_X);
    const float* cw = p.in[3];
    for (int i = blockIdx.x * NTHREADS + opaque_tid(); i < T * (CW / 8); i += gridDim.x * NTHREADS) {
        const int t = i >> 7, c = (i & 127) * 8;
        f32x4 p0a, p0b, p1a, p1b, p2a, p2b, ba, bb;
        unpack8(*(const u32x4*)(P + (size_t)t * CW + c), p2a, p2b); unpack8(*(const u32x4*)(Bc + (size_t)t * CW + c), ba, bb);
        if (t >= 1) unpack8(*(const u32x4*)(P + (size_t)(t - 1) * CW + c), p1a, p1b); else { p1a = (f32x4){0, 0, 0, 0}; p1b = p1a; }
        if (t >= 2) unpack8(*(const u32x4*)(P + (size_t)(t - 2) * CW + c), p0a, p0b); else { p0a = (f32x4){0, 0, 0, 0}; p0b = p0a; }
        const f32x4 w0a = *(const f32x4*)(cw + c), w0b = *(const f32x4*)(cw + c + 4), w1a = *(const f32x4*)(cw + CW + c), w1b = *(const f32x4*)(cw + CW + c + 4),
                    w2a = *(const f32x4*)(cw + 2 * CW + c), w2b = *(const f32x4*)(cw + 2 * CW + c + 4);
        const f32x4 ya = ba * (w0a * p0a + w1a * p1a + w2a * p2a), yb = bb * (w0b * p0b + w1b * p1b + w2b * p2b);
        *(u32x4*)(Y + (size_t)t * 2048 + c) = pack8(ya, yb);
    }
}
__device__ __forceinline__ void phase2_sgu(const Params& p, LAS unsigned char* lds) {
    const int tid = opaque_tid(), wave = __builtin_amdgcn_readfirstlane(tid >> 6), lane = tid & 63, fr = lane & 15, fq = lane >> 4;
    const bf16_t* U = (const bf16_t*)(p.ws + WS_P + P_U); const bf16_t* V = (const bf16_t*)(p.ws + WS_P + P_V); bf16_t* Y = (bf16_t*)(p.ws + WS_X);
    const bf16_t* WmB = (const bf16_t*)(p.ws + WS_WMB);
    const float* lng = p.in[4]; const float* lnb = p.in[5]; const float* bs = p.in[7];
    LAS f32x2* st = (LAS f32x2*)lds;
    LAS unsigned char* vT = lds + 1024;
    constexpr int VP = 272;
    for (int unit = blockIdx.x; unit < 64 * 8; unit += gridDim.x) {
        const int nb = unit >> 3, h = unit & 7, t0 = nb * 128, c0 = h * 128;
        __syncthreads();
        u32x4 vraw[16][2];
#pragma unroll
        for (int jj = 0; jj < 16; ++jj) { const u32x4* vr = (const u32x4*)(V + (size_t)(t0 + wave * 16 + jj) * SW) + lane * 2; vraw[jj][0] = vr[0]; vraw[jj][1] = vr[1]; }
#pragma unroll
        for (int jj = 0; jj < 16; ++jj) { const int j = wave * 16 + jj;
            f32x4 a, b, c, d; unpack8(vraw[jj][0], a, b); unpack8(vraw[jj][1], c, d);
            float s = (a[0] + a[1] + a[2] + a[3]) + (b[0] + b[1] + b[2] + b[3]) + (c[0] + c[1] + c[2] + c[3]) + (d[0] + d[1] + d[2] + d[3]);
            const float mu = wave_sum(s) * (1.0f / SW);
            a -= mu; b -= mu; c -= mu; d -= mu;
            float q = (a[0] * a[0] + a[1] * a[1] + a[2] * a[2] + a[3] * a[3]) + (b[0] * b[0] + b[1] * b[1] + b[2] * b[2] + b[3] * b[3]) + (c[0] * c[0] + c[1] * c[1] + c[2] * c[2] + c[3] * c[3]) + (d[0] * d[0] + d[1] * d[1] + d[2] * d[2] + d[3] * d[3]);
            const float rs = 1.0f / sqrtf(wave_sum(q) * (1.0f / SW) + EPS);
            if (lane == 0) st[j] = (f32x2){mu, rs}; }
        __syncthreads();
        if (tid < 256) {
            const int jb = tid >> 4, cb = tid & 15, j0 = jb * 8, cc0 = cb * 8;
            const f32x4 g0 = *(const f32x4*)(lng + c0 + cc0), g1 = *(const f32x4*)(lng + c0 + cc0 + 4), b0 = *(const f32x4*)(lnb + c0 + cc0), b1 = *(const f32x4*)(lnb + c0 + cc0 + 4);
            f32x4 lo[8], hi[8];
#pragma unroll
            for (int r = 0; r < 8; ++r) { const f32x2 s = st[j0 + r]; f32x4 a, b; unpack8(*(const u32x4*)(V + (size_t)(t0 + j0 + r) * SW + c0 + cc0), a, b);
                lo[r] = (a - s.x) * s.y * g0 + b0; hi[r] = (b - s.x) * s.y * g1 + b1; }
#pragma unroll
            for (int cc = 0; cc < 4; ++cc) { u32x4 o;
                o.x = cvt_pk_bf16(lo[0][cc], lo[1][cc]); o.y = cvt_pk_bf16(lo[2][cc], lo[3][cc]); o.z = cvt_pk_bf16(lo[4][cc], lo[5][cc]); o.w = cvt_pk_bf16(lo[6][cc], lo[7][cc]);
                *(LAS u32x4*)(vT + (cc0 + cc) * VP + j0 * 2) = o;
                o.x = cvt_pk_bf16(hi[0][cc], hi[1][cc]); o.y = cvt_pk_bf16(hi[2][cc], hi[3][cc]); o.z = cvt_pk_bf16(hi[4][cc], hi[5][cc]); o.w = cvt_pk_bf16(hi[6][cc], hi[7][cc]);
                *(LAS u32x4*)(vT + (cc0 + 4 + cc) * VP + j0 * 2) = o; }
        }
        __syncthreads();
        bf16x8 wf[4];
#pragma unroll
        for (int ks = 0; ks < 4; ++ks) wf[ks] = *(const bf16x8*)(WmB + ((size_t)h * 128 + wave * 16 + fr) * 128 + ks * 32 + fq * 8);
        f32x4 acc[8];
#pragma unroll
        for (int nk = 0; nk < 8; ++nk) { acc[nk] = (f32x4){0.f, 0.f, 0.f, 0.f};
#pragma unroll
            for (int ks = 0; ks < 4; ++ks) { const bf16x8 vf = *(const LAS bf16x8*)(vT + (nk * 16 + fr) * VP + (ks * 32 + fq * 8) * 2);
                acc[nk] = __builtin_amdgcn_mfma_f32_16x16x32_bf16(vf, wf[ks], acc[nk], 0, 0, 0); } }
        { const int i = wave * 16 + fr; const float bb = bs[h * 128 + i]; const size_t t = (size_t)(t0 + i);
#pragma unroll
          for (int nk = 0; nk < 8; ++nk) { const int c = c0 + nk * 16 + 4 * fq; const u32x2 uu = *(const u32x2*)(U + t * SW + c);
              u32x2 o; o.x = cvt_pk_bf16(bf_lo(uu.x) * (acc[nk][0] + bb), bf_hi(uu.x) * (acc[nk][1] + bb)); o.y = cvt_pk_bf16(bf_lo(uu.y) * (acc[nk][2] + bb), bf_hi(uu.y) * (acc[nk][3] + bb));
              *(u32x2*)(Y + t * 2048 + 1024 + c) = o; } }
    }
}

__device__ __forceinline__ void phase5_router(const Params& p, LAS unsigned char* lds) {
    const int tid = opaque_tid(), wave = __builtin_amdgcn_readfirstlane(tid >> 6), lane = tid & 63, fr = lane & 15, fq = lane >> 4;
    const bf16_t* A2 = (const bf16_t*)(p.ws + WS_A2); const bf16_t* wr = (const bf16_t*)(p.ws + WS_WR);
    float* rstd = (float*)(p.ws + WS_SMALL + SM_RSTD); int* ent = (int*)(p.ws + WS_SMALL + SM_ENT); float* lw = (float*)(p.ws + WS_SMALL + SM_W); int* cnt = (int*)(p.ws + WS_CTL);
    const float* brg = p.in[13]; const float* bre = p.in[15];
    LAS float* part = (LAS float*)lds;
    LAS float* pss  = (LAS float*)(lds + 65536);
    LAS float* lg   = (LAS float*)(lds + 65536 + 1024);
    LAS float* lss  = (LAS float*)(lds + 65536 + 1024 + 2560);
    LAS int* lcnt  = (LAS int*)(lds + 70000);
    LAS int* lbase = (LAS int*)(lds + 70000 + 64);
    LAS int* le    = (LAS int*)(lds + 70000 + 128);
    LAS int* lp    = (LAS int*)(lds + 70000 + 128 + 256);
    LAS float* lwt = (LAS float*)(lds + 70000 + 128 + 512);
    for (int tile = blockIdx.x; tile < T / 32; tile += gridDim.x) {
        const int tok0 = tile * 32;
        __syncthreads();
        if (tid < 16) lcnt[tid] = 0;
        f32x4 acc[2][4]; float ss[2] = {0.f, 0.f};
#pragma unroll
        for (int m = 0; m < 2; ++m)
#pragma unroll
            for (int n = 0; n < 4; ++n) acc[m][n] = (f32x4){0.f, 0.f, 0.f, 0.f};
#pragma unroll 2
        for (int ks = 0; ks < 8; ++ks) {
            const int k = wave * 256 + ks * 32 + fq * 8;
            bf16x8 af[2], bfr[4];
#pragma unroll
            for (int m = 0; m < 2; ++m) af[m] = *(const bf16x8*)(A2 + (size_t)(tok0 + 16 * m + fr) * D + k);
#pragma unroll
            for (int n = 0; n < 4; ++n) bfr[n] = *(const bf16x8*)(wr + (size_t)(16 * n + fr) * D + k);
#pragma unroll
            for (int m = 0; m < 2; ++m) {
#pragma unroll
                for (int j = 0; j < 8; ++j) { const float v = bf1((bf16_t)af[m][j]); ss[m] += v * v; }
#pragma unroll
                for (int n = 0; n < 4; ++n) acc[m][n] = __builtin_amdgcn_mfma_f32_16x16x32_bf16(bfr[n], af[m], acc[m][n], 0, 0, 0);
            }
        }
#pragma unroll
        for (int m = 0; m < 2; ++m) { ss[m] += __shfl_xor(ss[m], 16); ss[m] += __shfl_xor(ss[m], 32);
            if (fq == 0) pss[wave * 32 + 16 * m + fr] = ss[m];
#pragma unroll
            for (int n = 0; n < 4; ++n) *(LAS f32x4*)(part + (wave * 32 + 16 * m + fr) * 64 + 16 * n + 4 * fq) = acc[m][n]; }
        __syncthreads();
        for (int i = tid; i < 32 * 20; i += NTHREADS) { const int t = i / 20, j = i % 20; float s = 0.f;
#pragma unroll
            for (int w = 0; w < 8; ++w) s += part[(w * 32 + t) * 64 + j] + part[(w * 32 + t) * 64 + 32 + j];
            lg[t * 20 + j] = s; }
        if (tid < 32) { float s = 0.f;
#pragma unroll
            for (int w = 0; w < 8; ++w) s += pss[w * 32 + tid];
            lss[tid] = s; }
        __syncthreads();
        if (tid < 32) {
            const int t = tid; const float rs = 1.0f / sqrtf(lss[t] * (1.0f / D) + EPS);
            float g4[4];
#pragma unroll
            for (int j = 0; j < 4; ++j) g4[j] = lg[t * 20 + j] * rs + brg[j];
            int gi = 0; float gm = g4[0];
#pragma unroll
            for (int j = 1; j < 4; ++j) if (g4[j] > gm) { gm = g4[j]; gi = j; }
            float den = 0.f;
#pragma unroll
            for (int j = 0; j < 4; ++j) den += __expf(g4[j] - gm);
            const float pg = 1.0f / den;
            float le4[4];
#pragma unroll
            for (int j = 0; j < 4; ++j) le4[j] = lg[t * 20 + 4 + gi * 4 + j] * rs + bre[gi * 4 + j];
            int i1 = 0; float m1 = le4[0];
#pragma unroll
            for (int j = 1; j < 4; ++j) if (le4[j] > m1) { m1 = le4[j]; i1 = j; }
            int i2 = -1; float m2 = -3.0e38f;
#pragma unroll
            for (int j = 0; j < 4; ++j) if (j != i1 && le4[j] > m2) { m2 = le4[j]; i2 = j; }
            const float ex = __expf(m2 - m1); const float w1 = pg / (1.0f + ex), w2 = pg * ex / (1.0f + ex);
            rstd[tok0 + t] = rs;
            const int e1 = gi * 4 + i1, e2 = gi * 4 + i2;
            le[2 * t] = e1; le[2 * t + 1] = e2; lwt[2 * t] = w1; lwt[2 * t + 1] = w2;
            lp[2 * t] = atomicAdd((int*)&lcnt[e1], 1); lp[2 * t + 1] = atomicAdd((int*)&lcnt[e2], 1);
        }
        __syncthreads();
        if (tid < 16) { const int n = lcnt[tid]; lbase[tid] = n ? atomicAdd(&cnt[tid], n) : 0; }
        __syncthreads();
        if (tid < 64) { const int e = le[tid]; const int pos = lbase[e] + lp[tid]; ent[e * T + pos] = (tok0 + (tid >> 1)) | ((tid & 1) << 16); lw[e * T + pos] = lwt[tid]; }
    }
}

__device__ __forceinline__ void phase8_final(const Params& p) {
    const int tid = opaque_tid(), wave = __builtin_amdgcn_readfirstlane(tid >> 6), lane = tid & 63;
    const bf16_t* A2 = (const bf16_t*)(p.ws + WS_A2); const bf16_t* Y0 = (const bf16_t*)(p.ws + WS_YK0); const bf16_t* Y1 = (const bf16_t*)(p.ws + WS_YK1); const float* g = p.in[19];
    const int gw = blockIdx.x * NWAVES + wave, NGW = gridDim.x * NWAVES;
    for (int m = gw; m < T; m += NGW) {
        f32x4 v[8]; float s = 0.f;
#pragma unroll
        for (int j = 0; j < 8; ++j) { const size_t o = (size_t)m * D + 4 * lane + 256 * j;
            const u32x2 hh = *(const u32x2*)(A2 + o), a = *(const u32x2*)(Y0 + o), b = *(const u32x2*)(Y1 + o);
            v[j][0] = bf_lo(hh.x) + (bf_lo(a.x) + bf_lo(b.x)); v[j][1] = bf_hi(hh.x) + (bf_hi(a.x) + bf_hi(b.x)); v[j][2] = bf_lo(hh.y) + (bf_lo(a.y) + bf_lo(b.y)); v[j][3] = bf_hi(hh.y) + (bf_hi(a.y) + bf_hi(b.y));
            s += (v[j][0] * v[j][0] + v[j][1] * v[j][1]) + (v[j][2] * v[j][2] + v[j][3] * v[j][3]); }
        const float rs = 1.0f / sqrtf(wave_sum(s) * (1.0f / D) + EPS);
#pragma unroll
        for (int j = 0; j < 8; ++j) { const int c = 4 * lane + 256 * j; const f32x4 gg = *(const f32x4*)(g + c); *(f32x4*)(p.out + (size_t)m * D + c) = v[j] * rs * gg; }
    }
}

#define XB_TMO      128
#define XB_XCNT(j)  (256  + 64 * (j))
#define XB_XSUB(j)  (1280 + 64 * (j))
#define XB_XGEN(j)  (2304 + 64 * (j))
#define XB_TOP      3328
#define XB_TOPGEN   3392
#define XCD_BAR_WORDS 3456
#define XB_SPIN_CAP (1u << 18)
__device__ __forceinline__ unsigned xb_ld(unsigned* p)              { return __hip_atomic_load(p, __ATOMIC_RELAXED, __HIP_MEMORY_SCOPE_AGENT); }
__device__ __forceinline__ unsigned xb_add(unsigned* p, unsigned v) { return __hip_atomic_fetch_add(p, v, __ATOMIC_RELAXED, __HIP_MEMORY_SCOPE_AGENT); }
__device__ __forceinline__ unsigned xb_xcc_id() { return (unsigned)__builtin_amdgcn_s_getreg((3 << 11) | 20) & 0xFu; }
#define XB_SPIN(cond, bar) do { unsigned _sp = 0; while (cond) { __builtin_amdgcn_s_sleep(1); \
    if ((++_sp & 255u) == 0u) { if (xb_ld(&(bar)[XB_TMO])) break; if (_sp > XB_SPIN_CAP) { atomicAdd(&(bar)[XB_TMO], 1u); break; } } } } while (0)
struct XcdBarrier { unsigned* bar; unsigned x; volatile LAS unsigned* st; };
__device__ __forceinline__ XcdBarrier xcd_barrier_post(unsigned* bar, volatile LAS unsigned* st) {
    XcdBarrier b; b.bar = bar; b.x = xb_xcc_id(); b.st = st;
    if (threadIdx.x == 0) (void)xb_add(&bar[XB_XCNT(b.x)], 1u);
    return b;
}
__device__ __forceinline__ void xcd_barrier_complete(unsigned* bar, unsigned x, unsigned& nloc, unsigned& nx) {
    const unsigned G = gridDim.x * gridDim.y * gridDim.z;
    unsigned sum, cnt, mine, sp = 0u;
    for (;;) {
        sum = 0u; cnt = 0u; mine = 0u;
#pragma unroll
        for (unsigned j = 0; j < 16; ++j) { const unsigned c = xb_ld(&bar[XB_XCNT(j)]); sum += c; cnt += (c > 0u) ? 1u : 0u; mine = (j == x) ? c : mine; }
        if (sum == G) break;
        __builtin_amdgcn_s_sleep(1);
        if ((++sp & 255u) == 0u) { if (xb_ld(&bar[XB_TMO])) break; if (sp > XB_SPIN_CAP) { atomicAdd(&bar[XB_TMO], 1u); break; } }
    }
    nloc = mine > 0u ? mine : 1u; nx = cnt > 0u ? cnt : 1u;
}
__device__ __forceinline__ void xcd_barrier(const XcdBarrier& b) {
    asm volatile("s_waitcnt vmcnt(0)" ::: "memory");
    __syncthreads();
    if (threadIdx.x == 0) {
        unsigned* bar = b.bar;
        __builtin_amdgcn_s_waitcnt(0);
        unsigned nloc = b.st[0], nx = b.st[1];
        if (nloc == 0u) { xcd_barrier_complete(bar, b.x, nloc, nx); b.st[0] = nloc; b.st[1] = nx; }
        const unsigned old = xb_add(&bar[XB_XSUB(b.x)], 1u);
        const unsigned gen = old / nloc;
        if (old + 1u == (gen + 1u) * nloc) {
            __builtin_amdgcn_fence(__ATOMIC_RELEASE, "agent");
            asm volatile("s_waitcnt vmcnt(0)" ::: "memory");
            const unsigned og = xb_add(&bar[XB_TOP], 1u);
            const unsigned tg = og / nx;
            if (og + 1u == (tg + 1u) * nx) xb_add(&bar[XB_TOPGEN], 1u);
            else XB_SPIN(xb_ld(&bar[XB_TOPGEN]) == tg, bar);
            __builtin_amdgcn_fence(__ATOMIC_ACQUIRE, "agent");
            xb_add(&bar[XB_XGEN(b.x)], 1u);
            asm volatile("s_waitcnt vmcnt(0)" ::: "memory");
        } else {
            XB_SPIN(xb_ld(&bar[XB_XGEN(b.x)]) == gen, bar);
            __builtin_amdgcn_fence(__ATOMIC_ACQUIRE, "agent");
            asm volatile("s_waitcnt vmcnt(0)" ::: "memory");
        }
    }
    __syncthreads();
}

template <int PH> __device__ __forceinline__ void run_phase(const Params& p, LAS unsigned char* lds) {
    unsigned char* ws = p.ws;
    if constexpr (PH == 0) phase0(p, lds);
    if constexpr (PH == 1) { DenseSched S; S.init((const bf16_t*)(ws + WS_X), (const bf16_t*)(ws + WS_WINT), T, NIN, D);
        EpiProj E{(bf16_t*)(ws + WS_P + P_BC), (bf16_t*)(ws + WS_P + P_P), (bf16_t*)(ws + WS_P + P_U), (bf16_t*)(ws + WS_P + P_V), (bf16_t*)(ws + WS_P + P_R), (bf16_t*)(ws + WS_P + P_S)};
        gemm_run<0>(lds, S, E, D); convert_tail<0>(p, lds, (T / 256) * (NIN / 256)); }
    if constexpr (PH == 2) { phase2_conv(p); phase2_sgu(p, lds); }
    if constexpr (PH == 3) { DenseSched S; S.init((const bf16_t*)(ws + WS_X), (const bf16_t*)(ws + WS_WUPT), T, D, 2048);
        EpiUp E{(const bf16_t*)(ws + WS_P + P_R), (const bf16_t*)(ws + WS_P + P_S), (bf16_t*)(ws + WS_MM)}; gemm_run<1>(lds, S, E, 2048); }
    if constexpr (PH == 4) { DenseSched S; S.init((const bf16_t*)(ws + WS_MM), (const bf16_t*)(ws + WS_WOUTT), T, D, D);
        EpiOut E{p.in[0], (bf16_t*)(ws + WS_A2)}; gemm_run<2>(lds, S, E, D); }
    if constexpr (PH == 5) phase5_router(p, lds);
    if constexpr (PH == 6) { MoeSched<true, 4, D, 1024> S{(const bf16_t*)(ws + WS_A2), (const bf16_t*)(ws + WS_W1T), (const int*)(ws + WS_CTL), (const int*)(ws + WS_SMALL + SM_ENT), (int)gridDim.x, (int)blockIdx.x};
        EpiMoe1 E{(const int*)(ws + WS_SMALL + SM_ENT), (const float*)(ws + WS_SMALL + SM_W), (const float*)(ws + WS_SMALL + SM_RSTD), (bf16_t*)(ws + WS_HID)}; gemm_run<3>(lds, S, E, D); int nu = 0; for (int e = 0; e < NE; ++e) nu += ((__builtin_amdgcn_readfirstlane(S.cnt[e]) + 255) >> 8) * 4; convert_tail<1>(p, lds, nu); }
    if constexpr (PH == 7) { MoeSched<false, 8, DE, D> S{(const bf16_t*)(ws + WS_HID), (const bf16_t*)(ws + WS_W2T), (const int*)(ws + WS_CTL), (const int*)(ws + WS_SMALL + SM_ENT), (int)gridDim.x, (int)blockIdx.x};
        EpiMoe2 E{(const int*)(ws + WS_SMALL + SM_ENT), (bf16_t*)(ws + WS_YK0), (bf16_t*)(ws + WS_YK1)}; gemm_run<4>(lds, S, E, DE); }
    if constexpr (PH == 8) phase8_final(p);
}

template <int PH> __global__ void __launch_bounds__(NTHREADS, 2) k_phase(Params p) {
    extern __shared__ __attribute__((aligned(16))) unsigned char lds_raw[];
    run_phase<PH>(p, (LAS unsigned char*)lds_raw);
}

#ifndef PROBE_DUP
#define PROBE_DUP 0
#endif
#ifndef PROBE_SYNCS
#define PROBE_SYNCS 0
#endif
#define DUP(k) ((PROBE_DUP >> (k)) & 1)
typedef const __attribute__((address_space(4))) Params* KParamsPtr;
__device__ __forceinline__ Params load_params() {
    Params r{};
#if defined(__HIP_DEVICE_COMPILE__)
    unsigned long long v = (unsigned long long)__builtin_amdgcn_kernarg_segment_ptr(); asm volatile("" : "+s"(v));
    const __attribute__((address_space(4))) unsigned long long* q = (const __attribute__((address_space(4))) unsigned long long*)v;
#pragma unroll
    for (int i = 0; i < 20; ++i) r.in[i] = (const float*)(const __attribute__((address_space(1))) float*)q[i];
    r.out = (float*)(__attribute__((address_space(1))) float*)q[20]; r.ws = (unsigned char*)(__attribute__((address_space(1))) unsigned char*)q[21];
#endif
    return r;
}
#define RUN(k) do { const Params pk = load_params(); run_phase<k>(pk, lds); } while (0)
__global__ void __launch_bounds__(NTHREADS, 2) k_mega(Params p) {
    extern __shared__ __attribute__((aligned(16))) unsigned char lds_raw[];
    LAS unsigned char* lds = (LAS unsigned char*)lds_raw;
    cg::grid_group grid = cg::this_grid();
    volatile LAS unsigned* xbst = (volatile LAS unsigned*)(lds + LDS_BYTES - 64);
    if (threadIdx.x < 4) xbst[threadIdx.x] = 0u;
    __syncthreads();
    const XcdBarrier bar = xcd_barrier_post((unsigned*)(p.ws + WS_BAR), xbst);
#define GSYNC() xcd_barrier(bar)
    if (p.ws == nullptr) grid.sync();
    RUN(0); GSYNC();
    if (DUP(0)) { RUN(0); GSYNC(); }
    RUN(1); GSYNC();
    if (DUP(1)) { RUN(1); GSYNC(); }
    RUN(2); GSYNC();
    if (DUP(2)) { RUN(2); GSYNC(); }
    RUN(3); GSYNC();
    if (DUP(3)) { RUN(3); GSYNC(); }
    RUN(4); GSYNC();
    if (DUP(4)) { RUN(4); GSYNC(); }
    RUN(5); GSYNC();
    if (DUP(5)) { if (blockIdx.x == 0 && threadIdx.x < 16) ((int*)(load_params().ws + WS_CTL))[threadIdx.x] = 0; GSYNC(); RUN(5); GSYNC(); }
    RUN(6); GSYNC();
    if (DUP(6)) { RUN(6); GSYNC(); }
    RUN(7); GSYNC();
    if (DUP(7)) { RUN(7); GSYNC(); }
    for (int i = 0; i < PROBE_SYNCS; ++i) GSYNC();
    RUN(8);
    if (DUP(8)) { GSYNC(); RUN(8); }
}

template <int PH> static void launch_phase(const Params& p, int grid, hipStream_t stream) {
    static bool attr = false;
    if (!attr) { (void)hipFuncSetAttribute((const void*)k_phase<PH>, hipFuncAttributeMaxDynamicSharedMemorySize, LDS_BYTES); attr = true; }
    hipLaunchKernelGGL(k_phase<PH>, dim3(grid), dim3(NTHREADS), LDS_BYTES, stream, p);
}

extern "C" void kernel_launch(void* const* d_in, const int* in_sizes, int n_in, void* d_out, int out_size, void* d_ws, size_t ws_size, hipStream_t stream) {
    static int grid = 0;
    if (grid == 0) {
        if (n_in != 20 || out_size != T * D || ws_size < WS_END) { fprintf(stderr, "kernel_launch: unexpected shapes n_in %d out %d ws %zu (need %zu)\n", n_in, out_size, ws_size, (size_t)WS_END); grid = -1; return; }
        int dev = 0, cus = 0, per_cu = 0;
        (void)hipGetDevice(&dev); (void)hipDeviceGetAttribute(&cus, hipDeviceAttributeMultiprocessorCount, dev);
        (void)hipFuncSetAttribute((const void*)k_mega, hipFuncAttributeMaxDynamicSharedMemorySize, LDS_BYTES);
        (void)hipOccupancyMaxActiveBlocksPerMultiprocessor(&per_cu, (const void*)k_mega, NTHREADS, LDS_BYTES);
        if (per_cu < 1) { fprintf(stderr, "kernel_launch: occupancy query says %d blocks per CU\n", per_cu); per_cu = 1; }
        grid = cus * 1;
        (void)hipGetLastError();
    }
    if (grid < 0) return;
    Params p{};
    for (int i = 0; i < 20; ++i) p.in[i] = (const float*)d_in[i];
    p.out = (float*)d_out; p.ws = (unsigned char*)d_ws;
    (void)hipMemsetAsync((char*)d_ws + WS_CTL, 0, 64 * 1024, stream);
#if ONE_LAUNCH
    void* args[] = {&p};
    hipError_t e = hipLaunchCooperativeKernel((const void*)k_mega, dim3(grid), dim3(NTHREADS), args, LDS_BYTES, stream);
    if (e != hipSuccess) fprintf(stderr, "cooperative launch failed: %s (grid %d)\n", hipGetErrorString(e), grid);
#else
    launch_phase<0>(p, grid, stream); launch_phase<1>(p, grid, stream); launch_phase<2>(p, grid, stream); launch_phase<3>(p, grid, stream); launch_phase<4>(p, grid, stream);
    launch_phase<5>(p, grid, stream); launch_phase<6>(p, grid, stream); launch_phase<7>(p, grid, stream); launch_phase<8>(p, grid, stream);
#endif
}
```

```cpp
#include <hip/hip_runtime.h>
#include <hip/hip_cooperative_groups.h>
#include <cstdio>
#include <cstdint>
namespace cg = cooperative_groups;

#ifndef ONE_LAUNCH
#define ONE_LAUNCH 1
#endif

#define LAS __attribute__((address_space(3)))
typedef unsigned short bf16_t;
typedef short bf16x8 __attribute__((ext_vector_type(8)));
typedef float f32x4 __attribute__((ext_vector_type(4)));
typedef float f32x2 __attribute__((ext_vector_type(2)));
typedef unsigned u32x4 __attribute__((ext_vector_type(4)));
typedef unsigned u32x2 __attribute__((ext_vector_type(2)));

constexpr int T = 8192, D = 2048, CW = 1024, SW = 1024, NIN = 9216, NE = 16, DE = 512;
constexpr float EPS = 1e-6f;
constexpr int NTHREADS = 512, NWAVES = 8;
constexpr int LDS_BYTES = 140 * 1024;
constexpr int HID_ROWS = 2 * T + NE * 256;

constexpr size_t MiB = 1024 * 1024;
constexpr size_t WS_CTL   = 0;
constexpr size_t WS_BAR   = 4096;
constexpr size_t WS_SMALL = 64 * 1024;
constexpr size_t SM_RSTD = 0, SM_ENT = 32 * 1024, SM_W = SM_ENT + (size_t)NE * T * 4, SM_VST = SM_W + (size_t)NE * T * 4, SM_END = SM_VST + (size_t)T * 16 * 8;
constexpr size_t WS_WR    = WS_SMALL + 4 * MiB;
constexpr size_t WS_WMB   = WS_WR + 256 * 1024;
constexpr size_t WS_WINT  = WS_WMB + 256 * 1024;
constexpr size_t WS_WUPT  = WS_WINT + (size_t)NIN * D * 2;
constexpr size_t WS_WOUTT = WS_WUPT + (size_t)D * D * 2;
constexpr size_t WS_W1T   = WS_WOUTT + (size_t)D * D * 2;
constexpr size_t WS_W2T   = WS_W1T + (size_t)NE * 1024 * D * 2;
constexpr size_t WS_X     = WS_W2T + (size_t)NE * D * DE * 2;
constexpr size_t WS_P     = WS_X + (size_t)T * D * 2;
constexpr size_t P_BC = 0, P_P = P_BC + (size_t)T * CW * 2, P_U = P_P + (size_t)T * CW * 2, P_V = P_U + (size_t)T * SW * 2,
                 P_R = P_V + (size_t)T * SW * 2, P_S = P_R + (size_t)T * D * 2, P_END = P_S + (size_t)T * D * 2;
constexpr size_t WS_END   = WS_P + P_END;
constexpr size_t WS_MM  = WS_WINT;
constexpr size_t WS_H   = WS_P + P_BC;
constexpr size_t WS_A2  = WS_P + P_R;
constexpr size_t WS_HID = WS_P + P_S;
constexpr size_t WS_YK0 = WS_X;
constexpr size_t WS_YK1 = WS_WINT;
static_assert(SM_END <= 4 * MiB, "small region");
static_assert((size_t)HID_ROWS * DE * 2 <= (size_t)T * D * 2, "hid overlay");
static_assert((size_t)T * D * 4 <= P_R, "H overlay");

struct Params { const float* in[20]; float* out; unsigned char* ws; };

__device__ __forceinline__ unsigned cvt_pk_bf16(float lo, float hi) { unsigned r; asm("v_cvt_pk_bf16_f32 %0, %1, %2" : "=v"(r) : "v"(lo), "v"(hi)); return r; }
__device__ __forceinline__ float bf_lo(unsigned w) { return __uint_as_float(w << 16); }
__device__ __forceinline__ float bf_hi(unsigned w) { return __uint_as_float(w & 0xffff0000u); }
__device__ __forceinline__ float bf1(bf16_t b) { return __uint_as_float(((unsigned)b) << 16); }
__device__ __forceinline__ float wave_sum(float v) {
#pragma unroll
    for (int o = 1; o < 64; o <<= 1) v += __shfl_xor(v, o);
    return v;
}
__device__ __forceinline__ float fast_rcp(float x) { return __builtin_amdgcn_rcpf(x); }
__device__ __forceinline__ float fast_exp2(float x) { return __builtin_amdgcn_exp2f(x); }
__device__ __forceinline__ float sigmoid_f(float x) { return fast_rcp(1.0f + fast_exp2(-1.44269504f * x)); }
__device__ __forceinline__ float gelu_tanh(float x) {
    const float u = x + 0.044715f * x * x * x;
    return x * fast_rcp(1.0f + fast_exp2(-2.30220819f * u));
}
__device__ __forceinline__ int opaque_tid() { int t = threadIdx.x; asm volatile("" : "+v"(t)); return t; }
__host__ __device__ __forceinline__ int perm32(int rho) { const int n = rho >> 4, i = rho & 15; return 8 * (i >> 2) + 4 * n + (i & 3); }

struct Unit { int pm, pn, e, row0, nvalid; };
constexpr int NXCD = 8, WGM = 8;
struct DenseSched {
    const bf16_t* A; const bf16_t* Bt; int K; int nM, nN, nwg, G, c;
    __device__ __forceinline__ void init(const bf16_t* A_, const bf16_t* Bt_, int M, int N, int K_) { A = A_; Bt = Bt_; K = K_; nM = M / 256; nN = N / 256; nwg = nM * nN; G = gridDim.x; c = blockIdx.x; }
    __device__ __forceinline__ bool next(int i, Unit& u) const {
        const long L = (long)i * G + c; if (L >= nwg) return false;
        int wgid = (int)L; { const int q = nwg / NXCD, r = nwg % NXCD, xcd = wgid % NXCD, off = wgid / NXCD; wgid = (xcd < r ? xcd * (q + 1) : r * (q + 1) + (xcd - r) * q) + off; }
        const int nig = WGM * nN, gid = wgid / nig, fm = gid * WGM, gsz = (nM - fm) < WGM ? (nM - fm) : WGM;
        u.pm = fm + ((wgid % nig) % gsz); u.pn = (wgid % nig) / gsz; u.e = 0; u.row0 = u.pm * 256; u.nvalid = 256; return true;
    }
    __device__ __forceinline__ const char* a_base() const { return (const char*)A; }
    __device__ __forceinline__ unsigned a_off(const Unit& u, int r) const { return (unsigned)(u.row0 + r) * (unsigned)K * 2u; }
    __device__ __forceinline__ const char* b_base(const Unit& u) const { return (const char*)Bt + (size_t)u.pn * 256 * K * 2; }
};
template <bool GATHER, int NPN, int KK, int NROWS_E  >
struct MoeSched {
    const bf16_t* A; const bf16_t* Bt; const int* cnt; const int* ent; int G, c;
    __device__ __forceinline__ bool next(int i, Unit& u) const {
        int L = i * G + c; int hb = 0;
        for (int e = 0; e < NE; ++e) {
            const int n = __builtin_amdgcn_readfirstlane(cnt[e]); const int nt = (n + 255) >> 8;
            if (L < nt * NPN) { u.e = e; u.pm = L / NPN; u.pn = L % NPN; u.row0 = hb + u.pm * 256; u.nvalid = min(256, n - u.pm * 256); return true; }
            L -= nt * NPN; hb += nt * 256;
        }
        return false;
    }
    __device__ __forceinline__ const char* a_base() const { return (const char*)A; }
    __device__ __forceinline__ unsigned a_off(const Unit& u, int r) const {
        if (GATHER) { const int tok = (r < u.nvalid) ? (ent[u.e * T + u.pm * 256 + r] & 0xffff) : 0; return (unsigned)tok * (unsigned)KK * 2u; }
        return (unsigned)(u.row0 + r) * (unsigned)KK * 2u;
    }
    __device__ __forceinline__ const char* b_base(const Unit& u) const { return (const char*)Bt + ((size_t)u.e * NROWS_E + (size_t)u.pn * 256) * KK * 2; }
};

typedef f32x4 Acc[2][2][4][2];
__device__ __forceinline__ u32x4 pack8(f32x4 a, f32x4 b) { u32x4 w; w.x = cvt_pk_bf16(a[0], a[1]); w.y = cvt_pk_bf16(a[2], a[3]); w.z = cvt_pk_bf16(b[0], b[1]); w.w = cvt_pk_bf16(b[2], b[3]); return w; }
__device__ __forceinline__ void unpack8(u32x4 w, f32x4& a, f32x4& b) { a = (f32x4){bf_lo(w.x), bf_hi(w.x), bf_lo(w.y), bf_hi(w.y)}; b = (f32x4){bf_lo(w.z), bf_hi(w.z), bf_lo(w.w), bf_hi(w.w)}; }

struct EpiProj {
    static constexpr bool PERM = true; static constexpr int MIDK = 0;
    bf16_t *Bc, *P, *U, *V, *R, *S; f32x2* VST;
    __device__ __forceinline__ void mid(Acc&, const Unit&, int, int, int, int) const {}
    __device__ __forceinline__ void operator()(const Acc& acc, const Unit& u, int wr, int wc, int fr, int fq) const {
        const int pn = u.pn; const int rowb = u.row0 + wr * 64 + fr; const int cl = wc * 32 + 8 * fq;
#pragma unroll
        for (int ai = 0; ai < 2; ++ai)
#pragma unroll
            for (int m = 0; m < 4; ++m) {
                const size_t row = (size_t)(rowb + ai * 128 + m * 16);
                if (pn < 4) {
#pragma unroll
                    for (int bj = 0; bj < 2; ++bj) *(u32x4*)(Bc + row * CW + pn * 256 + bj * 128 + cl) = pack8(acc[ai][bj][m][0], acc[ai][bj][m][1]);
                } else if (pn < 12) {
                    *(u32x4*)(P + row * CW + (pn - 4) * 128 + cl) = pack8(acc[ai][0][m][0] * acc[ai][1][m][0], acc[ai][0][m][1] * acc[ai][1][m][1]);
                } else if (pn < 20) {
                    bf16_t* O = (pn < 16) ? (U + row * SW + (pn - 12) * 256) : (V + row * SW + (pn - 16) * 256);
                    float ssum = 0.f, ssq = 0.f;
#pragma unroll
                    for (int bj = 0; bj < 2; ++bj) { f32x4 a = acc[ai][bj][m][0], b = acc[ai][bj][m][1];
#pragma unroll
                        for (int j = 0; j < 4; ++j) { a[j] = gelu_tanh(a[j]); b[j] = gelu_tanh(b[j]); ssum += a[j] + b[j]; ssq += a[j] * a[j] + b[j] * b[j]; }
                        *(u32x4*)(O + bj * 128 + cl) = pack8(a, b); }
                    if (pn >= 16) {
                        ssum += __shfl_xor(ssum, 16); ssum += __shfl_xor(ssum, 32); ssq += __shfl_xor(ssq, 16); ssq += __shfl_xor(ssq, 32);
                        if (fq == 0) VST[row * 16 + (pn - 16) * 4 + wc] = (f32x2){ssum, ssq}; }
                } else {
                    f32x4 r0, r1, s0, s1;
#pragma unroll
                    for (int j = 0; j < 4; ++j) {
                        const float ec0 = fast_exp2(-1.44269504f * acc[ai][0][m][0][j]), es0 = fast_exp2(-1.44269504f * acc[ai][1][m][0][j]);
                        const float ec1 = fast_exp2(-1.44269504f * acc[ai][0][m][1][j]), es1 = fast_exp2(-1.44269504f * acc[ai][1][m][1][j]);
                        r0[j] = (1.0f + es0) * fast_rcp(1.0f + ec0); s0[j] = fast_rcp(1.0f + es0);
                        r1[j] = (1.0f + es1) * fast_rcp(1.0f + ec1); s1[j] = fast_rcp(1.0f + es1);
                    }
                    const size_t o = row * D + (pn - 20) * 128 + cl;
                    *(u32x4*)(R + o) = pack8(r0, r1); *(u32x4*)(S + o) = pack8(s0, s1);
                }
            }
    }
};
struct EpiUp {
    static constexpr bool PERM = true; static constexpr int MIDK = 1024;
    const bf16_t *R, *S; bf16_t* Mm;
    __device__ __forceinline__ void mid(Acc& acc, const Unit& u, int wr, int wc, int fr, int fq) const {
        int rowb = u.row0 + wr * 64 + fr; const int cb = u.pn * 256 + wc * 32 + 8 * fq;
        asm volatile("" : "+v"(rowb));
#pragma unroll
        for (int ai = 0; ai < 2; ++ai)
#pragma unroll
            for (int m = 0; m < 4; ++m)
#pragma unroll
                for (int bj = 0; bj < 2; ++bj) { f32x4 a, b; unpack8(*(const u32x4*)(R + (size_t)(rowb + ai * 128 + m * 16) * D + cb + bj * 128), a, b);
                    acc[ai][bj][m][0] *= a; acc[ai][bj][m][1] *= b; }
    }
    __device__ __forceinline__ void operator()(const Acc& acc, const Unit& u, int wr, int wc, int fr, int fq) const {
        const int rowb = u.row0 + wr * 64 + fr; const int cb = u.pn * 256 + wc * 32 + 8 * fq;
#pragma unroll
        for (int ai = 0; ai < 2; ++ai)
#pragma unroll
            for (int m = 0; m < 4; ++m)
#pragma unroll
                for (int bj = 0; bj < 2; ++bj) { const size_t o = (size_t)(rowb + ai * 128 + m * 16) * D + cb + bj * 128; f32x4 a, b; unpack8(*(const u32x4*)(S + o), a, b);
                    *(u32x4*)(Mm + o) = pack8(acc[ai][bj][m][0] * a, acc[ai][bj][m][1] * b); }
    }
};
struct EpiOut {
    static constexpr bool PERM = true; static constexpr int MIDK = 0;
    const float* x; bf16_t* A2;
    __device__ __forceinline__ void mid(Acc&, const Unit&, int, int, int, int) const {}
    __device__ __forceinline__ void operator()(const Acc& acc, const Unit& u, int wr, int wc, int fr, int fq) const {
        const int rowb = u.row0 + wr * 64 + fr; const int cb = u.pn * 256 + wc * 32 + 8 * fq;
#pragma unroll
        for (int ai = 0; ai < 2; ++ai)
#pragma unroll
            for (int m = 0; m < 4; ++m)
#pragma unroll
                for (int bj = 0; bj < 2; ++bj) { const size_t o = (size_t)(rowb + ai * 128 + m * 16) * D + cb + bj * 128;
                    const f32x4 h0 = *(const f32x4*)(x + o) + acc[ai][bj][m][0], h1 = *(const f32x4*)(x + o + 4) + acc[ai][bj][m][1];
                    *(u32x4*)(A2 + o) = pack8(h0, h1); }
    }
};
struct EpiMoe1 {
    static constexpr bool PERM = true; static constexpr int MIDK = 0;
    const int* ent; const float* lw; const float* rstd; bf16_t* Hid;
    __device__ __forceinline__ void mid(Acc&, const Unit&, int, int, int, int) const {}
    __device__ __forceinline__ void operator()(const Acc& acc, const Unit& u, int wr, int wc, int fr, int fq) const {
        const int cl = u.pn * 128 + wc * 32 + 8 * fq;
#pragma unroll
        for (int ai = 0; ai < 2; ++ai)
#pragma unroll
            for (int m = 0; m < 4; ++m) {
                const int r = ai * 128 + wr * 64 + m * 16 + fr;
                if (r < u.nvalid) {
                    const int li = u.e * T + u.pm * 256 + r; const int tok = ent[li] & 0xffff; const float rs = rstd[tok], w = lw[li];
                    f32x4 o[2];
#pragma unroll
                    for (int n = 0; n < 2; ++n)
#pragma unroll
                        for (int j = 0; j < 4; ++j) { const float gt = acc[ai][0][m][n][j] * rs, up = acc[ai][1][m][n][j] * rs; o[n][j] = gt * sigmoid_f(gt) * up * w; }
                    *(u32x4*)(Hid + (size_t)(u.row0 + r) * DE + cl) = pack8(o[0], o[1]);
                }
            }
    }
};
struct EpiMoe2 {
    static constexpr bool PERM = true; static constexpr int MIDK = 0;
    const int* ent; bf16_t* Yk0; bf16_t* Yk1;
    __device__ __forceinline__ void mid(Acc&, const Unit&, int, int, int, int) const {}
    __device__ __forceinline__ void operator()(const Acc& acc, const Unit& u, int wr, int wc, int fr, int fq) const {
        const int cb = u.pn * 256 + wc * 32 + 8 * fq;
#pragma unroll
        for (int ai = 0; ai < 2; ++ai)
#pragma unroll
            for (int m = 0; m < 4; ++m) {
                const int r = ai * 128 + wr * 64 + m * 16 + fr;
                if (r < u.nvalid) {
                    const int en = ent[u.e * T + u.pm * 256 + r]; const int tok = en & 0xffff; bf16_t* Y = (en >> 16) ? Yk1 : Yk0;
#pragma unroll
                    for (int bj = 0; bj < 2; ++bj) *(u32x4*)(Y + (size_t)tok * D + cb + bj * 128) = pack8(acc[ai][bj][m][0], acc[ai][bj][m][1]);
                }
            }
    }
};

template <class Epi, class Sched>
__device__ __forceinline__ void gemm_simple(const Sched& S, const Epi& E, const int K) {
    const int tid = opaque_tid(), wid = __builtin_amdgcn_readfirstlane(tid >> 6), lane = tid & 63, wr = wid >> 2, wc = wid & 3, fr = lane & 15, fq = lane >> 4;
    Unit u;
    for (int ui = 0; S.next(ui, u); ++ui) {
        Acc acc;
#pragma unroll
        for (int a = 0; a < 2; ++a)
#pragma unroll
            for (int b = 0; b < 2; ++b)
#pragma unroll
                for (int m = 0; m < 4; ++m)
#pragma unroll
                    for (int n = 0; n < 2; ++n) acc[a][b][m][n] = (f32x4){0.f, 0.f, 0.f, 0.f};
        const char* ab = S.a_base(); const char* bb = S.b_base(u);
        unsigned aoff[2][4], boff[2][2];
#pragma unroll
        for (int ai = 0; ai < 2; ++ai)
#pragma unroll
            for (int m = 0; m < 4; ++m) aoff[ai][m] = S.a_off(u, ai * 128 + wr * 64 + m * 16 + fr) + fq * 16;
#pragma unroll
        for (int bj = 0; bj < 2; ++bj)
#pragma unroll
            for (int n = 0; n < 2; ++n) { const int rr = Epi::PERM ? perm32(n * 16 + fr) : (n * 16 + fr); boff[bj][n] = (unsigned)(bj * 128 + wc * 32 + rr) * (unsigned)K * 2u + fq * 16; }
        for (int k0 = 0; k0 < K; k0 += 32) {
            if (Epi::MIDK != 0 && k0 == Epi::MIDK) E.mid(acc, u, wr, wc, fr, fq);
            bf16x8 a[2][4], b[2][2];
#pragma unroll
            for (int ai = 0; ai < 2; ++ai)
#pragma unroll
                for (int m = 0; m < 4; ++m) a[ai][m] = *(const bf16x8*)(ab + aoff[ai][m] + k0 * 2);
#pragma unroll
            for (int bj = 0; bj < 2; ++bj)
#pragma unroll
                for (int n = 0; n < 2; ++n) b[bj][n] = *(const bf16x8*)(bb + boff[bj][n] + k0 * 2);
#pragma unroll
            for (int ai = 0; ai < 2; ++ai)
#pragma unroll
                for (int bj = 0; bj < 2; ++bj)
#pragma unroll
                    for (int m = 0; m < 4; ++m)
#pragma unroll
                        for (int n = 0; n < 2; ++n) acc[ai][bj][m][n] = __builtin_amdgcn_mfma_f32_16x16x32_bf16(b[bj][n], a[ai][m], acc[ai][bj][m][n], 0, 0, 0);
        }
        E(acc, u, wr, wc, fr, fq);
    }
}

constexpr int BK = 64, HALF = 128, HTB = HALF * BK * 2, STAGE_BYTES = 8 * HTB;
__host__ __device__ __forceinline__ int lds_byte(int r, int c) { const int st = (r >> 4) * 2 + (c >> 5), rr = r & 15, cc = c & 31, ob = rr * 64 + cc * 2; return st * 1024 + (ob ^ (((ob >> 9) & 1) << 5)); }
__host__ __device__ __forceinline__ void stage_rc(int b, int& R, int& C) { const int st = b / 1024, sb = b % 1024, swz = sb ^ (((sb >> 9) & 1) << 5); R = (st >> 1) * 16 + swz / 64; C = (st & 1) * 32 + (swz % 64) / 2; }

template <class Epi, class Sched>
__device__ __forceinline__ void gemm_fast(LAS unsigned char* lds, const Sched& S, const Epi& E, const int K) {
    const int tid = opaque_tid(), wid = __builtin_amdgcn_readfirstlane(tid >> 6), lane = tid & 63, wr = wid >> 2, wc = wid & 3, fr = lane & 15, fq = lane >> 4;
    const int nt = K / BK;
    int sR[2], sC[2]; unsigned voffB[2];
#pragma unroll
    for (int i = 0; i < 2; ++i) { stage_rc(tid * 16 + i * 8192, sR[i], sC[i]); const int Rb = Epi::PERM ? ((sR[i] & ~31) + perm32(sR[i] & 31)) : sR[i]; voffB[i] = (unsigned)(Rb * K + sC[i]) * 2u; }
    const size_t kstep = (size_t)(BK * 2);
    const size_t hstepB = (size_t)HALF * K * 2;
    const unsigned ldsw = (unsigned)wid * 1024u;
    const int aoff = lds_byte(wr * 64 + fr, fq * 8), boff = lds_byte(wc * 32 + fr, fq * 8);
#define PG8_SA(b, h) (((b) * 2 + (h)) * HTB)
#define PG8_SB(b, h) ((4 + (b) * 2 + (h)) * HTB)
#define PG8_STAGE(bufoff, gbase, voff) do { _Pragma("unroll") for (int _i = 0; _i < 2; ++_i) \
        __builtin_amdgcn_global_load_lds((const unsigned*)((const char*)(gbase) + (voff)[_i]), (LAS unsigned*)(lds + (bufoff) + ldsw + _i * 8192), 16, 0, 0); } while (0)
#define PG8_LDA(dst, b, h) do { _Pragma("unroll") for (int m = 0; m < 4; ++m) _Pragma("unroll") for (int k = 0; k < 2; ++k) dst[m][k] = *(const LAS bf16x8*)(lds + PG8_SA(b, h) + aoff + m * 2048 + k * 1024); } while (0)
#define PG8_LDB(dst, b, h) do { _Pragma("unroll") for (int n = 0; n < 2; ++n) _Pragma("unroll") for (int k = 0; k < 2; ++k) dst[n][k] = *(const LAS bf16x8*)(lds + PG8_SB(b, h) + boff + n * 2048 + k * 1024); } while (0)
#define PG8_MMA(ai, bj, At, Bt) do { __builtin_amdgcn_s_setprio(1); _Pragma("unroll") for (int m = 0; m < 4; ++m) _Pragma("unroll") for (int n = 0; n < 2; ++n) _Pragma("unroll") for (int k = 0; k < 2; ++k) \
        acc[ai][bj][m][n] = __builtin_amdgcn_mfma_f32_16x16x32_bf16(Bt[n][k], At[m][k], acc[ai][bj][m][n], 0, 0, 0); __builtin_amdgcn_s_setprio(0); } while (0)
#define PG8_WAIT_V(n) asm volatile("s_waitcnt vmcnt(" #n ")" ::: "memory")
#define PG8_WAIT_L(n) asm volatile("s_waitcnt lgkmcnt(" #n ")" ::: "memory")
#define PG8_BAR __builtin_amdgcn_s_barrier()
#define PG8_SCHED __builtin_amdgcn_sched_barrier(0)
    Unit cur, nxt; int ui = 0;
    if (!S.next(0, cur)) return;
    Acc acc;
#pragma unroll
    for (int a = 0; a < 2; ++a)
#pragma unroll
        for (int b = 0; b < 2; ++b)
#pragma unroll
            for (int m = 0; m < 4; ++m)
#pragma unroll
                for (int n = 0; n < 2; ++n) acc[a][b][m][n] = (f32x4){0.f, 0.f, 0.f, 0.f};
    bf16x8 At[4][2], B0[2][2], B1[2][2];
    unsigned va[2][2], vn[2][2];
#pragma unroll
    for (int h = 0; h < 2; ++h)
#pragma unroll
        for (int i = 0; i < 2; ++i) va[h][i] = S.a_off(cur, h * 128 + sR[i]) + (unsigned)sC[i] * 2u;
    const char* const A0 = S.a_base(); const char* cB = S.b_base(cur);
    PG8_STAGE(PG8_SB(0, 0), cB, voffB); PG8_STAGE(PG8_SB(0, 1), cB + hstepB, voffB); PG8_STAGE(PG8_SA(0, 0), A0, va[0]); PG8_STAGE(PG8_SA(0, 1), A0, va[1]);
    if (wr == 1) PG8_BAR;
    PG8_WAIT_V(2); PG8_BAR;
    PG8_STAGE(PG8_SB(1, 0), cB + kstep, voffB); PG8_STAGE(PG8_SA(1, 0), A0 + kstep, va[0]); PG8_STAGE(PG8_SB(1, 1), cB + hstepB + kstep, voffB);
    PG8_WAIT_V(6); PG8_BAR;
    for (;;) {
        const bool has_next = S.next(ui + 1, nxt);
        const char* nB = has_next ? S.b_base(nxt) : cB;
#pragma unroll
        for (int h = 0; h < 2; ++h)
#pragma unroll
            for (int i = 0; i < 2; ++i) vn[h][i] = has_next ? (S.a_off(nxt, h * 128 + sR[i]) + (unsigned)sC[i] * 2u) : va[h][i];
        for (int t = 0; t < nt; t += 2) {
            const bool last = (t == nt - 2);
            if (Epi::MIDK != 0 && t * BK == Epi::MIDK) { PG8_SCHED; E.mid(acc, cur, wr, wc, fr, fq); PG8_SCHED; }
            const char* a1 = A0 + (size_t)(t + 1) * kstep;
            const char* a2 = last ? A0 : A0 + (size_t)(t + 2) * kstep; const char* b2 = last ? nB : cB + (size_t)(t + 2) * kstep;
            const char* a3 = a2 + kstep; const char* b3 = b2 + kstep;
            unsigned v2[2][2];
#pragma unroll
            for (int h = 0; h < 2; ++h)
#pragma unroll
                for (int i = 0; i < 2; ++i) v2[h][i] = last ? vn[h][i] : va[h][i];
            PG8_LDB(B0, 0, 0); PG8_LDB(B1, 0, 1); PG8_SCHED; PG8_LDA(At, 0, 0); PG8_STAGE(PG8_SA(1, 1), a1, va[1]);
            PG8_WAIT_V(8); PG8_WAIT_L(0); PG8_BAR; PG8_MMA(0, 0, At, B0); PG8_MMA(0, 1, At, B1); PG8_BAR; PG8_SCHED;
            PG8_LDA(At, 0, 1); PG8_STAGE(PG8_SB(0, 0), b2, voffB); PG8_STAGE(PG8_SB(0, 1), b2 + hstepB, voffB); PG8_STAGE(PG8_SA(0, 0), a2, v2[0]);
            PG8_WAIT_V(8); PG8_WAIT_L(0); PG8_BAR; PG8_MMA(1, 0, At, B0); PG8_MMA(1, 1, At, B1); PG8_BAR; PG8_SCHED;
            PG8_LDB(B0, 1, 0); PG8_LDB(B1, 1, 1); PG8_SCHED; PG8_LDA(At, 1, 0); PG8_STAGE(PG8_SA(0, 1), a2, v2[1]);
            PG8_WAIT_V(8); PG8_WAIT_L(0); PG8_BAR; PG8_MMA(0, 0, At, B0); PG8_MMA(0, 1, At, B1); PG8_BAR; PG8_SCHED;
            PG8_LDA(At, 1, 1); PG8_STAGE(PG8_SB(1, 0), b3, voffB); PG8_STAGE(PG8_SB(1, 1), b3 + hstepB, voffB); PG8_STAGE(PG8_SA(1, 0), a3, v2[0]);
            PG8_WAIT_V(8); PG8_WAIT_L(0); PG8_BAR; PG8_MMA(1, 0, At, B0); PG8_MMA(1, 1, At, B1); PG8_BAR; PG8_SCHED;
        }
        if (wr == 0) PG8_BAR;
        E(acc, cur, wr, wc, fr, fq);
        if (!has_next) break;
#pragma unroll
        for (int a = 0; a < 2; ++a)
#pragma unroll
            for (int b = 0; b < 2; ++b)
#pragma unroll
                for (int m = 0; m < 4; ++m)
#pragma unroll
                    for (int n = 0; n < 2; ++n) acc[a][b][m][n] = (f32x4){0.f, 0.f, 0.f, 0.f};
        cur = nxt; cB = nB; ++ui;
#pragma unroll
        for (int h = 0; h < 2; ++h)
#pragma unroll
            for (int i = 0; i < 2; ++i) va[h][i] = vn[h][i];
        if (wr == 1) PG8_BAR;
    }
    PG8_WAIT_V(0);
    PG8_BAR;
#undef PG8_SA
#undef PG8_SB
#undef PG8_STAGE
#undef PG8_LDA
#undef PG8_LDB
#undef PG8_MMA
#undef PG8_WAIT_V
#undef PG8_WAIT_L
#undef PG8_BAR
#undef PG8_SCHED
}
#ifndef FAST_MASK
#define FAST_MASK 0x1f
#endif
template <int BIT, class Epi, class Sched>
__device__ __forceinline__ void gemm_run(LAS unsigned char* lds, const Sched& S, const Epi& E, const int K) {
    if constexpr ((FAST_MASK >> BIT) & 1) gemm_fast(lds, S, E, K); else gemm_simple(S, E, K);
}

__device__ __forceinline__ void tr_item64(const float* W, int N, int k0, int ns, bf16_t* WT, int ldk, int nd, int kd, LAS float* scr, int lane, const float* kscale) {
    { const int r4 = lane >> 4, c4 = (lane & 15) * 4; f32x4 v[16];
#pragma unroll
      for (int i = 0; i < 16; ++i) v[i] = *(const f32x4*)(W + (size_t)(k0 + 4 * i + r4) * N + ns + c4);
#pragma unroll
      for (int i = 0; i < 16; ++i) { LAS float* d = scr + (4 * i + r4) * 65 + c4; d[0] = v[i][0]; d[1] = v[i][1]; d[2] = v[i][2]; d[3] = v[i][3]; } }
    const int c = lane & 7;
    f32x4 s0 = (f32x4){1.f, 1.f, 1.f, 1.f}, s1 = s0;
    if (kscale) { s0 = *(const f32x4*)(kscale + k0 + 8 * c); s1 = *(const f32x4*)(kscale + k0 + 8 * c + 4); }
    asm volatile("s_waitcnt lgkmcnt(0)" ::: "memory");
#pragma unroll
    for (int j = 0; j < 8; ++j) { const int n = (lane >> 3) + 8 * j; const LAS float* s = scr + (8 * c) * 65 + n;
        u32x4 o; o.x = cvt_pk_bf16(s[0 * 65] * s0[0], s[1 * 65] * s0[1]); o.y = cvt_pk_bf16(s[2 * 65] * s0[2], s[3 * 65] * s0[3]);
        o.z = cvt_pk_bf16(s[4 * 65] * s1[0], s[5 * 65] * s1[1]); o.w = cvt_pk_bf16(s[6 * 65] * s1[2], s[7 * 65] * s1[3]);
        *(u32x4*)(WT + (size_t)(nd + n) * ldk + kd + 8 * c) = o; }
    asm volatile("s_waitcnt lgkmcnt(0)" ::: "memory");
}
constexpr int TRS = 64 * 65 * 4;
static_assert(8 * TRS <= LDS_BYTES - 64, "transpose scratch vs barrier words");
struct TrItem { const float* W; int N; bf16_t* WT; int ldk, nd, kd, k0, ns; const float* ks; };
__device__ __forceinline__ void tr_load(f32x4 (&v)[16], const TrItem& it, int lane) {
    const int r4 = lane >> 4, c4 = (lane & 15) * 4;
#pragma unroll
    for (int i = 0; i < 16; ++i) v[i] = *(const f32x4*)(it.W + (size_t)(it.k0 + 4 * i + r4) * it.N + it.ns + c4);
}
__device__ __forceinline__ void tr_store(const f32x4 (&v)[16], const TrItem& it, LAS float* scr, int lane) {
    { const int r4 = lane >> 4, c4 = (lane & 15) * 4;
#pragma unroll
      for (int i = 0; i < 16; ++i) { LAS float* d = scr + (4 * i + r4) * 65 + c4; d[0] = v[i][0]; d[1] = v[i][1]; d[2] = v[i][2]; d[3] = v[i][3]; } }
    const int c = lane & 7;
    f32x4 s0 = (f32x4){1.f, 1.f, 1.f, 1.f}, s1 = s0;
    if (it.ks) { s0 = *(const f32x4*)(it.ks + it.k0 + 8 * c); s1 = *(const f32x4*)(it.ks + it.k0 + 8 * c + 4); }
    asm volatile("s_waitcnt lgkmcnt(0)" ::: "memory");
#pragma unroll
    for (int j = 0; j < 8; ++j) { const int n = (lane >> 3) + 8 * j; const LAS float* s = scr + (8 * c) * 65 + n;
        u32x4 o; o.x = cvt_pk_bf16(s[0 * 65] * s0[0], s[1 * 65] * s0[1]); o.y = cvt_pk_bf16(s[2 * 65] * s0[2], s[3 * 65] * s0[3]);
        o.z = cvt_pk_bf16(s[4 * 65] * s1[0], s[5 * 65] * s1[1]); o.w = cvt_pk_bf16(s[6 * 65] * s1[2], s[7 * 65] * s1[3]);
        *(u32x4*)(it.WT + (size_t)(it.nd + n) * it.ldk + it.kd + 8 * c) = o; }
    asm volatile("s_waitcnt lgkmcnt(0)" ::: "memory");
}
constexpr int NIT_EXP = 8192 + 4096;
__device__ __forceinline__ TrItem exp_item(const Params& p, int r) {
    TrItem it;
    if (r < 8192) { const int up = r >> 12, qq = r & 4095, e = qq >> 8, kb = (qq & 255) >> 3, nb = qq & 7;
        it.W = p.in[up ? 17 : 16] + (size_t)e * D * DE; it.N = DE; it.WT = (bf16_t*)(p.ws + WS_W1T) + (size_t)e * 1024 * D; it.ldk = D;
        it.nd = 256 * (nb >> 1) + (nb & 1) * 64 + (up ? 128 : 0); it.kd = kb * 64; it.k0 = kb * 64; it.ns = nb * 64; it.ks = p.in[11]; }
    else { const int q = r - 8192, e = q >> 8, kb = (q & 255) >> 5, nb = q & 31;
        it.W = p.in[18] + (size_t)e * DE * D; it.N = D; it.WT = (bf16_t*)(p.ws + WS_W2T) + (size_t)e * D * DE; it.ldk = DE; it.nd = nb * 64; it.kd = kb * 64; it.k0 = kb * 64; it.ns = nb * 64; it.ks = nullptr; }
    return it;
}
__device__ __forceinline__ void convert_tail(const Params& p, LAS unsigned char* lds, int nunits) {
    const int tid = opaque_tid(), wave = __builtin_amdgcn_readfirstlane(tid >> 6), lane = tid & 63;
    const int G = gridDim.x, rounds = (nunits + G - 1) / G, nfull = nunits - (rounds - 1) * G;
    int idle_idx, n_idle;
    if (nfull >= G || nunits == 0) { idle_idx = blockIdx.x; n_idle = G; } else { idle_idx = (int)blockIdx.x - nfull; n_idle = G - nfull; }
    if (idle_idx < 0) return;
    LAS float* scr = (LAS float*)(lds + wave * TRS);
    const int stride = n_idle * NWAVES; int r = idle_idx * NWAVES + wave;
    if (r >= NIT_EXP) return;
    f32x4 va[16], vb[16];
    TrItem ia = exp_item(p, r), ib = ia;
    tr_load(va, ia, lane);
    for (;;) {
        const bool hb = (r + stride) < NIT_EXP;
        if (hb) { ib = exp_item(p, r + stride); tr_load(vb, ib, lane); }
        tr_store(va, ia, scr, lane);
        if (!hb) break;
        r += stride;
        const bool ha = (r + stride) < NIT_EXP;
        if (ha) { ia = exp_item(p, r + stride); tr_load(va, ia, lane); }
        tr_store(vb, ib, scr, lane);
        if (!ha) break;
        r += stride;
    }
}
__device__ __forceinline__ int win_src_col(int nd) {
    if (nd < 1024) return nd;
    if (nd < 3072) { const int q = (nd - 1024) >> 8, r = (nd - 1024) & 255; return r < 128 ? (1024 + 128 * q + r) : (2048 + 128 * q + r - 128); }
    if (nd < 5120) return nd;
    { const int q = (nd - 5120) >> 8, r = (nd - 5120) & 255; return r < 128 ? (5120 + 128 * q + r) : (7168 + 128 * q + r - 128); }
}
__device__ __forceinline__ void phase0(const Params& p, LAS unsigned char* lds) {
    const int tid = opaque_tid(), wave = __builtin_amdgcn_readfirstlane(tid >> 6), lane = tid & 63;
    LAS float* scr = (LAS float*)(lds + wave * TRS);
    const int gw = blockIdx.x * NWAVES + wave, NGW = gridDim.x * NWAVES;
    unsigned char* ws = p.ws;
    constexpr int I_IN = 32 * 144, I_UP = 16 * 32, I_OUT = 32 * 32;
    constexpr int NITEMS = I_IN + 2 * I_UP + I_OUT;
    for (int it = gw; it < NITEMS; it += NGW) {
        int r = it;
        if (r < I_IN) { const int kb = r / 144, nb = r % 144; tr_item64(p.in[2], NIN, kb * 64, win_src_col(nb * 64), (bf16_t*)(ws + WS_WINT), D, nb * 64, kb * 64, scr, lane, nullptr); continue; } r -= I_IN;
        if (r < I_UP) { const int kb = r / 32, nb = r % 32; tr_item64(p.in[8], D, kb * 64, nb * 64, (bf16_t*)(ws + WS_WUPT), 2048, nb * 64, kb * 64, scr, lane, nullptr); continue; } r -= I_UP;
        if (r < I_UP) { const int kb = r / 32, nb = r % 32; tr_item64(p.in[9], D, kb * 64, nb * 64, (bf16_t*)(ws + WS_WUPT), 2048, nb * 64, 1024 + kb * 64, scr, lane, nullptr); continue; } r -= I_UP;
        { const int kb = r / 32, nb = r % 32; tr_item64(p.in[10], D, kb * 64, nb * 64, (bf16_t*)(ws + WS_WOUTT), D, nb * 64, kb * 64, scr, lane, nullptr); }
    }
    const float* x = p.in[0]; const float* g = p.in[1]; bf16_t* xn = (bf16_t*)(ws + WS_X);
    for (int m = gw; m < T; m += NGW) {
        const f32x4* xr = (const f32x4*)(x + (size_t)m * D) + lane; f32x4 v[8]; float s = 0.f;
#pragma unroll
        for (int j = 0; j < 8; ++j) { v[j] = xr[64 * j]; s += (v[j][0] * v[j][0] + v[j][1] * v[j][1]) + (v[j][2] * v[j][2] + v[j][3] * v[j][3]); }
        const float rs = 1.0f / sqrtf(wave_sum(s) * (1.0f / D) + EPS);
        u32x2* o = (u32x2*)(xn + (size_t)m * D) + lane;
#pragma unroll
        for (int j = 0; j < 8; ++j) { const f32x4 gg = *((const f32x4*)g + lane + 64 * j); u32x2 w; w.x = cvt_pk_bf16(v[j][0] * rs * gg[0], v[j][1] * rs * gg[1]); w.y = cvt_pk_bf16(v[j][2] * rs * gg[2], v[j][3] * rs * gg[3]); o[64 * j] = w; }
    }
    { bf16_t* wr = (bf16_t*)(ws + WS_WR); const float* gf = p.in[11];
      for (int i = blockIdx.x * NTHREADS + tid; i < 32 * D; i += gridDim.x * NTHREADS) { const int j = i / D, d = i % D; unsigned hi = 0, lo = 0;
          if (j < 20) { const float v = gf[d] * (j < 4 ? p.in[12][d * 4 + j] : p.in[14][d * 16 + (j - 4)]); hi = cvt_pk_bf16(v, 0.f) & 0xffffu; lo = cvt_pk_bf16(v - __uint_as_float(hi << 16), 0.f) & 0xffffu; }
          wr[(size_t)j * D + d] = (bf16_t)hi; wr[(size_t)(32 + j) * D + d] = (bf16_t)lo; } }
    { bf16_t* wmb = (bf16_t*)(ws + WS_WMB); const float* wsrc = p.in[6];
      for (int i = blockIdx.x * NTHREADS + tid; i < 8 * 128 * 128 / 2; i += gridDim.x * NTHREADS) { const int e0 = 2 * i, r = (e0 >> 7) & 127, c = e0 & 127; const bool ok = (r >= 64) || (c < 64);
          ((unsigned*)wmb)[i] = ok ? cvt_pk_bf16(wsrc[e0], wsrc[e0 + 1]) : 0u; } }
    if (blockIdx.x == 0 && tid < 64) ((int*)(ws + WS_CTL))[tid] = 0;
}

__device__ __forceinline__ void phase2_conv(const Params& p) {
    const bf16_t* Bc = (const bf16_t*)(p.ws + WS_P + P_BC); const bf16_t* P = (const bf16_t*)(p.ws + WS_P + P_P); bf16_t* Y = (bf16_t*)(p.ws + WS_X);
    const float* cw = p.in[3];
    for (int i = blockIdx.x * NTHREADS + opaque_tid(); i < T * (CW / 8); i += gridDim.x * NTHREADS) {
        const int t = i >> 7, c = (i & 127) * 8;
        f32x4 p0a, p0b, p1a, p1b, p2a, p2b, ba, bb;
        unpack8(*(const u32x4*)(P + (size_t)t * CW + c), p2a, p2b); unpack8(*(const u32x4*)(Bc + (size_t)t * CW + c), ba, bb);
        if (t >= 1) unpack8(*(const u32x4*)(P + (size_t)(t - 1) * CW + c), p1a, p1b); else { p1a = (f32x4){0, 0, 0, 0}; p1b = p1a; }
        if (t >= 2) unpack8(*(const u32x4*)(P + (size_t)(t - 2) * CW + c), p0a, p0b); else { p0a = (f32x4){0, 0, 0, 0}; p0b = p0a; }
        const f32x4 w0a = *(const f32x4*)(cw + c), w0b = *(const f32x4*)(cw + c + 4), w1a = *(const f32x4*)(cw + CW + c), w1b = *(const f32x4*)(cw + CW + c + 4),
                    w2a = *(const f32x4*)(cw + 2 * CW + c), w2b = *(const f32x4*)(cw + 2 * CW + c + 4);
        const f32x4 ya = ba * (w0a * p0a + w1a * p1a + w2a * p2a), yb = bb * (w0b * p0b + w1b * p1b + w2b * p2b);
        *(u32x4*)(Y + (size_t)t * 2048 + c) = pack8(ya, yb);
    }
}
__device__ __forceinline__ void phase2_sgu(const Params& p, LAS unsigned char* lds) {
    const int tid = opaque_tid(), wave = __builtin_amdgcn_readfirstlane(tid >> 6), lane = tid & 63, fr = lane & 15, fq = lane >> 4;
    const bf16_t* U = (const bf16_t*)(p.ws + WS_P + P_U); const bf16_t* V = (const bf16_t*)(p.ws + WS_P + P_V); bf16_t* Y = (bf16_t*)(p.ws + WS_X);
    const bf16_t* WmB = (const bf16_t*)(p.ws + WS_WMB); const f32x2* VST = (const f32x2*)(p.ws + WS_SMALL + SM_VST);
    const float* lng = p.in[4]; const float* lnb = p.in[5]; const float* bs = p.in[7];
    LAS f32x2* st = (LAS f32x2*)lds;
    LAS unsigned char* vT = lds + 1024;
    constexpr int VP = 272;
    for (int unit = blockIdx.x; unit < 64 * 8; unit += gridDim.x) {
        const int nb = unit >> 3, h = unit & 7, t0 = nb * 128, c0 = h * 128;
        __syncthreads();
        if (tid < 128) { const f32x4* ps = (const f32x4*)(VST + (size_t)(t0 + tid) * 16); float s = 0.f, q = 0.f;
#pragma unroll
            for (int i = 0; i < 8; ++i) { const f32x4 v = ps[i]; s += v[0] + v[2]; q += v[1] + v[3]; }
            const float mu = s * (1.0f / SW); const float var = fmaxf(q * (1.0f / SW) - mu * mu, 0.f);
            st[tid] = (f32x2){mu, 1.0f / sqrtf(var + EPS)}; }
        __syncthreads();
        if (tid < 256) {
            const int jb = tid >> 4, cb = tid & 15, j0 = jb * 8, cc0 = cb * 8;
            const f32x4 g0 = *(const f32x4*)(lng + c0 + cc0), g1 = *(const f32x4*)(lng + c0 + cc0 + 4), b0 = *(const f32x4*)(lnb + c0 + cc0), b1 = *(const f32x4*)(lnb + c0 + cc0 + 4);
            f32x4 lo[8], hi[8];
#pragma unroll
            for (int r = 0; r < 8; ++r) { const f32x2 s = st[j0 + r]; f32x4 a, b; unpack8(*(const u32x4*)(V + (size_t)(t0 + j0 + r) * SW + c0 + cc0), a, b);
                lo[r] = (a - s.x) * s.y * g0 + b0; hi[r] = (b - s.x) * s.y * g1 + b1; }
#pragma unroll
            for (int cc = 0; cc < 4; ++cc) { u32x4 o;
                o.x = cvt_pk_bf16(lo[0][cc], lo[1][cc]); o.y = cvt_pk_bf16(lo[2][cc], lo[3][cc]); o.z = cvt_pk_bf16(lo[4][cc], lo[5][cc]); o.w = cvt_pk_bf16(lo[6][cc], lo[7][cc]);
                *(LAS u32x4*)(vT + (cc0 + cc) * VP + j0 * 2) = o;
                o.x = cvt_pk_bf16(hi[0][cc], hi[1][cc]); o.y = cvt_pk_bf16(hi[2][cc], hi[3][cc]); o.z = cvt_pk_bf16(hi[4][cc], hi[5][cc]); o.w = cvt_pk_bf16(hi[6][cc], hi[7][cc]);
                *(LAS u32x4*)(vT + (cc0 + 4 + cc) * VP + j0 * 2) = o; }
        }
        __syncthreads();
        bf16x8 wf[4];
#pragma unroll
        for (int ks = 0; ks < 4; ++ks) wf[ks] = *(const bf16x8*)(WmB + ((size_t)h * 128 + wave * 16 + fr) * 128 + ks * 32 + fq * 8);
        f32x4 acc[8];
#pragma unroll
        for (int nk = 0; nk < 8; ++nk) { acc[nk] = (f32x4){0.f, 0.f, 0.f, 0.f};
#pragma unroll
            for (int ks = 0; ks < 4; ++ks) { const bf16x8 vf = *(const LAS bf16x8*)(vT + (nk * 16 + fr) * VP + (ks * 32 + fq * 8) * 2);
                acc[nk] = __builtin_amdgcn_mfma_f32_16x16x32_bf16(vf, wf[ks], acc[nk], 0, 0, 0); } }
        { const int i = wave * 16 + fr; const float bb = bs[h * 128 + i]; const size_t t = (size_t)(t0 + i);
#pragma unroll
          for (int nk = 0; nk < 8; ++nk) { const int c = c0 + nk * 16 + 4 * fq; const u32x2 uu = *(const u32x2*)(U + t * SW + c);
              u32x2 o; o.x = cvt_pk_bf16(bf_lo(uu.x) * (acc[nk][0] + bb), bf_hi(uu.x) * (acc[nk][1] + bb)); o.y = cvt_pk_bf16(bf_lo(uu.y) * (acc[nk][2] + bb), bf_hi(uu.y) * (acc[nk][3] + bb));
              *(u32x2*)(Y + t * 2048 + 1024 + c) = o; } }
    }
}

__device__ __forceinline__ void phase5_router(const Params& p, LAS unsigned char* lds) {
    const int tid = opaque_tid(), wave = __builtin_amdgcn_readfirstlane(tid >> 6), lane = tid & 63, fr = lane & 15, fq = lane >> 4;
    const bf16_t* A2 = (const bf16_t*)(p.ws + WS_A2); const bf16_t* wr = (const bf16_t*)(p.ws + WS_WR);
    float* rstd = (float*)(p.ws + WS_SMALL + SM_RSTD); int* ent = (int*)(p.ws + WS_SMALL + SM_ENT); float* lw = (float*)(p.ws + WS_SMALL + SM_W); int* cnt = (int*)(p.ws + WS_CTL);
    const float* brg = p.in[13]; const float* bre = p.in[15];
    LAS float* part = (LAS float*)lds;
    LAS float* pss  = (LAS float*)(lds + 65536);
    LAS float* lg   = (LAS float*)(lds + 65536 + 1024);
    LAS float* lss  = (LAS float*)(lds + 65536 + 1024 + 2560);
    LAS int* lcnt  = (LAS int*)(lds + 70000);
    LAS int* lbase = (LAS int*)(lds + 70000 + 64);
    LAS int* le    = (LAS int*)(lds + 70000 + 128);
    LAS int* lp    = (LAS int*)(lds + 70000 + 128 + 256);
    LAS float* lwt = (LAS float*)(lds + 70000 + 128 + 512);
    for (int tile = blockIdx.x; tile < T / 32; tile += gridDim.x) {
        const int tok0 = tile * 32;
        __syncthreads();
        if (tid < 16) lcnt[tid] = 0;
        f32x4 acc[2][4]; float ss[2] = {0.f, 0.f};
#pragma unroll
        for (int m = 0; m < 2; ++m)
#pragma unroll
            for (int n = 0; n < 4; ++n) acc[m][n] = (f32x4){0.f, 0.f, 0.f, 0.f};
#pragma unroll 2
        for (int ks = 0; ks < 8; ++ks) {
            const int k = wave * 256 + ks * 32 + fq * 8;
            bf16x8 af[2], bfr[4];
#pragma unroll
            for (int m = 0; m < 2; ++m) af[m] = *(const bf16x8*)(A2 + (size_t)(tok0 + 16 * m + fr) * D + k);
#pragma unroll
            for (int n = 0; n < 4; ++n) bfr[n] = *(const bf16x8*)(wr + (size_t)(16 * n + fr) * D + k);
#pragma unroll
            for (int m = 0; m < 2; ++m) {
#pragma unroll
                for (int j = 0; j < 8; ++j) { const float v = bf1((bf16_t)af[m][j]); ss[m] += v * v; }
#pragma unroll
                for (int n = 0; n < 4; ++n) acc[m][n] = __builtin_amdgcn_mfma_f32_16x16x32_bf16(bfr[n], af[m], acc[m][n], 0, 0, 0);
            }
        }
#pragma unroll
        for (int m = 0; m < 2; ++m) { ss[m] += __shfl_xor(ss[m], 16); ss[m] += __shfl_xor(ss[m], 32);
            if (fq == 0) pss[wave * 32 + 16 * m + fr] = ss[m];
#pragma unroll
            for (int n = 0; n < 4; ++n) *(LAS f32x4*)(part + (wave * 32 + 16 * m + fr) * 64 + 16 * n + 4 * fq) = acc[m][n]; }
        __syncthreads();
        for (int i = tid; i < 32 * 20; i += NTHREADS) { const int t = i / 20, j = i % 20; float s = 0.f;
#pragma unroll
            for (int w = 0; w < 8; ++w) s += part[(w * 32 + t) * 64 + j] + part[(w * 32 + t) * 64 + 32 + j];
            lg[t * 20 + j] = s; }
        if (tid < 32) { float s = 0.f;
#pragma unroll
            for (int w = 0; w < 8; ++w) s += pss[w * 32 + tid];
            lss[tid] = s; }
        __syncthreads();
        if (tid < 32) {
            const int t = tid; const float rs = 1.0f / sqrtf(lss[t] * (1.0f / D) + EPS);
            float g4[4];
#pragma unroll
            for (int j = 0; j < 4; ++j) g4[j] = lg[t * 20 + j] * rs + brg[j];
            int gi = 0; float gm = g4[0];
#pragma unroll
            for (int j = 1; j < 4; ++j) if (g4[j] > gm) { gm = g4[j]; gi = j; }
            float den = 0.f;
#pragma unroll
            for (int j = 0; j < 4; ++j) den += __expf(g4[j] - gm);
            const float pg = 1.0f / den;
            float le4[4];
#pragma unroll
            for (int j = 0; j < 4; ++j) le4[j] = lg[t * 20 + 4 + gi * 4 + j] * rs + bre[gi * 4 + j];
            int i1 = 0; float m1 = le4[0];
#pragma unroll
            for (int j = 1; j < 4; ++j) if (le4[j] > m1) { m1 = le4[j]; i1 = j; }
            int i2 = -1; float m2 = -3.0e38f;
#pragma unroll
            for (int j = 0; j < 4; ++j) if (j != i1 && le4[j] > m2) { m2 = le4[j]; i2 = j; }
            const float ex = __expf(m2 - m1); const float w1 = pg / (1.0f + ex), w2 = pg * ex / (1.0f + ex);
            rstd[tok0 + t] = rs;
            const int e1 = gi * 4 + i1, e2 = gi * 4 + i2;
            le[2 * t] = e1; le[2 * t + 1] = e2; lwt[2 * t] = w1; lwt[2 * t + 1] = w2;
            lp[2 * t] = atomicAdd((int*)&lcnt[e1], 1); lp[2 * t + 1] = atomicAdd((int*)&lcnt[e2], 1);
        }
        __syncthreads();
        if (tid < 16) { const int n = lcnt[tid]; lbase[tid] = n ? atomicAdd(&cnt[tid], n) : 0; }
        __syncthreads();
        if (tid < 64) { const int e = le[tid]; const int pos = lbase[e] + lp[tid]; ent[e * T + pos] = (tok0 + (tid >> 1)) | ((tid & 1) << 16); lw[e * T + pos] = lwt[tid]; }
    }
}

__device__ __forceinline__ void phase8_final(const Params& p) {
    const int tid = opaque_tid(), wave = __builtin_amdgcn_readfirstlane(tid >> 6), lane = tid & 63;
    const bf16_t* A2 = (const bf16_t*)(p.ws + WS_A2); const bf16_t* Y0 = (const bf16_t*)(p.ws + WS_YK0); const bf16_t* Y1 = (const bf16_t*)(p.ws + WS_YK1); const float* g = p.in[19];
    const int gw = blockIdx.x * NWAVES + wave, NGW = gridDim.x * NWAVES;
    for (int m = gw; m < T; m += NGW) {
        f32x4 v[8]; float s = 0.f;
#pragma unroll
        for (int j = 0; j < 8; ++j) { const size_t o = (size_t)m * D + 4 * lane + 256 * j;
            const u32x2 hh = *(const u32x2*)(A2 + o), a = *(const u32x2*)(Y0 + o), b = *(const u32x2*)(Y1 + o);
            v[j][0] = bf_lo(hh.x) + (bf_lo(a.x) + bf_lo(b.x)); v[j][1] = bf_hi(hh.x) + (bf_hi(a.x) + bf_hi(b.x)); v[j][2] = bf_lo(hh.y) + (bf_lo(a.y) + bf_lo(b.y)); v[j][3] = bf_hi(hh.y) + (bf_hi(a.y) + bf_hi(b.y));
            s += (v[j][0] * v[j][0] + v[j][1] * v[j][1]) + (v[j][2] * v[j][2] + v[j][3] * v[j][3]); }
        const float rs = 1.0f / sqrtf(wave_sum(s) * (1.0f / D) + EPS);
#pragma unroll
        for (int j = 0; j < 8; ++j) { const int c = 4 * lane + 256 * j; const f32x4 gg = *(const f32x4*)(g + c); *(f32x4*)(p.out + (size_t)m * D + c) = v[j] * rs * gg; }
    }
}

#define XB_TMO      128
#define XB_XCNT(j)  (256  + 64 * (j))
#define XB_XSUB(j)  (1280 + 64 * (j))
#define XB_XGEN(j)  (2304 + 64 * (j))
#define XB_TOP      3328
#define XB_TOPGEN   3392
#define XCD_BAR_WORDS 3456
#define XB_SPIN_CAP (1u << 18)
__device__ __forceinline__ unsigned xb_ld(unsigned* p)              { return __hip_atomic_load(p, __ATOMIC_RELAXED, __HIP_MEMORY_SCOPE_AGENT); }
__device__ __forceinline__ unsigned xb_add(unsigned* p, unsigned v) { return __hip_atomic_fetch_add(p, v, __ATOMIC_RELAXED, __HIP_MEMORY_SCOPE_AGENT); }
__device__ __forceinline__ unsigned xb_xcc_id() { return (unsigned)__builtin_amdgcn_s_getreg((3 << 11) | 20) & 0xFu; }
#define XB_SPIN(cond, bar) do { unsigned _sp = 0; while (cond) { __builtin_amdgcn_s_sleep(1); \
    if ((++_sp & 255u) == 0u) { if (xb_ld(&(bar)[XB_TMO])) break; if (_sp > XB_SPIN_CAP) { atomicAdd(&(bar)[XB_TMO], 1u); break; } } } } while (0)
struct XcdBarrier { unsigned* bar; unsigned x; volatile LAS unsigned* st; };
__device__ __forceinline__ XcdBarrier xcd_barrier_post(unsigned* bar, volatile LAS unsigned* st) {
    XcdBarrier b; b.bar = bar; b.x = xb_xcc_id(); b.st = st;
    if (threadIdx.x == 0) (void)xb_add(&bar[XB_XCNT(b.x)], 1u);
    return b;
}
__device__ __forceinline__ void xcd_barrier_complete(unsigned* bar, unsigned x, unsigned& nloc, unsigned& nx) {
    const unsigned G = gridDim.x * gridDim.y * gridDim.z;
    unsigned sum, cnt, mine, sp = 0u;
    for (;;) {
        sum = 0u; cnt = 0u; mine = 0u;
#pragma unroll
        for (unsigned j = 0; j < 16; ++j) { const unsigned c = xb_ld(&bar[XB_XCNT(j)]); sum += c; cnt += (c > 0u) ? 1u : 0u; mine = (j == x) ? c : mine; }
        if (sum == G) break;
        __builtin_amdgcn_s_sleep(1);
        if ((++sp & 255u) == 0u) { if (xb_ld(&bar[XB_TMO])) break; if (sp > XB_SPIN_CAP) { atomicAdd(&bar[XB_TMO], 1u); break; } }
    }
    nloc = mine > 0u ? mine : 1u; nx = cnt > 0u ? cnt : 1u;
}
__device__ __forceinline__ void xcd_barrier(const XcdBarrier& b) {
    asm volatile("s_waitcnt vmcnt(0)" ::: "memory");
    __syncthreads();
    if (threadIdx.x == 0) {
        unsigned* bar = b.bar;
        __builtin_amdgcn_s_waitcnt(0);
        unsigned nloc = b.st[0], nx = b.st[1];
        if (nloc == 0u) { xcd_barrier_complete(bar, b.x, nloc, nx); b.st[0] = nloc; b.st[1] = nx; }
        const unsigned old = xb_add(&bar[XB_XSUB(b.x)], 1u);
        const unsigned gen = old / nloc;
        if (old + 1u == (gen + 1u) * nloc) {
            __builtin_amdgcn_fence(__ATOMIC_RELEASE, "agent");
            asm volatile("s_waitcnt vmcnt(0)" ::: "memory");
            const unsigned og = xb_add(&bar[XB_TOP], 1u);
            const unsigned tg = og / nx;
            if (og + 1u == (tg + 1u) * nx) xb_add(&bar[XB_TOPGEN], 1u);
            else XB_SPIN(xb_ld(&bar[XB_TOPGEN]) == tg, bar);
            __builtin_amdgcn_fence(__ATOMIC_ACQUIRE, "agent");
            xb_add(&bar[XB_XGEN(b.x)], 1u);
            asm volatile("s_waitcnt vmcnt(0)" ::: "memory");
        } else {
            XB_SPIN(xb_ld(&bar[XB_XGEN(b.x)]) == gen, bar);
            __builtin_amdgcn_fence(__ATOMIC_ACQUIRE, "agent");
            asm volatile("s_waitcnt vmcnt(0)" ::: "memory");
        }
    }
    __syncthreads();
}

template <int PH> __device__ __forceinline__ void run_phase(const Params& p, LAS unsigned char* lds) {
    unsigned char* ws = p.ws;
    if constexpr (PH == 0) phase0(p, lds);
    if constexpr (PH == 1) { DenseSched S; S.init((const bf16_t*)(ws + WS_X), (const bf16_t*)(ws + WS_WINT), T, NIN, D);
        EpiProj E{(bf16_t*)(ws + WS_P + P_BC), (bf16_t*)(ws + WS_P + P_P), (bf16_t*)(ws + WS_P + P_U), (bf16_t*)(ws + WS_P + P_V), (bf16_t*)(ws + WS_P + P_R), (bf16_t*)(ws + WS_P + P_S), (f32x2*)(ws + WS_SMALL + SM_VST)};
        gemm_run<0>(lds, S, E, D); convert_tail(p, lds, (T / 256) * (NIN / 256)); }
    if constexpr (PH == 2) { phase2_conv(p); phase2_sgu(p, lds); }
    if constexpr (PH == 3) { DenseSched S; S.init((const bf16_t*)(ws + WS_X), (const bf16_t*)(ws + WS_WUPT), T, D, 2048);
        EpiUp E{(const bf16_t*)(ws + WS_P + P_R), (const bf16_t*)(ws + WS_P + P_S), (bf16_t*)(ws + WS_MM)}; gemm_run<1>(lds, S, E, 2048); }
    if constexpr (PH == 4) { DenseSched S; S.init((const bf16_t*)(ws + WS_MM), (const bf16_t*)(ws + WS_WOUTT), T, D, D);
        EpiOut E{p.in[0], (bf16_t*)(ws + WS_A2)}; gemm_run<2>(lds, S, E, D); }
    if constexpr (PH == 5) phase5_router(p, lds);
    if constexpr (PH == 6) { MoeSched<true, 4, D, 1024> S{(const bf16_t*)(ws + WS_A2), (const bf16_t*)(ws + WS_W1T), (const int*)(ws + WS_CTL), (const int*)(ws + WS_SMALL + SM_ENT), (int)gridDim.x, (int)blockIdx.x};
        EpiMoe1 E{(const int*)(ws + WS_SMALL + SM_ENT), (const float*)(ws + WS_SMALL + SM_W), (const float*)(ws + WS_SMALL + SM_RSTD), (bf16_t*)(ws + WS_HID)}; gemm_run<3>(lds, S, E, D); }
    if constexpr (PH == 7) { MoeSched<false, 8, DE, D> S{(const bf16_t*)(ws + WS_HID), (const bf16_t*)(ws + WS_W2T), (const int*)(ws + WS_CTL), (const int*)(ws + WS_SMALL + SM_ENT), (int)gridDim.x, (int)blockIdx.x};
        EpiMoe2 E{(const int*)(ws + WS_SMALL + SM_ENT), (bf16_t*)(ws + WS_YK0), (bf16_t*)(ws + WS_YK1)}; gemm_run<4>(lds, S, E, DE); }
    if constexpr (PH == 8) phase8_final(p);
}

template <int PH> __global__ void __launch_bounds__(NTHREADS, 2) k_phase(Params p) {
    extern __shared__ __attribute__((aligned(16))) unsigned char lds_raw[];
    run_phase<PH>(p, (LAS unsigned char*)lds_raw);
}

#ifndef PROBE_DUP
#define PROBE_DUP 0
#endif
#ifndef PROBE_SYNCS
#define PROBE_SYNCS 0
#endif
#define DUP(k) ((PROBE_DUP >> (k)) & 1)
typedef const __attribute__((address_space(4))) Params* KParamsPtr;
__device__ __forceinline__ Params load_params() {
    Params r{};
#if defined(__HIP_DEVICE_COMPILE__)
    unsigned long long v = (unsigned long long)__builtin_amdgcn_kernarg_segment_ptr(); asm volatile("" : "+s"(v));
    const __attribute__((address_space(4))) unsigned long long* q = (const __attribute__((address_space(4))) unsigned long long*)v;
#pragma unroll
    for (int i = 0; i < 20; ++i) r.in[i] = (const float*)(const __attribute__((address_space(1))) float*)q[i];
    r.out = (float*)(__attribute__((address_space(1))) float*)q[20]; r.ws = (unsigned char*)(__attribute__((address_space(1))) unsigned char*)q[21];
#endif
    return r;
}
#define RUN(k) do { const Params pk = load_params(); run_phase<k>(pk, lds); } while (0)
__global__ void __launch_bounds__(NTHREADS, 2) k_mega(Params p) {
    extern __shared__ __attribute__((aligned(16))) unsigned char lds_raw[];
    LAS unsigned char* lds = (LAS unsigned char*)lds_raw;
    cg::grid_group grid = cg::this_grid();
    volatile LAS unsigned* xbst = (volatile LAS unsigned*)(lds + LDS_BYTES - 64);
    if (threadIdx.x < 4) xbst[threadIdx.x] = 0u;
    __syncthreads();
    const XcdBarrier bar = xcd_barrier_post((unsigned*)(p.ws + WS_BAR), xbst);
#define GSYNC() xcd_barrier(bar)
    if (p.ws == nullptr) grid.sync();
    RUN(0); GSYNC();
    if (DUP(0)) { RUN(0); GSYNC(); }
    RUN(1); GSYNC();
    if (DUP(1)) { RUN(1); GSYNC(); }
    RUN(2); GSYNC();
    if (DUP(2)) { RUN(2); GSYNC(); }
    RUN(3); GSYNC();
    if (DUP(3)) { RUN(3); GSYNC(); }
    RUN(4); GSYNC();
    if (DUP(4)) { RUN(4); GSYNC(); }
    RUN(5); GSYNC();
    if (DUP(5)) { if (blockIdx.x == 0 && threadIdx.x < 16) ((int*)(load_params().ws + WS_CTL))[threadIdx.x] = 0; GSYNC(); RUN(5); GSYNC(); }
    RUN(6); GSYNC();
    if (DUP(6)) { RUN(6); GSYNC(); }
    RUN(7); GSYNC();
    if (DUP(7)) { RUN(7); GSYNC(); }
    for (int i = 0; i < PROBE_SYNCS; ++i) GSYNC();
    RUN(8);
    if (DUP(8)) { GSYNC(); RUN(8); }
}

template <int PH> static void launch_phase(const Params& p, int grid, hipStream_t stream) {
    static bool attr = false;
    if (!attr) { (void)hipFuncSetAttribute((const void*)k_phase<PH>, hipFuncAttributeMaxDynamicSharedMemorySize, LDS_BYTES); attr = true; }
    hipLaunchKernelGGL(k_phase<PH>, dim3(grid), dim3(NTHREADS), LDS_BYTES, stream, p);
}

extern "C" void kernel_launch(void* const* d_in, const int* in_sizes, int n_in, void* d_out, int out_size, void* d_ws, size_t ws_size, hipStream_t stream) {
    static int grid = 0;
    if (grid == 0) {
        if (n_in != 20 || out_size != T * D || ws_size < WS_END) { fprintf(stderr, "kernel_launch: unexpected shapes n_in %d out %d ws %zu (need %zu)\n", n_in, out_size, ws_size, (size_t)WS_END); grid = -1; return; }
        int dev = 0, cus = 0, per_cu = 0;
        (void)hipGetDevice(&dev); (void)hipDeviceGetAttribute(&cus, hipDeviceAttributeMultiprocessorCount, dev);
        (void)hipFuncSetAttribute((const void*)k_mega, hipFuncAttributeMaxDynamicSharedMemorySize, LDS_BYTES);
        (void)hipOccupancyMaxActiveBlocksPerMultiprocessor(&per_cu, (const void*)k_mega, NTHREADS, LDS_BYTES);
        if (per_cu < 1) { fprintf(stderr, "kernel_launch: occupancy query says %d blocks per CU\n", per_cu); per_cu = 1; }
        grid = cus * 1;
        (void)hipGetLastError();
    }
    if (grid < 0) return;
    Params p{};
    for (int i = 0; i < 20; ++i) p.in[i] = (const float*)d_in[i];
    p.out = (float*)d_out; p.ws = (unsigned char*)d_ws;
    (void)hipMemsetAsync((char*)d_ws + WS_CTL, 0, 64 * 1024, stream);
#if ONE_LAUNCH
    void* args[] = {&p};
    hipError_t e = hipLaunchCooperativeKernel((const void*)k_mega, dim3(grid), dim3(NTHREADS), args, LDS_BYTES, stream);
    if (e != hipSuccess) fprintf(stderr, "cooperative launch failed: %s (grid %d)\n", hipGetErrorString(e), grid);
#else
    launch_phase<0>(p, grid, stream); launch_phase<1>(p, grid, stream); launch_phase<2>(p, grid, stream); launch_phase<3>(p, grid, stream); launch_phase<4>(p, grid, stream);
    launch_phase<5>(p, grid, stream); launch_phase<6>(p, grid, stream); launch_phase<7>(p, grid, stream); launch_phase<8>(p, grid, stream);
#endif
}
```

```cpp
#include <hip/hip_runtime.h>
#include <hip/hip_cooperative_groups.h>
#include <cstdio>
#include <cstdint>
namespace cg = cooperative_groups;

#ifndef ONE_LAUNCH
#define ONE_LAUNCH 1
#endif

#define LAS __attribute__((address_space(3)))
typedef unsigned short bf16_t;
typedef short bf16x8 __attribute__((ext_vector_type(8)));
typedef float f32x4 __attribute__((ext_vector_type(4)));
typedef float f32x2 __attribute__((ext_vector_type(2)));
typedef unsigned u32x4 __attribute__((ext_vector_type(4)));
typedef unsigned u32x2 __attribute__((ext_vector_type(2)));

constexpr int T = 8192, D = 2048, CW = 1024, SW = 1024, NIN = 9216, NE = 16, DE = 512;
constexpr float EPS = 1e-6f;
constexpr int NTHREADS = 512, NWAVES = 8;
constexpr int LDS_BYTES = 140 * 1024;
constexpr int HID_ROWS = 2 * T + NE * 256;

constexpr size_t MiB = 1024 * 1024;
constexpr size_t WS_CTL   = 0;
constexpr size_t WS_BAR   = 4096;
constexpr size_t WS_SMALL = 64 * 1024;
constexpr size_t SM_RSTD = 0, SM_ENT = 32 * 1024, SM_W = SM_ENT + (size_t)NE * T * 4, SM_VST = SM_W + (size_t)NE * T * 4, SM_OVF = SM_VST + (size_t)T * 16 * 8, SM_END = SM_OVF + (size_t)T * 4;
constexpr size_t WS_WR    = WS_SMALL + 4 * MiB;
constexpr size_t WS_WMB   = WS_WR + 256 * 1024;
constexpr size_t WS_WINT  = WS_WMB + 256 * 1024;
constexpr size_t WS_WUPT  = WS_WINT + (size_t)NIN * D * 2;
constexpr size_t WS_WOUTT = WS_WUPT + (size_t)D * D * 2;
constexpr size_t WS_W1T   = WS_WOUTT + (size_t)D * D * 2;
constexpr size_t WS_W2T   = WS_W1T + (size_t)NE * 1024 * D * 2;
constexpr size_t WS_X     = WS_W2T + (size_t)NE * D * DE * 2;
constexpr size_t WS_P     = WS_X + (size_t)T * D * 2;
constexpr size_t P_BC = 0, P_P = P_BC + (size_t)T * CW * 2, P_U = P_P + (size_t)T * CW * 2, P_V = P_U + (size_t)T * SW * 2,
                 P_R = P_V + (size_t)T * SW * 2, P_S = P_R + (size_t)T * D * 2, P_END = P_S + (size_t)T * D * 2;
constexpr size_t WS_END   = WS_P + P_END;
constexpr size_t WS_MM  = WS_WINT;
constexpr size_t WS_H   = WS_P + P_BC;
constexpr size_t WS_A2  = WS_P + P_R;
constexpr size_t WS_HID = WS_P + P_S;
constexpr size_t WS_YK0 = WS_X;
constexpr size_t WS_YK1 = WS_WINT;
static_assert(SM_END <= 4 * MiB, "small region");
static_assert((size_t)HID_ROWS * DE * 2 <= (size_t)T * D * 2, "hid overlay");
static_assert((size_t)T * D * 4 <= P_R, "H overlay");

struct Params { const float* in[20]; float* out; unsigned char* ws; };

__device__ __forceinline__ unsigned cvt_pk_bf16(float lo, float hi) { unsigned r; asm("v_cvt_pk_bf16_f32 %0, %1, %2" : "=v"(r) : "v"(lo), "v"(hi)); return r; }
__device__ __forceinline__ float bf_lo(unsigned w) { return __uint_as_float(w << 16); }
__device__ __forceinline__ float bf_hi(unsigned w) { return __uint_as_float(w & 0xffff0000u); }
__device__ __forceinline__ float bf1(bf16_t b) { return __uint_as_float(((unsigned)b) << 16); }
__device__ __forceinline__ float wave_sum(float v) {
#pragma unroll
    for (int o = 1; o < 64; o <<= 1) v += __shfl_xor(v, o);
    return v;
}
__device__ __forceinline__ float fast_rcp(float x) { return __builtin_amdgcn_rcpf(x); }
__device__ __forceinline__ float fast_exp2(float x) { return __builtin_amdgcn_exp2f(x); }
__device__ __forceinline__ float sigmoid_f(float x) { return fast_rcp(1.0f + fast_exp2(-1.44269504f * x)); }
__device__ __forceinline__ float gelu_tanh(float x) {
    const float u = x + 0.044715f * x * x * x;
    return x * fast_rcp(1.0f + fast_exp2(-2.30220819f * u));
}
__device__ __forceinline__ int opaque_tid() { int t = threadIdx.x; asm volatile("" : "+v"(t)); return t; }
__host__ __device__ __forceinline__ int perm32(int rho) { const int n = rho >> 4, i = rho & 15; return 8 * (i >> 2) + 4 * n + (i & 3); }

struct Unit { int pm, pn, e, row0, nvalid; };
constexpr int NXCD = 8, WGM = 8;
struct DenseSched {
    static constexpr bool DYN_HALF = false;
    const bf16_t* A; const bf16_t* Bt; int K; int nM, nN, nwg, G, c;
    __device__ __forceinline__ void init(const bf16_t* A_, const bf16_t* Bt_, int M, int N, int K_) { A = A_; Bt = Bt_; K = K_; nM = M / 256; nN = N / 256; nwg = nM * nN; G = gridDim.x; c = blockIdx.x; }
    __device__ __forceinline__ bool next(int i, Unit& u) const {
        const long L = (long)i * G + c; if (L >= nwg) return false;
        int wgid = (int)L; { const int q = nwg / NXCD, r = nwg % NXCD, xcd = wgid % NXCD, off = wgid / NXCD; wgid = (xcd < r ? xcd * (q + 1) : r * (q + 1) + (xcd - r) * q) + off; }
        const int nig = WGM * nN, gid = wgid / nig, fm = gid * WGM, gsz = (nM - fm) < WGM ? (nM - fm) : WGM;
        u.pm = fm + ((wgid % nig) % gsz); u.pn = (wgid % nig) / gsz; u.e = 0; u.row0 = u.pm * 256; u.nvalid = 256; return true;
    }
    __device__ __forceinline__ const char* a_base() const { return (const char*)A; }
    __device__ __forceinline__ unsigned a_off(const Unit& u, int r) const { return (unsigned)(u.row0 + r) * (unsigned)K * 2u; }
    __device__ __forceinline__ const char* b_base(const Unit& u) const { return (const char*)Bt + (size_t)u.pn * 256 * K * 2; }
};
constexpr int MOE_REG = 4;
template <bool GATHER, int NPN, int KK, int NROWS_E  >
struct MoeSched {
    static constexpr bool DYN_HALF = true;
    const bf16_t* A; const bf16_t* Bt; const int* cnt; const int* ent; int mode, idx, stride;
    __device__ __forceinline__ bool next(int i, Unit& u) const {
        if (idx < 0) return false;
        int L = i * stride + idx; int hb = 0;
        for (int e = 0; e < NE; ++e) {
            const int n = __builtin_amdgcn_readfirstlane(cnt[e]); const int nt = (n + 255) >> 8;
            const int lo = (mode == 1) ? min(nt, MOE_REG) : 0, hi = (mode == 0) ? min(nt, MOE_REG) : nt;
            const int nsel = (hi - lo) * NPN;
            if (L < nsel) { u.e = e; u.pm = lo + L / NPN; u.pn = L % NPN; u.row0 = hb + u.pm * 256; u.nvalid = min(256, n - u.pm * 256); return true; }
            L -= nsel; hb += nt * 256;
        }
        return false;
    }
    __device__ __forceinline__ const char* a_base() const { return (const char*)A; }
    __device__ __forceinline__ unsigned a_off(const Unit& u, int r) const {
        if (GATHER) { const int tok = (r < u.nvalid) ? (ent[u.e * T + u.pm * 256 + r] & 0xffff) : 0; return (unsigned)tok * (unsigned)KK * 2u; }
        return (unsigned)(u.row0 + r) * (unsigned)KK * 2u;
    }
    __device__ __forceinline__ const char* b_base(const Unit& u) const { return (const char*)Bt + ((size_t)u.e * NROWS_E + (size_t)u.pn * 256) * KK * 2; }
};
__device__ __forceinline__ int moe_overflow_tiles(const int* cnt) { int t = 0; for (int e = 0; e < NE; ++e) { const int nt = (__builtin_amdgcn_readfirstlane(cnt[e]) + 255) >> 8; t += max(nt - MOE_REG, 0); } return t; }

typedef f32x4 Acc[2][2][4][2];
__device__ __forceinline__ u32x4 pack8(f32x4 a, f32x4 b) { u32x4 w; w.x = cvt_pk_bf16(a[0], a[1]); w.y = cvt_pk_bf16(a[2], a[3]); w.z = cvt_pk_bf16(b[0], b[1]); w.w = cvt_pk_bf16(b[2], b[3]); return w; }
__device__ __forceinline__ void unpack8(u32x4 w, f32x4& a, f32x4& b) { a = (f32x4){bf_lo(w.x), bf_hi(w.x), bf_lo(w.y), bf_hi(w.y)}; b = (f32x4){bf_lo(w.z), bf_hi(w.z), bf_lo(w.w), bf_hi(w.w)}; }

struct EpiProj {
    static constexpr bool PERM = true; static constexpr int MIDK = 0;
    bf16_t *Bc, *P, *U, *V, *R, *S; f32x2* VST;
    __device__ __forceinline__ void mid(Acc&, const Unit&, int, int, int, int) const {}
    __device__ __forceinline__ void operator()(const Acc& acc, const Unit& u, int wr, int wc, int fr, int fq) const {
        const int pn = u.pn; const int rowb = u.row0 + wr * 64 + fr; const int cl = wc * 32 + 8 * fq;
#pragma unroll
        for (int ai = 0; ai < 2; ++ai)
#pragma unroll
            for (int m = 0; m < 4; ++m) {
                const size_t row = (size_t)(rowb + ai * 128 + m * 16);
                if (pn < 4) {
#pragma unroll
                    for (int bj = 0; bj < 2; ++bj) *(u32x4*)(Bc + row * CW + pn * 256 + bj * 128 + cl) = pack8(acc[ai][bj][m][0], acc[ai][bj][m][1]);
                } else if (pn < 12) {
                    *(u32x4*)(P + row * CW + (pn - 4) * 128 + cl) = pack8(acc[ai][0][m][0] * acc[ai][1][m][0], acc[ai][0][m][1] * acc[ai][1][m][1]);
                } else if (pn < 20) {
                    bf16_t* O = (pn < 16) ? (U + row * SW + (pn - 12) * 256) : (V + row * SW + (pn - 16) * 256);
                    float ssum = 0.f, ssq = 0.f;
#pragma unroll
                    for (int bj = 0; bj < 2; ++bj) { f32x4 a = acc[ai][bj][m][0], b = acc[ai][bj][m][1];
#pragma unroll
                        for (int j = 0; j < 4; ++j) { a[j] = gelu_tanh(a[j]); b[j] = gelu_tanh(b[j]); ssum += a[j] + b[j]; ssq += a[j] * a[j] + b[j] * b[j]; }
                        *(u32x4*)(O + bj * 128 + cl) = pack8(a, b); }
                    if (pn >= 16) {
                        ssum += __shfl_xor(ssum, 16); ssum += __shfl_xor(ssum, 32); ssq += __shfl_xor(ssq, 16); ssq += __shfl_xor(ssq, 32);
                        if (fq == 0) VST[row * 16 + (pn - 16) * 4 + wc] = (f32x2){ssum, ssq}; }
                } else {
                    f32x4 r0, r1, s0, s1;
#pragma unroll
                    for (int j = 0; j < 4; ++j) {
                        const float ec0 = fast_exp2(-1.44269504f * acc[ai][0][m][0][j]), es0 = fast_exp2(-1.44269504f * acc[ai][1][m][0][j]);
                        const float ec1 = fast_exp2(-1.44269504f * acc[ai][0][m][1][j]), es1 = fast_exp2(-1.44269504f * acc[ai][1][m][1][j]);
                        r0[j] = (1.0f + es0) * fast_rcp(1.0f + ec0); s0[j] = fast_rcp(1.0f + es0);
                        r1[j] = (1.0f + es1) * fast_rcp(1.0f + ec1); s1[j] = fast_rcp(1.0f + es1);
                    }
                    const size_t o = row * D + (pn - 20) * 128 + cl;
                    *(u32x4*)(R + o) = pack8(r0, r1); *(u32x4*)(S + o) = pack8(s0, s1);
                }
            }
    }
};
struct EpiUp {
    static constexpr bool PERM = true; static constexpr int MIDK = 1024;
    const bf16_t *R, *S; bf16_t* Mm;
    __device__ __forceinline__ void mid(Acc& acc, const Unit& u, int wr, int wc, int fr, int fq) const {
        int rowb = u.row0 + wr * 64 + fr; const int cb = u.pn * 256 + wc * 32 + 8 * fq;
        asm volatile("" : "+v"(rowb));
#pragma unroll
        for (int ai = 0; ai < 2; ++ai)
#pragma unroll
            for (int m = 0; m < 4; ++m)
#pragma unroll
                for (int bj = 0; bj < 2; ++bj) { f32x4 a, b; unpack8(*(const u32x4*)(R + (size_t)(rowb + ai * 128 + m * 16) * D + cb + bj * 128), a, b);
                    acc[ai][bj][m][0] *= a; acc[ai][bj][m][1] *= b; }
    }
    __device__ __forceinline__ void operator()(const Acc& acc, const Unit& u, int wr, int wc, int fr, int fq) const {
        const int rowb = u.row0 + wr * 64 + fr; const int cb = u.pn * 256 + wc * 32 + 8 * fq;
#pragma unroll
        for (int ai = 0; ai < 2; ++ai)
#pragma unroll
            for (int m = 0; m < 4; ++m)
#pragma unroll
                for (int bj = 0; bj < 2; ++bj) { const size_t o = (size_t)(rowb + ai * 128 + m * 16) * D + cb + bj * 128; f32x4 a, b; unpack8(*(const u32x4*)(S + o), a, b);
                    *(u32x4*)(Mm + o) = pack8(acc[ai][bj][m][0] * a, acc[ai][bj][m][1] * b); }
    }
};
struct EpiOut {
    static constexpr bool PERM = true; static constexpr int MIDK = 0;
    const float* x; bf16_t* A2;
    __device__ __forceinline__ void mid(Acc&, const Unit&, int, int, int, int) const {}
    __device__ __forceinline__ void operator()(const Acc& acc, const Unit& u, int wr, int wc, int fr, int fq) const {
        const int rowb = u.row0 + wr * 64 + fr; const int cb = u.pn * 256 + wc * 32 + 8 * fq;
#pragma unroll
        for (int ai = 0; ai < 2; ++ai)
#pragma unroll
            for (int m = 0; m < 4; ++m)
#pragma unroll
                for (int bj = 0; bj < 2; ++bj) { const size_t o = (size_t)(rowb + ai * 128 + m * 16) * D + cb + bj * 128;
                    const f32x4 h0 = *(const f32x4*)(x + o) + acc[ai][bj][m][0], h1 = *(const f32x4*)(x + o + 4) + acc[ai][bj][m][1];
                    *(u32x4*)(A2 + o) = pack8(h0, h1); }
    }
};
struct EpiMoe1 {
    static constexpr bool PERM = true; static constexpr int MIDK = 0;
    const int* ent; const float* lw; const float* rstd; bf16_t* Hid;
    __device__ __forceinline__ void mid(Acc&, const Unit&, int, int, int, int) const {}
    __device__ __forceinline__ void operator()(const Acc& acc, const Unit& u, int wr, int wc, int fr, int fq) const {
        const int cl = u.pn * 128 + wc * 32 + 8 * fq;
#pragma unroll
        for (int ai = 0; ai < 2; ++ai)
#pragma unroll
            for (int m = 0; m < 4; ++m) {
                const int r = ai * 128 + wr * 64 + m * 16 + fr;
                if (r < u.nvalid) {
                    const int li = u.e * T + u.pm * 256 + r; const int tok = ent[li] & 0xffff; const float rs = rstd[tok], w = lw[li];
                    f32x4 o[2];
#pragma unroll
                    for (int n = 0; n < 2; ++n)
#pragma unroll
                        for (int j = 0; j < 4; ++j) { const float gt = acc[ai][0][m][n][j] * rs, up = acc[ai][1][m][n][j] * rs; o[n][j] = gt * sigmoid_f(gt) * up * w; }
                    *(u32x4*)(Hid + (size_t)(u.row0 + r) * DE + cl) = pack8(o[0], o[1]);
                }
            }
    }
};
struct EpiMoe2 {
    static constexpr bool PERM = true; static constexpr int MIDK = 0;
    const int* ent; bf16_t* Yk0; bf16_t* Yk1;
    __device__ __forceinline__ void mid(Acc&, const Unit&, int, int, int, int) const {}
    __device__ __forceinline__ void operator()(const Acc& acc, const Unit& u, int wr, int wc, int fr, int fq) const {
        const int cb = u.pn * 256 + wc * 32 + 8 * fq;
#pragma unroll
        for (int ai = 0; ai < 2; ++ai)
#pragma unroll
            for (int m = 0; m < 4; ++m) {
                const int r = ai * 128 + wr * 64 + m * 16 + fr;
                if (r < u.nvalid) {
                    const int en = ent[u.e * T + u.pm * 256 + r]; const int tok = en & 0xffff; bf16_t* Y = (en >> 16) ? Yk1 : Yk0;
#pragma unroll
                    for (int bj = 0; bj < 2; ++bj) *(u32x4*)(Y + (size_t)tok * D + cb + bj * 128) = pack8(acc[ai][bj][m][0], acc[ai][bj][m][1]);
                }
            }
    }
};

template <class Epi, class Sched>
__device__ __forceinline__ void gemm_simple(const Sched& S, const Epi& E, const int K) {
    const int tid = opaque_tid(), wid = __builtin_amdgcn_readfirstlane(tid >> 6), lane = tid & 63, wr = wid >> 2, wc = wid & 3, fr = lane & 15, fq = lane >> 4;
    Unit u;
    for (int ui = 0; S.next(ui, u); ++ui) {
        Acc acc;
#pragma unroll
        for (int a = 0; a < 2; ++a)
#pragma unroll
            for (int b = 0; b < 2; ++b)
#pragma unroll
                for (int m = 0; m < 4; ++m)
#pragma unroll
                    for (int n = 0; n < 2; ++n) acc[a][b][m][n] = (f32x4){0.f, 0.f, 0.f, 0.f};
        const char* ab = S.a_base(); const char* bb = S.b_base(u);
        unsigned aoff[2][4], boff[2][2];
#pragma unroll
        for (int ai = 0; ai < 2; ++ai)
#pragma unroll
            for (int m = 0; m < 4; ++m) aoff[ai][m] = S.a_off(u, ai * 128 + wr * 64 + m * 16 + fr) + fq * 16;
#pragma unroll
        for (int bj = 0; bj < 2; ++bj)
#pragma unroll
            for (int n = 0; n < 2; ++n) { const int rr = Epi::PERM ? perm32(n * 16 + fr) : (n * 16 + fr); boff[bj][n] = (unsigned)(bj * 128 + wc * 32 + rr) * (unsigned)K * 2u + fq * 16; }
        for (int k0 = 0; k0 < K; k0 += 32) {
            if (Epi::MIDK != 0 && k0 == Epi::MIDK) E.mid(acc, u, wr, wc, fr, fq);
            bf16x8 a[2][4], b[2][2];
#pragma unroll
            for (int ai = 0; ai < 2; ++ai)
#pragma unroll
                for (int m = 0; m < 4; ++m) a[ai][m] = *(const bf16x8*)(ab + aoff[ai][m] + k0 * 2);
#pragma unroll
            for (int bj = 0; bj < 2; ++bj)
#pragma unroll
                for (int n = 0; n < 2; ++n) b[bj][n] = *(const bf16x8*)(bb + boff[bj][n] + k0 * 2);
#pragma unroll
            for (int ai = 0; ai < 2; ++ai)
#pragma unroll
                for (int bj = 0; bj < 2; ++bj)
#pragma unroll
                    for (int m = 0; m < 4; ++m)
#pragma unroll
                        for (int n = 0; n < 2; ++n) acc[ai][bj][m][n] = __builtin_amdgcn_mfma_f32_16x16x32_bf16(b[bj][n], a[ai][m], acc[ai][bj][m][n], 0, 0, 0);
        }
        E(acc, u, wr, wc, fr, fq);
    }
}

constexpr int BK = 64, HALF = 128, HTB = HALF * BK * 2, STAGE_BYTES = 8 * HTB;
__host__ __device__ __forceinline__ int lds_byte(int r, int c) { const int st = (r >> 4) * 2 + (c >> 5), rr = r & 15, cc = c & 31, ob = rr * 64 + cc * 2; return st * 1024 + (ob ^ (((ob >> 9) & 1) << 5)); }
__host__ __device__ __forceinline__ void stage_rc(int b, int& R, int& C) { const int st = b / 1024, sb = b % 1024, swz = sb ^ (((sb >> 9) & 1) << 5); R = (st >> 1) * 16 + swz / 64; C = (st & 1) * 32 + (swz % 64) / 2; }

template <class Epi, class Sched>
__device__ __forceinline__ void gemm_fast(LAS unsigned char* lds, const Sched& S, const Epi& E, const int K) {
    const int tid = opaque_tid(), wid = __builtin_amdgcn_readfirstlane(tid >> 6), lane = tid & 63, wr = wid >> 2, wc = wid & 3, fr = lane & 15, fq = lane >> 4;
    const int nt = K / BK;
    int sR[2], sC[2]; unsigned voffB[2];
#pragma unroll
    for (int i = 0; i < 2; ++i) { stage_rc(tid * 16 + i * 8192, sR[i], sC[i]); const int Rb = Epi::PERM ? ((sR[i] & ~31) + perm32(sR[i] & 31)) : sR[i]; voffB[i] = (unsigned)(Rb * K + sC[i]) * 2u; }
    const size_t kstep = (size_t)(BK * 2);
    const size_t hstepB = (size_t)HALF * K * 2;
    const unsigned ldsw = (unsigned)wid * 1024u;
    const int aoff = lds_byte(wr * 64 + fr, fq * 8), boff = lds_byte(wc * 32 + fr, fq * 8);
#define PG8_SA(b, h) (((b) * 2 + (h)) * HTB)
#define PG8_SB(b, h) ((4 + (b) * 2 + (h)) * HTB)
#define PG8_STAGE(bufoff, gbase, voff) do { _Pragma("unroll") for (int _i = 0; _i < 2; ++_i) \
        __builtin_amdgcn_global_load_lds((const unsigned*)((const char*)(gbase) + (voff)[_i]), (LAS unsigned*)(lds + (bufoff) + ldsw + _i * 8192), 16, 0, 0); } while (0)
#define PG8_LDA(dst, b, h) do { _Pragma("unroll") for (int m = 0; m < 4; ++m) _Pragma("unroll") for (int k = 0; k < 2; ++k) dst[m][k] = *(const LAS bf16x8*)(lds + PG8_SA(b, h) + aoff + m * 2048 + k * 1024); } while (0)
#define PG8_LDB(dst, b, h) do { _Pragma("unroll") for (int n = 0; n < 2; ++n) _Pragma("unroll") for (int k = 0; k < 2; ++k) dst[n][k] = *(const LAS bf16x8*)(lds + PG8_SB(b, h) + boff + n * 2048 + k * 1024); } while (0)
#define PG8_MMA(ai, bj, At, Bt) do { __builtin_amdgcn_s_setprio(1); _Pragma("unroll") for (int m = 0; m < 4; ++m) _Pragma("unroll") for (int n = 0; n < 2; ++n) _Pragma("unroll") for (int k = 0; k < 2; ++k) \
        acc[ai][bj][m][n] = __builtin_amdgcn_mfma_f32_16x16x32_bf16(Bt[n][k], At[m][k], acc[ai][bj][m][n], 0, 0, 0); __builtin_amdgcn_s_setprio(0); } while (0)
#define PG8_WAIT_V(n) asm volatile("s_waitcnt vmcnt(" #n ")" ::: "memory")
#define PG8_WAIT_L(n) asm volatile("s_waitcnt lgkmcnt(" #n ")" ::: "memory")
#define PG8_BAR __builtin_amdgcn_s_barrier()
#define PG8_SCHED __builtin_amdgcn_sched_barrier(0)
    Unit cur, nxt; int ui = 0;
    if (!S.next(0, cur)) return;
    Acc acc;
#pragma unroll
    for (int a = 0; a < 2; ++a)
#pragma unroll
        for (int b = 0; b < 2; ++b)
#pragma unroll
            for (int m = 0; m < 4; ++m)
#pragma unroll
                for (int n = 0; n < 2; ++n) acc[a][b][m][n] = (f32x4){0.f, 0.f, 0.f, 0.f};
    bf16x8 At[4][2], B0[2][2], B1[2][2];
    unsigned va[2][2], vn[2][2];
#pragma unroll
    for (int h = 0; h < 2; ++h)
#pragma unroll
        for (int i = 0; i < 2; ++i) va[h][i] = S.a_off(cur, h * 128 + sR[i]) + (unsigned)sC[i] * 2u;
    const char* const A0 = S.a_base(); const char* cB = S.b_base(cur);
    PG8_STAGE(PG8_SB(0, 0), cB, voffB); PG8_STAGE(PG8_SB(0, 1), cB + hstepB, voffB); PG8_STAGE(PG8_SA(0, 0), A0, va[0]); PG8_STAGE(PG8_SA(0, 1), A0, va[1]);
    if (wr == 1) PG8_BAR;
    PG8_WAIT_V(2); PG8_BAR;
    PG8_STAGE(PG8_SB(1, 0), cB + kstep, voffB); PG8_STAGE(PG8_SA(1, 0), A0 + kstep, va[0]); PG8_STAGE(PG8_SB(1, 1), cB + hstepB + kstep, voffB);
    PG8_WAIT_V(6); PG8_BAR;
    for (;;) {
        const bool has_next = S.next(ui + 1, nxt);
        const char* nB = has_next ? S.b_base(nxt) : cB;
#pragma unroll
        for (int h = 0; h < 2; ++h)
#pragma unroll
            for (int i = 0; i < 2; ++i) vn[h][i] = has_next ? (S.a_off(nxt, h * 128 + sR[i]) + (unsigned)sC[i] * 2u) : va[h][i];
        for (int t = 0; t < nt; t += 2) {
            const bool last = (t == nt - 2);
            if (Epi::MIDK != 0 && t * BK == Epi::MIDK) { PG8_SCHED; E.mid(acc, cur, wr, wc, fr, fq); PG8_SCHED; }
            const char* a1 = A0 + (size_t)(t + 1) * kstep;
            const char* a2 = last ? A0 : A0 + (size_t)(t + 2) * kstep; const char* b2 = last ? nB : cB + (size_t)(t + 2) * kstep;
            const char* a3 = a2 + kstep; const char* b3 = b2 + kstep;
            unsigned v2[2][2];
#pragma unroll
            for (int h = 0; h < 2; ++h)
#pragma unroll
                for (int i = 0; i < 2; ++i) v2[h][i] = last ? vn[h][i] : va[h][i];
            const bool full = !Sched::DYN_HALF || cur.nvalid > 128;
            PG8_LDB(B0, 0, 0); PG8_LDB(B1, 0, 1); PG8_SCHED; PG8_LDA(At, 0, 0); PG8_STAGE(PG8_SA(1, 1), a1, va[1]);
            PG8_WAIT_V(8); PG8_WAIT_L(0); PG8_BAR; PG8_MMA(0, 0, At, B0); PG8_MMA(0, 1, At, B1); PG8_BAR; PG8_SCHED;
            if (full) { PG8_LDA(At, 0, 1); } PG8_STAGE(PG8_SB(0, 0), b2, voffB); PG8_STAGE(PG8_SB(0, 1), b2 + hstepB, voffB); PG8_STAGE(PG8_SA(0, 0), a2, v2[0]);
            PG8_WAIT_V(8); PG8_WAIT_L(0); PG8_BAR; if (full) { PG8_MMA(1, 0, At, B0); PG8_MMA(1, 1, At, B1); } PG8_BAR; PG8_SCHED;
            PG8_LDB(B0, 1, 0); PG8_LDB(B1, 1, 1); PG8_SCHED; PG8_LDA(At, 1, 0); PG8_STAGE(PG8_SA(0, 1), a2, v2[1]);
            PG8_WAIT_V(8); PG8_WAIT_L(0); PG8_BAR; PG8_MMA(0, 0, At, B0); PG8_MMA(0, 1, At, B1); PG8_BAR; PG8_SCHED;
            if (full) { PG8_LDA(At, 1, 1); } PG8_STAGE(PG8_SB(1, 0), b3, voffB); PG8_STAGE(PG8_SB(1, 1), b3 + hstepB, voffB); PG8_STAGE(PG8_SA(1, 0), a3, v2[0]);
            PG8_WAIT_V(8); PG8_WAIT_L(0); PG8_BAR; if (full) { PG8_MMA(1, 0, At, B0); PG8_MMA(1, 1, At, B1); } PG8_BAR; PG8_SCHED;
        }
        if (wr == 0) PG8_BAR;
        E(acc, cur, wr, wc, fr, fq);
        if (!has_next) break;
#pragma unroll
        for (int a = 0; a < 2; ++a)
#pragma unroll
            for (int b = 0; b < 2; ++b)
#pragma unroll
                for (int m = 0; m < 4; ++m)
#pragma unroll
                    for (int n = 0; n < 2; ++n) acc[a][b][m][n] = (f32x4){0.f, 0.f, 0.f, 0.f};
        cur = nxt; cB = nB; ++ui;
#pragma unroll
        for (int h = 0; h < 2; ++h)
#pragma unroll
            for (int i = 0; i < 2; ++i) va[h][i] = vn[h][i];
        if (wr == 1) PG8_BAR;
    }
    PG8_WAIT_V(0);
    PG8_BAR;
#undef PG8_SA
#undef PG8_SB
#undef PG8_STAGE
#undef PG8_LDA
#undef PG8_LDB
#undef PG8_MMA
#undef PG8_WAIT_V
#undef PG8_WAIT_L
#undef PG8_BAR
#undef PG8_SCHED
}
#ifndef FAST_MASK
#define FAST_MASK 0x1f
#endif
template <int BIT, class Epi, class Sched>
__device__ __forceinline__ void gemm_run(LAS unsigned char* lds, const Sched& S, const Epi& E, const int K) {
    if constexpr ((FAST_MASK >> BIT) & 1) gemm_fast(lds, S, E, K); else gemm_simple(S, E, K);
}

__device__ __forceinline__ void tr_item64(const float* W, int N, int k0, int ns, bf16_t* WT, int ldk, int nd, int kd, LAS float* scr, int lane, const float* kscale) {
    { const int r4 = lane >> 4, c4 = (lane & 15) * 4; f32x4 v[16];
#pragma unroll
      for (int i = 0; i < 16; ++i) v[i] = __builtin_nontemporal_load((const f32x4*)(W + (size_t)(k0 + 4 * i + r4) * N + ns + c4));
#pragma unroll
      for (int i = 0; i < 16; ++i) { LAS float* d = scr + (4 * i + r4) * 65 + c4; d[0] = v[i][0]; d[1] = v[i][1]; d[2] = v[i][2]; d[3] = v[i][3]; } }
    const int c = lane & 7;
    f32x4 s0 = (f32x4){1.f, 1.f, 1.f, 1.f}, s1 = s0;
    if (kscale) { s0 = *(const f32x4*)(kscale + k0 + 8 * c); s1 = *(const f32x4*)(kscale + k0 + 8 * c + 4); }
    asm volatile("s_waitcnt lgkmcnt(0)" ::: "memory");
#pragma unroll
    for (int j = 0; j < 8; ++j) { const int n = (lane >> 3) + 8 * j; const LAS float* s = scr + (8 * c) * 65 + n;
        u32x4 o; o.x = cvt_pk_bf16(s[0 * 65] * s0[0], s[1 * 65] * s0[1]); o.y = cvt_pk_bf16(s[2 * 65] * s0[2], s[3 * 65] * s0[3]);
        o.z = cvt_pk_bf16(s[4 * 65] * s1[0], s[5 * 65] * s1[1]); o.w = cvt_pk_bf16(s[6 * 65] * s1[2], s[7 * 65] * s1[3]);
        *(u32x4*)(WT + (size_t)(nd + n) * ldk + kd + 8 * c) = o; }
    asm volatile("s_waitcnt lgkmcnt(0)" ::: "memory");
}
constexpr int TRS = 64 * 65 * 4;
static_assert(8 * TRS <= LDS_BYTES - 64, "transpose scratch vs barrier words");
struct TrItem { const float* W; int N; bf16_t* WT; int ldk, nd, kd, k0, ns; const float* ks; };
__device__ __forceinline__ void tr_load(f32x4 (&v)[16], const TrItem& it, int lane) {
    const int r4 = lane >> 4, c4 = (lane & 15) * 4;
#pragma unroll
    for (int i = 0; i < 16; ++i) v[i] = __builtin_nontemporal_load((const f32x4*)(it.W + (size_t)(it.k0 + 4 * i + r4) * it.N + it.ns + c4));
}
__device__ __forceinline__ void tr_store(const f32x4 (&v)[16], const TrItem& it, LAS float* scr, int lane) {
    { const int r4 = lane >> 4, c4 = (lane & 15) * 4;
#pragma unroll
      for (int i = 0; i < 16; ++i) { LAS float* d = scr + (4 * i + r4) * 65 + c4; d[0] = v[i][0]; d[1] = v[i][1]; d[2] = v[i][2]; d[3] = v[i][3]; } }
    const int c = lane & 7;
    f32x4 s0 = (f32x4){1.f, 1.f, 1.f, 1.f}, s1 = s0;
    if (it.ks) { s0 = *(const f32x4*)(it.ks + it.k0 + 8 * c); s1 = *(const f32x4*)(it.ks + it.k0 + 8 * c + 4); }
    asm volatile("s_waitcnt lgkmcnt(0)" ::: "memory");
#pragma unroll
    for (int j = 0; j < 8; ++j) { const int n = (lane >> 3) + 8 * j; const LAS float* s = scr + (8 * c) * 65 + n;
        u32x4 o; o.x = cvt_pk_bf16(s[0 * 65] * s0[0], s[1 * 65] * s0[1]); o.y = cvt_pk_bf16(s[2 * 65] * s0[2], s[3 * 65] * s0[3]);
        o.z = cvt_pk_bf16(s[4 * 65] * s1[0], s[5 * 65] * s1[1]); o.w = cvt_pk_bf16(s[6 * 65] * s1[2], s[7 * 65] * s1[3]);
        __builtin_nontemporal_store(o, (u32x4*)(it.WT + (size_t)(it.nd + n) * it.ldk + it.kd + 8 * c)); }
    asm volatile("s_waitcnt lgkmcnt(0)" ::: "memory");
}
constexpr int NIT_EXP = 8192 + 4096;
__device__ __forceinline__ TrItem exp_item(const Params& p, int r) {
    TrItem it;
    if (r < 8192) { const int up = r >> 12, qq = r & 4095, e = qq >> 8, kb = (qq & 255) >> 3, nb = qq & 7;
        it.W = p.in[up ? 17 : 16] + (size_t)e * D * DE; it.N = DE; it.WT = (bf16_t*)(p.ws + WS_W1T) + (size_t)e * 1024 * D; it.ldk = D;
        it.nd = 256 * (nb >> 1) + (nb & 1) * 64 + (up ? 128 : 0); it.kd = kb * 64; it.k0 = kb * 64; it.ns = nb * 64; it.ks = p.in[11]; }
    else { const int q = r - 8192, e = q >> 8, kb = (q & 255) >> 5, nb = q & 31;
        it.W = p.in[18] + (size_t)e * DE * D; it.N = D; it.WT = (bf16_t*)(p.ws + WS_W2T) + (size_t)e * D * DE; it.ldk = DE; it.nd = nb * 64; it.kd = kb * 64; it.k0 = kb * 64; it.ns = nb * 64; it.ks = nullptr; }
    return it;
}
__device__ __forceinline__ void convert_tail(const Params& p, LAS unsigned char* lds, int nunits) {
    const int tid = opaque_tid(), wave = __builtin_amdgcn_readfirstlane(tid >> 6), lane = tid & 63;
    const int G = gridDim.x, rounds = (nunits + G - 1) / G, nfull = nunits - (rounds - 1) * G;
    int idle_idx, n_idle;
    if (nfull >= G || nunits == 0) { idle_idx = blockIdx.x; n_idle = G; } else { idle_idx = (int)blockIdx.x - nfull; n_idle = G - nfull; }
    if (idle_idx < 0) return;
    LAS float* scr = (LAS float*)(lds + wave * TRS);
    const int stride = n_idle * NWAVES; int r = idle_idx * NWAVES + wave;
    if (r >= NIT_EXP) return;
    f32x4 va[16], vb[16];
    TrItem ia = exp_item(p, r), ib = ia;
    tr_load(va, ia, lane);
    for (;;) {
        const bool hb = (r + stride) < NIT_EXP;
        if (hb) { ib = exp_item(p, r + stride); tr_load(vb, ib, lane); }
        tr_store(va, ia, scr, lane);
        if (!hb) break;
        r += stride;
        const bool ha = (r + stride) < NIT_EXP;
        if (ha) { ia = exp_item(p, r + stride); tr_load(va, ia, lane); }
        tr_store(vb, ib, scr, lane);
        if (!ha) break;
        r += stride;
    }
}
__device__ __forceinline__ int win_src_col(int nd) {
    if (nd < 1024) return nd;
    if (nd < 3072) { const int q = (nd - 1024) >> 8, r = (nd - 1024) & 255; return r < 128 ? (1024 + 128 * q + r) : (2048 + 128 * q + r - 128); }
    if (nd < 5120) return nd;
    { const int q = (nd - 5120) >> 8, r = (nd - 5120) & 255; return r < 128 ? (5120 + 128 * q + r) : (7168 + 128 * q + r - 128); }
}
__device__ __forceinline__ void phase0(const Params& p, LAS unsigned char* lds) {
    const int tid = opaque_tid(), wave = __builtin_amdgcn_readfirstlane(tid >> 6), lane = tid & 63;
    LAS float* scr = (LAS float*)(lds + wave * TRS);
    const int gw = blockIdx.x * NWAVES + wave, NGW = gridDim.x * NWAVES;
    unsigned char* ws = p.ws;
    constexpr int I_IN = 32 * 144, I_UP = 16 * 32, I_OUT = 32 * 32;
    constexpr int NITEMS = I_IN + 2 * I_UP + I_OUT;
    for (int it = gw; it < NITEMS; it += NGW) {
        int r = it;
        if (r < I_IN) { const int kb = r / 144, nb = r % 144; tr_item64(p.in[2], NIN, kb * 64, win_src_col(nb * 64), (bf16_t*)(ws + WS_WINT), D, nb * 64, kb * 64, scr, lane, nullptr); continue; } r -= I_IN;
        if (r < I_UP) { const int kb = r / 32, nb = r % 32; tr_item64(p.in[8], D, kb * 64, nb * 64, (bf16_t*)(ws + WS_WUPT), 2048, nb * 64, kb * 64, scr, lane, nullptr); continue; } r -= I_UP;
        if (r < I_UP) { const int kb = r / 32, nb = r % 32; tr_item64(p.in[9], D, kb * 64, nb * 64, (bf16_t*)(ws + WS_WUPT), 2048, nb * 64, 1024 + kb * 64, scr, lane, nullptr); continue; } r -= I_UP;
        { const int kb = r / 32, nb = r % 32; tr_item64(p.in[10], D, kb * 64, nb * 64, (bf16_t*)(ws + WS_WOUTT), D, nb * 64, kb * 64, scr, lane, nullptr); }
    }
    const float* x = p.in[0]; const float* g = p.in[1]; bf16_t* xn = (bf16_t*)(ws + WS_X);
    for (int m = gw; m < T; m += NGW) {
        const f32x4* xr = (const f32x4*)(x + (size_t)m * D) + lane; f32x4 v[8]; float s = 0.f;
#pragma unroll
        for (int j = 0; j < 8; ++j) { v[j] = __builtin_nontemporal_load(xr + 64 * j); s += (v[j][0] * v[j][0] + v[j][1] * v[j][1]) + (v[j][2] * v[j][2] + v[j][3] * v[j][3]); }
        const float rs = 1.0f / sqrtf(wave_sum(s) * (1.0f / D) + EPS);
        u32x2* o = (u32x2*)(xn + (size_t)m * D) + lane;
#pragma unroll
        for (int j = 0; j < 8; ++j) { const f32x4 gg = *((const f32x4*)g + lane + 64 * j); u32x2 w; w.x = cvt_pk_bf16(v[j][0] * rs * gg[0], v[j][1] * rs * gg[1]); w.y = cvt_pk_bf16(v[j][2] * rs * gg[2], v[j][3] * rs * gg[3]); o[64 * j] = w; }
    }
    { bf16_t* wr = (bf16_t*)(ws + WS_WR); const float* gf = p.in[11];
      for (int i = blockIdx.x * NTHREADS + tid; i < 32 * D; i += gridDim.x * NTHREADS) { const int j = i / D, d = i % D; unsigned hi = 0, lo = 0;
          if (j < 20) { const float v = gf[d] * (j < 4 ? p.in[12][d * 4 + j] : p.in[14][d * 16 + (j - 4)]); hi = cvt_pk_bf16(v, 0.f) & 0xffffu; lo = cvt_pk_bf16(v - __uint_as_float(hi << 16), 0.f) & 0xffffu; }
          wr[(size_t)j * D + d] = (bf16_t)hi; wr[(size_t)(32 + j) * D + d] = (bf16_t)lo; } }
    { bf16_t* wmb = (bf16_t*)(ws + WS_WMB); const float* wsrc = p.in[6];
      for (int i = blockIdx.x * NTHREADS + tid; i < 8 * 128 * 128 / 2; i += gridDim.x * NTHREADS) { const int e0 = 2 * i, r = (e0 >> 7) & 127, c = e0 & 127; const bool ok = (r >= 64) || (c < 64);
          ((unsigned*)wmb)[i] = ok ? cvt_pk_bf16(wsrc[e0], wsrc[e0 + 1]) : 0u; } }
    if (blockIdx.x == 0 && tid < 64) ((int*)(ws + WS_CTL))[tid] = 0;
}

__device__ __forceinline__ void phase2_conv(const Params& p) {
    const bf16_t* Bc = (const bf16_t*)(p.ws + WS_P + P_BC); const bf16_t* P = (const bf16_t*)(p.ws + WS_P + P_P); bf16_t* Y = (bf16_t*)(p.ws + WS_X);
    const float* cw = p.in[3];
    for (int i = blockIdx.x * NTHREADS + opaque_tid(); i < T * (CW / 8); i += gridDim.x * NTHREADS) {
        const int t = i >> 7, c = (i & 127) * 8;
        f32x4 p0a, p0b, p1a, p1b, p2a, p2b, ba, bb;
        unpack8(*(const u32x4*)(P + (size_t)t * CW + c), p2a, p2b); unpack8(*(const u32x4*)(Bc + (size_t)t * CW + c), ba, bb);
        if (t >= 1) unpack8(*(const u32x4*)(P + (size_t)(t - 1) * CW + c), p1a, p1b); else { p1a = (f32x4){0, 0, 0, 0}; p1b = p1a; }
        if (t >= 2) unpack8(*(const u32x4*)(P + (size_t)(t - 2) * CW + c), p0a, p0b); else { p0a = (f32x4){0, 0, 0, 0}; p0b = p0a; }
        const f32x4 w0a = *(const f32x4*)(cw + c), w0b = *(const f32x4*)(cw + c + 4), w1a = *(const f32x4*)(cw + CW + c), w1b = *(const f32x4*)(cw + CW + c + 4),
                    w2a = *(const f32x4*)(cw + 2 * CW + c), w2b = *(const f32x4*)(cw + 2 * CW + c + 4);
        const f32x4 ya = ba * (w0a * p0a + w1a * p1a + w2a * p2a), yb = bb * (w0b * p0b + w1b * p1b + w2b * p2b);
        *(u32x4*)(Y + (size_t)t * 2048 + c) = pack8(ya, yb);
    }
}
__device__ __forceinline__ void phase2_sgu(const Params& p, LAS unsigned char* lds) {
    const int tid = opaque_tid(), wave = __builtin_amdgcn_readfirstlane(tid >> 6), lane = tid & 63, fr = lane & 15, fq = lane >> 4;
    const bf16_t* U = (const bf16_t*)(p.ws + WS_P + P_U); const bf16_t* V = (const bf16_t*)(p.ws + WS_P + P_V); bf16_t* Y = (bf16_t*)(p.ws + WS_X);
    const bf16_t* WmB = (const bf16_t*)(p.ws + WS_WMB); const f32x2* VST = (const f32x2*)(p.ws + WS_SMALL + SM_VST);
    const float* lng = p.in[4]; const float* lnb = p.in[5]; const float* bs = p.in[7];
    LAS f32x2* st = (LAS f32x2*)lds;
    LAS unsigned char* vT = lds + 1024;
    constexpr int VP = 272;
    for (int unit = blockIdx.x; unit < 64 * 8; unit += gridDim.x) {
        const int nb = unit >> 3, h = unit & 7, t0 = nb * 128, c0 = h * 128;
        __syncthreads();
        if (tid < 128) { const f32x4* ps = (const f32x4*)(VST + (size_t)(t0 + tid) * 16); float s = 0.f, q = 0.f;
#pragma unroll
            for (int i = 0; i < 8; ++i) { const f32x4 v = ps[i]; s += v[0] + v[2]; q += v[1] + v[3]; }
            const float mu = s * (1.0f / SW); const float var = fmaxf(q * (1.0f / SW) - mu * mu, 0.f);
            st[tid] = (f32x2){mu, 1.0f / sqrtf(var + EPS)}; }
        __syncthreads();
        if (tid < 256) {
            const int jb = tid >> 4, cb = tid & 15, j0 = jb * 8, cc0 = cb * 8;
            const f32x4 g0 = *(const f32x4*)(lng + c0 + cc0), g1 = *(const f32x4*)(lng + c0 + cc0 + 4), b0 = *(const f32x4*)(lnb + c0 + cc0), b1 = *(const f32x4*)(lnb + c0 + cc0 + 4);
            f32x4 lo[8], hi[8];
#pragma unroll
            for (int r = 0; r < 8; ++r) { const f32x2 s = st[j0 + r]; f32x4 a, b; unpack8(*(const u32x4*)(V + (size_t)(t0 + j0 + r) * SW + c0 + cc0), a, b);
                lo[r] = (a - s.x) * s.y * g0 + b0; hi[r] = (b - s.x) * s.y * g1 + b1; }
#pragma unroll
            for (int cc = 0; cc < 4; ++cc) { u32x4 o;
                o.x = cvt_pk_bf16(lo[0][cc], lo[1][cc]); o.y = cvt_pk_bf16(lo[2][cc], lo[3][cc]); o.z = cvt_pk_bf16(lo[4][cc], lo[5][cc]); o.w = cvt_pk_bf16(lo[6][cc], lo[7][cc]);
                *(LAS u32x4*)(vT + (cc0 + cc) * VP + j0 * 2) = o;
                o.x = cvt_pk_bf16(hi[0][cc], hi[1][cc]); o.y = cvt_pk_bf16(hi[2][cc], hi[3][cc]); o.z = cvt_pk_bf16(hi[4][cc], hi[5][cc]); o.w = cvt_pk_bf16(hi[6][cc], hi[7][cc]);
                *(LAS u32x4*)(vT + (cc0 + 4 + cc) * VP + j0 * 2) = o; }
        }
        __syncthreads();
        bf16x8 wf[4];
#pragma unroll
        for (int ks = 0; ks < 4; ++ks) wf[ks] = *(const bf16x8*)(WmB + ((size_t)h * 128 + wave * 16 + fr) * 128 + ks * 32 + fq * 8);
        f32x4 acc[8];
#pragma unroll
        for (int nk = 0; nk < 8; ++nk) { acc[nk] = (f32x4){0.f, 0.f, 0.f, 0.f};
#pragma unroll
            for (int ks = 0; ks < 4; ++ks) { const bf16x8 vf = *(const LAS bf16x8*)(vT + (nk * 16 + fr) * VP + (ks * 32 + fq * 8) * 2);
                acc[nk] = __builtin_amdgcn_mfma_f32_16x16x32_bf16(vf, wf[ks], acc[nk], 0, 0, 0); } }
        { const int i = wave * 16 + fr; const float bb = bs[h * 128 + i]; const size_t t = (size_t)(t0 + i);
#pragma unroll
          for (int nk = 0; nk < 8; ++nk) { const int c = c0 + nk * 16 + 4 * fq; const u32x2 uu = *(const u32x2*)(U + t * SW + c);
              u32x2 o; o.x = cvt_pk_bf16(bf_lo(uu.x) * (acc[nk][0] + bb), bf_hi(uu.x) * (acc[nk][1] + bb)); o.y = cvt_pk_bf16(bf_lo(uu.y) * (acc[nk][2] + bb), bf_hi(uu.y) * (acc[nk][3] + bb));
              *(u32x2*)(Y + t * 2048 + 1024 + c) = o; } }
    }
}

__device__ __forceinline__ void phase5_router(const Params& p, LAS unsigned char* lds) {
    const int tid = opaque_tid(), wave = __builtin_amdgcn_readfirstlane(tid >> 6), lane = tid & 63, fr = lane & 15, fq = lane >> 4;
    const bf16_t* A2 = (const bf16_t*)(p.ws + WS_A2); const bf16_t* wr = (const bf16_t*)(p.ws + WS_WR);
    float* rstd = (float*)(p.ws + WS_SMALL + SM_RSTD); int* ent = (int*)(p.ws + WS_SMALL + SM_ENT); float* lw = (float*)(p.ws + WS_SMALL + SM_W); int* cnt = (int*)(p.ws + WS_CTL); int* ovf = (int*)(p.ws + WS_SMALL + SM_OVF);
    const float* brg = p.in[13]; const float* bre = p.in[15];
    LAS float* part = (LAS float*)lds;
    LAS float* pss  = (LAS float*)(lds + 65536);
    LAS float* lg   = (LAS float*)(lds + 65536 + 1024);
    LAS float* lss  = (LAS float*)(lds + 65536 + 1024 + 2560);
    LAS int* lcnt  = (LAS int*)(lds + 70000);
    LAS int* lbase = (LAS int*)(lds + 70000 + 64);
    LAS int* le    = (LAS int*)(lds + 70000 + 128);
    LAS int* lp    = (LAS int*)(lds + 70000 + 128 + 256);
    LAS float* lwt = (LAS float*)(lds + 70000 + 128 + 512);
    for (int tile = blockIdx.x; tile < T / 32; tile += gridDim.x) {
        const int tok0 = tile * 32;
        __syncthreads();
        if (tid < 16) lcnt[tid] = 0;
        f32x4 acc[2][4]; float ss[2] = {0.f, 0.f};
#pragma unroll
        for (int m = 0; m < 2; ++m)
#pragma unroll
            for (int n = 0; n < 4; ++n) acc[m][n] = (f32x4){0.f, 0.f, 0.f, 0.f};
#pragma unroll 2
        for (int ks = 0; ks < 8; ++ks) {
            const int k = wave * 256 + ks * 32 + fq * 8;
            bf16x8 af[2], bfr[4];
#pragma unroll
            for (int m = 0; m < 2; ++m) af[m] = *(const bf16x8*)(A2 + (size_t)(tok0 + 16 * m + fr) * D + k);
#pragma unroll
            for (int n = 0; n < 4; ++n) bfr[n] = *(const bf16x8*)(wr + (size_t)(16 * n + fr) * D + k);
#pragma unroll
            for (int m = 0; m < 2; ++m) {
#pragma unroll
                for (int j = 0; j < 8; ++j) { const float v = bf1((bf16_t)af[m][j]); ss[m] += v * v; }
#pragma unroll
                for (int n = 0; n < 4; ++n) acc[m][n] = __builtin_amdgcn_mfma_f32_16x16x32_bf16(bfr[n], af[m], acc[m][n], 0, 0, 0);
            }
        }
#pragma unroll
        for (int m = 0; m < 2; ++m) { ss[m] += __shfl_xor(ss[m], 16); ss[m] += __shfl_xor(ss[m], 32);
            if (fq == 0) pss[wave * 32 + 16 * m + fr] = ss[m];
#pragma unroll
            for (int n = 0; n < 4; ++n) *(LAS f32x4*)(part + (wave * 32 + 16 * m + fr) * 64 + 16 * n + 4 * fq) = acc[m][n]; }
        __syncthreads();
        for (int i = tid; i < 32 * 20; i += NTHREADS) { const int t = i / 20, j = i % 20; float s = 0.f;
#pragma unroll
            for (int w = 0; w < 8; ++w) s += part[(w * 32 + t) * 64 + j] + part[(w * 32 + t) * 64 + 32 + j];
            lg[t * 20 + j] = s; }
        if (tid < 32) { float s = 0.f;
#pragma unroll
            for (int w = 0; w < 8; ++w) s += pss[w * 32 + tid];
            lss[tid] = s; }
        __syncthreads();
        if (tid < 32) {
            const int t = tid; const float rs = 1.0f / sqrtf(lss[t] * (1.0f / D) + EPS);
            float g4[4];
#pragma unroll
            for (int j = 0; j < 4; ++j) g4[j] = lg[t * 20 + j] * rs + brg[j];
            int gi = 0; float gm = g4[0];
#pragma unroll
            for (int j = 1; j < 4; ++j) if (g4[j] > gm) { gm = g4[j]; gi = j; }
            float den = 0.f;
#pragma unroll
            for (int j = 0; j < 4; ++j) den += __expf(g4[j] - gm);
            const float pg = 1.0f / den;
            float le4[4];
#pragma unroll
            for (int j = 0; j < 4; ++j) le4[j] = lg[t * 20 + 4 + gi * 4 + j] * rs + bre[gi * 4 + j];
            int i1 = 0; float m1 = le4[0];
#pragma unroll
            for (int j = 1; j < 4; ++j) if (le4[j] > m1) { m1 = le4[j]; i1 = j; }
            int i2 = -1; float m2 = -3.0e38f;
#pragma unroll
            for (int j = 0; j < 4; ++j) if (j != i1 && le4[j] > m2) { m2 = le4[j]; i2 = j; }
            const float ex = __expf(m2 - m1); const float w1 = pg / (1.0f + ex), w2 = pg * ex / (1.0f + ex);
            rstd[tok0 + t] = rs;
            const int e1 = gi * 4 + i1, e2 = gi * 4 + i2;
            le[2 * t] = e1; le[2 * t + 1] = e2; lwt[2 * t] = w1; lwt[2 * t + 1] = w2;
            lp[2 * t] = atomicAdd((int*)&lcnt[e1], 1); lp[2 * t + 1] = atomicAdd((int*)&lcnt[e2], 1);
        }
        __syncthreads();
        if (tid < 16) { const int n = lcnt[tid]; lbase[tid] = n ? atomicAdd(&cnt[tid], n) : 0; }
        __syncthreads();
        if (tid < 64) { const int e = le[tid]; const int pos = lbase[e] + lp[tid]; ent[e * T + pos] = (tok0 + (tid >> 1)) | ((tid & 1) << 16); lw[e * T + pos] = lwt[tid];
            int dirty = pos >= MOE_REG * 256; dirty |= __shfl_xor(dirty, 1); if ((tid & 1) == 0) ovf[tok0 + (tid >> 1)] = dirty; }
    }
}

__device__ __forceinline__ void phase8_final(const Params& p, int sel, int widx, int nw) {
    const int tid = opaque_tid(), wave = __builtin_amdgcn_readfirstlane(tid >> 6), lane = tid & 63;
    const bf16_t* A2 = (const bf16_t*)(p.ws + WS_A2); const bf16_t* Y0 = (const bf16_t*)(p.ws + WS_YK0); const bf16_t* Y1 = (const bf16_t*)(p.ws + WS_YK1); const float* g = p.in[19];
    const int* ovf = (const int*)(p.ws + WS_SMALL + SM_OVF);
    const int gw = widx * NWAVES + wave, NGW = nw * NWAVES;
    for (int m0 = gw; m0 < T; m0 += 2 * NGW) {
        const int m1 = m0 + NGW;
        bool do0 = true, do1 = m1 < T;
        if (sel != 0) { const int d0 = __builtin_amdgcn_readfirstlane(ovf[m0]); do0 = (sel == 1) != (d0 != 0);
                        if (do1) { const int d1 = __builtin_amdgcn_readfirstlane(ovf[m1]); do1 = (sel == 1) != (d1 != 0); } }
        u32x2 hh[2][8], ya[2][8], yb[2][8];
#pragma unroll
        for (int r = 0; r < 2; ++r) { const bool dr = r ? do1 : do0; const int m = r ? m1 : m0;
            if (dr) {
#pragma unroll
                for (int j = 0; j < 8; ++j) { const size_t o = (size_t)m * D + 4 * lane + 256 * j; hh[r][j] = *(const u32x2*)(A2 + o); ya[r][j] = *(const u32x2*)(Y0 + o); yb[r][j] = *(const u32x2*)(Y1 + o); } } }
#pragma unroll
        for (int r = 0; r < 2; ++r) { const bool dr = r ? do1 : do0; const int m = r ? m1 : m0;
            if (dr) {
                f32x4 v[8]; float s = 0.f;
#pragma unroll
                for (int j = 0; j < 8; ++j) { const u32x2 h2 = hh[r][j], a = ya[r][j], b = yb[r][j];
                    v[j][0] = bf_lo(h2.x) + (bf_lo(a.x) + bf_lo(b.x)); v[j][1] = bf_hi(h2.x) + (bf_hi(a.x) + bf_hi(b.x)); v[j][2] = bf_lo(h2.y) + (bf_lo(a.y) + bf_lo(b.y)); v[j][3] = bf_hi(h2.y) + (bf_hi(a.y) + bf_hi(b.y));
                    s += (v[j][0] * v[j][0] + v[j][1] * v[j][1]) + (v[j][2] * v[j][2] + v[j][3] * v[j][3]); }
                const float rs = 1.0f / sqrtf(wave_sum(s) * (1.0f / D) + EPS);
#pragma unroll
                for (int j = 0; j < 8; ++j) { const int c = 4 * lane + 256 * j; const f32x4 gg = *(const f32x4*)(g + c); __builtin_nontemporal_store(v[j] * rs * gg, (f32x4*)(p.out + (size_t)m * D + c)); } } }
    }
}

#define XB_TMO      128
#define XB_XCNT(j)  (256  + 64 * (j))
#define XB_XSUB(j)  (1280 + 64 * (j))
#define XB_XGEN(j)  (2304 + 64 * (j))
#define XB_TOP      3328
#define XB_TOPGEN   3392
#define XCD_BAR_WORDS 3456
#define XB_SPIN_CAP (1u << 18)
__device__ __forceinline__ unsigned xb_ld(unsigned* p)              { return __hip_atomic_load(p, __ATOMIC_RELAXED, __HIP_MEMORY_SCOPE_AGENT); }
__device__ __forceinline__ unsigned xb_add(unsigned* p, unsigned v) { return __hip_atomic_fetch_add(p, v, __ATOMIC_RELAXED, __HIP_MEMORY_SCOPE_AGENT); }
__device__ __forceinline__ unsigned xb_xcc_id() { return (unsigned)__builtin_amdgcn_s_getreg((3 << 11) | 20) & 0xFu; }
#define XB_SPIN(cond, bar) do { unsigned _sp = 0; while (cond) { __builtin_amdgcn_s_sleep(1); \
    if ((++_sp & 255u) == 0u) { if (xb_ld(&(bar)[XB_TMO])) break; if (_sp > XB_SPIN_CAP) { atomicAdd(&(bar)[XB_TMO], 1u); break; } } } } while (0)
struct XcdBarrier { unsigned* bar; unsigned x; volatile LAS unsigned* st; };
__device__ __forceinline__ XcdBarrier xcd_barrier_post(unsigned* bar, volatile LAS unsigned* st) {
    XcdBarrier b; b.bar = bar; b.x = xb_xcc_id(); b.st = st;
    if (threadIdx.x == 0) (void)xb_add(&bar[XB_XCNT(b.x)], 1u);
    return b;
}
__device__ __forceinline__ void xcd_barrier_complete(unsigned* bar, unsigned x, unsigned& nloc, unsigned& nx) {
    const unsigned G = gridDim.x * gridDim.y * gridDim.z;
    unsigned sum, cnt, mine, sp = 0u;
    for (;;) {
        sum = 0u; cnt = 0u; mine = 0u;
#pragma unroll
        for (unsigned j = 0; j < 16; ++j) { const unsigned c = xb_ld(&bar[XB_XCNT(j)]); sum += c; cnt += (c > 0u) ? 1u : 0u; mine = (j == x) ? c : mine; }
        if (sum == G) break;
        __builtin_amdgcn_s_sleep(1);
        if ((++sp & 255u) == 0u) { if (xb_ld(&bar[XB_TMO])) break; if (sp > XB_SPIN_CAP) { atomicAdd(&bar[XB_TMO], 1u); break; } }
    }
    nloc = mine > 0u ? mine : 1u; nx = cnt > 0u ? cnt : 1u;
}
__device__ __forceinline__ void xcd_barrier(const XcdBarrier& b) {
    asm volatile("s_waitcnt vmcnt(0)" ::: "memory");
    __syncthreads();
    if (threadIdx.x == 0) {
        unsigned* bar = b.bar;
        __builtin_amdgcn_s_waitcnt(0);
        unsigned nloc = b.st[0], nx = b.st[1];
        if (nloc == 0u) { xcd_barrier_complete(bar, b.x, nloc, nx); b.st[0] = nloc; b.st[1] = nx; }
        const unsigned old = xb_add(&bar[XB_XSUB(b.x)], 1u);
        const unsigned gen = old / nloc;
        if (old + 1u == (gen + 1u) * nloc) {
            __builtin_amdgcn_fence(__ATOMIC_RELEASE, "agent");
            asm volatile("s_waitcnt vmcnt(0)" ::: "memory");
            const unsigned og = xb_add(&bar[XB_TOP], 1u);
            const unsigned tg = og / nx;
            if (og + 1u == (tg + 1u) * nx) xb_add(&bar[XB_TOPGEN], 1u);
            else XB_SPIN(xb_ld(&bar[XB_TOPGEN]) == tg, bar);
            __builtin_amdgcn_fence(__ATOMIC_ACQUIRE, "agent");
            xb_add(&bar[XB_XGEN(b.x)], 1u);
            asm volatile("s_waitcnt vmcnt(0)" ::: "memory");
        } else {
            XB_SPIN(xb_ld(&bar[XB_XGEN(b.x)]) == gen, bar);
            __builtin_amdgcn_fence(__ATOMIC_ACQUIRE, "agent");
            asm volatile("s_waitcnt vmcnt(0)" ::: "memory");
        }
    }
    __syncthreads();
}

template <int PH> __device__ __forceinline__ void run_phase(const Params& p, LAS unsigned char* lds) {
    unsigned char* ws = p.ws;
    if constexpr (PH == 0) phase0(p, lds);
    if constexpr (PH == 1) { DenseSched S; S.init((const bf16_t*)(ws + WS_X), (const bf16_t*)(ws + WS_WINT), T, NIN, D);
        EpiProj E{(bf16_t*)(ws + WS_P + P_BC), (bf16_t*)(ws + WS_P + P_P), (bf16_t*)(ws + WS_P + P_U), (bf16_t*)(ws + WS_P + P_V), (bf16_t*)(ws + WS_P + P_R), (bf16_t*)(ws + WS_P + P_S), (f32x2*)(ws + WS_SMALL + SM_VST)};
        gemm_run<0>(lds, S, E, D); convert_tail(p, lds, (T / 256) * (NIN / 256)); }
    if constexpr (PH == 2) { phase2_conv(p); phase2_sgu(p, lds); }
    if constexpr (PH == 3) { DenseSched S; S.init((const bf16_t*)(ws + WS_X), (const bf16_t*)(ws + WS_WUPT), T, D, 2048);
        EpiUp E{(const bf16_t*)(ws + WS_P + P_R), (const bf16_t*)(ws + WS_P + P_S), (bf16_t*)(ws + WS_MM)}; gemm_run<1>(lds, S, E, 2048); }
    if constexpr (PH == 4) { DenseSched S; S.init((const bf16_t*)(ws + WS_MM), (const bf16_t*)(ws + WS_WOUTT), T, D, D);
        EpiOut E{p.in[0], (bf16_t*)(ws + WS_A2)}; gemm_run<2>(lds, S, E, D); }
    if constexpr (PH == 5) phase5_router(p, lds);
    if constexpr (PH == 6 || PH == 7 || PH == 9) {
        const int* cnt = (const int*)(ws + WS_CTL); const int* ent = (const int*)(ws + WS_SMALL + SM_ENT); const int G = gridDim.x, c = blockIdx.x;
        EpiMoe1 E1{ent, (const float*)(ws + WS_SMALL + SM_W), (const float*)(ws + WS_SMALL + SM_RSTD), (bf16_t*)(ws + WS_HID)};
        EpiMoe2 E2{ent, (bf16_t*)(ws + WS_YK0), (bf16_t*)(ws + WS_YK1)};
        typedef MoeSched<true, 4, D, 1024> S1T; typedef MoeSched<false, 8, DE, D> S2T;
        if constexpr (PH == 6) {
            S1T S{(const bf16_t*)(ws + WS_A2), (const bf16_t*)(ws + WS_W1T), cnt, ent, 0, c, G}; gemm_run<3>(lds, S, E1, D); }
        if constexpr (PH == 7) {
            const int UH = moe_overflow_tiles(cnt) * 4;
            if (UH > G / 2) { S1T S{(const bf16_t*)(ws + WS_A2), (const bf16_t*)(ws + WS_W1T), cnt, ent, 1, c, G}; gemm_run<3>(lds, S, E1, D); }
            else if (c < UH) { S1T S{(const bf16_t*)(ws + WS_A2), (const bf16_t*)(ws + WS_W1T), cnt, ent, 1, c, UH}; gemm_run<3>(lds, S, E1, D); }
            else { S2T S{(const bf16_t*)(ws + WS_HID), (const bf16_t*)(ws + WS_W2T), cnt, ent, 0, c - UH, G - UH}; gemm_run<4>(lds, S, E2, DE); } }
        if constexpr (PH == 9) {
            const int UH = moe_overflow_tiles(cnt) * 4, UC = UH * 2;
            if (UH > G / 2) { S2T S{(const bf16_t*)(ws + WS_HID), (const bf16_t*)(ws + WS_W2T), cnt, ent, 2, c, G}; gemm_run<4>(lds, S, E2, DE); }
            else if (c < UC) { S2T S{(const bf16_t*)(ws + WS_HID), (const bf16_t*)(ws + WS_W2T), cnt, ent, 1, c, UC}; gemm_run<4>(lds, S, E2, DE); }
            else phase8_final(p, 1, c - UC, G - UC); }
    }
    if constexpr (PH == 8) { const int UH = moe_overflow_tiles((const int*)(ws + WS_CTL)) * 4; phase8_final(p, (UH > (int)gridDim.x / 2) ? 0 : 2, blockIdx.x, gridDim.x); }
}

template <int PH> __global__ void __launch_bounds__(NTHREADS, 2) k_phase(Params p) {
    extern __shared__ __attribute__((aligned(16))) unsigned char lds_raw[];
    run_phase<PH>(p, (LAS unsigned char*)lds_raw);
}

#ifndef PROBE_DUP
#define PROBE_DUP 0
#endif
#ifndef PROBE_SYNCS
#define PROBE_SYNCS 0
#endif
#define DUP(k) ((PROBE_DUP >> (k)) & 1)
#ifndef PROBE_T
#define PROBE_T (-1)
#endif
#ifndef PROBE_MULT
#define PROBE_MULT 4
#endif
typedef const __attribute__((address_space(4))) Params* KParamsPtr;
__device__ __forceinline__ Params load_params() {
    Params r{};
#if defined(__HIP_DEVICE_COMPILE__)
    unsigned long long v = (unsigned long long)__builtin_amdgcn_kernarg_segment_ptr(); asm volatile("" : "+s"(v));
    const __attribute__((address_space(4))) unsigned long long* q = (const __attribute__((address_space(4))) unsigned long long*)v;
#pragma unroll
    for (int i = 0; i < 20; ++i) r.in[i] = (const float*)(const __attribute__((address_space(1))) float*)q[i];
    r.out = (float*)(__attribute__((address_space(1))) float*)q[20]; r.ws = (unsigned char*)(__attribute__((address_space(1))) unsigned char*)q[21];
#endif
    return r;
}
#define RUN(k) do { const Params pk = load_params(); run_phase<k>(pk, lds); } while (0)
__global__ void __launch_bounds__(NTHREADS, 2) k_mega(Params p) {
    extern __shared__ __attribute__((aligned(16))) unsigned char lds_raw[];
    LAS unsigned char* lds = (LAS unsigned char*)lds_raw;
    cg::grid_group grid = cg::this_grid();
    volatile LAS unsigned* xbst = (volatile LAS unsigned*)(lds + LDS_BYTES - 64);
    if (threadIdx.x < 4) xbst[threadIdx.x] = 0u;
    __syncthreads();
    const XcdBarrier bar = xcd_barrier_post((unsigned*)(p.ws + WS_BAR), xbst);
    volatile LAS unsigned long long* stamps = (volatile LAS unsigned long long*)(lds + LDS_BYTES - 256);
    int nstamp = 0;
#define STAMP() do { if (PROBE_T >= 0 && blockIdx.x == 0 && threadIdx.x == 0) stamps[nstamp] = __builtin_amdgcn_s_memrealtime(); ++nstamp; } while (0)
#define GSYNC() do { xcd_barrier(bar); STAMP(); } while (0)
    STAMP();
    if (p.ws == nullptr) grid.sync();
    RUN(0); GSYNC();
    if (DUP(0)) { RUN(0); GSYNC(); }
    RUN(1); GSYNC();
    if (DUP(1)) { RUN(1); GSYNC(); }
    RUN(2); GSYNC();
    if (DUP(2)) { RUN(2); GSYNC(); }
    RUN(3); GSYNC();
    if (DUP(3)) { RUN(3); GSYNC(); }
    RUN(4); GSYNC();
    if (DUP(4)) { RUN(4); GSYNC(); }
    RUN(5); GSYNC();
    if (DUP(5)) { if (blockIdx.x == 0 && threadIdx.x < 16) ((int*)(load_params().ws + WS_CTL))[threadIdx.x] = 0; GSYNC(); RUN(5); GSYNC(); }
    RUN(6); GSYNC();
    if (DUP(6)) { RUN(6); GSYNC(); }
    RUN(7); GSYNC();
    if (DUP(7)) { RUN(7); GSYNC(); }
    RUN(9); GSYNC();
    if (DUP(9)) { RUN(9); GSYNC(); }
    for (int i = 0; i < PROBE_SYNCS; ++i) GSYNC();
    RUN(8);
    if (DUP(8)) { GSYNC(); RUN(8); }
    if (PROBE_T >= 0) { __syncthreads(); STAMP();
        if (blockIdx.x == 0 && threadIdx.x == 0) { const unsigned long long d = (stamps[PROBE_T + 1] - stamps[PROBE_T]) * PROBE_MULT; const unsigned long long t0 = __builtin_amdgcn_s_memrealtime();
            while (__builtin_amdgcn_s_memrealtime() - t0 < d) __builtin_amdgcn_s_sleep(8); } }
}

template <int PH> static void launch_phase(const Params& p, int grid, hipStream_t stream) {
    static bool attr = false;
    if (!attr) { (void)hipFuncSetAttribute((const void*)k_phase<PH>, hipFuncAttributeMaxDynamicSharedMemorySize, LDS_BYTES); attr = true; }
    hipLaunchKernelGGL(k_phase<PH>, dim3(grid), dim3(NTHREADS), LDS_BYTES, stream, p);
}

extern "C" void kernel_launch(void* const* d_in, const int* in_sizes, int n_in, void* d_out, int out_size, void* d_ws, size_t ws_size, hipStream_t stream) {
    static int grid = 0;
    if (grid == 0) {
        if (n_in != 20 || out_size != T * D || ws_size < WS_END) { fprintf(stderr, "kernel_launch: unexpected shapes n_in %d out %d ws %zu (need %zu)\n", n_in, out_size, ws_size, (size_t)WS_END); grid = -1; return; }
        int dev = 0, cus = 0, per_cu = 0;
        (void)hipGetDevice(&dev); (void)hipDeviceGetAttribute(&cus, hipDeviceAttributeMultiprocessorCount, dev);
        (void)hipFuncSetAttribute((const void*)k_mega, hipFuncAttributeMaxDynamicSharedMemorySize, LDS_BYTES);
        (void)hipOccupancyMaxActiveBlocksPerMultiprocessor(&per_cu, (const void*)k_mega, NTHREADS, LDS_BYTES);
        if (per_cu < 1) { fprintf(stderr, "kernel_launch: occupancy query says %d blocks per CU\n", per_cu); per_cu = 1; }
        grid = cus * 1;
        (void)hipGetLastError();
    }
    if (grid < 0) return;
    Params p{};
    for (int i = 0; i < 20; ++i) p.in[i] = (const float*)d_in[i];
    p.out = (float*)d_out; p.ws = (unsigned char*)d_ws;
    (void)hipMemsetAsync((char*)d_ws + WS_CTL, 0, 64 * 1024, stream);
#if ONE_LAUNCH
    void* args[] = {&p};
    hipError_t e = hipLaunchCooperativeKernel((const void*)k_mega, dim3(grid), dim3(NTHREADS), args, LDS_BYTES, stream);
    if (e != hipSuccess) fprintf(stderr, "cooperative launch failed: %s (grid %d)\n", hipGetErrorString(e), grid);
#else
    launch_phase<0>(p, grid, stream); launch_phase<1>(p, grid, stream); launch_phase<2>(p, grid, stream); launch_phase<3>(p, grid, stream); launch_phase<4>(p, grid, stream);
    launch_phase<5>(p, grid, stream); launch_phase<6>(p, grid, stream); launch_phase<7>(p, grid, stream); launch_phase<9>(p, grid, stream); launch_phase<8>(p, grid, stream);
#endif
}
```

```cpp
#include <hip/hip_runtime.h>
#include <hip/hip_cooperative_groups.h>
#include <cstdio>
#include <cstdint>
namespace cg = cooperative_groups;

#ifndef ONE_LAUNCH
#define ONE_LAUNCH 1
#endif

#define LAS __attribute__((address_space(3)))
typedef unsigned short bf16_t;
typedef short bf16x8 __attribute__((ext_vector_type(8)));
typedef float f32x4 __attribute__((ext_vector_type(4)));
typedef float f32x2 __attribute__((ext_vector_type(2)));
typedef unsigned u32x4 __attribute__((ext_vector_type(4)));
typedef unsigned u32x2 __attribute__((ext_vector_type(2)));

constexpr int T = 8192, D = 2048, CW = 1024, SW = 1024, NIN = 9216, NE = 16, DE = 512;
constexpr float EPS = 1e-6f;
constexpr int NTHREADS = 512, NWAVES = 8;
constexpr int LDS_BYTES = 140 * 1024;
constexpr int HID_ROWS = 2 * T + NE * 256;

constexpr size_t MiB = 1024 * 1024;
constexpr size_t WS_CTL   = 0;
constexpr size_t WS_BAR   = 4096;
constexpr size_t WS_SMALL = 64 * 1024;
constexpr size_t SM_RSTD = 0, SM_ENT = 32 * 1024, SM_W = SM_ENT + (size_t)NE * T * 4, SM_VST = SM_W + (size_t)NE * T * 4, SM_END = SM_VST + (size_t)T * 16 * 8;
constexpr size_t WS_WR    = WS_SMALL + 4 * MiB;
constexpr size_t WS_WMB   = WS_WR + 256 * 1024;
constexpr size_t WS_WINT  = WS_WMB + 256 * 1024;
constexpr size_t WS_WUPT  = WS_WINT + (size_t)NIN * D * 2;
constexpr size_t WS_WOUTT = WS_WUPT + (size_t)D * D * 2;
constexpr size_t WS_W1T   = WS_WOUTT + (size_t)D * D * 2;
constexpr size_t WS_W2T   = WS_W1T + (size_t)NE * 1024 * D * 2;
constexpr size_t WS_X     = WS_W2T + (size_t)NE * D * DE * 2;
constexpr size_t WS_P     = WS_X + (size_t)T * D * 2;
constexpr size_t P_BC = 0, P_P = P_BC + (size_t)T * CW * 2, P_U = P_P + (size_t)T * CW * 2, P_V = P_U + (size_t)T * SW * 2,
                 P_R = P_V + (size_t)T * SW * 2, P_S = P_R + (size_t)T * D * 2, P_END = P_S + (size_t)T * D * 2;
constexpr size_t WS_END   = WS_P + P_END;
constexpr size_t WS_MM  = WS_WINT;
constexpr size_t WS_H   = WS_P + P_BC;
constexpr size_t WS_A2  = WS_P + P_R;
constexpr size_t WS_HID = WS_P + P_S;
constexpr size_t WS_YK0 = WS_X;
constexpr size_t WS_YK1 = WS_WINT;
static_assert(SM_END <= 4 * MiB, "small region");
static_assert((size_t)HID_ROWS * DE * 2 <= (size_t)T * D * 2, "hid overlay");
static_assert((size_t)T * D * 4 <= P_R, "H overlay");

struct Params { const float* in[20]; float* out; unsigned char* ws; };

__device__ __forceinline__ unsigned cvt_pk_bf16(float lo, float hi) { unsigned r; asm("v_cvt_pk_bf16_f32 %0, %1, %2" : "=v"(r) : "v"(lo), "v"(hi)); return r; }
__device__ __forceinline__ float bf_lo(unsigned w) { return __uint_as_float(w << 16); }
__device__ __forceinline__ float bf_hi(unsigned w) { return __uint_as_float(w & 0xffff0000u); }
__device__ __forceinline__ float bf1(bf16_t b) { return __uint_as_float(((unsigned)b) << 16); }
__device__ __forceinline__ float wave_sum(float v) {
#pragma unroll
    for (int o = 1; o < 64; o <<= 1) v += __shfl_xor(v, o);
    return v;
}
__device__ __forceinline__ float fast_rcp(float x) { return __builtin_amdgcn_rcpf(x); }
__device__ __forceinline__ float fast_exp2(float x) { return __builtin_amdgcn_exp2f(x); }
__device__ __forceinline__ float sigmoid_f(float x) { return fast_rcp(1.0f + fast_exp2(-1.44269504f * x)); }
__device__ __forceinline__ float gelu_tanh(float x) {
    const float u = x + 0.044715f * x * x * x;
    return x * fast_rcp(1.0f + fast_exp2(-2.30220819f * u));
}
__device__ __forceinline__ int opaque_tid() { int t = threadIdx.x; asm volatile("" : "+v"(t)); return t; }
__host__ __device__ __forceinline__ int perm32(int rho) { const int n = rho >> 4, i = rho & 15; return 8 * (i >> 2) + 4 * n + (i & 3); }

struct Unit { int pm, pn, e, row0, nvalid; };
constexpr int NXCD = 8, WGM = 8;
struct DenseSched {
    static constexpr bool DYN_HALF = false;
    const bf16_t* A; const bf16_t* Bt; int K; int nM, nN, nwg, G, c;
    __device__ __forceinline__ void init(const bf16_t* A_, const bf16_t* Bt_, int M, int N, int K_) { A = A_; Bt = Bt_; K = K_; nM = M / 256; nN = N / 256; nwg = nM * nN; G = gridDim.x; c = blockIdx.x; }
    __device__ __forceinline__ bool next(int i, Unit& u) const {
        const long L = (long)i * G + c; if (L >= nwg) return false;
        int wgid = (int)L; { const int q = nwg / NXCD, r = nwg % NXCD, xcd = wgid % NXCD, off = wgid / NXCD; wgid = (xcd < r ? xcd * (q + 1) : r * (q + 1) + (xcd - r) * q) + off; }
        const int nig = WGM * nN, gid = wgid / nig, fm = gid * WGM, gsz = (nM - fm) < WGM ? (nM - fm) : WGM;
        u.pm = fm + ((wgid % nig) % gsz); u.pn = (wgid % nig) / gsz; u.e = 0; u.row0 = u.pm * 256; u.nvalid = 256; return true;
    }
    __device__ __forceinline__ const char* a_base() const { return (const char*)A; }
    __device__ __forceinline__ unsigned a_off(const Unit& u, int r) const { return (unsigned)(u.row0 + r) * (unsigned)K * 2u; }
    __device__ __forceinline__ const char* b_base(const Unit& u) const { return (const char*)Bt + (size_t)u.pn * 256 * K * 2; }
};
constexpr int MOE_REG = 4;
template <bool GATHER, int NPN, int KK, int NROWS_E  >
struct MoeSched {
    static constexpr bool DYN_HALF = true;
    const bf16_t* A; const bf16_t* Bt; const int* cnt; const int* ent; int mode, idx, stride, maxi;
    __device__ __forceinline__ bool next(int i, Unit& u) const {
        if (idx < 0 || i >= maxi) return false;
        int L = i * stride + idx; int hb = 0;
        for (int e = 0; e < NE; ++e) {
            const int n = __builtin_amdgcn_readfirstlane(cnt[e]); const int nt = (n + 255) >> 8;
            const int lo = (mode == 1) ? min(nt, MOE_REG) : 0, hi = (mode == 0) ? min(nt, MOE_REG) : nt;
            const int nsel = (hi - lo) * NPN;
            if (L < nsel) { u.e = e; u.pm = lo + L / NPN; u.pn = L % NPN; u.row0 = hb + u.pm * 256; u.nvalid = min(256, n - u.pm * 256); return true; }
            L -= nsel; hb += nt * 256;
        }
        return false;
    }
    __device__ __forceinline__ const char* a_base() const { return (const char*)A; }
    __device__ __forceinline__ unsigned a_off(const Unit& u, int r) const {
        if (GATHER) { const int tok = (r < u.nvalid) ? (ent[u.e * T + u.pm * 256 + r] & 0xffff) : 0; return (unsigned)tok * (unsigned)KK * 2u; }
        return (unsigned)(u.row0 + r) * (unsigned)KK * 2u;
    }
    __device__ __forceinline__ const char* b_base(const Unit& u) const { return (const char*)Bt + ((size_t)u.e * NROWS_E + (size_t)u.pn * 256) * KK * 2; }
};
__device__ __forceinline__ int moe_overflow_tiles(const int* cnt) { int t = 0; for (int e = 0; e < NE; ++e) { const int nt = (__builtin_amdgcn_readfirstlane(cnt[e]) + 255) >> 8; t += max(nt - MOE_REG, 0); } return t; }

typedef f32x4 Acc[2][2][4][2];
__device__ __forceinline__ u32x4 pack8(f32x4 a, f32x4 b) { u32x4 w; w.x = cvt_pk_bf16(a[0], a[1]); w.y = cvt_pk_bf16(a[2], a[3]); w.z = cvt_pk_bf16(b[0], b[1]); w.w = cvt_pk_bf16(b[2], b[3]); return w; }
__device__ __forceinline__ void unpack8(u32x4 w, f32x4& a, f32x4& b) { a = (f32x4){bf_lo(w.x), bf_hi(w.x), bf_lo(w.y), bf_hi(w.y)}; b = (f32x4){bf_lo(w.z), bf_hi(w.z), bf_lo(w.w), bf_hi(w.w)}; }

struct EpiProj {
    static constexpr bool PERM = true; static constexpr int MIDK = 0;
    bf16_t *Bc, *P, *U, *V, *R, *S; f32x2* VST;
    __device__ __forceinline__ void mid(Acc&, const Unit&, int, int, int, int) const {}
    __device__ __forceinline__ void operator()(const Acc& acc, const Unit& u, int wr, int wc, int fr, int fq) const {
        const int pn = u.pn; const int rowb = u.row0 + wr * 64 + fr; const int cl = wc * 32 + 8 * fq;
#pragma unroll
        for (int ai = 0; ai < 2; ++ai)
#pragma unroll
            for (int m = 0; m < 4; ++m) {
                const size_t row = (size_t)(rowb + ai * 128 + m * 16);
                if (pn < 4) {
#pragma unroll
                    for (int bj = 0; bj < 2; ++bj) *(u32x4*)(Bc + row * CW + pn * 256 + bj * 128 + cl) = pack8(acc[ai][bj][m][0], acc[ai][bj][m][1]);
                } else if (pn < 12) {
                    *(u32x4*)(P + row * CW + (pn - 4) * 128 + cl) = pack8(acc[ai][0][m][0] * acc[ai][1][m][0], acc[ai][0][m][1] * acc[ai][1][m][1]);
                } else if (pn < 20) {
                    bf16_t* O = (pn < 16) ? (U + row * SW + (pn - 12) * 256) : (V + row * SW + (pn - 16) * 256);
                    float ssum = 0.f, ssq = 0.f;
#pragma unroll
                    for (int bj = 0; bj < 2; ++bj) { f32x4 a = acc[ai][bj][m][0], b = acc[ai][bj][m][1];
#pragma unroll
                        for (int j = 0; j < 4; ++j) { a[j] = gelu_tanh(a[j]); b[j] = gelu_tanh(b[j]); ssum += a[j] + b[j]; ssq += a[j] * a[j] + b[j] * b[j]; }
                        *(u32x4*)(O + bj * 128 + cl) = pack8(a, b); }
                    if (pn >= 16) {
                        ssum += __shfl_xor(ssum, 16); ssum += __shfl_xor(ssum, 32); ssq += __shfl_xor(ssq, 16); ssq += __shfl_xor(ssq, 32);
                        if (fq == 0) VST[row * 16 + (pn - 16) * 4 + wc] = (f32x2){ssum, ssq}; }
                } else {
                    f32x4 r0, r1, s0, s1;
#pragma unroll
                    for (int j = 0; j < 4; ++j) {
                        const float ec0 = fast_exp2(-1.44269504f * acc[ai][0][m][0][j]), es0 = fast_exp2(-1.44269504f * acc[ai][1][m][0][j]);
                        const float ec1 = fast_exp2(-1.44269504f * acc[ai][0][m][1][j]), es1 = fast_exp2(-1.44269504f * acc[ai][1][m][1][j]);
                        r0[j] = (1.0f + es0) * fast_rcp(1.0f + ec0); s0[j] = fast_rcp(1.0f + es0);
                        r1[j] = (1.0f + es1) * fast_rcp(1.0f + ec1); s1[j] = fast_rcp(1.0f + es1);
                    }
                    const size_t o = row * D + (pn - 20) * 128 + cl;
                    *(u32x4*)(R + o) = pack8(r0, r1); *(u32x4*)(S + o) = pack8(s0, s1);
                }
            }
    }
};
struct EpiUp {
    static constexpr bool PERM = true; static constexpr int MIDK = 1024;
    const bf16_t *R, *S; bf16_t* Mm;
    __device__ __forceinline__ void mid(Acc& acc, const Unit& u, int wr, int wc, int fr, int fq) const {
        int rowb = u.row0 + wr * 64 + fr; const int cb = u.pn * 256 + wc * 32 + 8 * fq;
        asm volatile("" : "+v"(rowb));
#pragma unroll
        for (int ai = 0; ai < 2; ++ai)
#pragma unroll
            for (int m = 0; m < 4; ++m)
#pragma unroll
                for (int bj = 0; bj < 2; ++bj) { f32x4 a, b; unpack8(*(const u32x4*)(R + (size_t)(rowb + ai * 128 + m * 16) * D + cb + bj * 128), a, b);
                    acc[ai][bj][m][0] *= a; acc[ai][bj][m][1] *= b; }
    }
    __device__ __forceinline__ void operator()(const Acc& acc, const Unit& u, int wr, int wc, int fr, int fq) const {
        const int rowb = u.row0 + wr * 64 + fr; const int cb = u.pn * 256 + wc * 32 + 8 * fq;
#pragma unroll
        for (int ai = 0; ai < 2; ++ai)
#pragma unroll
            for (int m = 0; m < 4; ++m)
#pragma unroll
                for (int bj = 0; bj < 2; ++bj) { const size_t o = (size_t)(rowb + ai * 128 + m * 16) * D + cb + bj * 128; f32x4 a, b; unpack8(*(const u32x4*)(S + o), a, b);
                    *(u32x4*)(Mm + o) = pack8(acc[ai][bj][m][0] * a, acc[ai][bj][m][1] * b); }
    }
};
struct EpiOut {
    static constexpr bool PERM = true; static constexpr int MIDK = 0;
    const float* x; bf16_t* A2;
    __device__ __forceinline__ void mid(Acc&, const Unit&, int, int, int, int) const {}
    __device__ __forceinline__ void operator()(const Acc& acc, const Unit& u, int wr, int wc, int fr, int fq) const {
        const int rowb = u.row0 + wr * 64 + fr; const int cb = u.pn * 256 + wc * 32 + 8 * fq;
#pragma unroll
        for (int ai = 0; ai < 2; ++ai)
#pragma unroll
            for (int m = 0; m < 4; ++m)
#pragma unroll
                for (int bj = 0; bj < 2; ++bj) { const size_t o = (size_t)(rowb + ai * 128 + m * 16) * D + cb + bj * 128;
                    const f32x4 h0 = *(const f32x4*)(x + o) + acc[ai][bj][m][0], h1 = *(const f32x4*)(x + o + 4) + acc[ai][bj][m][1];
                    *(u32x4*)(A2 + o) = pack8(h0, h1); }
    }
};
struct EpiMoe1 {
    static constexpr bool PERM = true; static constexpr int MIDK = 0;
    const int* ent; const float* lw; const float* rstd; bf16_t* Hid;
    __device__ __forceinline__ void mid(Acc&, const Unit&, int, int, int, int) const {}
    __device__ __forceinline__ void operator()(const Acc& acc, const Unit& u, int wr, int wc, int fr, int fq) const {
        const int cl = u.pn * 128 + wc * 32 + 8 * fq;
#pragma unroll
        for (int ai = 0; ai < 2; ++ai)
#pragma unroll
            for (int m = 0; m < 4; ++m) {
                const int r = ai * 128 + wr * 64 + m * 16 + fr;
                if (r < u.nvalid) {
                    const int li = u.e * T + u.pm * 256 + r; const int tok = ent[li] & 0xffff; const float rs = rstd[tok], w = lw[li];
                    f32x4 o[2];
#pragma unroll
                    for (int n = 0; n < 2; ++n)
#pragma unroll
                        for (int j = 0; j < 4; ++j) { const float gt = acc[ai][0][m][n][j] * rs, up = acc[ai][1][m][n][j] * rs; o[n][j] = gt * sigmoid_f(gt) * up * w; }
                    *(u32x4*)(Hid + (size_t)(u.row0 + r) * DE + cl) = pack8(o[0], o[1]);
                }
            }
    }
};
struct EpiMoe2 {
    static constexpr bool PERM = true; static constexpr int MIDK = 0;
    const int* ent; bf16_t* Yk0; bf16_t* Yk1;
    __device__ __forceinline__ void mid(Acc&, const Unit&, int, int, int, int) const {}
    __device__ __forceinline__ void operator()(const Acc& acc, const Unit& u, int wr, int wc, int fr, int fq) const {
        const int cb = u.pn * 256 + wc * 32 + 8 * fq;
#pragma unroll
        for (int ai = 0; ai < 2; ++ai)
#pragma unroll
            for (int m = 0; m < 4; ++m) {
                const int r = ai * 128 + wr * 64 + m * 16 + fr;
                if (r < u.nvalid) {
                    const int en = ent[u.e * T + u.pm * 256 + r]; const int tok = en & 0xffff; bf16_t* Y = (en >> 16) ? Yk1 : Yk0;
#pragma unroll
                    for (int bj = 0; bj < 2; ++bj) *(u32x4*)(Y + (size_t)tok * D + cb + bj * 128) = pack8(acc[ai][bj][m][0], acc[ai][bj][m][1]);
                }
            }
    }
};

template <class Epi, class Sched>
__device__ __forceinline__ void gemm_simple(const Sched& S, const Epi& E, const int K) {
    const int tid = opaque_tid(), wid = __builtin_amdgcn_readfirstlane(tid >> 6), lane = tid & 63, wr = wid >> 2, wc = wid & 3, fr = lane & 15, fq = lane >> 4;
    Unit u;
    for (int ui = 0; S.next(ui, u); ++ui) {
        Acc acc;
#pragma unroll
        for (int a = 0; a < 2; ++a)
#pragma unroll
            for (int b = 0; b < 2; ++b)
#pragma unroll
                for (int m = 0; m < 4; ++m)
#pragma unroll
                    for (int n = 0; n < 2; ++n) acc[a][b][m][n] = (f32x4){0.f, 0.f, 0.f, 0.f};
        const char* ab = S.a_base(); const char* bb = S.b_base(u);
        unsigned aoff[2][4], boff[2][2];
#pragma unroll
        for (int ai = 0; ai < 2; ++ai)
#pragma unroll
            for (int m = 0; m < 4; ++m) aoff[ai][m] = S.a_off(u, ai * 128 + wr * 64 + m * 16 + fr) + fq * 16;
#pragma unroll
        for (int bj = 0; bj < 2; ++bj)
#pragma unroll
            for (int n = 0; n < 2; ++n) { const int rr = Epi::PERM ? perm32(n * 16 + fr) : (n * 16 + fr); boff[bj][n] = (unsigned)(bj * 128 + wc * 32 + rr) * (unsigned)K * 2u + fq * 16; }
        for (int k0 = 0; k0 < K; k0 += 32) {
            if (Epi::MIDK != 0 && k0 == Epi::MIDK) E.mid(acc, u, wr, wc, fr, fq);
            bf16x8 a[2][4], b[2][2];
#pragma unroll
            for (int ai = 0; ai < 2; ++ai)
#pragma unroll
                for (int m = 0; m < 4; ++m) a[ai][m] = *(const bf16x8*)(ab + aoff[ai][m] + k0 * 2);
#pragma unroll
            for (int bj = 0; bj < 2; ++bj)
#pragma unroll
                for (int n = 0; n < 2; ++n) b[bj][n] = *(const bf16x8*)(bb + boff[bj][n] + k0 * 2);
#pragma unroll
            for (int ai = 0; ai < 2; ++ai)
#pragma unroll
                for (int bj = 0; bj < 2; ++bj)
#pragma unroll
                    for (int m = 0; m < 4; ++m)
#pragma unroll
                        for (int n = 0; n < 2; ++n) acc[ai][bj][m][n] = __builtin_amdgcn_mfma_f32_16x16x32_bf16(b[bj][n], a[ai][m], acc[ai][bj][m][n], 0, 0, 0);
        }
        E(acc, u, wr, wc, fr, fq);
    }
}

constexpr int BK = 64, HALF = 128, HTB = HALF * BK * 2, STAGE_BYTES = 8 * HTB;
__host__ __device__ __forceinline__ int lds_byte(int r, int c) { const int st = (r >> 4) * 2 + (c >> 5), rr = r & 15, cc = c & 31, ob = rr * 64 + cc * 2; return st * 1024 + (ob ^ (((ob >> 9) & 1) << 5)); }
__host__ __device__ __forceinline__ void stage_rc(int b, int& R, int& C) { const int st = b / 1024, sb = b % 1024, swz = sb ^ (((sb >> 9) & 1) << 5); R = (st >> 1) * 16 + swz / 64; C = (st & 1) * 32 + (swz % 64) / 2; }

template <class Epi, class Sched>
__device__ __forceinline__ void gemm_fast(LAS unsigned char* lds, const Sched& S, const Epi& E, const int K) {
    const int tid = opaque_tid(), wid = __builtin_amdgcn_readfirstlane(tid >> 6), lane = tid & 63, wr = wid >> 2, wc = wid & 3, fr = lane & 15, fq = lane >> 4;
    const int nt = K / BK;
    int sR[2], sC[2]; unsigned voffB[2];
#pragma unroll
    for (int i = 0; i < 2; ++i) { stage_rc(tid * 16 + i * 8192, sR[i], sC[i]); const int Rb = Epi::PERM ? ((sR[i] & ~31) + perm32(sR[i] & 31)) : sR[i]; voffB[i] = (unsigned)(Rb * K + sC[i]) * 2u; }
    const size_t kstep = (size_t)(BK * 2);
    const size_t hstepB = (size_t)HALF * K * 2;
    const unsigned ldsw = (unsigned)wid * 1024u;
    const int aoff = lds_byte(wr * 64 + fr, fq * 8), boff = lds_byte(wc * 32 + fr, fq * 8);
#define PG8_SA(b, h) (((b) * 2 + (h)) * HTB)
#define PG8_SB(b, h) ((4 + (b) * 2 + (h)) * HTB)
#define PG8_STAGE(bufoff, gbase, voff) do { _Pragma("unroll") for (int _i = 0; _i < 2; ++_i) \
        __builtin_amdgcn_global_load_lds((const unsigned*)((const char*)(gbase) + (voff)[_i]), (LAS unsigned*)(lds + (bufoff) + ldsw + _i * 8192), 16, 0, 0); } while (0)
#define PG8_LDA(dst, b, h) do { _Pragma("unroll") for (int m = 0; m < 4; ++m) _Pragma("unroll") for (int k = 0; k < 2; ++k) dst[m][k] = *(const LAS bf16x8*)(lds + PG8_SA(b, h) + aoff + m * 2048 + k * 1024); } while (0)
#define PG8_LDB(dst, b, h) do { _Pragma("unroll") for (int n = 0; n < 2; ++n) _Pragma("unroll") for (int k = 0; k < 2; ++k) dst[n][k] = *(const LAS bf16x8*)(lds + PG8_SB(b, h) + boff + n * 2048 + k * 1024); } while (0)
#define PG8_MMA(ai, bj, At, Bt) do { __builtin_amdgcn_s_setprio(1); _Pragma("unroll") for (int m = 0; m < 4; ++m) _Pragma("unroll") for (int n = 0; n < 2; ++n) _Pragma("unroll") for (int k = 0; k < 2; ++k) \
        acc[ai][bj][m][n] = __builtin_amdgcn_mfma_f32_16x16x32_bf16(Bt[n][k], At[m][k], acc[ai][bj][m][n], 0, 0, 0); __builtin_amdgcn_s_setprio(0); } while (0)
#define PG8_WAIT_V(n) asm volatile("s_waitcnt vmcnt(" #n ")" ::: "memory")
#define PG8_WAIT_L(n) asm volatile("s_waitcnt lgkmcnt(" #n ")" ::: "memory")
#define PG8_BAR __builtin_amdgcn_s_barrier()
#define PG8_SCHED __builtin_amdgcn_sched_barrier(0)
    Unit cur, nxt; int ui = 0;
    if (!S.next(0, cur)) return;
    Acc acc;
#pragma unroll
    for (int a = 0; a < 2; ++a)
#pragma unroll
        for (int b = 0; b < 2; ++b)
#pragma unroll
            for (int m = 0; m < 4; ++m)
#pragma unroll
                for (int n = 0; n < 2; ++n) acc[a][b][m][n] = (f32x4){0.f, 0.f, 0.f, 0.f};
    bf16x8 At[4][2], B0[2][2], B1[2][2];
    unsigned va[2][2], vn[2][2];
#pragma unroll
    for (int h = 0; h < 2; ++h)
#pragma unroll
        for (int i = 0; i < 2; ++i) va[h][i] = S.a_off(cur, h * 128 + sR[i]) + (unsigned)sC[i] * 2u;
    const char* const A0 = S.a_base(); const char* cB = S.b_base(cur);
    PG8_STAGE(PG8_SB(0, 0), cB, voffB); PG8_STAGE(PG8_SB(0, 1), cB + hstepB, voffB); PG8_STAGE(PG8_SA(0, 0), A0, va[0]); PG8_STAGE(PG8_SA(0, 1), A0, va[1]);
    if (wr == 1) PG8_BAR;
    PG8_WAIT_V(2); PG8_BAR;
    PG8_STAGE(PG8_SB(1, 0), cB + kstep, voffB); PG8_STAGE(PG8_SA(1, 0), A0 + kstep, va[0]); PG8_STAGE(PG8_SB(1, 1), cB + hstepB + kstep, voffB);
    PG8_WAIT_V(6); PG8_BAR;
    for (;;) {
        const bool has_next = S.next(ui + 1, nxt);
        const char* nB = has_next ? S.b_base(nxt) : cB;
#pragma unroll
        for (int h = 0; h < 2; ++h)
#pragma unroll
            for (int i = 0; i < 2; ++i) vn[h][i] = has_next ? (S.a_off(nxt, h * 128 + sR[i]) + (unsigned)sC[i] * 2u) : va[h][i];
        for (int t = 0; t < nt; t += 2) {
            const bool last = (t == nt - 2);
            if (Epi::MIDK != 0 && t * BK == Epi::MIDK) { PG8_SCHED; E.mid(acc, cur, wr, wc, fr, fq); PG8_SCHED; }
            const char* a1 = A0 + (size_t)(t + 1) * kstep;
            const char* a2 = last ? A0 : A0 + (size_t)(t + 2) * kstep; const char* b2 = last ? nB : cB + (size_t)(t + 2) * kstep;
            const char* a3 = a2 + kstep; const char* b3 = b2 + kstep;
            unsigned v2[2][2];
#pragma unroll
            for (int h = 0; h < 2; ++h)
#pragma unroll
                for (int i = 0; i < 2; ++i) v2[h][i] = last ? vn[h][i] : va[h][i];
            const bool full = !Sched::DYN_HALF || cur.nvalid > 128;
            PG8_LDB(B0, 0, 0); PG8_LDB(B1, 0, 1); PG8_SCHED; PG8_LDA(At, 0, 0); PG8_STAGE(PG8_SA(1, 1), a1, va[1]);
            PG8_WAIT_V(8); PG8_WAIT_L(0); PG8_BAR; PG8_MMA(0, 0, At, B0); PG8_MMA(0, 1, At, B1); PG8_BAR; PG8_SCHED;
            if (full) { PG8_LDA(At, 0, 1); } PG8_STAGE(PG8_SB(0, 0), b2, voffB); PG8_STAGE(PG8_SB(0, 1), b2 + hstepB, voffB); PG8_STAGE(PG8_SA(0, 0), a2, v2[0]);
            PG8_WAIT_V(8); PG8_WAIT_L(0); PG8_BAR; if (full) { PG8_MMA(1, 0, At, B0); PG8_MMA(1, 1, At, B1); } PG8_BAR; PG8_SCHED;
            PG8_LDB(B0, 1, 0); PG8_LDB(B1, 1, 1); PG8_SCHED; PG8_LDA(At, 1, 0); PG8_STAGE(PG8_SA(0, 1), a2, v2[1]);
            PG8_WAIT_V(8); PG8_WAIT_L(0); PG8_BAR; PG8_MMA(0, 0, At, B0); PG8_MMA(0, 1, At, B1); PG8_BAR; PG8_SCHED;
            if (full) { PG8_LDA(At, 1, 1); } PG8_STAGE(PG8_SB(1, 0), b3, voffB); PG8_STAGE(PG8_SB(1, 1), b3 + hstepB, voffB); PG8_STAGE(PG8_SA(1, 0), a3, v2[0]);
            PG8_WAIT_V(8); PG8_WAIT_L(0); PG8_BAR; if (full) { PG8_MMA(1, 0, At, B0); PG8_MMA(1, 1, At, B1); } PG8_BAR; PG8_SCHED;
        }
        if (wr == 0) PG8_BAR;
        E(acc, cur, wr, wc, fr, fq);
        if (!has_next) break;
#pragma unroll
        for (int a = 0; a < 2; ++a)
#pragma unroll
            for (int b = 0; b < 2; ++b)
#pragma unroll
                for (int m = 0; m < 4; ++m)
#pragma unroll
                    for (int n = 0; n < 2; ++n) acc[a][b][m][n] = (f32x4){0.f, 0.f, 0.f, 0.f};
        cur = nxt; cB = nB; ++ui;
#pragma unroll
        for (int h = 0; h < 2; ++h)
#pragma unroll
            for (int i = 0; i < 2; ++i) va[h][i] = vn[h][i];
        if (wr == 1) PG8_BAR;
    }
    PG8_WAIT_V(0);
    PG8_BAR;
#undef PG8_SA
#undef PG8_SB
#undef PG8_STAGE
#undef PG8_LDA
#undef PG8_LDB
#undef PG8_MMA
#undef PG8_WAIT_V
#undef PG8_WAIT_L
#undef PG8_BAR
#undef PG8_SCHED
}
#ifndef FAST_MASK
#define FAST_MASK 0x1f
#endif
template <int BIT, class Epi, class Sched>
__device__ __forceinline__ void gemm_run(LAS unsigned char* lds, const Sched& S, const Epi& E, const int K) {
    if constexpr ((FAST_MASK >> BIT) & 1) gemm_fast(lds, S, E, K); else gemm_simple(S, E, K);
}

__device__ __forceinline__ void tr_item64(const float* W, int N, int k0, int ns, bf16_t* WT, int ldk, int nd, int kd, LAS float* scr, int lane, const float* kscale) {
    { const int r4 = lane >> 4, c4 = (lane & 15) * 4; f32x4 v[16];
#pragma unroll
      for (int i = 0; i < 16; ++i) v[i] = __builtin_nontemporal_load((const f32x4*)(W + (size_t)(k0 + 4 * i + r4) * N + ns + c4));
#pragma unroll
      for (int i = 0; i < 16; ++i) { LAS float* d = scr + (4 * i + r4) * 65 + c4; d[0] = v[i][0]; d[1] = v[i][1]; d[2] = v[i][2]; d[3] = v[i][3]; } }
    const int c = lane & 7;
    f32x4 s0 = (f32x4){1.f, 1.f, 1.f, 1.f}, s1 = s0;
    if (kscale) { s0 = *(const f32x4*)(kscale + k0 + 8 * c); s1 = *(const f32x4*)(kscale + k0 + 8 * c + 4); }
    asm volatile("s_waitcnt lgkmcnt(0)" ::: "memory");
#pragma unroll
    for (int j = 0; j < 8; ++j) { const int n = (lane >> 3) + 8 * j; const LAS float* s = scr + (8 * c) * 65 + n;
        u32x4 o; o.x = cvt_pk_bf16(s[0 * 65] * s0[0], s[1 * 65] * s0[1]); o.y = cvt_pk_bf16(s[2 * 65] * s0[2], s[3 * 65] * s0[3]);
        o.z = cvt_pk_bf16(s[4 * 65] * s1[0], s[5 * 65] * s1[1]); o.w = cvt_pk_bf16(s[6 * 65] * s1[2], s[7 * 65] * s1[3]);
        *(u32x4*)(WT + (size_t)(nd + n) * ldk + kd + 8 * c) = o; }
    asm volatile("s_waitcnt lgkmcnt(0)" ::: "memory");
}
constexpr int TRS = 64 * 65 * 4;
static_assert(8 * TRS <= LDS_BYTES - 64, "transpose scratch vs barrier words");
struct TrItem { const float* W; int N; bf16_t* WT; int ldk, nd, kd, k0, ns; const float* ks; };
__device__ __forceinline__ void tr_load(f32x4 (&v)[16], const TrItem& it, int lane) {
    const int r4 = lane >> 4, c4 = (lane & 15) * 4;
#pragma unroll
    for (int i = 0; i < 16; ++i) v[i] = __builtin_nontemporal_load((const f32x4*)(it.W + (size_t)(it.k0 + 4 * i + r4) * it.N + it.ns + c4));
}
__device__ __forceinline__ void tr_store(const f32x4 (&v)[16], const TrItem& it, LAS float* scr, int lane) {
    { const int r4 = lane >> 4, c4 = (lane & 15) * 4;
#pragma unroll
      for (int i = 0; i < 16; ++i) { LAS float* d = scr + (4 * i + r4) * 65 + c4; d[0] = v[i][0]; d[1] = v[i][1]; d[2] = v[i][2]; d[3] = v[i][3]; } }
    const int c = lane & 7;
    f32x4 s0 = (f32x4){1.f, 1.f, 1.f, 1.f}, s1 = s0;
    if (it.ks) { s0 = *(const f32x4*)(it.ks + it.k0 + 8 * c); s1 = *(const f32x4*)(it.ks + it.k0 + 8 * c + 4); }
    asm volatile("s_waitcnt lgkmcnt(0)" ::: "memory");
#pragma unroll
    for (int j = 0; j < 8; ++j) { const int n = (lane >> 3) + 8 * j; const LAS float* s = scr + (8 * c) * 65 + n;
        u32x4 o; o.x = cvt_pk_bf16(s[0 * 65] * s0[0], s[1 * 65] * s0[1]); o.y = cvt_pk_bf16(s[2 * 65] * s0[2], s[3 * 65] * s0[3]);
        o.z = cvt_pk_bf16(s[4 * 65] * s1[0], s[5 * 65] * s1[1]); o.w = cvt_pk_bf16(s[6 * 65] * s1[2], s[7 * 65] * s1[3]);
        __builtin_nontemporal_store(o, (u32x4*)(it.WT + (size_t)(it.nd + n) * it.ldk + it.kd + 8 * c)); }
    asm volatile("s_waitcnt lgkmcnt(0)" ::: "memory");
}
constexpr int NIT_EXP = 8192 + 4096;
__device__ __forceinline__ TrItem exp_item(const Params& p, int r) {
    TrItem it;
    if (r < 8192) { const int up = r >> 12, qq = r & 4095, e = qq >> 8, kb = (qq & 255) >> 3, nb = qq & 7;
        it.W = p.in[up ? 17 : 16] + (size_t)e * D * DE; it.N = DE; it.WT = (bf16_t*)(p.ws + WS_W1T) + (size_t)e * 1024 * D; it.ldk = D;
        it.nd = 256 * (nb >> 1) + (nb & 1) * 64 + (up ? 128 : 0); it.kd = kb * 64; it.k0 = kb * 64; it.ns = nb * 64; it.ks = p.in[11]; }
    else { const int q = r - 8192, e = q >> 8, kb = (q & 255) >> 5, nb = q & 31;
        it.W = p.in[18] + (size_t)e * DE * D; it.N = D; it.WT = (bf16_t*)(p.ws + WS_W2T) + (size_t)e * D * DE; it.ldk = DE; it.nd = nb * 64; it.kd = kb * 64; it.k0 = kb * 64; it.ns = nb * 64; it.ks = nullptr; }
    return it;
}
__device__ __forceinline__ void convert_tail(const Params& p, LAS unsigned char* lds, int nunits) {
    const int tid = opaque_tid(), wave = __builtin_amdgcn_readfirstlane(tid >> 6), lane = tid & 63;
    const int G = gridDim.x, rounds = (nunits + G - 1) / G, nfull = nunits - (rounds - 1) * G;
    int idle_idx, n_idle;
    if (nfull >= G || nunits == 0) { idle_idx = blockIdx.x; n_idle = G; } else { idle_idx = (int)blockIdx.x - nfull; n_idle = G - nfull; }
    if (idle_idx < 0) return;
    LAS float* scr = (LAS float*)(lds + wave * TRS);
    const int stride = n_idle * NWAVES; int r = idle_idx * NWAVES + wave;
    if (r >= NIT_EXP) return;
    f32x4 va[16], vb[16];
    TrItem ia = exp_item(p, r), ib = ia;
    tr_load(va, ia, lane);
    for (;;) {
        const bool hb = (r + stride) < NIT_EXP;
        if (hb) { ib = exp_item(p, r + stride); tr_load(vb, ib, lane); }
        tr_store(va, ia, scr, lane);
        if (!hb) break;
        r += stride;
        const bool ha = (r + stride) < NIT_EXP;
        if (ha) { ia = exp_item(p, r + stride); tr_load(va, ia, lane); }
        tr_store(vb, ib, scr, lane);
        if (!ha) break;
        r += stride;
    }
}
__device__ __forceinline__ int win_src_col(int nd) {
    if (nd < 1024) return nd;
    if (nd < 3072) { const int q = (nd - 1024) >> 8, r = (nd - 1024) & 255; return r < 128 ? (1024 + 128 * q + r) : (2048 + 128 * q + r - 128); }
    if (nd < 5120) return nd;
    { const int q = (nd - 5120) >> 8, r = (nd - 5120) & 255; return r < 128 ? (5120 + 128 * q + r) : (7168 + 128 * q + r - 128); }
}
__device__ __forceinline__ void phase0(const Params& p, LAS unsigned char* lds) {
    const int tid = opaque_tid(), wave = __builtin_amdgcn_readfirstlane(tid >> 6), lane = tid & 63;
    LAS float* scr = (LAS float*)(lds + wave * TRS);
    const int gw = blockIdx.x * NWAVES + wave, NGW = gridDim.x * NWAVES;
    unsigned char* ws = p.ws;
    constexpr int I_IN = 32 * 144, I_UP = 16 * 32, I_OUT = 32 * 32;
    constexpr int NITEMS = I_IN + 2 * I_UP + I_OUT;
    for (int it = gw; it < NITEMS; it += NGW) {
        int r = it;
        if (r < I_IN) { const int kb = r / 144, nb = r % 144; tr_item64(p.in[2], NIN, kb * 64, win_src_col(nb * 64), (bf16_t*)(ws + WS_WINT), D, nb * 64, kb * 64, scr, lane, nullptr); continue; } r -= I_IN;
        if (r < I_UP) { const int kb = r / 32, nb = r % 32; tr_item64(p.in[8], D, kb * 64, nb * 64, (bf16_t*)(ws + WS_WUPT), 2048, nb * 64, kb * 64, scr, lane, nullptr); continue; } r -= I_UP;
        if (r < I_UP) { const int kb = r / 32, nb = r % 32; tr_item64(p.in[9], D, kb * 64, nb * 64, (bf16_t*)(ws + WS_WUPT), 2048, nb * 64, 1024 + kb * 64, scr, lane, nullptr); continue; } r -= I_UP;
        { const int kb = r / 32, nb = r % 32; tr_item64(p.in[10], D, kb * 64, nb * 64, (bf16_t*)(ws + WS_WOUTT), D, nb * 64, kb * 64, scr, lane, nullptr); }
    }
    const float* x = p.in[0]; const float* g = p.in[1]; bf16_t* xn = (bf16_t*)(ws + WS_X);
    for (int m = gw; m < T; m += NGW) {
        const f32x4* xr = (const f32x4*)(x + (size_t)m * D) + lane; f32x4 v[8]; float s = 0.f;
#pragma unroll
        for (int j = 0; j < 8; ++j) { v[j] = __builtin_nontemporal_load(xr + 64 * j); s += (v[j][0] * v[j][0] + v[j][1] * v[j][1]) + (v[j][2] * v[j][2] + v[j][3] * v[j][3]); }
        const float rs = 1.0f / sqrtf(wave_sum(s) * (1.0f / D) + EPS);
        u32x2* o = (u32x2*)(xn + (size_t)m * D) + lane;
#pragma unroll
        for (int j = 0; j < 8; ++j) { const f32x4 gg = *((const f32x4*)g + lane + 64 * j); u32x2 w; w.x = cvt_pk_bf16(v[j][0] * rs * gg[0], v[j][1] * rs * gg[1]); w.y = cvt_pk_bf16(v[j][2] * rs * gg[2], v[j][3] * rs * gg[3]); o[64 * j] = w; }
    }
    { bf16_t* wr = (bf16_t*)(ws + WS_WR); const float* gf = p.in[11];
      for (int i = blockIdx.x * NTHREADS + tid; i < 32 * D; i += gridDim.x * NTHREADS) { const int j = i / D, d = i % D; unsigned hi = 0, lo = 0;
          if (j < 20) { const float v = gf[d] * (j < 4 ? p.in[12][d * 4 + j] : p.in[14][d * 16 + (j - 4)]); hi = cvt_pk_bf16(v, 0.f) & 0xffffu; lo = cvt_pk_bf16(v - __uint_as_float(hi << 16), 0.f) & 0xffffu; }
          wr[(size_t)j * D + d] = (bf16_t)hi; wr[(size_t)(32 + j) * D + d] = (bf16_t)lo; } }
    { bf16_t* wmb = (bf16_t*)(ws + WS_WMB); const float* wsrc = p.in[6];
      for (int i = blockIdx.x * NTHREADS + tid; i < 8 * 128 * 128 / 2; i += gridDim.x * NTHREADS) { const int e0 = 2 * i, r = (e0 >> 7) & 127, c = e0 & 127; const bool ok = (r >= 64) || (c < 64);
          ((unsigned*)wmb)[i] = ok ? cvt_pk_bf16(wsrc[e0], wsrc[e0 + 1]) : 0u; } }
    if (blockIdx.x == 0 && tid < 64) ((int*)(ws + WS_CTL))[tid] = 0;
}

__device__ __forceinline__ void phase2_conv(const Params& p) {
    const bf16_t* Bc = (const bf16_t*)(p.ws + WS_P + P_BC); const bf16_t* P = (const bf16_t*)(p.ws + WS_P + P_P); bf16_t* Y = (bf16_t*)(p.ws + WS_X);
    const float* cw = p.in[3];
    for (int i = blockIdx.x * NTHREADS + opaque_tid(); i < T * (CW / 8); i += gridDim.x * NTHREADS) {
        const int t = i >> 7, c = (i & 127) * 8;
        f32x4 p0a, p0b, p1a, p1b, p2a, p2b, ba, bb;
        unpack8(*(const u32x4*)(P + (size_t)t * CW + c), p2a, p2b); unpack8(*(const u32x4*)(Bc + (size_t)t * CW + c), ba, bb);
        if (t >= 1) unpack8(*(const u32x4*)(P + (size_t)(t - 1) * CW + c), p1a, p1b); else { p1a = (f32x4){0, 0, 0, 0}; p1b = p1a; }
        if (t >= 2) unpack8(*(const u32x4*)(P + (size_t)(t - 2) * CW + c), p0a, p0b); else { p0a = (f32x4){0, 0, 0, 0}; p0b = p0a; }
        const f32x4 w0a = *(const f32x4*)(cw + c), w0b = *(const f32x4*)(cw + c + 4), w1a = *(const f32x4*)(cw + CW + c), w1b = *(const f32x4*)(cw + CW + c + 4),
                    w2a = *(const f32x4*)(cw + 2 * CW + c), w2b = *(const f32x4*)(cw + 2 * CW + c + 4);
        const f32x4 ya = ba * (w0a * p0a + w1a * p1a + w2a * p2a), yb = bb * (w0b * p0b + w1b * p1b + w2b * p2b);
        *(u32x4*)(Y + (size_t)t * 2048 + c) = pack8(ya, yb);
    }
}
__device__ __forceinline__ void phase2_sgu(const Params& p, LAS unsigned char* lds) {
    const int tid = opaque_tid(), wave = __builtin_amdgcn_readfirstlane(tid >> 6), lane = tid & 63, fr = lane & 15, fq = lane >> 4;
    const bf16_t* U = (const bf16_t*)(p.ws + WS_P + P_U); const bf16_t* V = (const bf16_t*)(p.ws + WS_P + P_V); bf16_t* Y = (bf16_t*)(p.ws + WS_X);
    const bf16_t* WmB = (const bf16_t*)(p.ws + WS_WMB); const f32x2* VST = (const f32x2*)(p.ws + WS_SMALL + SM_VST);
    const float* lng = p.in[4]; const float* lnb = p.in[5]; const float* bs = p.in[7];
    LAS f32x2* st = (LAS f32x2*)lds;
    LAS unsigned char* vT = lds + 1024;
    constexpr int VP = 272;
    for (int unit = blockIdx.x; unit < 64 * 8; unit += gridDim.x) {
        const int nb = unit >> 3, h = unit & 7, t0 = nb * 128, c0 = h * 128;
        __syncthreads();
        if (tid < 128) { const f32x4* ps = (const f32x4*)(VST + (size_t)(t0 + tid) * 16); float s = 0.f, q = 0.f;
#pragma unroll
            for (int i = 0; i < 8; ++i) { const f32x4 v = ps[i]; s += v[0] + v[2]; q += v[1] + v[3]; }
            const float mu = s * (1.0f / SW); const float var = fmaxf(q * (1.0f / SW) - mu * mu, 0.f);
            st[tid] = (f32x2){mu, 1.0f / sqrtf(var + EPS)}; }
        __syncthreads();
        if (tid < 256) {
            const int jb = tid >> 4, cb = tid & 15, j0 = jb * 8, cc0 = cb * 8;
            const f32x4 g0 = *(const f32x4*)(lng + c0 + cc0), g1 = *(const f32x4*)(lng + c0 + cc0 + 4), b0 = *(const f32x4*)(lnb + c0 + cc0), b1 = *(const f32x4*)(lnb + c0 + cc0 + 4);
            f32x4 lo[8], hi[8];
#pragma unroll
            for (int r = 0; r < 8; ++r) { const f32x2 s = st[j0 + r]; f32x4 a, b; unpack8(*(const u32x4*)(V + (size_t)(t0 + j0 + r) * SW + c0 + cc0), a, b);
                lo[r] = (a - s.x) * s.y * g0 + b0; hi[r] = (b - s.x) * s.y * g1 + b1; }
#pragma unroll
            for (int cc = 0; cc < 4; ++cc) { u32x4 o;
                o.x = cvt_pk_bf16(lo[0][cc], lo[1][cc]); o.y = cvt_pk_bf16(lo[2][cc], lo[3][cc]); o.z = cvt_pk_bf16(lo[4][cc], lo[5][cc]); o.w = cvt_pk_bf16(lo[6][cc], lo[7][cc]);
                *(LAS u32x4*)(vT + (cc0 + cc) * VP + j0 * 2) = o;
                o.x = cvt_pk_bf16(hi[0][cc], hi[1][cc]); o.y = cvt_pk_bf16(hi[2][cc], hi[3][cc]); o.z = cvt_pk_bf16(hi[4][cc], hi[5][cc]); o.w = cvt_pk_bf16(hi[6][cc], hi[7][cc]);
                *(LAS u32x4*)(vT + (cc0 + 4 + cc) * VP + j0 * 2) = o; }
        }
        __syncthreads();
        bf16x8 wf[4];
#pragma unroll
        for (int ks = 0; ks < 4; ++ks) wf[ks] = *(const bf16x8*)(WmB + ((size_t)h * 128 + wave * 16 + fr) * 128 + ks * 32 + fq * 8);
        f32x4 acc[8];
#pragma unroll
        for (int nk = 0; nk < 8; ++nk) { acc[nk] = (f32x4){0.f, 0.f, 0.f, 0.f};
#pragma unroll
            for (int ks = 0; ks < 4; ++ks) { const bf16x8 vf = *(const LAS bf16x8*)(vT + (nk * 16 + fr) * VP + (ks * 32 + fq * 8) * 2);
                acc[nk] = __builtin_amdgcn_mfma_f32_16x16x32_bf16(vf, wf[ks], acc[nk], 0, 0, 0); } }
        { const int i = wave * 16 + fr; const float bb = bs[h * 128 + i]; const size_t t = (size_t)(t0 + i);
#pragma unroll
          for (int nk = 0; nk < 8; ++nk) { const int c = c0 + nk * 16 + 4 * fq; const u32x2 uu = *(const u32x2*)(U + t * SW + c);
              u32x2 o; o.x = cvt_pk_bf16(bf_lo(uu.x) * (acc[nk][0] + bb), bf_hi(uu.x) * (acc[nk][1] + bb)); o.y = cvt_pk_bf16(bf_lo(uu.y) * (acc[nk][2] + bb), bf_hi(uu.y) * (acc[nk][3] + bb));
              *(u32x2*)(Y + t * 2048 + 1024 + c) = o; } }
    }
}

__device__ __forceinline__ void phase5_router(const Params& p, LAS unsigned char* lds) {
    const int tid = opaque_tid(), wave = __builtin_amdgcn_readfirstlane(tid >> 6), lane = tid & 63, fr = lane & 15, fq = lane >> 4;
    const bf16_t* A2 = (const bf16_t*)(p.ws + WS_A2); const bf16_t* wr = (const bf16_t*)(p.ws + WS_WR);
    float* rstd = (float*)(p.ws + WS_SMALL + SM_RSTD); int* ent = (int*)(p.ws + WS_SMALL + SM_ENT); float* lw = (float*)(p.ws + WS_SMALL + SM_W); int* cnt = (int*)(p.ws + WS_CTL);
    const float* brg = p.in[13]; const float* bre = p.in[15];
    LAS float* part = (LAS float*)lds;
    LAS float* pss  = (LAS float*)(lds + 65536);
    LAS float* lg   = (LAS float*)(lds + 65536 + 1024);
    LAS float* lss  = (LAS float*)(lds + 65536 + 1024 + 2560);
    LAS int* lcnt  = (LAS int*)(lds + 70000);
    LAS int* lbase = (LAS int*)(lds + 70000 + 64);
    LAS int* le    = (LAS int*)(lds + 70000 + 128);
    LAS int* lp    = (LAS int*)(lds + 70000 + 128 + 256);
    LAS float* lwt = (LAS float*)(lds + 70000 + 128 + 512);
    for (int tile = blockIdx.x; tile < T / 32; tile += gridDim.x) {
        const int tok0 = tile * 32;
        __syncthreads();
        if (tid < 16) lcnt[tid] = 0;
        f32x4 acc[2][4]; float ss[2] = {0.f, 0.f};
#pragma unroll
        for (int m = 0; m < 2; ++m)
#pragma unroll
            for (int n = 0; n < 4; ++n) acc[m][n] = (f32x4){0.f, 0.f, 0.f, 0.f};
#pragma unroll 2
        for (int ks = 0; ks < 8; ++ks) {
            const int k = wave * 256 + ks * 32 + fq * 8;
            bf16x8 af[2], bfr[4];
#pragma unroll
            for (int m = 0; m < 2; ++m) af[m] = *(const bf16x8*)(A2 + (size_t)(tok0 + 16 * m + fr) * D + k);
#pragma unroll
            for (int n = 0; n < 4; ++n) bfr[n] = *(const bf16x8*)(wr + (size_t)(16 * n + fr) * D + k);
#pragma unroll
            for (int m = 0; m < 2; ++m) {
#pragma unroll
                for (int j = 0; j < 8; ++j) { const float v = bf1((bf16_t)af[m][j]); ss[m] += v * v; }
#pragma unroll
                for (int n = 0; n < 4; ++n) acc[m][n] = __builtin_amdgcn_mfma_f32_16x16x32_bf16(bfr[n], af[m], acc[m][n], 0, 0, 0);
            }
        }
#pragma unroll
        for (int m = 0; m < 2; ++m) { ss[m] += __shfl_xor(ss[m], 16); ss[m] += __shfl_xor(ss[m], 32);
            if (fq == 0) pss[wave * 32 + 16 * m + fr] = ss[m];
#pragma unroll
            for (int n = 0; n < 4; ++n) *(LAS f32x4*)(part + (wave * 32 + 16 * m + fr) * 64 + 16 * n + 4 * fq) = acc[m][n]; }
        __syncthreads();
        for (int i = tid; i < 32 * 20; i += NTHREADS) { const int t = i / 20, j = i % 20; float s = 0.f;
#pragma unroll
            for (int w = 0; w < 8; ++w) s += part[(w * 32 + t) * 64 + j] + part[(w * 32 + t) * 64 + 32 + j];
            lg[t * 20 + j] = s; }
        if (tid < 32) { float s = 0.f;
#pragma unroll
            for (int w = 0; w < 8; ++w) s += pss[w * 32 + tid];
            lss[tid] = s; }
        __syncthreads();
        if (tid < 32) {
            const int t = tid; const float rs = 1.0f / sqrtf(lss[t] * (1.0f / D) + EPS);
            float g4[4];
#pragma unroll
            for (int j = 0; j < 4; ++j) g4[j] = lg[t * 20 + j] * rs + brg[j];
            int gi = 0; float gm = g4[0];
#pragma unroll
            for (int j = 1; j < 4; ++j) if (g4[j] > gm) { gm = g4[j]; gi = j; }
            float den = 0.f;
#pragma unroll
            for (int j = 0; j < 4; ++j) den += __expf(g4[j] - gm);
            const float pg = 1.0f / den;
            float le4[4];
#pragma unroll
            for (int j = 0; j < 4; ++j) le4[j] = lg[t * 20 + 4 + gi * 4 + j] * rs + bre[gi * 4 + j];
            int i1 = 0; float m1 = le4[0];
#pragma unroll
            for (int j = 1; j < 4; ++j) if (le4[j] > m1) { m1 = le4[j]; i1 = j; }
            int i2 = -1; float m2 = -3.0e38f;
#pragma unroll
            for (int j = 0; j < 4; ++j) if (j != i1 && le4[j] > m2) { m2 = le4[j]; i2 = j; }
            const float ex = __expf(m2 - m1); const float w1 = pg / (1.0f + ex), w2 = pg * ex / (1.0f + ex);
            rstd[tok0 + t] = rs;
            const int e1 = gi * 4 + i1, e2 = gi * 4 + i2;
            le[2 * t] = e1; le[2 * t + 1] = e2; lwt[2 * t] = w1; lwt[2 * t + 1] = w2;
            lp[2 * t] = atomicAdd((int*)&lcnt[e1], 1); lp[2 * t + 1] = atomicAdd((int*)&lcnt[e2], 1);
        }
        __syncthreads();
        if (tid < 16) { const int n = lcnt[tid]; lbase[tid] = n ? atomicAdd(&cnt[tid], n) : 0; }
        __syncthreads();
        if (tid < 64) { const int e = le[tid]; const int pos = lbase[e] + lp[tid]; ent[e * T + pos] = (tok0 + (tid >> 1)) | ((tid & 1) << 16); lw[e * T + pos] = lwt[tid]; }
    }
}

__device__ __forceinline__ void phase8_final(const Params& p) {
    const int tid = opaque_tid(), wave = __builtin_amdgcn_readfirstlane(tid >> 6), lane = tid & 63;
    const bf16_t* A2 = (const bf16_t*)(p.ws + WS_A2); const bf16_t* Y0 = (const bf16_t*)(p.ws + WS_YK0); const bf16_t* Y1 = (const bf16_t*)(p.ws + WS_YK1); const float* g = p.in[19];
    const int gw = blockIdx.x * NWAVES + wave, NGW = gridDim.x * NWAVES;
    for (int m = gw; m < T; m += NGW) {
        f32x4 v[8]; float s = 0.f;
#pragma unroll
        for (int j = 0; j < 8; ++j) { const size_t o = (size_t)m * D + 4 * lane + 256 * j;
            const u32x2 hh = *(const u32x2*)(A2 + o), a = *(const u32x2*)(Y0 + o), b = *(const u32x2*)(Y1 + o);
            v[j][0] = bf_lo(hh.x) + (bf_lo(a.x) + bf_lo(b.x)); v[j][1] = bf_hi(hh.x) + (bf_hi(a.x) + bf_hi(b.x)); v[j][2] = bf_lo(hh.y) + (bf_lo(a.y) + bf_lo(b.y)); v[j][3] = bf_hi(hh.y) + (bf_hi(a.y) + bf_hi(b.y));
            s += (v[j][0] * v[j][0] + v[j][1] * v[j][1]) + (v[j][2] * v[j][2] + v[j][3] * v[j][3]); }
        const float rs = 1.0f / sqrtf(wave_sum(s) * (1.0f / D) + EPS);
#pragma unroll
        for (int j = 0; j < 8; ++j) { const int c = 4 * lane + 256 * j; const f32x4 gg = *(const f32x4*)(g + c); __builtin_nontemporal_store(v[j] * rs * gg, (f32x4*)(p.out + (size_t)m * D + c)); }
    }
}

#define XB_TMO      128
#define XB_XCNT(j)  (256  + 64 * (j))
#define XB_XSUB(j)  (1280 + 64 * (j))
#define XB_XGEN(j)  (2304 + 64 * (j))
#define XB_TOP      3328
#define XB_TOPGEN   3392
#define XCD_BAR_WORDS 3456
#define XB_SPIN_CAP (1u << 18)
__device__ __forceinline__ unsigned xb_ld(unsigned* p)              { return __hip_atomic_load(p, __ATOMIC_RELAXED, __HIP_MEMORY_SCOPE_AGENT); }
__device__ __forceinline__ unsigned xb_add(unsigned* p, unsigned v) { return __hip_atomic_fetch_add(p, v, __ATOMIC_RELAXED, __HIP_MEMORY_SCOPE_AGENT); }
__device__ __forceinline__ unsigned xb_xcc_id() { return (unsigned)__builtin_amdgcn_s_getreg((3 << 11) | 20) & 0xFu; }
#define XB_SPIN(cond, bar) do { unsigned _sp = 0; while (cond) { __builtin_amdgcn_s_sleep(1); \
    if ((++_sp & 255u) == 0u) { if (xb_ld(&(bar)[XB_TMO])) break; if (_sp > XB_SPIN_CAP) { atomicAdd(&(bar)[XB_TMO], 1u); break; } } } } while (0)
struct XcdBarrier { unsigned* bar; unsigned x; volatile LAS unsigned* st; };
__device__ __forceinline__ XcdBarrier xcd_barrier_post(unsigned* bar, volatile LAS unsigned* st) {
    XcdBarrier b; b.bar = bar; b.x = xb_xcc_id(); b.st = st;
    if (threadIdx.x == 0) (void)xb_add(&bar[XB_XCNT(b.x)], 1u);
    return b;
}
__device__ __forceinline__ void xcd_barrier_complete(unsigned* bar, unsigned x, unsigned& nloc, unsigned& nx) {
    const unsigned G = gridDim.x * gridDim.y * gridDim.z;
    unsigned sum, cnt, mine, sp = 0u;
    for (;;) {
        sum = 0u; cnt = 0u; mine = 0u;
#pragma unroll
        for (unsigned j = 0; j < 16; ++j) { const unsigned c = xb_ld(&bar[XB_XCNT(j)]); sum += c; cnt += (c > 0u) ? 1u : 0u; mine = (j == x) ? c : mine; }
        if (sum == G) break;
        __builtin_amdgcn_s_sleep(1);
        if ((++sp & 255u) == 0u) { if (xb_ld(&bar[XB_TMO])) break; if (sp > XB_SPIN_CAP) { atomicAdd(&bar[XB_TMO], 1u); break; } }
    }
    nloc = mine > 0u ? mine : 1u; nx = cnt > 0u ? cnt : 1u;
}
__device__ __forceinline__ void xcd_barrier(const XcdBarrier& b) {
    asm volatile("s_waitcnt vmcnt(0)" ::: "memory");
    __syncthreads();
    if (threadIdx.x == 0) {
        unsigned* bar = b.bar;
        __builtin_amdgcn_s_waitcnt(0);
        unsigned nloc = b.st[0], nx = b.st[1];
        if (nloc == 0u) { xcd_barrier_complete(bar, b.x, nloc, nx); b.st[0] = nloc; b.st[1] = nx; }
        const unsigned old = xb_add(&bar[XB_XSUB(b.x)], 1u);
        const unsigned gen = old / nloc;
        if (old + 1u == (gen + 1u) * nloc) {
            __builtin_amdgcn_fence(__ATOMIC_RELEASE, "agent");
            asm volatile("s_waitcnt vmcnt(0)" ::: "memory");
            const unsigned og = xb_add(&bar[XB_TOP], 1u);
            const unsigned tg = og / nx;
            if (og + 1u == (tg + 1u) * nx) xb_add(&bar[XB_TOPGEN], 1u);
            else XB_SPIN(xb_ld(&bar[XB_TOPGEN]) == tg, bar);
            __builtin_amdgcn_fence(__ATOMIC_ACQUIRE, "agent");
            xb_add(&bar[XB_XGEN(b.x)], 1u);
            asm volatile("s_waitcnt vmcnt(0)" ::: "memory");
        } else {
            XB_SPIN(xb_ld(&bar[XB_XGEN(b.x)]) == gen, bar);
            __builtin_amdgcn_fence(__ATOMIC_ACQUIRE, "agent");
            asm volatile("s_waitcnt vmcnt(0)" ::: "memory");
        }
    }
    __syncthreads();
}

template <int PH> __device__ __forceinline__ void run_phase(const Params& p, LAS unsigned char* lds) {
    unsigned char* ws = p.ws;
    if constexpr (PH == 0) phase0(p, lds);
    if constexpr (PH == 1) { DenseSched S; S.init((const bf16_t*)(ws + WS_X), (const bf16_t*)(ws + WS_WINT), T, NIN, D);
        EpiProj E{(bf16_t*)(ws + WS_P + P_BC), (bf16_t*)(ws + WS_P + P_P), (bf16_t*)(ws + WS_P + P_U), (bf16_t*)(ws + WS_P + P_V), (bf16_t*)(ws + WS_P + P_R), (bf16_t*)(ws + WS_P + P_S), (f32x2*)(ws + WS_SMALL + SM_VST)};
        gemm_run<0>(lds, S, E, D); convert_tail(p, lds, (T / 256) * (NIN / 256)); }
    if constexpr (PH == 2) { phase2_conv(p); phase2_sgu(p, lds); }
    if constexpr (PH == 3) { DenseSched S; S.init((const bf16_t*)(ws + WS_X), (const bf16_t*)(ws + WS_WUPT), T, D, 2048);
        EpiUp E{(const bf16_t*)(ws + WS_P + P_R), (const bf16_t*)(ws + WS_P + P_S), (bf16_t*)(ws + WS_MM)}; gemm_run<1>(lds, S, E, 2048); }
    if constexpr (PH == 4) { DenseSched S; S.init((const bf16_t*)(ws + WS_MM), (const bf16_t*)(ws + WS_WOUTT), T, D, D);
        EpiOut E{p.in[0], (bf16_t*)(ws + WS_A2)}; gemm_run<2>(lds, S, E, D); }
    if constexpr (PH == 5) phase5_router(p, lds);
    if constexpr (PH == 6 || PH == 7 || PH == 9) {
        const int* cnt = (const int*)(ws + WS_CTL); const int* ent = (const int*)(ws + WS_SMALL + SM_ENT); const int G = gridDim.x, c = blockIdx.x;
        EpiMoe1 E1{ent, (const float*)(ws + WS_SMALL + SM_W), (const float*)(ws + WS_SMALL + SM_RSTD), (bf16_t*)(ws + WS_HID)};
        EpiMoe2 E2{ent, (bf16_t*)(ws + WS_YK0), (bf16_t*)(ws + WS_YK1)};
        typedef MoeSched<true, 4, D, 1024> S1T; typedef MoeSched<false, 8, DE, D> S2T;
        constexpr int BIG = 1 << 20;
        const int UH = moe_overflow_tiles(cnt) * 4, UC = UH * 2; const bool fancy = UH <= G / 4;
        const int LB = 2 * (G - UH);
        if constexpr (PH == 6) {
            S1T S{(const bf16_t*)(ws + WS_A2), (const bf16_t*)(ws + WS_W1T), cnt, ent, 0, c, G, BIG}; gemm_run<3>(lds, S, E1, D); }
        if constexpr (PH == 7) {
            if (!fancy) { S1T S{(const bf16_t*)(ws + WS_A2), (const bf16_t*)(ws + WS_W1T), cnt, ent, 1, c, G, BIG}; gemm_run<3>(lds, S, E1, D); }
            else if (c < UH) { S1T S{(const bf16_t*)(ws + WS_A2), (const bf16_t*)(ws + WS_W1T), cnt, ent, 1, c, UH, 1}; gemm_run<3>(lds, S, E1, D); }
            else { S2T S{(const bf16_t*)(ws + WS_HID), (const bf16_t*)(ws + WS_W2T), cnt, ent, 0, c - UH, G - UH, 2}; gemm_run<4>(lds, S, E2, DE); } }
        if constexpr (PH == 9) {
            if (!fancy) { S2T S{(const bf16_t*)(ws + WS_HID), (const bf16_t*)(ws + WS_W2T), cnt, ent, 2, c, G, BIG}; gemm_run<4>(lds, S, E2, DE); }
            else if (c < UC) { S2T S{(const bf16_t*)(ws + WS_HID), (const bf16_t*)(ws + WS_W2T), cnt, ent, 1, c, UC, 1}; gemm_run<4>(lds, S, E2, DE); }
            else { S2T S{(const bf16_t*)(ws + WS_HID), (const bf16_t*)(ws + WS_W2T), cnt, ent, 0, LB + (c - UC), G - UC, BIG}; gemm_run<4>(lds, S, E2, DE); } }
    }
    if constexpr (PH == 8) phase8_final(p);
}

template <int PH> __global__ void __launch_bounds__(NTHREADS, 2) k_phase(Params p) {
    extern __shared__ __attribute__((aligned(16))) unsigned char lds_raw[];
    run_phase<PH>(p, (LAS unsigned char*)lds_raw);
}

#ifndef PROBE_DUP
#define PROBE_DUP 0
#endif
#ifndef PROBE_SYNCS
#define PROBE_SYNCS 0
#endif
#define DUP(k) ((PROBE_DUP >> (k)) & 1)
#ifndef PROBE_T
#define PROBE_T (-1)
#endif
#ifndef PROBE_MULT
#define PROBE_MULT 4
#endif
typedef const __attribute__((address_space(4))) Params* KParamsPtr;
__device__ __forceinline__ Params load_params() {
    Params r{};
#if defined(__HIP_DEVICE_COMPILE__)
    unsigned long long v = (unsigned long long)__builtin_amdgcn_kernarg_segment_ptr(); asm volatile("" : "+s"(v));
    const __attribute__((address_space(4))) unsigned long long* q = (const __attribute__((address_space(4))) unsigned long long*)v;
#pragma unroll
    for (int i = 0; i < 20; ++i) r.in[i] = (const float*)(const __attribute__((address_space(1))) float*)q[i];
    r.out = (float*)(__attribute__((address_space(1))) float*)q[20]; r.ws = (unsigned char*)(__attribute__((address_space(1))) unsigned char*)q[21];
#endif
    return r;
}
#define RUN(k) do { const Params pk = load_params(); run_phase<k>(pk, lds); } while (0)
__global__ void __launch_bounds__(NTHREADS, 2) k_mega(Params p) {
    extern __shared__ __attribute__((aligned(16))) unsigned char lds_raw[];
    LAS unsigned char* lds = (LAS unsigned char*)lds_raw;
    cg::grid_group grid = cg::this_grid();
    volatile LAS unsigned* xbst = (volatile LAS unsigned*)(lds + LDS_BYTES - 64);
    if (threadIdx.x < 4) xbst[threadIdx.x] = 0u;
    __syncthreads();
    const XcdBarrier bar = xcd_barrier_post((unsigned*)(p.ws + WS_BAR), xbst);
    volatile LAS unsigned long long* stamps = (volatile LAS unsigned long long*)(lds + LDS_BYTES - 256);
    int nstamp = 0;
#define STAMP() do { if (PROBE_T >= 0 && blockIdx.x == 0 && threadIdx.x == 0) stamps[nstamp] = __builtin_amdgcn_s_memrealtime(); ++nstamp; } while (0)
#define GSYNC() do { xcd_barrier(bar); STAMP(); } while (0)
    STAMP();
    if (p.ws == nullptr) grid.sync();
    RUN(0); GSYNC();
    if (DUP(0)) { RUN(0); GSYNC(); }
    RUN(1); GSYNC();
    if (DUP(1)) { RUN(1); GSYNC(); }
    RUN(2); GSYNC();
    if (DUP(2)) { RUN(2); GSYNC(); }
    RUN(3); GSYNC();
    if (DUP(3)) { RUN(3); GSYNC(); }
    RUN(4); GSYNC();
    if (DUP(4)) { RUN(4); GSYNC(); }
    RUN(5); GSYNC();
    if (DUP(5)) { if (blockIdx.x == 0 && threadIdx.x < 16) ((int*)(load_params().ws + WS_CTL))[threadIdx.x] = 0; GSYNC(); RUN(5); GSYNC(); }
    RUN(6); GSYNC();
    if (DUP(6)) { RUN(6); GSYNC(); }
    RUN(7); GSYNC();
    if (DUP(7)) { RUN(7); GSYNC(); }
    RUN(9); GSYNC();
    if (DUP(9)) { RUN(9); GSYNC(); }
    for (int i = 0; i < PROBE_SYNCS; ++i) GSYNC();
    RUN(8);
    if (DUP(8)) { GSYNC(); RUN(8); }
    if (PROBE_T >= 0) { __syncthreads(); STAMP();
        if (blockIdx.x == 0 && threadIdx.x == 0) { const unsigned long long d = (stamps[PROBE_T + 1] - stamps[PROBE_T]) * PROBE_MULT; const unsigned long long t0 = __builtin_amdgcn_s_memrealtime();
            while (__builtin_amdgcn_s_memrealtime() - t0 < d) __builtin_amdgcn_s_sleep(8); } }
}

template <int PH> static void launch_phase(const Params& p, int grid, hipStream_t stream) {
    static bool attr = false;
    if (!attr) { (void)hipFuncSetAttribute((const void*)k_phase<PH>, hipFuncAttributeMaxDynamicSharedMemorySize, LDS_BYTES); attr = true; }
    hipLaunchKernelGGL(k_phase<PH>, dim3(grid), dim3(NTHREADS), LDS_BYTES, stream, p);
}

extern "C" void kernel_launch(void* const* d_in, const int* in_sizes, int n_in, void* d_out, int out_size, void* d_ws, size_t ws_size, hipStream_t stream) {
    static int grid = 0;
    if (grid == 0) {
        if (n_in != 20 || out_size != T * D || ws_size < WS_END) { fprintf(stderr, "kernel_launch: unexpected shapes n_in %d out %d ws %zu (need %zu)\n", n_in, out_size, ws_size, (size_t)WS_END); grid = -1; return; }
        int dev = 0, cus = 0, per_cu = 0;
        (void)hipGetDevice(&dev); (void)hipDeviceGetAttribute(&cus, hipDeviceAttributeMultiprocessorCount, dev);
        (void)hipFuncSetAttribute((const void*)k_mega, hipFuncAttributeMaxDynamicSharedMemorySize, LDS_BYTES);
        (void)hipOccupancyMaxActiveBlocksPerMultiprocessor(&per_cu, (const void*)k_mega, NTHREADS, LDS_BYTES);
        if (per_cu < 1) { fprintf(stderr, "kernel_launch: occupancy query says %d blocks per CU\n", per_cu); per_cu = 1; }
        grid = cus * 1;
        (void)hipGetLastError();
    }
    if (grid < 0) return;
    Params p{};
    for (int i = 0; i < 20; ++i) p.in[i] = (const float*)d_in[i];
    p.out = (float*)d_out; p.ws = (unsigned char*)d_ws;
    (void)hipMemsetAsync((char*)d_ws + WS_CTL, 0, 64 * 1024, stream);
#if ONE_LAUNCH
    void* args[] = {&p};
    hipError_t e = hipLaunchCooperativeKernel((const void*)k_mega, dim3(grid), dim3(NTHREADS), args, LDS_BYTES, stream);
    if (e != hipSuccess) fprintf(stderr, "cooperative launch failed: %s (grid %d)\n", hipGetErrorString(e), grid);
#else
    launch_phase<0>(p, grid, stream); launch_phase<1>(p, grid, stream); launch_phase<2>(p, grid, stream); launch_phase<3>(p, grid, stream); launch_phase<4>(p, grid, stream);
    launch_phase<5>(p, grid, stream); launch_phase<6>(p, grid, stream); launch_phase<7>(p, grid, stream); launch_phase<9>(p, grid, stream); launch_phase<8>(p, grid, stream);
#endif
}
```

```cpp
#include <hip/hip_runtime.h>
#include <hip/hip_cooperative_groups.h>
#include <cstdio>
#include <cstdint>
namespace cg = cooperative_groups;

#ifndef ONE_LAUNCH
#define ONE_LAUNCH 1
#endif

#define LAS __attribute__((address_space(3)))
typedef unsigned short bf16_t;
typedef short bf16x8 __attribute__((ext_vector_type(8)));
typedef float f32x4 __attribute__((ext_vector_type(4)));
typedef float f32x2 __attribute__((ext_vector_type(2)));
typedef unsigned u32x4 __attribute__((ext_vector_type(4)));
typedef unsigned u32x2 __attribute__((ext_vector_type(2)));

constexpr int T = 8192, D = 2048, CW = 1024, SW = 1024, NIN = 9216, NE = 16, DE = 512;
constexpr float EPS = 1e-6f;
constexpr int NTHREADS = 512, NWAVES = 8;
constexpr int LDS_BYTES = 140 * 1024;
constexpr int HID_ROWS = 2 * T + NE * 256;

constexpr size_t MiB = 1024 * 1024;
constexpr size_t WS_CTL   = 0;
constexpr size_t WS_BAR   = 4096;
constexpr size_t WS_FLAGS = 32768;
constexpr size_t WS_SMALL = 64 * 1024;
constexpr size_t SM_RSTD = 0, SM_ENT = 32 * 1024, SM_W = SM_ENT + (size_t)NE * T * 4, SM_VST = SM_W + (size_t)NE * T * 4, SM_END = SM_VST + (size_t)T * 16 * 8;
constexpr size_t WS_WR    = WS_SMALL + 4 * MiB;
constexpr size_t WS_WMB   = WS_WR + 256 * 1024;
constexpr size_t WS_WINT  = WS_WMB + 256 * 1024;
constexpr size_t WS_WUPT  = WS_WINT + (size_t)NIN * D * 2;
constexpr size_t WS_WOUTT = WS_WUPT + (size_t)D * D * 2;
constexpr size_t WS_W1T   = WS_WOUTT + (size_t)D * D * 2;
constexpr size_t WS_W2T   = WS_W1T + (size_t)NE * 1024 * D * 2;
constexpr size_t WS_X     = WS_W2T + (size_t)NE * D * DE * 2;
constexpr size_t WS_P     = WS_X + (size_t)T * D * 2;
constexpr size_t P_BC = 0, P_P = P_BC + (size_t)T * CW * 2, P_U = P_P + (size_t)T * CW * 2, P_V = P_U + (size_t)T * SW * 2,
                 P_R = P_V + (size_t)T * SW * 2, P_S = P_R + (size_t)T * D * 2, P_END = P_S + (size_t)T * D * 2;
constexpr size_t WS_END   = WS_P + P_END;
constexpr size_t WS_MM  = WS_WINT;
constexpr size_t WS_H   = WS_P + P_BC;
constexpr size_t WS_A2  = WS_P + P_R;
constexpr size_t WS_HID = WS_P + P_S;
constexpr size_t WS_YK0 = WS_X;
constexpr size_t WS_YK1 = WS_WINT;
static_assert(SM_END <= 4 * MiB, "small region");
static_assert((size_t)HID_ROWS * DE * 2 <= (size_t)T * D * 2, "hid overlay");
static_assert((size_t)T * D * 4 <= P_R, "H overlay");

struct Params { const float* in[20]; float* out; unsigned char* ws; };

__device__ __forceinline__ unsigned cvt_pk_bf16(float lo, float hi) { unsigned r; asm("v_cvt_pk_bf16_f32 %0, %1, %2" : "=v"(r) : "v"(lo), "v"(hi)); return r; }
__device__ __forceinline__ float bf_lo(unsigned w) { return __uint_as_float(w << 16); }
__device__ __forceinline__ float bf_hi(unsigned w) { return __uint_as_float(w & 0xffff0000u); }
__device__ __forceinline__ float bf1(bf16_t b) { return __uint_as_float(((unsigned)b) << 16); }
__device__ __forceinline__ float wave_sum(float v) {
#pragma unroll
    for (int o = 1; o < 64; o <<= 1) v += __shfl_xor(v, o);
    return v;
}
__device__ __forceinline__ float fast_rcp(float x) { return __builtin_amdgcn_rcpf(x); }
__device__ __forceinline__ float fast_exp2(float x) { return __builtin_amdgcn_exp2f(x); }
__device__ __forceinline__ float sigmoid_f(float x) { return fast_rcp(1.0f + fast_exp2(-1.44269504f * x)); }
__device__ __forceinline__ float gelu_tanh(float x) {
    const float u = x + 0.044715f * x * x * x;
    return x * fast_rcp(1.0f + fast_exp2(-2.30220819f * u));
}
__device__ __forceinline__ int opaque_tid() { int t = threadIdx.x; asm volatile("" : "+v"(t)); return t; }
__device__ __forceinline__ void st16_wt(void* p, u32x4 v) { asm volatile("global_store_dwordx4 %0, %1, off sc1\n\ts_nop 1" :: "v"(p), "v"(v) : "memory"); }
__host__ __device__ __forceinline__ int perm32(int rho) { const int n = rho >> 4, i = rho & 15; return 8 * (i >> 2) + 4 * n + (i & 3); }

struct Unit { int pm, pn, e, row0, nvalid; };
constexpr int NXCD = 8, WGM = 8;
struct DenseSched {
    static constexpr bool DYN_HALF = false;
    __device__ __forceinline__ void a_ready(const Unit&) const {}
    __device__ __forceinline__ void done(const Unit&) const {}
    const bf16_t* A; const bf16_t* Bt; int K; int nM, nN, nwg, G, c;
    __device__ __forceinline__ void init(const bf16_t* A_, const bf16_t* Bt_, int M, int N, int K_) { A = A_; Bt = Bt_; K = K_; nM = M / 256; nN = N / 256; nwg = nM * nN; G = gridDim.x; c = blockIdx.x; }
    __device__ __forceinline__ bool next(int i, Unit& u) const {
        const long L = (long)i * G + c; if (L >= nwg) return false;
        int wgid = (int)L; { const int q = nwg / NXCD, r = nwg % NXCD, xcd = wgid % NXCD, off = wgid / NXCD; wgid = (xcd < r ? xcd * (q + 1) : r * (q + 1) + (xcd - r) * q) + off; }
        const int nig = WGM * nN, gid = wgid / nig, fm = gid * WGM, gsz = (nM - fm) < WGM ? (nM - fm) : WGM;
        u.pm = fm + ((wgid % nig) % gsz); u.pn = (wgid % nig) / gsz; u.e = 0; u.row0 = u.pm * 256; u.nvalid = 256; return true;
    }
    __device__ __forceinline__ const char* a_base() const { return (const char*)A; }
    __device__ __forceinline__ unsigned a_off(const Unit& u, int r) const { return (unsigned)(u.row0 + r) * (unsigned)K * 2u; }
    __device__ __forceinline__ const char* b_base(const Unit& u) const { return (const char*)Bt + (size_t)u.pn * 256 * K * 2; }
};
constexpr int MOE_REG = 4;
template <bool GATHER, int NPN, int KK, int NROWS_E  >
struct MoeSched {
    static constexpr bool DYN_HALF = true;
    const bf16_t* A; const bf16_t* Bt; const int* cnt; const int* ent;
    int mode;
    int idx, stride, maxi;
    int idx1;
    unsigned* flags; int role;
    __device__ __forceinline__ bool lookup(int L, int md, Unit& u) const {
        int hb = 0;
        for (int e = 0; e < NE; ++e) {
            const int n = __builtin_amdgcn_readfirstlane(cnt[e]); const int nt = (n + 255) >> 8;
            const int lo = (md == 1) ? min(nt, MOE_REG) : 0, hi = (md == 0) ? min(nt, MOE_REG) : nt;
            const int nsel = (hi - lo) * NPN;
            if (L < nsel) { u.e = e; u.pm = lo + L / NPN; u.pn = L % NPN; u.row0 = hb + u.pm * 256; u.nvalid = min(256, n - u.pm * 256); return true; }
            L -= nsel; hb += nt * 256;
        }
        return false;
    }
    __device__ __forceinline__ bool next(int i, Unit& u) const {
        int L;
        const int n0 = (idx >= 0) ? maxi : 0;
        if (i < n0) L = idx + i * stride; else if (i == n0 && idx1 >= 0) L = idx1; else return false;
        if (mode != 3) return lookup(L, mode, u);
        int nreg = 0; for (int e = 0; e < NE; ++e) nreg += min((__builtin_amdgcn_readfirstlane(cnt[e]) + 255) >> 8, MOE_REG) * NPN;
        return (L < nreg) ? lookup(L, 0, u) : lookup(L - nreg, 1, u);
    }
    __device__ __forceinline__ const char* a_base() const { return (const char*)A; }
    __device__ __forceinline__ unsigned a_off(const Unit& u, int r) const {
        if (GATHER) { const int tok = (r < u.nvalid) ? (ent[u.e * T + u.pm * 256 + r] & 0xffff) : 0; return (unsigned)tok * (unsigned)KK * 2u; }
        return (unsigned)(u.row0 + r) * (unsigned)KK * 2u;
    }
    __device__ __forceinline__ const char* b_base(const Unit& u) const { return (const char*)Bt + ((size_t)u.e * NROWS_E + (size_t)u.pn * 256) * KK * 2; }
    __device__ __forceinline__ void a_ready(const Unit& u) const {
        if (role != 2) return;
        if (threadIdx.x < 64) {
            unsigned* f = flags + (u.row0 >> 8) * 64; unsigned spins = 0;
            while ((unsigned)__builtin_amdgcn_readfirstlane(__hip_atomic_load(f, __ATOMIC_RELAXED, __HIP_MEMORY_SCOPE_AGENT)) < 32u) { __builtin_amdgcn_s_sleep(2); if (++spins > (1u << 22)) break; }
            __builtin_amdgcn_fence(__ATOMIC_ACQUIRE, "agent");
            asm volatile("s_waitcnt vmcnt(0)" ::: "memory");
        }
        asm volatile("" ::: "memory"); __builtin_amdgcn_s_barrier(); asm volatile("" ::: "memory");
    }
    __device__ __forceinline__ void done(const Unit& u) const {
        if (role != 1) return;
        asm volatile("s_waitcnt vmcnt(0)" ::: "memory");
        if ((threadIdx.x & 63) == 0) __hip_atomic_fetch_add(flags + (u.row0 >> 8) * 64, 1u, __ATOMIC_RELAXED, __HIP_MEMORY_SCOPE_AGENT);
    }
};
__device__ __forceinline__ int moe_overflow_tiles(const int* cnt) { int t = 0; for (int e = 0; e < NE; ++e) { const int nt = (__builtin_amdgcn_readfirstlane(cnt[e]) + 255) >> 8; t += max(nt - MOE_REG, 0); } return t; }

typedef f32x4 Acc[2][2][4][2];
__device__ __forceinline__ u32x4 pack8(f32x4 a, f32x4 b) { u32x4 w; w.x = cvt_pk_bf16(a[0], a[1]); w.y = cvt_pk_bf16(a[2], a[3]); w.z = cvt_pk_bf16(b[0], b[1]); w.w = cvt_pk_bf16(b[2], b[3]); return w; }
__device__ __forceinline__ void unpack8(u32x4 w, f32x4& a, f32x4& b) { a = (f32x4){bf_lo(w.x), bf_hi(w.x), bf_lo(w.y), bf_hi(w.y)}; b = (f32x4){bf_lo(w.z), bf_hi(w.z), bf_lo(w.w), bf_hi(w.w)}; }

struct EpiProj {
    static constexpr bool PERM = true; static constexpr int MIDK = 0;
    bf16_t *Bc, *P, *U, *V, *R, *S; f32x2* VST;
    __device__ __forceinline__ void mid(Acc&, const Unit&, int, int, int, int) const {}
    __device__ __forceinline__ void operator()(const Acc& acc, const Unit& u, int wr, int wc, int fr, int fq) const {
        const int pn = u.pn; const int rowb = u.row0 + wr * 64 + fr; const int cl = wc * 32 + 8 * fq;
#pragma unroll
        for (int ai = 0; ai < 2; ++ai)
#pragma unroll
            for (int m = 0; m < 4; ++m) {
                const size_t row = (size_t)(rowb + ai * 128 + m * 16);
                if (pn < 4) {
#pragma unroll
                    for (int bj = 0; bj < 2; ++bj) *(u32x4*)(Bc + row * CW + pn * 256 + bj * 128 + cl) = pack8(acc[ai][bj][m][0], acc[ai][bj][m][1]);
                } else if (pn < 12) {
                    *(u32x4*)(P + row * CW + (pn - 4) * 128 + cl) = pack8(acc[ai][0][m][0] * acc[ai][1][m][0], acc[ai][0][m][1] * acc[ai][1][m][1]);
                } else if (pn < 20) {
                    bf16_t* O = (pn < 16) ? (U + row * SW + (pn - 12) * 256) : (V + row * SW + (pn - 16) * 256);
                    float ssum = 0.f, ssq = 0.f;
#pragma unroll
                    for (int bj = 0; bj < 2; ++bj) { f32x4 a = acc[ai][bj][m][0], b = acc[ai][bj][m][1];
#pragma unroll
                        for (int j = 0; j < 4; ++j) { a[j] = gelu_tanh(a[j]); b[j] = gelu_tanh(b[j]); ssum += a[j] + b[j]; ssq += a[j] * a[j] + b[j] * b[j]; }
                        *(u32x4*)(O + bj * 128 + cl) = pack8(a, b); }
                    if (pn >= 16) {
                        ssum += __shfl_xor(ssum, 16); ssum += __shfl_xor(ssum, 32); ssq += __shfl_xor(ssq, 16); ssq += __shfl_xor(ssq, 32);
                        if (fq == 0) VST[row * 16 + (pn - 16) * 4 + wc] = (f32x2){ssum, ssq}; }
                } else {
                    f32x4 r0, r1, s0, s1;
#pragma unroll
                    for (int j = 0; j < 4; ++j) {
                        const float ec0 = fast_exp2(-1.44269504f * acc[ai][0][m][0][j]), es0 = fast_exp2(-1.44269504f * acc[ai][1][m][0][j]);
                        const float ec1 = fast_exp2(-1.44269504f * acc[ai][0][m][1][j]), es1 = fast_exp2(-1.44269504f * acc[ai][1][m][1][j]);
                        r0[j] = (1.0f + es0) * fast_rcp(1.0f + ec0); s0[j] = fast_rcp(1.0f + es0);
                        r1[j] = (1.0f + es1) * fast_rcp(1.0f + ec1); s1[j] = fast_rcp(1.0f + es1);
                    }
                    const size_t o = row * D + (pn - 20) * 128 + cl;
                    *(u32x4*)(R + o) = pack8(r0, r1); *(u32x4*)(S + o) = pack8(s0, s1);
                }
            }
    }
};
struct EpiUp {
    static constexpr bool PERM = true; static constexpr int MIDK = 1024;
    const bf16_t *R, *S; bf16_t* Mm;
    __device__ __forceinline__ void mid(Acc& acc, const Unit& u, int wr, int wc, int fr, int fq) const {
        int rowb = u.row0 + wr * 64 + fr; const int cb = u.pn * 256 + wc * 32 + 8 * fq;
        asm volatile("" : "+v"(rowb));
#pragma unroll
        for (int ai = 0; ai < 2; ++ai)
#pragma unroll
            for (int m = 0; m < 4; ++m)
#pragma unroll
                for (int bj = 0; bj < 2; ++bj) { f32x4 a, b; unpack8(*(const u32x4*)(R + (size_t)(rowb + ai * 128 + m * 16) * D + cb + bj * 128), a, b);
                    acc[ai][bj][m][0] *= a; acc[ai][bj][m][1] *= b; }
    }
    __device__ __forceinline__ void operator()(const Acc& acc, const Unit& u, int wr, int wc, int fr, int fq) const {
        const int rowb = u.row0 + wr * 64 + fr; const int cb = u.pn * 256 + wc * 32 + 8 * fq;
#pragma unroll
        for (int ai = 0; ai < 2; ++ai)
#pragma unroll
            for (int m = 0; m < 4; ++m)
#pragma unroll
                for (int bj = 0; bj < 2; ++bj) { const size_t o = (size_t)(rowb + ai * 128 + m * 16) * D + cb + bj * 128; f32x4 a, b; unpack8(*(const u32x4*)(S + o), a, b);
                    *(u32x4*)(Mm + o) = pack8(acc[ai][bj][m][0] * a, acc[ai][bj][m][1] * b); }
    }
};
struct EpiOut {
    static constexpr bool PERM = true; static constexpr int MIDK = 0;
    const float* x; bf16_t* A2;
    __device__ __forceinline__ void mid(Acc&, const Unit&, int, int, int, int) const {}
    __device__ __forceinline__ void operator()(const Acc& acc, const Unit& u, int wr, int wc, int fr, int fq) const {
        const int rowb = u.row0 + wr * 64 + fr; const int cb = u.pn * 256 + wc * 32 + 8 * fq;
#pragma unroll
        for (int ai = 0; ai < 2; ++ai)
#pragma unroll
            for (int m = 0; m < 4; ++m)
#pragma unroll
                for (int bj = 0; bj < 2; ++bj) { const size_t o = (size_t)(rowb + ai * 128 + m * 16) * D + cb + bj * 128;
                    const f32x4 h0 = *(const f32x4*)(x + o) + acc[ai][bj][m][0], h1 = *(const f32x4*)(x + o + 4) + acc[ai][bj][m][1];
                    *(u32x4*)(A2 + o) = pack8(h0, h1); }
    }
};
struct EpiMoe1 {
    static constexpr bool PERM = true; static constexpr int MIDK = 0;
    const int* ent; const float* lw; const float* rstd; bf16_t* Hid; bool wt;
    __device__ __forceinline__ void mid(Acc&, const Unit&, int, int, int, int) const {}
    __device__ __forceinline__ void operator()(const Acc& acc, const Unit& u, int wr, int wc, int fr, int fq) const {
        const int cl = u.pn * 128 + wc * 32 + 8 * fq;
#pragma unroll
        for (int ai = 0; ai < 2; ++ai)
#pragma unroll
            for (int m = 0; m < 4; ++m) {
                const int r = ai * 128 + wr * 64 + m * 16 + fr;
                if (r < u.nvalid) {
                    const int li = u.e * T + u.pm * 256 + r; const int tok = ent[li] & 0xffff; const float rs = rstd[tok], w = lw[li];
                    f32x4 o[2];
#pragma unroll
                    for (int n = 0; n < 2; ++n)
#pragma unroll
                        for (int j = 0; j < 4; ++j) { const float gt = acc[ai][0][m][n][j] * rs, up = acc[ai][1][m][n][j] * rs; o[n][j] = gt * sigmoid_f(gt) * up * w; }
                    bf16_t* dst = Hid + (size_t)(u.row0 + r) * DE + cl; if (wt) st16_wt(dst, pack8(o[0], o[1])); else *(u32x4*)dst = pack8(o[0], o[1]);
                }
            }
    }
};
struct EpiMoe2 {
    static constexpr bool PERM = true; static constexpr int MIDK = 0;
    const int* ent; bf16_t* Yk0; bf16_t* Yk1;
    __device__ __forceinline__ void mid(Acc&, const Unit&, int, int, int, int) const {}
    __device__ __forceinline__ void operator()(const Acc& acc, const Unit& u, int wr, int wc, int fr, int fq) const {
        const int cb = u.pn * 256 + wc * 32 + 8 * fq;
#pragma unroll
        for (int ai = 0; ai < 2; ++ai)
#pragma unroll
            for (int m = 0; m < 4; ++m) {
                const int r = ai * 128 + wr * 64 + m * 16 + fr;
                if (r < u.nvalid) {
                    const int en = ent[u.e * T + u.pm * 256 + r]; const int tok = en & 0xffff; bf16_t* Y = (en >> 16) ? Yk1 : Yk0;
#pragma unroll
                    for (int bj = 0; bj < 2; ++bj) *(u32x4*)(Y + (size_t)tok * D + cb + bj * 128) = pack8(acc[ai][bj][m][0], acc[ai][bj][m][1]);
                }
            }
    }
};

template <class Epi, class Sched>
__device__ __forceinline__ void gemm_simple(const Sched& S, const Epi& E, const int K) {
    const int tid = opaque_tid(), wid = __builtin_amdgcn_readfirstlane(tid >> 6), lane = tid & 63, wr = wid >> 2, wc = wid & 3, fr = lane & 15, fq = lane >> 4;
    Unit u;
    for (int ui = 0; S.next(ui, u); ++ui) {
        Acc acc;
#pragma unroll
        for (int a = 0; a < 2; ++a)
#pragma unroll
            for (int b = 0; b < 2; ++b)
#pragma unroll
                for (int m = 0; m < 4; ++m)
#pragma unroll
                    for (int n = 0; n < 2; ++n) acc[a][b][m][n] = (f32x4){0.f, 0.f, 0.f, 0.f};
        S.a_ready(u);
        const char* ab = S.a_base(); const char* bb = S.b_base(u);
        unsigned aoff[2][4], boff[2][2];
#pragma unroll
        for (int ai = 0; ai < 2; ++ai)
#pragma unroll
            for (int m = 0; m < 4; ++m) aoff[ai][m] = S.a_off(u, ai * 128 + wr * 64 + m * 16 + fr) + fq * 16;
#pragma unroll
        for (int bj = 0; bj < 2; ++bj)
#pragma unroll
            for (int n = 0; n < 2; ++n) { const int rr = Epi::PERM ? perm32(n * 16 + fr) : (n * 16 + fr); boff[bj][n] = (unsigned)(bj * 128 + wc * 32 + rr) * (unsigned)K * 2u + fq * 16; }
        for (int k0 = 0; k0 < K; k0 += 32) {
            if (Epi::MIDK != 0 && k0 == Epi::MIDK) E.mid(acc, u, wr, wc, fr, fq);
            bf16x8 a[2][4], b[2][2];
#pragma unroll
            for (int ai = 0; ai < 2; ++ai)
#pragma unroll
                for (int m = 0; m < 4; ++m) a[ai][m] = *(const bf16x8*)(ab + aoff[ai][m] + k0 * 2);
#pragma unroll
            for (int bj = 0; bj < 2; ++bj)
#pragma unroll
                for (int n = 0; n < 2; ++n) b[bj][n] = *(const bf16x8*)(bb + boff[bj][n] + k0 * 2);
#pragma unroll
            for (int ai = 0; ai < 2; ++ai)
#pragma unroll
                for (int bj = 0; bj < 2; ++bj)
#pragma unroll
                    for (int m = 0; m < 4; ++m)
#pragma unroll
                        for (int n = 0; n < 2; ++n) acc[ai][bj][m][n] = __builtin_amdgcn_mfma_f32_16x16x32_bf16(b[bj][n], a[ai][m], acc[ai][bj][m][n], 0, 0, 0);
        }
        E(acc, u, wr, wc, fr, fq); S.done(u);
    }
}

constexpr int BK = 64, HALF = 128, HTB = HALF * BK * 2, STAGE_BYTES = 8 * HTB;
__host__ __device__ __forceinline__ int lds_byte(int r, int c) { const int st = (r >> 4) * 2 + (c >> 5), rr = r & 15, cc = c & 31, ob = rr * 64 + cc * 2; return st * 1024 + (ob ^ (((ob >> 9) & 1) << 5)); }
__host__ __device__ __forceinline__ void stage_rc(int b, int& R, int& C) { const int st = b / 1024, sb = b % 1024, swz = sb ^ (((sb >> 9) & 1) << 5); R = (st >> 1) * 16 + swz / 64; C = (st & 1) * 32 + (swz % 64) / 2; }

template <class Epi, class Sched>
__device__ __forceinline__ void gemm_fast(LAS unsigned char* lds, const Sched& S, const Epi& E, const int K) {
    const int tid = opaque_tid(), wid = __builtin_amdgcn_readfirstlane(tid >> 6), lane = tid & 63, wr = wid >> 2, wc = wid & 3, fr = lane & 15, fq = lane >> 4;
    const int nt = K / BK;
    int sR[2], sC[2]; unsigned voffB[2];
#pragma unroll
    for (int i = 0; i < 2; ++i) { stage_rc(tid * 16 + i * 8192, sR[i], sC[i]); const int Rb = Epi::PERM ? ((sR[i] & ~31) + perm32(sR[i] & 31)) : sR[i]; voffB[i] = (unsigned)(Rb * K + sC[i]) * 2u; }
    const size_t kstep = (size_t)(BK * 2);
    const size_t hstepB = (size_t)HALF * K * 2;
    const unsigned ldsw = (unsigned)wid * 1024u;
    const int aoff = lds_byte(wr * 64 + fr, fq * 8), boff = lds_byte(wc * 32 + fr, fq * 8);
#define PG8_SA(b, h) (((b) * 2 + (h)) * HTB)
#define PG8_SB(b, h) ((4 + (b) * 2 + (h)) * HTB)
#define PG8_STAGE(bufoff, gbase, voff) do { _Pragma("unroll") for (int _i = 0; _i < 2; ++_i) \
        __builtin_amdgcn_global_load_lds((const unsigned*)((const char*)(gbase) + (voff)[_i]), (LAS unsigned*)(lds + (bufoff) + ldsw + _i * 8192), 16, 0, 0); } while (0)
#define PG8_LDA(dst, b, h) do { _Pragma("unroll") for (int m = 0; m < 4; ++m) _Pragma("unroll") for (int k = 0; k < 2; ++k) dst[m][k] = *(const LAS bf16x8*)(lds + PG8_SA(b, h) + aoff + m * 2048 + k * 1024); } while (0)
#define PG8_LDB(dst, b, h) do { _Pragma("unroll") for (int n = 0; n < 2; ++n) _Pragma("unroll") for (int k = 0; k < 2; ++k) dst[n][k] = *(const LAS bf16x8*)(lds + PG8_SB(b, h) + boff + n * 2048 + k * 1024); } while (0)
#define PG8_MMA(ai, bj, At, Bt) do { __builtin_amdgcn_s_setprio(1); _Pragma("unroll") for (int m = 0; m < 4; ++m) _Pragma("unroll") for (int n = 0; n < 2; ++n) _Pragma("unroll") for (int k = 0; k < 2; ++k) \
        acc[ai][bj][m][n] = __builtin_amdgcn_mfma_f32_16x16x32_bf16(Bt[n][k], At[m][k], acc[ai][bj][m][n], 0, 0, 0); __builtin_amdgcn_s_setprio(0); } while (0)
#define PG8_WAIT_V(n) asm volatile("s_waitcnt vmcnt(" #n ")" ::: "memory")
#define PG8_WAIT_L(n) asm volatile("s_waitcnt lgkmcnt(" #n ")" ::: "memory")
#define PG8_BAR __builtin_amdgcn_s_barrier()
#define PG8_SCHED __builtin_amdgcn_sched_barrier(0)
    Unit cur, nxt; int ui = 0;
    if (!S.next(0, cur)) return;
    Acc acc;
#pragma unroll
    for (int a = 0; a < 2; ++a)
#pragma unroll
        for (int b = 0; b < 2; ++b)
#pragma unroll
            for (int m = 0; m < 4; ++m)
#pragma unroll
                for (int n = 0; n < 2; ++n) acc[a][b][m][n] = (f32x4){0.f, 0.f, 0.f, 0.f};
    bf16x8 At[4][2], B0[2][2], B1[2][2];
    unsigned va[2][2], vn[2][2];
#pragma unroll
    for (int h = 0; h < 2; ++h)
#pragma unroll
        for (int i = 0; i < 2; ++i) va[h][i] = S.a_off(cur, h * 128 + sR[i]) + (unsigned)sC[i] * 2u;
    const char* const A0 = S.a_base(); const char* cB = S.b_base(cur);
    S.a_ready(cur);
    PG8_STAGE(PG8_SB(0, 0), cB, voffB); PG8_STAGE(PG8_SB(0, 1), cB + hstepB, voffB); PG8_STAGE(PG8_SA(0, 0), A0, va[0]); PG8_STAGE(PG8_SA(0, 1), A0, va[1]);
    if (wr == 1) PG8_BAR;
    PG8_WAIT_V(2); PG8_BAR;
    PG8_STAGE(PG8_SB(1, 0), cB + kstep, voffB); PG8_STAGE(PG8_SA(1, 0), A0 + kstep, va[0]); PG8_STAGE(PG8_SB(1, 1), cB + hstepB + kstep, voffB);
    PG8_WAIT_V(6); PG8_BAR;
    for (;;) {
        const bool has_next = S.next(ui + 1, nxt);
        const char* nB = has_next ? S.b_base(nxt) : cB;
#pragma unroll
        for (int h = 0; h < 2; ++h)
#pragma unroll
            for (int i = 0; i < 2; ++i) vn[h][i] = has_next ? (S.a_off(nxt, h * 128 + sR[i]) + (unsigned)sC[i] * 2u) : va[h][i];
        for (int t = 0; t < nt; t += 2) {
            const bool last = (t == nt - 2);
            if (Epi::MIDK != 0 && t * BK == Epi::MIDK) { PG8_SCHED; E.mid(acc, cur, wr, wc, fr, fq); PG8_SCHED; }
            if (last && has_next) S.a_ready(nxt);
            const char* a1 = A0 + (size_t)(t + 1) * kstep;
            const char* a2 = last ? A0 : A0 + (size_t)(t + 2) * kstep; const char* b2 = last ? nB : cB + (size_t)(t + 2) * kstep;
            const char* a3 = a2 + kstep; const char* b3 = b2 + kstep;
            unsigned v2[2][2];
#pragma unroll
            for (int h = 0; h < 2; ++h)
#pragma unroll
                for (int i = 0; i < 2; ++i) v2[h][i] = last ? vn[h][i] : va[h][i];
            const bool full = !Sched::DYN_HALF || cur.nvalid > 128;
            PG8_LDB(B0, 0, 0); PG8_LDB(B1, 0, 1); PG8_SCHED; PG8_LDA(At, 0, 0); PG8_STAGE(PG8_SA(1, 1), a1, va[1]);
            PG8_WAIT_V(8); PG8_WAIT_L(0); PG8_BAR; PG8_MMA(0, 0, At, B0); PG8_MMA(0, 1, At, B1); PG8_BAR; PG8_SCHED;
            if (full) { PG8_LDA(At, 0, 1); } PG8_STAGE(PG8_SB(0, 0), b2, voffB); PG8_STAGE(PG8_SB(0, 1), b2 + hstepB, voffB); PG8_STAGE(PG8_SA(0, 0), a2, v2[0]);
            PG8_WAIT_V(8); PG8_WAIT_L(0); PG8_BAR; if (full) { PG8_MMA(1, 0, At, B0); PG8_MMA(1, 1, At, B1); } PG8_BAR; PG8_SCHED;
            PG8_LDB(B0, 1, 0); PG8_LDB(B1, 1, 1); PG8_SCHED; PG8_LDA(At, 1, 0); PG8_STAGE(PG8_SA(0, 1), a2, v2[1]);
            PG8_WAIT_V(8); PG8_WAIT_L(0); PG8_BAR; PG8_MMA(0, 0, At, B0); PG8_MMA(0, 1, At, B1); PG8_BAR; PG8_SCHED;
            if (full) { PG8_LDA(At, 1, 1); } PG8_STAGE(PG8_SB(1, 0), b3, voffB); PG8_STAGE(PG8_SB(1, 1), b3 + hstepB, voffB); PG8_STAGE(PG8_SA(1, 0), a3, v2[0]);
            PG8_WAIT_V(8); PG8_WAIT_L(0); PG8_BAR; if (full) { PG8_MMA(1, 0, At, B0); PG8_MMA(1, 1, At, B1); } PG8_BAR; PG8_SCHED;
        }
        if (wr == 0) PG8_BAR;
        E(acc, cur, wr, wc, fr, fq); S.done(cur);
        if (!has_next) break;
#pragma unroll
        for (int a = 0; a < 2; ++a)
#pragma unroll
            for (int b = 0; b < 2; ++b)
#pragma unroll
                for (int m = 0; m < 4; ++m)
#pragma unroll
                    for (int n = 0; n < 2; ++n) acc[a][b][m][n] = (f32x4){0.f, 0.f, 0.f, 0.f};
        cur = nxt; cB = nB; ++ui;
#pragma unroll
        for (int h = 0; h < 2; ++h)
#pragma unroll
            for (int i = 0; i < 2; ++i) va[h][i] = vn[h][i];
        if (wr == 1) PG8_BAR;
    }
    PG8_WAIT_V(0);
    PG8_BAR;
#undef PG8_SA
#undef PG8_SB
#undef PG8_STAGE
#undef PG8_LDA
#undef PG8_LDB
#undef PG8_MMA
#undef PG8_WAIT_V
#undef PG8_WAIT_L
#undef PG8_BAR
#undef PG8_SCHED
}
#ifndef FAST_MASK
#define FAST_MASK 0x1f
#endif
template <int BIT, class Epi, class Sched>
__device__ __forceinline__ void gemm_run(LAS unsigned char* lds, const Sched& S, const Epi& E, const int K) {
    if constexpr ((FAST_MASK >> BIT) & 1) gemm_fast(lds, S, E, K); else gemm_simple(S, E, K);
}

__device__ __forceinline__ void tr_item64(const float* W, int N, int k0, int ns, bf16_t* WT, int ldk, int nd, int kd, LAS float* scr, int lane, const float* kscale) {
    { const int r4 = lane >> 4, c4 = (lane & 15) * 4; f32x4 v[16];
#pragma unroll
      for (int i = 0; i < 16; ++i) v[i] = __builtin_nontemporal_load((const f32x4*)(W + (size_t)(k0 + 4 * i + r4) * N + ns + c4));
#pragma unroll
      for (int i = 0; i < 16; ++i) { LAS float* d = scr + (4 * i + r4) * 65 + c4; d[0] = v[i][0]; d[1] = v[i][1]; d[2] = v[i][2]; d[3] = v[i][3]; } }
    const int c = lane & 7;
    f32x4 s0 = (f32x4){1.f, 1.f, 1.f, 1.f}, s1 = s0;
    if (kscale) { s0 = *(const f32x4*)(kscale + k0 + 8 * c); s1 = *(const f32x4*)(kscale + k0 + 8 * c + 4); }
    asm volatile("s_waitcnt lgkmcnt(0)" ::: "memory");
#pragma unroll
    for (int j = 0; j < 8; ++j) { const int n = (lane >> 3) + 8 * j; const LAS float* s = scr + (8 * c) * 65 + n;
        u32x4 o; o.x = cvt_pk_bf16(s[0 * 65] * s0[0], s[1 * 65] * s0[1]); o.y = cvt_pk_bf16(s[2 * 65] * s0[2], s[3 * 65] * s0[3]);
        o.z = cvt_pk_bf16(s[4 * 65] * s1[0], s[5 * 65] * s1[1]); o.w = cvt_pk_bf16(s[6 * 65] * s1[2], s[7 * 65] * s1[3]);
        *(u32x4*)(WT + (size_t)(nd + n) * ldk + kd + 8 * c) = o; }
    asm volatile("s_waitcnt lgkmcnt(0)" ::: "memory");
}
constexpr int TRS = 64 * 65 * 4;
static_assert(8 * TRS <= LDS_BYTES - 64, "transpose scratch vs barrier words");
struct TrItem { const float* W; int N; bf16_t* WT; int ldk, nd, kd, k0, ns; const float* ks; };
__device__ __forceinline__ void tr_load(f32x4 (&v)[16], const TrItem& it, int lane) {
    const int r4 = lane >> 4, c4 = (lane & 15) * 4;
#pragma unroll
    for (int i = 0; i < 16; ++i) v[i] = __builtin_nontemporal_load((const f32x4*)(it.W + (size_t)(it.k0 + 4 * i + r4) * it.N + it.ns + c4));
}
__device__ __forceinline__ void tr_store(const f32x4 (&v)[16], const TrItem& it, LAS float* scr, int lane) {
    { const int r4 = lane >> 4, c4 = (lane & 15) * 4;
#pragma unroll
      for (int i = 0; i < 16; ++i) { LAS float* d = scr + (4 * i + r4) * 65 + c4; d[0] = v[i][0]; d[1] = v[i][1]; d[2] = v[i][2]; d[3] = v[i][3]; } }
    const int c = lane & 7;
    f32x4 s0 = (f32x4){1.f, 1.f, 1.f, 1.f}, s1 = s0;
    if (it.ks) { s0 = *(const f32x4*)(it.ks + it.k0 + 8 * c); s1 = *(const f32x4*)(it.ks + it.k0 + 8 * c + 4); }
    asm volatile("s_waitcnt lgkmcnt(0)" ::: "memory");
#pragma unroll
    for (int j = 0; j < 8; ++j) { const int n = (lane >> 3) + 8 * j; const LAS float* s = scr + (8 * c) * 65 + n;
        u32x4 o; o.x = cvt_pk_bf16(s[0 * 65] * s0[0], s[1 * 65] * s0[1]); o.y = cvt_pk_bf16(s[2 * 65] * s0[2], s[3 * 65] * s0[3]);
        o.z = cvt_pk_bf16(s[4 * 65] * s1[0], s[5 * 65] * s1[1]); o.w = cvt_pk_bf16(s[6 * 65] * s1[2], s[7 * 65] * s1[3]);
        __builtin_nontemporal_store(o, (u32x4*)(it.WT + (size_t)(it.nd + n) * it.ldk + it.kd + 8 * c)); }
    asm volatile("s_waitcnt lgkmcnt(0)" ::: "memory");
}
constexpr int NIT_EXP = 8192 + 4096;
__device__ __forceinline__ TrItem exp_item(const Params& p, int r) {
    TrItem it;
    if (r < 8192) { const int up = r >> 12, qq = r & 4095, e = qq >> 8, kb = (qq & 255) >> 3, nb = qq & 7;
        it.W = p.in[up ? 17 : 16] + (size_t)e * D * DE; it.N = DE; it.WT = (bf16_t*)(p.ws + WS_W1T) + (size_t)e * 1024 * D; it.ldk = D;
        it.nd = 256 * (nb >> 1) + (nb & 1) * 64 + (up ? 128 : 0); it.kd = kb * 64; it.k0 = kb * 64; it.ns = nb * 64; it.ks = p.in[11]; }
    else { const int q = r - 8192, e = q >> 8, kb = (q & 255) >> 5, nb = q & 31;
        it.W = p.in[18] + (size_t)e * DE * D; it.N = D; it.WT = (bf16_t*)(p.ws + WS_W2T) + (size_t)e * D * DE; it.ldk = DE; it.nd = nb * 64; it.kd = kb * 64; it.k0 = kb * 64; it.ns = nb * 64; it.ks = nullptr; }
    return it;
}
__device__ __forceinline__ void convert_tail(const Params& p, LAS unsigned char* lds, int nunits) {
    const int tid = opaque_tid(), wave = __builtin_amdgcn_readfirstlane(tid >> 6), lane = tid & 63;
    const int G = gridDim.x, rounds = (nunits + G - 1) / G, nfull = nunits - (rounds - 1) * G;
    int idle_idx, n_idle;
    if (nfull >= G || nunits == 0) { idle_idx = blockIdx.x; n_idle = G; } else { idle_idx = (int)blockIdx.x - nfull; n_idle = G - nfull; }
    if (idle_idx < 0) return;
    LAS float* scr = (LAS float*)(lds + wave * TRS);
    const int stride = n_idle * NWAVES; int r = idle_idx * NWAVES + wave;
    if (r >= NIT_EXP) return;
    f32x4 va[16], vb[16];
    TrItem ia = exp_item(p, r), ib = ia;
    tr_load(va, ia, lane);
    for (;;) {
        const bool hb = (r + stride) < NIT_EXP;
        if (hb) { ib = exp_item(p, r + stride); tr_load(vb, ib, lane); }
        tr_store(va, ia, scr, lane);
        if (!hb) break;
        r += stride;
        const bool ha = (r + stride) < NIT_EXP;
        if (ha) { ia = exp_item(p, r + stride); tr_load(va, ia, lane); }
        tr_store(vb, ib, scr, lane);
        if (!ha) break;
        r += stride;
    }
}
__device__ __forceinline__ int win_src_col(int nd) {
    if (nd < 1024) return nd;
    if (nd < 3072) { const int q = (nd - 1024) >> 8, r = (nd - 1024) & 255; return r < 128 ? (1024 + 128 * q + r) : (2048 + 128 * q + r - 128); }
    if (nd < 5120) return nd;
    { const int q = (nd - 5120) >> 8, r = (nd - 5120) & 255; return r < 128 ? (5120 + 128 * q + r) : (7168 + 128 * q + r - 128); }
}
__device__ __forceinline__ void phase0(const Params& p, LAS unsigned char* lds) {
    const int tid = opaque_tid(), wave = __builtin_amdgcn_readfirstlane(tid >> 6), lane = tid & 63;
    LAS float* scr = (LAS float*)(lds + wave * TRS);
    const int gw = blockIdx.x * NWAVES + wave, NGW = gridDim.x * NWAVES;
    unsigned char* ws = p.ws;
    constexpr int I_IN = 32 * 144, I_UP = 16 * 32, I_OUT = 32 * 32;
    constexpr int NITEMS = I_IN + 2 * I_UP + I_OUT;
    for (int it = gw; it < NITEMS; it += NGW) {
        int r = it;
        if (r < I_IN) { const int kb = r / 144, nb = r % 144; tr_item64(p.in[2], NIN, kb * 64, win_src_col(nb * 64), (bf16_t*)(ws + WS_WINT), D, nb * 64, kb * 64, scr, lane, nullptr); continue; } r -= I_IN;
        if (r < I_UP) { const int kb = r / 32, nb = r % 32; tr_item64(p.in[8], D, kb * 64, nb * 64, (bf16_t*)(ws + WS_WUPT), 2048, nb * 64, kb * 64, scr, lane, nullptr); continue; } r -= I_UP;
        if (r < I_UP) { const int kb = r / 32, nb = r % 32; tr_item64(p.in[9], D, kb * 64, nb * 64, (bf16_t*)(ws + WS_WUPT), 2048, nb * 64, 1024 + kb * 64, scr, lane, nullptr); continue; } r -= I_UP;
        { const int kb = r / 32, nb = r % 32; tr_item64(p.in[10], D, kb * 64, nb * 64, (bf16_t*)(ws + WS_WOUTT), D, nb * 64, kb * 64, scr, lane, nullptr); }
    }
    const float* x = p.in[0]; const float* g = p.in[1]; bf16_t* xn = (bf16_t*)(ws + WS_X);
    for (int m = gw; m < T; m += NGW) {
        const f32x4* xr = (const f32x4*)(x + (size_t)m * D) + lane; f32x4 v[8]; float s = 0.f;
#pragma unroll
        for (int j = 0; j < 8; ++j) { v[j] = __builtin_nontemporal_load(xr + 64 * j); s += (v[j][0] * v[j][0] + v[j][1] * v[j][1]) + (v[j][2] * v[j][2] + v[j][3] * v[j][3]); }
        const float rs = 1.0f / sqrtf(wave_sum(s) * (1.0f / D) + EPS);
        u32x2* o = (u32x2*)(xn + (size_t)m * D) + lane;
#pragma unroll
        for (int j = 0; j < 8; ++j) { const f32x4 gg = *((const f32x4*)g + lane + 64 * j); u32x2 w; w.x = cvt_pk_bf16(v[j][0] * rs * gg[0], v[j][1] * rs * gg[1]); w.y = cvt_pk_bf16(v[j][2] * rs * gg[2], v[j][3] * rs * gg[3]); o[64 * j] = w; }
    }
    { bf16_t* wr = (bf16_t*)(ws + WS_WR); const float* gf = p.in[11];
      for (int i = blockIdx.x * NTHREADS + tid; i < 32 * D; i += gridDim.x * NTHREADS) { const int j = i / D, d = i % D; unsigned hi = 0, lo = 0;
          if (j < 20) { const float v = gf[d] * (j < 4 ? p.in[12][d * 4 + j] : p.in[14][d * 16 + (j - 4)]); hi = cvt_pk_bf16(v, 0.f) & 0xffffu; lo = cvt_pk_bf16(v - __uint_as_float(hi << 16), 0.f) & 0xffffu; }
          wr[(size_t)j * D + d] = (bf16_t)hi; wr[(size_t)(32 + j) * D + d] = (bf16_t)lo; } }
    { bf16_t* wmb = (bf16_t*)(ws + WS_WMB); const float* wsrc = p.in[6];
      for (int i = blockIdx.x * NTHREADS + tid; i < 8 * 128 * 128 / 2; i += gridDim.x * NTHREADS) { const int e0 = 2 * i, r = (e0 >> 7) & 127, c = e0 & 127; const bool ok = (r >= 64) || (c < 64);
          ((unsigned*)wmb)[i] = ok ? cvt_pk_bf16(wsrc[e0], wsrc[e0 + 1]) : 0u; } }
    if (blockIdx.x == 0 && tid < 64) ((int*)(ws + WS_CTL))[tid] = 0;
}

__device__ __forceinline__ void phase2_conv(const Params& p) {
    const bf16_t* Bc = (const bf16_t*)(p.ws + WS_P + P_BC); const bf16_t* P = (const bf16_t*)(p.ws + WS_P + P_P); bf16_t* Y = (bf16_t*)(p.ws + WS_X);
    const float* cw = p.in[3];
    for (int i = blockIdx.x * NTHREADS + opaque_tid(); i < T * (CW / 8); i += gridDim.x * NTHREADS) {
        const int t = i >> 7, c = (i & 127) * 8;
        f32x4 p0a, p0b, p1a, p1b, p2a, p2b, ba, bb;
        unpack8(*(const u32x4*)(P + (size_t)t * CW + c), p2a, p2b); unpack8(*(const u32x4*)(Bc + (size_t)t * CW + c), ba, bb);
        if (t >= 1) unpack8(*(const u32x4*)(P + (size_t)(t - 1) * CW + c), p1a, p1b); else { p1a = (f32x4){0, 0, 0, 0}; p1b = p1a; }
        if (t >= 2) unpack8(*(const u32x4*)(P + (size_t)(t - 2) * CW + c), p0a, p0b); else { p0a = (f32x4){0, 0, 0, 0}; p0b = p0a; }
        const f32x4 w0a = *(const f32x4*)(cw + c), w0b = *(const f32x4*)(cw + c + 4), w1a = *(const f32x4*)(cw + CW + c), w1b = *(const f32x4*)(cw + CW + c + 4),
                    w2a = *(const f32x4*)(cw + 2 * CW + c), w2b = *(const f32x4*)(cw + 2 * CW + c + 4);
        const f32x4 ya = ba * (w0a * p0a + w1a * p1a + w2a * p2a), yb = bb * (w0b * p0b + w1b * p1b + w2b * p2b);
        *(u32x4*)(Y + (size_t)t * 2048 + c) = pack8(ya, yb);
    }
}
__device__ __forceinline__ void phase2_sgu(const Params& p, LAS unsigned char* lds) {
    const int tid = opaque_tid(), wave = __builtin_amdgcn_readfirstlane(tid >> 6), lane = tid & 63, fr = lane & 15, fq = lane >> 4;
    const bf16_t* U = (const bf16_t*)(p.ws + WS_P + P_U); const bf16_t* V = (const bf16_t*)(p.ws + WS_P + P_V); bf16_t* Y = (bf16_t*)(p.ws + WS_X);
    const bf16_t* WmB = (const bf16_t*)(p.ws + WS_WMB); const f32x2* VST = (const f32x2*)(p.ws + WS_SMALL + SM_VST);
    const float* lng = p.in[4]; const float* lnb = p.in[5]; const float* bs = p.in[7];
    LAS f32x2* st = (LAS f32x2*)lds;
    LAS unsigned char* vT = lds + 1024;
    constexpr int VP = 272;
    for (int unit = blockIdx.x; unit < 64 * 8; unit += gridDim.x) {
        const int nb = unit >> 3, h = unit & 7, t0 = nb * 128, c0 = h * 128;
        __syncthreads();
        if (tid < 128) { const f32x4* ps = (const f32x4*)(VST + (size_t)(t0 + tid) * 16); float s = 0.f, q = 0.f;
#pragma unroll
            for (int i = 0; i < 8; ++i) { const f32x4 v = ps[i]; s += v[0] + v[2]; q += v[1] + v[3]; }
            const float mu = s * (1.0f / SW); const float var = fmaxf(q * (1.0f / SW) - mu * mu, 0.f);
            st[tid] = (f32x2){mu, 1.0f / sqrtf(var + EPS)}; }
        __syncthreads();
        if (tid < 256) {
            const int jb = tid >> 4, cb = tid & 15, j0 = jb * 8, cc0 = cb * 8;
            const f32x4 g0 = *(const f32x4*)(lng + c0 + cc0), g1 = *(const f32x4*)(lng + c0 + cc0 + 4), b0 = *(const f32x4*)(lnb + c0 + cc0), b1 = *(const f32x4*)(lnb + c0 + cc0 + 4);
            f32x4 lo[8], hi[8];
#pragma unroll
            for (int r = 0; r < 8; ++r) { const f32x2 s = st[j0 + r]; f32x4 a, b; unpack8(*(const u32x4*)(V + (size_t)(t0 + j0 + r) * SW + c0 + cc0), a, b);
                lo[r] = (a - s.x) * s.y * g0 + b0; hi[r] = (b - s.x) * s.y * g1 + b1; }
#pragma unroll
            for (int cc = 0; cc < 4; ++cc) { u32x4 o;
                o.x = cvt_pk_bf16(lo[0][cc], lo[1][cc]); o.y = cvt_pk_bf16(lo[2][cc], lo[3][cc]); o.z = cvt_pk_bf16(lo[4][cc], lo[5][cc]); o.w = cvt_pk_bf16(lo[6][cc], lo[7][cc]);
                *(LAS u32x4*)(vT + (cc0 + cc) * VP + j0 * 2) = o;
                o.x = cvt_pk_bf16(hi[0][cc], hi[1][cc]); o.y = cvt_pk_bf16(hi[2][cc], hi[3][cc]); o.z = cvt_pk_bf16(hi[4][cc], hi[5][cc]); o.w = cvt_pk_bf16(hi[6][cc], hi[7][cc]);
                *(LAS u32x4*)(vT + (cc0 + 4 + cc) * VP + j0 * 2) = o; }
        }
        __syncthreads();
        bf16x8 wf[4];
#pragma unroll
        for (int ks = 0; ks < 4; ++ks) wf[ks] = *(const bf16x8*)(WmB + ((size_t)h * 128 + wave * 16 + fr) * 128 + ks * 32 + fq * 8);
        f32x4 acc[8];
#pragma unroll
        for (int nk = 0; nk < 8; ++nk) { acc[nk] = (f32x4){0.f, 0.f, 0.f, 0.f};
#pragma unroll
            for (int ks = 0; ks < 4; ++ks) { const bf16x8 vf = *(const LAS bf16x8*)(vT + (nk * 16 + fr) * VP + (ks * 32 + fq * 8) * 2);
                acc[nk] = __builtin_amdgcn_mfma_f32_16x16x32_bf16(vf, wf[ks], acc[nk], 0, 0, 0); } }
        { const int i = wave * 16 + fr; const float bb = bs[h * 128 + i]; const size_t t = (size_t)(t0 + i);
#pragma unroll
          for (int nk = 0; nk < 8; ++nk) { const int c = c0 + nk * 16 + 4 * fq; const u32x2 uu = *(const u32x2*)(U + t * SW + c);
              u32x2 o; o.x = cvt_pk_bf16(bf_lo(uu.x) * (acc[nk][0] + bb), bf_hi(uu.x) * (acc[nk][1] + bb)); o.y = cvt_pk_bf16(bf_lo(uu.y) * (acc[nk][2] + bb), bf_hi(uu.y) * (acc[nk][3] + bb));
              *(u32x2*)(Y + t * 2048 + 1024 + c) = o; } }
    }
}

__device__ __forceinline__ void phase5_router(const Params& p, LAS unsigned char* lds) {
    const int tid = opaque_tid(), wave = __builtin_amdgcn_readfirstlane(tid >> 6), lane = tid & 63, fr = lane & 15, fq = lane >> 4;
    const bf16_t* A2 = (const bf16_t*)(p.ws + WS_A2); const bf16_t* wr = (const bf16_t*)(p.ws + WS_WR);
    float* rstd = (float*)(p.ws + WS_SMALL + SM_RSTD); int* ent = (int*)(p.ws + WS_SMALL + SM_ENT); float* lw = (float*)(p.ws + WS_SMALL + SM_W); int* cnt = (int*)(p.ws + WS_CTL);
    const float* brg = p.in[13]; const float* bre = p.in[15];
    LAS float* part = (LAS float*)lds;
    LAS float* pss  = (LAS float*)(lds + 65536);
    LAS float* lg   = (LAS float*)(lds + 65536 + 1024);
    LAS float* lss  = (LAS float*)(lds + 65536 + 1024 + 2560);
    LAS int* lcnt  = (LAS int*)(lds + 70000);
    LAS int* lbase = (LAS int*)(lds + 70000 + 64);
    LAS int* le    = (LAS int*)(lds + 70000 + 128);
    LAS int* lp    = (LAS int*)(lds + 70000 + 128 + 256);
    LAS float* lwt = (LAS float*)(lds + 70000 + 128 + 512);
    for (int tile = blockIdx.x; tile < T / 32; tile += gridDim.x) {
        const int tok0 = tile * 32;
        __syncthreads();
        if (tid < 16) lcnt[tid] = 0;
        f32x4 acc[2][4]; float ss[2] = {0.f, 0.f};
#pragma unroll
        for (int m = 0; m < 2; ++m)
#pragma unroll
            for (int n = 0; n < 4; ++n) acc[m][n] = (f32x4){0.f, 0.f, 0.f, 0.f};
#pragma unroll 2
        for (int ks = 0; ks < 8; ++ks) {
            const int k = wave * 256 + ks * 32 + fq * 8;
            bf16x8 af[2], bfr[4];
#pragma unroll
            for (int m = 0; m < 2; ++m) af[m] = *(const bf16x8*)(A2 + (size_t)(tok0 + 16 * m + fr) * D + k);
#pragma unroll
            for (int n = 0; n < 4; ++n) bfr[n] = *(const bf16x8*)(wr + (size_t)(16 * n + fr) * D + k);
#pragma unroll
            for (int m = 0; m < 2; ++m) {
#pragma unroll
                for (int j = 0; j < 8; ++j) { const float v = bf1((bf16_t)af[m][j]); ss[m] += v * v; }
#pragma unroll
                for (int n = 0; n < 4; ++n) acc[m][n] = __builtin_amdgcn_mfma_f32_16x16x32_bf16(bfr[n], af[m], acc[m][n], 0, 0, 0);
            }
        }
#pragma unroll
        for (int m = 0; m < 2; ++m) { ss[m] += __shfl_xor(ss[m], 16); ss[m] += __shfl_xor(ss[m], 32);
            if (fq == 0) pss[wave * 32 + 16 * m + fr] = ss[m];
#pragma unroll
            for (int n = 0; n < 4; ++n) *(LAS f32x4*)(part + (wave * 32 + 16 * m + fr) * 64 + 16 * n + 4 * fq) = acc[m][n]; }
        __syncthreads();
        for (int i = tid; i < 32 * 20; i += NTHREADS) { const int t = i / 20, j = i % 20; float s = 0.f;
#pragma unroll
            for (int w = 0; w < 8; ++w) s += part[(w * 32 + t) * 64 + j] + part[(w * 32 + t) * 64 + 32 + j];
            lg[t * 20 + j] = s; }
        if (tid < 32) { float s = 0.f;
#pragma unroll
            for (int w = 0; w < 8; ++w) s += pss[w * 32 + tid];
            lss[tid] = s; }
        __syncthreads();
        if (tid < 32) {
            const int t = tid; const float rs = 1.0f / sqrtf(lss[t] * (1.0f / D) + EPS);
            float g4[4];
#pragma unroll
            for (int j = 0; j < 4; ++j) g4[j] = lg[t * 20 + j] * rs + brg[j];
            int gi = 0; float gm = g4[0];
#pragma unroll
            for (int j = 1; j < 4; ++j) if (g4[j] > gm) { gm = g4[j]; gi = j; }
            float den = 0.f;
#pragma unroll
            for (int j = 0; j < 4; ++j) den += __expf(g4[j] - gm);
            const float pg = 1.0f / den;
            float le4[4];
#pragma unroll
            for (int j = 0; j < 4; ++j) le4[j] = lg[t * 20 + 4 + gi * 4 + j] * rs + bre[gi * 4 + j];
            int i1 = 0; float m1 = le4[0];
#pragma unroll
            for (int j = 1; j < 4; ++j) if (le4[j] > m1) { m1 = le4[j]; i1 = j; }
            int i2 = -1; float m2 = -3.0e38f;
#pragma unroll
            for (int j = 0; j < 4; ++j) if (j != i1 && le4[j] > m2) { m2 = le4[j]; i2 = j; }
            const float ex = __expf(m2 - m1); const float w1 = pg / (1.0f + ex), w2 = pg * ex / (1.0f + ex);
            rstd[tok0 + t] = rs;
            const int e1 = gi * 4 + i1, e2 = gi * 4 + i2;
            le[2 * t] = e1; le[2 * t + 1] = e2; lwt[2 * t] = w1; lwt[2 * t + 1] = w2;
            lp[2 * t] = atomicAdd((int*)&lcnt[e1], 1); lp[2 * t + 1] = atomicAdd((int*)&lcnt[e2], 1);
        }
        __syncthreads();
        if (tid < 16) { const int n = lcnt[tid]; lbase[tid] = n ? atomicAdd(&cnt[tid], n) : 0; }
        __syncthreads();
        if (tid < 64) { const int e = le[tid]; const int pos = lbase[e] + lp[tid]; ent[e * T + pos] = (tok0 + (tid >> 1)) | ((tid & 1) << 16); lw[e * T + pos] = lwt[tid]; }
    }
}

__device__ __forceinline__ void phase8_final(const Params& p) {
    const int tid = opaque_tid(), wave = __builtin_amdgcn_readfirstlane(tid >> 6), lane = tid & 63;
    const bf16_t* A2 = (const bf16_t*)(p.ws + WS_A2); const bf16_t* Y0 = (const bf16_t*)(p.ws + WS_YK0); const bf16_t* Y1 = (const bf16_t*)(p.ws + WS_YK1); const float* g = p.in[19];
    const int gw = blockIdx.x * NWAVES + wave, NGW = gridDim.x * NWAVES;
    for (int m = gw; m < T; m += NGW) {
        f32x4 v[8]; float s = 0.f;
#pragma unroll
        for (int j = 0; j < 8; ++j) { const size_t o = (size_t)m * D + 4 * lane + 256 * j;
            const u32x2 hh = *(const u32x2*)(A2 + o), a = *(const u32x2*)(Y0 + o), b = *(const u32x2*)(Y1 + o);
            v[j][0] = bf_lo(hh.x) + (bf_lo(a.x) + bf_lo(b.x)); v[j][1] = bf_hi(hh.x) + (bf_hi(a.x) + bf_hi(b.x)); v[j][2] = bf_lo(hh.y) + (bf_lo(a.y) + bf_lo(b.y)); v[j][3] = bf_hi(hh.y) + (bf_hi(a.y) + bf_hi(b.y));
            s += (v[j][0] * v[j][0] + v[j][1] * v[j][1]) + (v[j][2] * v[j][2] + v[j][3] * v[j][3]); }
        const float rs = 1.0f / sqrtf(wave_sum(s) * (1.0f / D) + EPS);
#pragma unroll
        for (int j = 0; j < 8; ++j) { const int c = 4 * lane + 256 * j; const f32x4 gg = *(const f32x4*)(g + c); __builtin_nontemporal_store(v[j] * rs * gg, (f32x4*)(p.out + (size_t)m * D + c)); }
    }
}

#define XB_TMO      128
#define XB_XCNT(j)  (256  + 64 * (j))
#define XB_XSUB(j)  (1280 + 64 * (j))
#define XB_XGEN(j)  (2304 + 64 * (j))
#define XB_TOP      3328
#define XB_TOPGEN   3392
#define XCD_BAR_WORDS 3456
#define XB_SPIN_CAP (1u << 18)
__device__ __forceinline__ unsigned xb_ld(unsigned* p)              { return __hip_atomic_load(p, __ATOMIC_RELAXED, __HIP_MEMORY_SCOPE_AGENT); }
__device__ __forceinline__ unsigned xb_add(unsigned* p, unsigned v) { return __hip_atomic_fetch_add(p, v, __ATOMIC_RELAXED, __HIP_MEMORY_SCOPE_AGENT); }
__device__ __forceinline__ unsigned xb_xcc_id() { return (unsigned)__builtin_amdgcn_s_getreg((3 << 11) | 20) & 0xFu; }
#define XB_SPIN(cond, bar) do { unsigned _sp = 0; while (cond) { __builtin_amdgcn_s_sleep(1); \
    if ((++_sp & 255u) == 0u) { if (xb_ld(&(bar)[XB_TMO])) break; if (_sp > XB_SPIN_CAP) { atomicAdd(&(bar)[XB_TMO], 1u); break; } } } } while (0)
struct XcdBarrier { unsigned* bar; unsigned x; volatile LAS unsigned* st; };
__device__ __forceinline__ XcdBarrier xcd_barrier_post(unsigned* bar, volatile LAS unsigned* st) {
    XcdBarrier b; b.bar = bar; b.x = xb_xcc_id(); b.st = st;
    if (threadIdx.x == 0) (void)xb_add(&bar[XB_XCNT(b.x)], 1u);
    return b;
}
__device__ __forceinline__ void xcd_barrier_complete(unsigned* bar, unsigned x, unsigned& nloc, unsigned& nx) {
    const unsigned G = gridDim.x * gridDim.y * gridDim.z;
    unsigned sum, cnt, mine, sp = 0u;
    for (;;) {
        sum = 0u; cnt = 0u; mine = 0u;
#pragma unroll
        for (unsigned j = 0; j < 16; ++j) { const unsigned c = xb_ld(&bar[XB_XCNT(j)]); sum += c; cnt += (c > 0u) ? 1u : 0u; mine = (j == x) ? c : mine; }
        if (sum == G) break;
        __builtin_amdgcn_s_sleep(1);
        if ((++sp & 255u) == 0u) { if (xb_ld(&bar[XB_TMO])) break; if (sp > XB_SPIN_CAP) { atomicAdd(&bar[XB_TMO], 1u); break; } }
    }
    nloc = mine > 0u ? mine : 1u; nx = cnt > 0u ? cnt : 1u;
}
__device__ __forceinline__ void xcd_barrier(const XcdBarrier& b) {
    asm volatile("s_waitcnt vmcnt(0)" ::: "memory");
    __syncthreads();
    if (threadIdx.x == 0) {
        unsigned* bar = b.bar;
        __builtin_amdgcn_s_waitcnt(0);
        unsigned nloc = b.st[0], nx = b.st[1];
        if (nloc == 0u) { xcd_barrier_complete(bar, b.x, nloc, nx); b.st[0] = nloc; b.st[1] = nx; }
        const unsigned old = xb_add(&bar[XB_XSUB(b.x)], 1u);
        const unsigned gen = old / nloc;
        if (old + 1u == (gen + 1u) * nloc) {
            __builtin_amdgcn_fence(__ATOMIC_RELEASE, "agent");
            asm volatile("s_waitcnt vmcnt(0)" ::: "memory");
            const unsigned og = xb_add(&bar[XB_TOP], 1u);
            const unsigned tg = og / nx;
            if (og + 1u == (tg + 1u) * nx) xb_add(&bar[XB_TOPGEN], 1u);
            else XB_SPIN(xb_ld(&bar[XB_TOPGEN]) == tg, bar);
            __builtin_amdgcn_fence(__ATOMIC_ACQUIRE, "agent");
            xb_add(&bar[XB_XGEN(b.x)], 1u);
            asm volatile("s_waitcnt vmcnt(0)" ::: "memory");
        } else {
            XB_SPIN(xb_ld(&bar[XB_XGEN(b.x)]) == gen, bar);
            __builtin_amdgcn_fence(__ATOMIC_ACQUIRE, "agent");
            asm volatile("s_waitcnt vmcnt(0)" ::: "memory");
        }
    }
    __syncthreads();
}

template <int PH> __device__ __forceinline__ void run_phase(const Params& p, LAS unsigned char* lds) {
    unsigned char* ws = p.ws;
    if constexpr (PH == 0) phase0(p, lds);
    if constexpr (PH == 1) { DenseSched S; S.init((const bf16_t*)(ws + WS_X), (const bf16_t*)(ws + WS_WINT), T, NIN, D);
        EpiProj E{(bf16_t*)(ws + WS_P + P_BC), (bf16_t*)(ws + WS_P + P_P), (bf16_t*)(ws + WS_P + P_U), (bf16_t*)(ws + WS_P + P_V), (bf16_t*)(ws + WS_P + P_R), (bf16_t*)(ws + WS_P + P_S), (f32x2*)(ws + WS_SMALL + SM_VST)};
        gemm_run<0>(lds, S, E, D); convert_tail(p, lds, (T / 256) * (NIN / 256)); }
    if constexpr (PH == 2) { phase2_conv(p); phase2_sgu(p, lds); }
    if constexpr (PH == 3) { DenseSched S; S.init((const bf16_t*)(ws + WS_X), (const bf16_t*)(ws + WS_WUPT), T, D, 2048);
        EpiUp E{(const bf16_t*)(ws + WS_P + P_R), (const bf16_t*)(ws + WS_P + P_S), (bf16_t*)(ws + WS_MM)}; gemm_run<1>(lds, S, E, 2048); }
    if constexpr (PH == 4) { DenseSched S; S.init((const bf16_t*)(ws + WS_MM), (const bf16_t*)(ws + WS_WOUTT), T, D, D);
        EpiOut E{p.in[0], (bf16_t*)(ws + WS_A2)}; gemm_run<2>(lds, S, E, D); }
    if constexpr (PH == 5) phase5_router(p, lds);
    if constexpr (PH == 6 || PH == 7) {
        const int* cnt = (const int*)(ws + WS_CTL); const int* ent = (const int*)(ws + WS_SMALL + SM_ENT); const int G = gridDim.x, c = blockIdx.x;
        EpiMoe1 E1{ent, (const float*)(ws + WS_SMALL + SM_W), (const float*)(ws + WS_SMALL + SM_RSTD), (bf16_t*)(ws + WS_HID), false};
        EpiMoe2 E2{ent, (bf16_t*)(ws + WS_YK0), (bf16_t*)(ws + WS_YK1)};
        typedef MoeSched<true, 4, D, 1024> S1T; typedef MoeSched<false, 8, DE, D> S2T;
        constexpr int BIG = 1 << 20;
        unsigned* flags = (unsigned*)(ws + WS_FLAGS);
        int UA = 0, UH = 0; for (int e = 0; e < NE; ++e) { const int nt = (__builtin_amdgcn_readfirstlane(cnt[e]) + 255) >> 8; UA += min(nt, MOE_REG) * 4; UH += max(nt - MOE_REG, 0) * 4; }
        const bool fancy = (UA <= G) && (UH <= G / 4);
        if constexpr (PH == 6) {
            if (fancy) {
                E1.wt = true;
                { S1T S{(const bf16_t*)(ws + WS_A2), (const bf16_t*)(ws + WS_W1T), cnt, ent, 3, (c < UA) ? c : -1, 0, 1, (c < UH) ? UA + c : -1, flags, 1}; gemm_run<3>(lds, S, E1, D); }
                { S2T S{(const bf16_t*)(ws + WS_HID), (const bf16_t*)(ws + WS_W2T), cnt, ent, 3, (c >= UH) ? c - UH : -1, G - UH, BIG, -1, flags, 2}; gemm_run<4>(lds, S, E2, DE); }
            } else { S1T S{(const bf16_t*)(ws + WS_A2), (const bf16_t*)(ws + WS_W1T), cnt, ent, 2, c, G, BIG, -1, flags, 0}; gemm_run<3>(lds, S, E1, D); }
        }
        if constexpr (PH == 7) { S2T S{(const bf16_t*)(ws + WS_HID), (const bf16_t*)(ws + WS_W2T), cnt, ent, 2, c, G, BIG, -1, flags, 0}; gemm_run<4>(lds, S, E2, DE); }
    }
    if constexpr (PH == 8) phase8_final(p);
}

template <int PH> __global__ void __launch_bounds__(NTHREADS, 2) k_phase(Params p) {
    extern __shared__ __attribute__((aligned(16))) unsigned char lds_raw[];
    run_phase<PH>(p, (LAS unsigned char*)lds_raw);
}

#ifndef PROBE_DUP
#define PROBE_DUP 0
#endif
#ifndef PROBE_SYNCS
#define PROBE_SYNCS 0
#endif
#define DUP(k) ((PROBE_DUP >> (k)) & 1)
#ifndef PROBE_T
#define PROBE_T (-1)
#endif
#ifndef PROBE_MULT
#define PROBE_MULT 4
#endif
typedef const __attribute__((address_space(4))) Params* KParamsPtr;
__device__ __forceinline__ Params load_params() {
    Params r{};
#if defined(__HIP_DEVICE_COMPILE__)
    unsigned long long v = (unsigned long long)__builtin_amdgcn_kernarg_segment_ptr(); asm volatile("" : "+s"(v));
    const __attribute__((address_space(4))) unsigned long long* q = (const __attribute__((address_space(4))) unsigned long long*)v;
#pragma unroll
    for (int i = 0; i < 20; ++i) r.in[i] = (const float*)(const __attribute__((address_space(1))) float*)q[i];
    r.out = (float*)(__attribute__((address_space(1))) float*)q[20]; r.ws = (unsigned char*)(__attribute__((address_space(1))) unsigned char*)q[21];
#endif
    return r;
}
#define RUN(k) do { const Params pk = load_params(); run_phase<k>(pk, lds); } while (0)
__global__ void __launch_bounds__(NTHREADS, 2) k_mega(Params p) {
    extern __shared__ __attribute__((aligned(16))) unsigned char lds_raw[];
    LAS unsigned char* lds = (LAS unsigned char*)lds_raw;
    cg::grid_group grid = cg::this_grid();
    volatile LAS unsigned* xbst = (volatile LAS unsigned*)(lds + LDS_BYTES - 64);
    if (threadIdx.x < 4) xbst[threadIdx.x] = 0u;
    __syncthreads();
    const XcdBarrier bar = xcd_barrier_post((unsigned*)(p.ws + WS_BAR), xbst);
    volatile LAS unsigned long long* stamps = (volatile LAS unsigned long long*)(lds + LDS_BYTES - 256);
    int nstamp = 0;
#define STAMP() do { if (PROBE_T >= 0 && blockIdx.x == 0 && threadIdx.x == 0) stamps[nstamp] = __builtin_amdgcn_s_memrealtime(); ++nstamp; } while (0)
#define GSYNC() do { xcd_barrier(bar); STAMP(); } while (0)
    STAMP();
    if (p.ws == nullptr) grid.sync();
    RUN(0); GSYNC();
    if (DUP(0)) { RUN(0); GSYNC(); }
    RUN(1); GSYNC();
    if (DUP(1)) { RUN(1); GSYNC(); }
    RUN(2); GSYNC();
    if (DUP(2)) { RUN(2); GSYNC(); }
    RUN(3); GSYNC();
    if (DUP(3)) { RUN(3); GSYNC(); }
    RUN(4); GSYNC();
    if (DUP(4)) { RUN(4); GSYNC(); }
    RUN(5); GSYNC();
    if (DUP(5)) { if (blockIdx.x == 0 && threadIdx.x < 16) ((int*)(load_params().ws + WS_CTL))[threadIdx.x] = 0; GSYNC(); RUN(5); GSYNC(); }
    RUN(6); GSYNC();
    if (DUP(6)) { RUN(6); GSYNC(); }
    { const int* cnt = (const int*)(load_params().ws + WS_CTL); int UA = 0, UH = 0;
      for (int e = 0; e < NE; ++e) { const int nt = (__builtin_amdgcn_readfirstlane(cnt[e]) + 255) >> 8; UA += min(nt, MOE_REG) * 4; UH += max(nt - MOE_REG, 0) * 4; }
      if (!((UA <= (int)gridDim.x) && (UH <= (int)gridDim.x / 4))) { RUN(7); GSYNC(); } }
    for (int i = 0; i < PROBE_SYNCS; ++i) GSYNC();
    RUN(8);
    if (DUP(8)) { GSYNC(); RUN(8); }
    if (PROBE_T >= 0) { __syncthreads(); STAMP();
        if (blockIdx.x == 0 && threadIdx.x == 0) { const unsigned long long d = (stamps[PROBE_T + 1] - stamps[PROBE_T]) * PROBE_MULT; const unsigned long long t0 = __builtin_amdgcn_s_memrealtime();
            while (__builtin_amdgcn_s_memrealtime() - t0 < d) __builtin_amdgcn_s_sleep(8); } }
}

template <int PH> static void launch_phase(const Params& p, int grid, hipStream_t stream) {
    static bool attr = false;
    if (!attr) { (void)hipFuncSetAttribute((const void*)k_phase<PH>, hipFuncAttributeMaxDynamicSharedMemorySize, LDS_BYTES); attr = true; }
    hipLaunchKernelGGL(k_phase<PH>, dim3(grid), dim3(NTHREADS), LDS_BYTES, stream, p);
}

extern "C" void kernel_launch(void* const* d_in, const int* in_sizes, int n_in, void* d_out, int out_size, void* d_ws, size_t ws_size, hipStream_t stream) {
    static int grid = 0;
    if (grid == 0) {
        if (n_in != 20 || out_size != T * D || ws_size < WS_END) { fprintf(stderr, "kernel_launch: unexpected shapes n_in %d out %d ws %zu (need %zu)\n", n_in, out_size, ws_size, (size_t)WS_END); grid = -1; return; }
        int dev = 0, cus = 0, per_cu = 0;
        (void)hipGetDevice(&dev); (void)hipDeviceGetAttribute(&cus, hipDeviceAttributeMultiprocessorCount, dev);
        (void)hipFuncSetAttribute((const void*)k_mega, hipFuncAttributeMaxDynamicSharedMemorySize, LDS_BYTES);
        (void)hipOccupancyMaxActiveBlocksPerMultiprocessor(&per_cu, (const void*)k_mega, NTHREADS, LDS_BYTES);
        if (per_cu < 1) { fprintf(stderr, "kernel_launch: occupancy query says %d blocks per CU\n", per_cu); per_cu = 1; }
        grid = cus * 1;
        (void)hipGetLastError();
    }
    if (grid < 0) return;
    Params p{};
    for (int i = 0; i < 20; ++i) p.in[i] = (const float*)d_in[i];
    p.out = (float*)d_out; p.ws = (unsigned char*)d_ws;
    (void)hipMemsetAsync((char*)d_ws + WS_CTL, 0, 64 * 1024, stream);
#if ONE_LAUNCH
    void* args[] = {&p};
    hipError_t e = hipLaunchCooperativeKernel((const void*)k_mega, dim3(grid), dim3(NTHREADS), args, LDS_BYTES, stream);
    if (e != hipSuccess) fprintf(stderr, "cooperative launch failed: %s (grid %d)\n", hipGetErrorString(e), grid);
#else
    launch_phase<0>(p, grid, stream); launch_phase<1>(p, grid, stream); launch_phase<2>(p, grid, stream); launch_phase<3>(p, grid, stream); launch_phase<4>(p, grid, stream);
    launch_phase<5>(p, grid, stream); launch_phase<6>(p, grid, stream); launch_phase<7>(p, grid, stream); launch_phase<8>(p, grid, stream);
#endif
}
```

```cpp
#include <hip/hip_runtime.h>
#include <hip/hip_cooperative_groups.h>
#include <cstdio>
#include <cstdint>
namespace cg = cooperative_groups;

#ifndef ONE_LAUNCH
#define ONE_LAUNCH 1
#endif

#define LAS __attribute__((address_space(3)))
typedef unsigned short bf16_t;
typedef short bf16x8 __attribute__((ext_vector_type(8)));
typedef float f32x4 __attribute__((ext_vector_type(4)));
typedef float f32x2 __attribute__((ext_vector_type(2)));
typedef unsigned u32x4 __attribute__((ext_vector_type(4)));
typedef unsigned u32x2 __attribute__((ext_vector_type(2)));

constexpr int T = 8192, D = 2048, CW = 1024, SW = 1024, NIN = 9216, NE = 16, DE = 512;
constexpr float EPS = 1e-6f;
constexpr int NTHREADS = 512, NWAVES = 8;
constexpr int LDS_BYTES = 140 * 1024;
constexpr int HID_ROWS = 2 * T + NE * 256;

constexpr size_t MiB = 1024 * 1024;
constexpr size_t WS_CTL   = 0;
constexpr size_t WS_BAR   = 4096;
constexpr size_t WS_FLAGS = 32768;
constexpr size_t WS_SMALL = 64 * 1024;
constexpr size_t SM_RSTD = 0, SM_ENT = 32 * 1024, SM_W = SM_ENT + (size_t)NE * T * 4, SM_VST = SM_W + (size_t)NE * T * 4, SM_END = SM_VST + (size_t)T * 16 * 8;
constexpr size_t WS_WR    = WS_SMALL + 4 * MiB;
constexpr size_t WS_WMB   = WS_WR + 256 * 1024;
constexpr size_t WS_WINT  = WS_WMB + 256 * 1024;
constexpr size_t WS_WUPT  = WS_WINT + (size_t)NIN * D * 2;
constexpr size_t WS_WOUTT = WS_WUPT + (size_t)D * D * 2;
constexpr size_t WS_W1T   = WS_WOUTT + (size_t)D * D * 2;
constexpr size_t WS_W2T   = WS_W1T + (size_t)NE * 1024 * D * 2;
constexpr size_t WS_X     = WS_W2T + (size_t)NE * D * DE * 2;
constexpr size_t WS_P     = WS_X + (size_t)T * D * 2;
constexpr size_t P_BC = 0, P_P = P_BC + (size_t)T * CW * 2, P_U = P_P + (size_t)T * CW * 2, P_V = P_U + (size_t)T * SW * 2,
                 P_R = P_V + (size_t)T * SW * 2, P_S = P_R + (size_t)T * D * 2, P_END = P_S + (size_t)T * D * 2;
constexpr size_t WS_END   = WS_P + P_END;
constexpr size_t WS_MM  = WS_WINT;
constexpr size_t WS_H   = WS_P + P_BC;
constexpr size_t WS_A2  = WS_P + P_R;
constexpr size_t WS_HID = WS_P + P_S;
constexpr size_t WS_YK0 = WS_X;
constexpr size_t WS_YK1 = WS_WINT;
static_assert(SM_END <= 4 * MiB, "small region");
static_assert((size_t)HID_ROWS * DE * 2 <= (size_t)T * D * 2, "hid overlay");
static_assert((size_t)T * D * 4 <= P_R, "H overlay");

struct Params { const float* in[20]; float* out; unsigned char* ws; };

__device__ __forceinline__ unsigned cvt_pk_bf16(float lo, float hi) { unsigned r; asm("v_cvt_pk_bf16_f32 %0, %1, %2" : "=v"(r) : "v"(lo), "v"(hi)); return r; }
__device__ __forceinline__ float bf_lo(unsigned w) { return __uint_as_float(w << 16); }
__device__ __forceinline__ float bf_hi(unsigned w) { return __uint_as_float(w & 0xffff0000u); }
__device__ __forceinline__ float bf1(bf16_t b) { return __uint_as_float(((unsigned)b) << 16); }
__device__ __forceinline__ float wave_sum(float v) {
#pragma unroll
    for (int o = 1; o < 64; o <<= 1) v += __shfl_xor(v, o);
    return v;
}
__device__ __forceinline__ float fast_rcp(float x) { return __builtin_amdgcn_rcpf(x); }
__device__ __forceinline__ float fast_exp2(float x) { return __builtin_amdgcn_exp2f(x); }
__device__ __forceinline__ float sigmoid_f(float x) { return fast_rcp(1.0f + fast_exp2(-1.44269504f * x)); }
__device__ __forceinline__ float gelu_tanh(float x) {
    const float u = x + 0.044715f * x * x * x;
    return x * fast_rcp(1.0f + fast_exp2(-2.30220819f * u));
}
__device__ __forceinline__ int opaque_tid() { int t = threadIdx.x; asm volatile("" : "+v"(t)); return t; }
__device__ __forceinline__ void st16_wt(void* p, u32x4 v) { asm volatile("global_store_dwordx4 %0, %1, off sc1\n\ts_nop 1" :: "v"(p), "v"(v) : "memory"); }
__host__ __device__ __forceinline__ int perm32(int rho) { const int n = rho >> 4, i = rho & 15; return 8 * (i >> 2) + 4 * n + (i & 3); }

struct Unit { int pm, pn, e, row0, nvalid; };
constexpr int NXCD = 8, WGM = 2;
struct DenseSched {
    static constexpr bool DYN_HALF = false;
    __device__ __forceinline__ void a_ready(const Unit&) const {}
    __device__ __forceinline__ void done(const Unit&) const {}
    const bf16_t* A; const bf16_t* Bt; int K; int nM, nN, nwg, G, c;
    __device__ __forceinline__ void init(const bf16_t* A_, const bf16_t* Bt_, int M, int N, int K_) { A = A_; Bt = Bt_; K = K_; nM = M / 256; nN = N / 256; nwg = nM * nN; G = gridDim.x; c = blockIdx.x; }
    __device__ __forceinline__ bool next(int i, Unit& u) const {
        const long L = (long)i * G + c; if (L >= nwg) return false;
        int wgid = (int)L; { const int q = nwg / NXCD, r = nwg % NXCD, xcd = wgid % NXCD, off = wgid / NXCD; wgid = (xcd < r ? xcd * (q + 1) : r * (q + 1) + (xcd - r) * q) + off; }
        const int nig = WGM * nN, gid = wgid / nig, fm = gid * WGM, gsz = (nM - fm) < WGM ? (nM - fm) : WGM;
        u.pm = fm + ((wgid % nig) % gsz); u.pn = (wgid % nig) / gsz; u.e = 0; u.row0 = u.pm * 256; u.nvalid = 256; return true;
    }
    __device__ __forceinline__ const char* a_base() const { return (const char*)A; }
    __device__ __forceinline__ unsigned a_off(const Unit& u, int r) const { return (unsigned)(u.row0 + r) * (unsigned)K * 2u; }
    __device__ __forceinline__ const char* b_base(const Unit& u) const { return (const char*)Bt + (size_t)u.pn * 256 * K * 2; }
};
constexpr int MOE_REG = 4;
template <bool GATHER, int NPN, int KK, int NROWS_E  >
struct MoeSched {
    static constexpr bool DYN_HALF = true;
    const bf16_t* A; const bf16_t* Bt; const int* cnt; const int* ent;
    int mode;
    int idx, stride, maxi;
    int idx1;
    unsigned* flags; int role;
    __device__ __forceinline__ bool lookup(int L, int md, Unit& u) const {
        int hb = 0;
        for (int e = 0; e < NE; ++e) {
            const int n = __builtin_amdgcn_readfirstlane(cnt[e]); const int nt = (n + 255) >> 8;
            const int lo = (md == 1) ? min(nt, MOE_REG) : 0, hi = (md == 0) ? min(nt, MOE_REG) : nt;
            const int nsel = (hi - lo) * NPN;
            if (L < nsel) { u.e = e; u.pm = lo + L / NPN; u.pn = L % NPN; u.row0 = hb + u.pm * 256; u.nvalid = min(256, n - u.pm * 256); return true; }
            L -= nsel; hb += nt * 256;
        }
        return false;
    }
    __device__ __forceinline__ bool next(int i, Unit& u) const {
        int L;
        const int n0 = (idx >= 0) ? maxi : 0;
        if (i < n0) L = idx + i * stride; else if (i == n0 && idx1 >= 0) L = idx1; else return false;
        if (mode != 3) return lookup(L, mode, u);
        int nreg = 0; for (int e = 0; e < NE; ++e) nreg += min((__builtin_amdgcn_readfirstlane(cnt[e]) + 255) >> 8, MOE_REG) * NPN;
        return (L < nreg) ? lookup(L, 0, u) : lookup(L - nreg, 1, u);
    }
    __device__ __forceinline__ const char* a_base() const { return (const char*)A; }
    __device__ __forceinline__ unsigned a_off(const Unit& u, int r) const {
        if (GATHER) { const int tok = (r < u.nvalid) ? (ent[u.e * T + u.pm * 256 + r] & 0xffff) : 0; return (unsigned)tok * (unsigned)KK * 2u; }
        return (unsigned)(u.row0 + r) * (unsigned)KK * 2u;
    }
    __device__ __forceinline__ const char* b_base(const Unit& u) const { return (const char*)Bt + ((size_t)u.e * NROWS_E + (size_t)u.pn * 256) * KK * 2; }
    __device__ __forceinline__ void a_ready(const Unit& u) const {
        if (role != 2) return;
        if (threadIdx.x < 64) {
            unsigned* f = flags + (u.row0 >> 8) * 64; unsigned spins = 0;
            while ((unsigned)__builtin_amdgcn_readfirstlane(__hip_atomic_load(f, __ATOMIC_RELAXED, __HIP_MEMORY_SCOPE_AGENT)) < 32u) { __builtin_amdgcn_s_sleep(2); if (++spins > (1u << 22)) break; }
            __builtin_amdgcn_fence(__ATOMIC_ACQUIRE, "agent");
            asm volatile("s_waitcnt vmcnt(0)" ::: "memory");
        }
        asm volatile("" ::: "memory"); __builtin_amdgcn_s_barrier(); asm volatile("" ::: "memory");
    }
    __device__ __forceinline__ void done(const Unit& u) const {
        if (role != 1) return;
        asm volatile("s_waitcnt vmcnt(0)" ::: "memory");
        if ((threadIdx.x & 63) == 0) __hip_atomic_fetch_add(flags + (u.row0 >> 8) * 64, 1u, __ATOMIC_RELAXED, __HIP_MEMORY_SCOPE_AGENT);
    }
};
__device__ __forceinline__ int moe_overflow_tiles(const int* cnt) { int t = 0; for (int e = 0; e < NE; ++e) { const int nt = (__builtin_amdgcn_readfirstlane(cnt[e]) + 255) >> 8; t += max(nt - MOE_REG, 0); } return t; }

typedef f32x4 Acc[2][2][4][2];
__device__ __forceinline__ u32x4 pack8(f32x4 a, f32x4 b) { u32x4 w; w.x = cvt_pk_bf16(a[0], a[1]); w.y = cvt_pk_bf16(a[2], a[3]); w.z = cvt_pk_bf16(b[0], b[1]); w.w = cvt_pk_bf16(b[2], b[3]); return w; }
__device__ __forceinline__ void unpack8(u32x4 w, f32x4& a, f32x4& b) { a = (f32x4){bf_lo(w.x), bf_hi(w.x), bf_lo(w.y), bf_hi(w.y)}; b = (f32x4){bf_lo(w.z), bf_hi(w.z), bf_lo(w.w), bf_hi(w.w)}; }

struct EpiProj {
    static constexpr bool PERM = true; static constexpr int MIDK = 0;
    bf16_t *Bc, *P, *U, *V, *R, *S; f32x2* VST;
    __device__ __forceinline__ void mid(Acc&, const Unit&, int, int, int, int) const {}
    __device__ __forceinline__ void operator()(const Acc& acc, const Unit& u, int wr, int wc, int fr, int fq) const {
        const int pn = u.pn; const int rowb = u.row0 + wr * 64 + fr; const int cl = wc * 32 + 8 * fq;
#pragma unroll
        for (int ai = 0; ai < 2; ++ai)
#pragma unroll
            for (int m = 0; m < 4; ++m) {
                const size_t row = (size_t)(rowb + ai * 128 + m * 16);
                if (pn < 4) {
#pragma unroll
                    for (int bj = 0; bj < 2; ++bj) *(u32x4*)(Bc + row * CW + pn * 256 + bj * 128 + cl) = pack8(acc[ai][bj][m][0], acc[ai][bj][m][1]);
                } else if (pn < 12) {
                    *(u32x4*)(P + row * CW + (pn - 4) * 128 + cl) = pack8(acc[ai][0][m][0] * acc[ai][1][m][0], acc[ai][0][m][1] * acc[ai][1][m][1]);
                } else if (pn < 20) {
                    bf16_t* O = (pn < 16) ? (U + row * SW + (pn - 12) * 256) : (V + row * SW + (pn - 16) * 256);
                    float ssum = 0.f, ssq = 0.f;
#pragma unroll
                    for (int bj = 0; bj < 2; ++bj) { f32x4 a = acc[ai][bj][m][0], b = acc[ai][bj][m][1];
#pragma unroll
                        for (int j = 0; j < 4; ++j) { a[j] = gelu_tanh(a[j]); b[j] = gelu_tanh(b[j]); ssum += a[j] + b[j]; ssq += a[j] * a[j] + b[j] * b[j]; }
                        *(u32x4*)(O + bj * 128 + cl) = pack8(a, b); }
                    if (pn >= 16) {
                        ssum += __shfl_xor(ssum, 16); ssum += __shfl_xor(ssum, 32); ssq += __shfl_xor(ssq, 16); ssq += __shfl_xor(ssq, 32);
                        if (fq == 0) VST[row * 16 + (pn - 16) * 4 + wc] = (f32x2){ssum, ssq}; }
                } else {
                    f32x4 r0, r1, s0, s1;
#pragma unroll
                    for (int j = 0; j < 4; ++j) {
                        const float ec0 = fast_exp2(-1.44269504f * acc[ai][0][m][0][j]), es0 = fast_exp2(-1.44269504f * acc[ai][1][m][0][j]);
                        const float ec1 = fast_exp2(-1.44269504f * acc[ai][0][m][1][j]), es1 = fast_exp2(-1.44269504f * acc[ai][1][m][1][j]);
                        r0[j] = (1.0f + es0) * fast_rcp(1.0f + ec0); s0[j] = fast_rcp(1.0f + es0);
                        r1[j] = (1.0f + es1) * fast_rcp(1.0f + ec1); s1[j] = fast_rcp(1.0f + es1);
                    }
                    const size_t o = row * D + (pn - 20) * 128 + cl;
                    *(u32x4*)(R + o) = pack8(r0, r1); *(u32x4*)(S + o) = pack8(s0, s1);
                }
            }
    }
};
struct EpiUp {
    static constexpr bool PERM = true; static constexpr int MIDK = 1024;
    const bf16_t *R, *S; bf16_t* Mm;
    __device__ __forceinline__ void mid(Acc& acc, const Unit& u, int wr, int wc, int fr, int fq) const {
        int rowb = u.row0 + wr * 64 + fr; const int cb = u.pn * 256 + wc * 32 + 8 * fq;
        asm volatile("" : "+v"(rowb));
#pragma unroll
        for (int ai = 0; ai < 2; ++ai)
#pragma unroll
            for (int m = 0; m < 4; ++m)
#pragma unroll
                for (int bj = 0; bj < 2; ++bj) { f32x4 a, b; unpack8(*(const u32x4*)(R + (size_t)(rowb + ai * 128 + m * 16) * D + cb + bj * 128), a, b);
                    acc[ai][bj][m][0] *= a; acc[ai][bj][m][1] *= b; }
    }
    __device__ __forceinline__ void operator()(const Acc& acc, const Unit& u, int wr, int wc, int fr, int fq) const {
        const int rowb = u.row0 + wr * 64 + fr; const int cb = u.pn * 256 + wc * 32 + 8 * fq;
#pragma unroll
        for (int ai = 0; ai < 2; ++ai)
#pragma unroll
            for (int m = 0; m < 4; ++m)
#pragma unroll
                for (int bj = 0; bj < 2; ++bj) { const size_t o = (size_t)(rowb + ai * 128 + m * 16) * D + cb + bj * 128; f32x4 a, b; unpack8(*(const u32x4*)(S + o), a, b);
                    *(u32x4*)(Mm + o) = pack8(acc[ai][bj][m][0] * a, acc[ai][bj][m][1] * b); }
    }
};
struct EpiOut {
    static constexpr bool PERM = true; static constexpr int MIDK = 0;
    const float* x; bf16_t* A2;
    __device__ __forceinline__ void mid(Acc&, const Unit&, int, int, int, int) const {}
    __device__ __forceinline__ void operator()(const Acc& acc, const Unit& u, int wr, int wc, int fr, int fq) const {
        const int rowb = u.row0 + wr * 64 + fr; const int cb = u.pn * 256 + wc * 32 + 8 * fq;
#pragma unroll
        for (int ai = 0; ai < 2; ++ai)
#pragma unroll
            for (int m = 0; m < 4; ++m)
#pragma unroll
                for (int bj = 0; bj < 2; ++bj) { const size_t o = (size_t)(rowb + ai * 128 + m * 16) * D + cb + bj * 128;
                    const f32x4 h0 = *(const f32x4*)(x + o) + acc[ai][bj][m][0], h1 = *(const f32x4*)(x + o + 4) + acc[ai][bj][m][1];
                    *(u32x4*)(A2 + o) = pack8(h0, h1); }
    }
};
struct EpiMoe1 {
    static constexpr bool PERM = true; static constexpr int MIDK = 0;
    const int* ent; const float* lw; const float* rstd; bf16_t* Hid; bool wt;
    __device__ __forceinline__ void mid(Acc&, const Unit&, int, int, int, int) const {}
    __device__ __forceinline__ void operator()(const Acc& acc, const Unit& u, int wr, int wc, int fr, int fq) const {
        const int cl = u.pn * 128 + wc * 32 + 8 * fq;
#pragma unroll
        for (int ai = 0; ai < 2; ++ai)
#pragma unroll
            for (int m = 0; m < 4; ++m) {
                const int r = ai * 128 + wr * 64 + m * 16 + fr;
                if (r < u.nvalid) {
                    const int li = u.e * T + u.pm * 256 + r; const int tok = ent[li] & 0xffff; const float rs = rstd[tok], w = lw[li];
                    f32x4 o[2];
#pragma unroll
                    for (int n = 0; n < 2; ++n)
#pragma unroll
                        for (int j = 0; j < 4; ++j) { const float gt = acc[ai][0][m][n][j] * rs, up = acc[ai][1][m][n][j] * rs; o[n][j] = gt * sigmoid_f(gt) * up * w; }
                    bf16_t* dst = Hid + (size_t)(u.row0 + r) * DE + cl; if (wt) st16_wt(dst, pack8(o[0], o[1])); else *(u32x4*)dst = pack8(o[0], o[1]);
                }
            }
    }
};
struct EpiMoe2 {
    static constexpr bool PERM = true; static constexpr int MIDK = 0;
    const int* ent; bf16_t* Yk0; bf16_t* Yk1;
    __device__ __forceinline__ void mid(Acc&, const Unit&, int, int, int, int) const {}
    __device__ __forceinline__ void operator()(const Acc& acc, const Unit& u, int wr, int wc, int fr, int fq) const {
        const int cb = u.pn * 256 + wc * 32 + 8 * fq;
#pragma unroll
        for (int ai = 0; ai < 2; ++ai)
#pragma unroll
            for (int m = 0; m < 4; ++m) {
                const int r = ai * 128 + wr * 64 + m * 16 + fr;
                if (r < u.nvalid) {
                    const int en = ent[u.e * T + u.pm * 256 + r]; const int tok = en & 0xffff; bf16_t* Y = (en >> 16) ? Yk1 : Yk0;
#pragma unroll
                    for (int bj = 0; bj < 2; ++bj) *(u32x4*)(Y + (size_t)tok * D + cb + bj * 128) = pack8(acc[ai][bj][m][0], acc[ai][bj][m][1]);
                }
            }
    }
};

template <class Epi, class Sched>
__device__ __forceinline__ void gemm_simple(const Sched& S, const Epi& E, const int K) {
    const int tid = opaque_tid(), wid = __builtin_amdgcn_readfirstlane(tid >> 6), lane = tid & 63, wr = wid >> 2, wc = wid & 3, fr = lane & 15, fq = lane >> 4;
    Unit u;
    for (int ui = 0; S.next(ui, u); ++ui) {
        Acc acc;
#pragma unroll
        for (int a = 0; a < 2; ++a)
#pragma unroll
            for (int b = 0; b < 2; ++b)
#pragma unroll
                for (int m = 0; m < 4; ++m)
#pragma unroll
                    for (int n = 0; n < 2; ++n) acc[a][b][m][n] = (f32x4){0.f, 0.f, 0.f, 0.f};
        S.a_ready(u);
        const char* ab = S.a_base(); const char* bb = S.b_base(u);
        unsigned aoff[2][4], boff[2][2];
#pragma unroll
        for (int ai = 0; ai < 2; ++ai)
#pragma unroll
            for (int m = 0; m < 4; ++m) aoff[ai][m] = S.a_off(u, ai * 128 + wr * 64 + m * 16 + fr) + fq * 16;
#pragma unroll
        for (int bj = 0; bj < 2; ++bj)
#pragma unroll
            for (int n = 0; n < 2; ++n) { const int rr = Epi::PERM ? perm32(n * 16 + fr) : (n * 16 + fr); boff[bj][n] = (unsigned)(bj * 128 + wc * 32 + rr) * (unsigned)K * 2u + fq * 16; }
        for (int k0 = 0; k0 < K; k0 += 32) {
            if (Epi::MIDK != 0 && k0 == Epi::MIDK) E.mid(acc, u, wr, wc, fr, fq);
            bf16x8 a[2][4], b[2][2];
#pragma unroll
            for (int ai = 0; ai < 2; ++ai)
#pragma unroll
                for (int m = 0; m < 4; ++m) a[ai][m] = *(const bf16x8*)(ab + aoff[ai][m] + k0 * 2);
#pragma unroll
            for (int bj = 0; bj < 2; ++bj)
#pragma unroll
                for (int n = 0; n < 2; ++n) b[bj][n] = *(const bf16x8*)(bb + boff[bj][n] + k0 * 2);
#pragma unroll
            for (int ai = 0; ai < 2; ++ai)
#pragma unroll
                for (int bj = 0; bj < 2; ++bj)
#pragma unroll
                    for (int m = 0; m < 4; ++m)
#pragma unroll
                        for (int n = 0; n < 2; ++n) acc[ai][bj][m][n] = __builtin_amdgcn_mfma_f32_16x16x32_bf16(b[bj][n], a[ai][m], acc[ai][bj][m][n], 0, 0, 0);
        }
        E(acc, u, wr, wc, fr, fq); S.done(u);
    }
}

constexpr int BK = 64, HALF = 128, HTB = HALF * BK * 2, STAGE_BYTES = 8 * HTB;
__host__ __device__ __forceinline__ int lds_byte(int r, int c) { const int st = (r >> 4) * 2 + (c >> 5), rr = r & 15, cc = c & 31, ob = rr * 64 + cc * 2; return st * 1024 + (ob ^ (((ob >> 9) & 1) << 5)); }
__host__ __device__ __forceinline__ void stage_rc(int b, int& R, int& C) { const int st = b / 1024, sb = b % 1024, swz = sb ^ (((sb >> 9) & 1) << 5); R = (st >> 1) * 16 + swz / 64; C = (st & 1) * 32 + (swz % 64) / 2; }

template <class Epi, class Sched>
__device__ __forceinline__ void gemm_fast(LAS unsigned char* lds, const Sched& S, const Epi& E, const int K) {
    const int tid = opaque_tid(), wid = __builtin_amdgcn_readfirstlane(tid >> 6), lane = tid & 63, wr = wid >> 2, wc = wid & 3, fr = lane & 15, fq = lane >> 4;
    const int nt = K / BK;
    int sR[2], sC[2]; unsigned voffB[2];
#pragma unroll
    for (int i = 0; i < 2; ++i) { stage_rc(tid * 16 + i * 8192, sR[i], sC[i]); const int Rb = Epi::PERM ? ((sR[i] & ~31) + perm32(sR[i] & 31)) : sR[i]; voffB[i] = (unsigned)(Rb * K + sC[i]) * 2u; }
    const size_t kstep = (size_t)(BK * 2);
    const size_t hstepB = (size_t)HALF * K * 2;
    const unsigned ldsw = (unsigned)wid * 1024u;
    const int aoff = lds_byte(wr * 64 + fr, fq * 8), boff = lds_byte(wc * 32 + fr, fq * 8);
#define PG8_SA(b, h) (((b) * 2 + (h)) * HTB)
#define PG8_SB(b, h) ((4 + (b) * 2 + (h)) * HTB)
#define PG8_STAGE(bufoff, gbase, voff) do { _Pragma("unroll") for (int _i = 0; _i < 2; ++_i) \
        __builtin_amdgcn_global_load_lds((const unsigned*)((const char*)(gbase) + (voff)[_i]), (LAS unsigned*)(lds + (bufoff) + ldsw + _i * 8192), 16, 0, 0); } while (0)
#define PG8_LDA(dst, b, h) do { _Pragma("unroll") for (int m = 0; m < 4; ++m) _Pragma("unroll") for (int k = 0; k < 2; ++k) dst[m][k] = *(const LAS bf16x8*)(lds + PG8_SA(b, h) + aoff + m * 2048 + k * 1024); } while (0)
#define PG8_LDB(dst, b, h) do { _Pragma("unroll") for (int n = 0; n < 2; ++n) _Pragma("unroll") for (int k = 0; k < 2; ++k) dst[n][k] = *(const LAS bf16x8*)(lds + PG8_SB(b, h) + boff + n * 2048 + k * 1024); } while (0)
#define PG8_MMA(ai, bj, At, Bt) do { __builtin_amdgcn_s_setprio(1); _Pragma("unroll") for (int m = 0; m < 4; ++m) _Pragma("unroll") for (int n = 0; n < 2; ++n) _Pragma("unroll") for (int k = 0; k < 2; ++k) \
        acc[ai][bj][m][n] = __builtin_amdgcn_mfma_f32_16x16x32_bf16(Bt[n][k], At[m][k], acc[ai][bj][m][n], 0, 0, 0); __builtin_amdgcn_s_setprio(0); } while (0)
#define PG8_WAIT_V(n) asm volatile("s_waitcnt vmcnt(" #n ")" ::: "memory")
#define PG8_WAIT_L(n) asm volatile("s_waitcnt lgkmcnt(" #n ")" ::: "memory")
#define PG8_BAR __builtin_amdgcn_s_barrier()
#define PG8_SCHED __builtin_amdgcn_sched_barrier(0)
    Unit cur, nxt; int ui = 0;
    if (!S.next(0, cur)) return;
    Acc acc;
#pragma unroll
    for (int a = 0; a < 2; ++a)
#pragma unroll
        for (int b = 0; b < 2; ++b)
#pragma unroll
            for (int m = 0; m < 4; ++m)
#pragma unroll
                for (int n = 0; n < 2; ++n) acc[a][b][m][n] = (f32x4){0.f, 0.f, 0.f, 0.f};
    bf16x8 At[4][2], B0[2][2], B1[2][2];
    unsigned va[2][2], vn[2][2];
#pragma unroll
    for (int h = 0; h < 2; ++h)
#pragma unroll
        for (int i = 0; i < 2; ++i) va[h][i] = S.a_off(cur, h * 128 + sR[i]) + (unsigned)sC[i] * 2u;
    const char* const A0 = S.a_base(); const char* cB = S.b_base(cur);
    S.a_ready(cur);
    PG8_STAGE(PG8_SB(0, 0), cB, voffB); PG8_STAGE(PG8_SB(0, 1), cB + hstepB, voffB); PG8_STAGE(PG8_SA(0, 0), A0, va[0]); PG8_STAGE(PG8_SA(0, 1), A0, va[1]);
    if (wr == 1) PG8_BAR;
    PG8_WAIT_V(2); PG8_BAR;
    PG8_STAGE(PG8_SB(1, 0), cB + kstep, voffB); PG8_STAGE(PG8_SA(1, 0), A0 + kstep, va[0]); PG8_STAGE(PG8_SB(1, 1), cB + hstepB + kstep, voffB);
    PG8_WAIT_V(6); PG8_BAR;
    for (;;) {
        const bool has_next = S.next(ui + 1, nxt);
        const char* nB = has_next ? S.b_base(nxt) : cB;
#pragma unroll
        for (int h = 0; h < 2; ++h)
#pragma unroll
            for (int i = 0; i < 2; ++i) vn[h][i] = has_next ? (S.a_off(nxt, h * 128 + sR[i]) + (unsigned)sC[i] * 2u) : va[h][i];
        for (int t = 0; t < nt; t += 2) {
            const bool last = (t == nt - 2);
            if (Epi::MIDK != 0 && t * BK == Epi::MIDK) { PG8_SCHED; E.mid(acc, cur, wr, wc, fr, fq); PG8_SCHED; }
            if (last && has_next) S.a_ready(nxt);
            const char* a1 = A0 + (size_t)(t + 1) * kstep;
            const char* a2 = last ? A0 : A0 + (size_t)(t + 2) * kstep; const char* b2 = last ? nB : cB + (size_t)(t + 2) * kstep;
            const char* a3 = a2 + kstep; const char* b3 = b2 + kstep;
            unsigned v2[2][2];
#pragma unroll
            for (int h = 0; h < 2; ++h)
#pragma unroll
                for (int i = 0; i < 2; ++i) v2[h][i] = last ? vn[h][i] : va[h][i];
            const bool full = !Sched::DYN_HALF || cur.nvalid > 128;
            PG8_LDB(B0, 0, 0); PG8_LDB(B1, 0, 1); PG8_SCHED; PG8_LDA(At, 0, 0); PG8_STAGE(PG8_SA(1, 1), a1, va[1]);
            PG8_WAIT_V(8); PG8_WAIT_L(0); PG8_BAR; PG8_MMA(0, 0, At, B0); PG8_MMA(0, 1, At, B1); PG8_BAR; PG8_SCHED;
            if (full) { PG8_LDA(At, 0, 1); } PG8_STAGE(PG8_SB(0, 0), b2, voffB); PG8_STAGE(PG8_SB(0, 1), b2 + hstepB, voffB); PG8_STAGE(PG8_SA(0, 0), a2, v2[0]);
            PG8_WAIT_V(8); PG8_WAIT_L(0); PG8_BAR; if (full) { PG8_MMA(1, 0, At, B0); PG8_MMA(1, 1, At, B1); } PG8_BAR; PG8_SCHED;
            PG8_LDB(B0, 1, 0); PG8_LDB(B1, 1, 1); PG8_SCHED; PG8_LDA(At, 1, 0); PG8_STAGE(PG8_SA(0, 1), a2, v2[1]);
            PG8_WAIT_V(8); PG8_WAIT_L(0); PG8_BAR; PG8_MMA(0, 0, At, B0); PG8_MMA(0, 1, At, B1); PG8_BAR; PG8_SCHED;
            if (full) { PG8_LDA(At, 1, 1); } PG8_STAGE(PG8_SB(1, 0), b3, voffB); PG8_STAGE(PG8_SB(1, 1), b3 + hstepB, voffB); PG8_STAGE(PG8_SA(1, 0), a3, v2[0]);
            PG8_WAIT_V(8); PG8_WAIT_L(0); PG8_BAR; if (full) { PG8_MMA(1, 0, At, B0); PG8_MMA(1, 1, At, B1); } PG8_BAR; PG8_SCHED;
        }
        if (wr == 0) PG8_BAR;
        E(acc, cur, wr, wc, fr, fq); S.done(cur);
        if (!has_next) break;
#pragma unroll
        for (int a = 0; a < 2; ++a)
#pragma unroll
            for (int b = 0; b < 2; ++b)
#pragma unroll
                for (int m = 0; m < 4; ++m)
#pragma unroll
                    for (int n = 0; n < 2; ++n) acc[a][b][m][n] = (f32x4){0.f, 0.f, 0.f, 0.f};
        cur = nxt; cB = nB; ++ui;
#pragma unroll
        for (int h = 0; h < 2; ++h)
#pragma unroll
            for (int i = 0; i < 2; ++i) va[h][i] = vn[h][i];
        if (wr == 1) PG8_BAR;
    }
    PG8_WAIT_V(0);
    PG8_BAR;
#undef PG8_SA
#undef PG8_SB
#undef PG8_STAGE
#undef PG8_LDA
#undef PG8_LDB
#undef PG8_MMA
#undef PG8_WAIT_V
#undef PG8_WAIT_L
#undef PG8_BAR
#undef PG8_SCHED
}
#ifndef FAST_MASK
#define FAST_MASK 0x1f
#endif
template <int BIT, class Epi, class Sched>
__device__ __forceinline__ void gemm_run(LAS unsigned char* lds, const Sched& S, const Epi& E, const int K) {
    if constexpr ((FAST_MASK >> BIT) & 1) gemm_fast(lds, S, E, K); else gemm_simple(S, E, K);
}

__device__ __forceinline__ void tr_item64(const float* W, int N, int k0, int ns, bf16_t* WT, int ldk, int nd, int kd, LAS float* scr, int lane, const float* kscale) {
    { const int r4 = lane >> 4, c4 = (lane & 15) * 4; f32x4 v[16];
#pragma unroll
      for (int i = 0; i < 16; ++i) v[i] = __builtin_nontemporal_load((const f32x4*)(W + (size_t)(k0 + 4 * i + r4) * N + ns + c4));
#pragma unroll
      for (int i = 0; i < 16; ++i) { LAS float* d = scr + (4 * i + r4) * 65 + c4; d[0] = v[i][0]; d[1] = v[i][1]; d[2] = v[i][2]; d[3] = v[i][3]; } }
    const int c = lane & 7;
    f32x4 s0 = (f32x4){1.f, 1.f, 1.f, 1.f}, s1 = s0;
    if (kscale) { s0 = *(const f32x4*)(kscale + k0 + 8 * c); s1 = *(const f32x4*)(kscale + k0 + 8 * c + 4); }
    asm volatile("s_waitcnt lgkmcnt(0)" ::: "memory");
#pragma unroll
    for (int j = 0; j < 8; ++j) { const int n = (lane >> 3) + 8 * j; const LAS float* s = scr + (8 * c) * 65 + n;
        u32x4 o; o.x = cvt_pk_bf16(s[0 * 65] * s0[0], s[1 * 65] * s0[1]); o.y = cvt_pk_bf16(s[2 * 65] * s0[2], s[3 * 65] * s0[3]);
        o.z = cvt_pk_bf16(s[4 * 65] * s1[0], s[5 * 65] * s1[1]); o.w = cvt_pk_bf16(s[6 * 65] * s1[2], s[7 * 65] * s1[3]);
        *(u32x4*)(WT + (size_t)(nd + n) * ldk + kd + 8 * c) = o; }
    asm volatile("s_waitcnt lgkmcnt(0)" ::: "memory");
}
constexpr int TRS = 64 * 65 * 4;
static_assert(8 * TRS <= LDS_BYTES - 64, "transpose scratch vs barrier words");
struct TrItem { const float* W; int N; bf16_t* WT; int ldk, nd, kd, k0, ns; const float* ks; };
__device__ __forceinline__ void tr_load(f32x4 (&v)[16], const TrItem& it, int lane) {
    const int r4 = lane >> 4, c4 = (lane & 15) * 4;
#pragma unroll
    for (int i = 0; i < 16; ++i) v[i] = __builtin_nontemporal_load((const f32x4*)(it.W + (size_t)(it.k0 + 4 * i + r4) * it.N + it.ns + c4));
}
__device__ __forceinline__ void tr_store(const f32x4 (&v)[16], const TrItem& it, LAS float* scr, int lane) {
    { const int r4 = lane >> 4, c4 = (lane & 15) * 4;
#pragma unroll
      for (int i = 0; i < 16; ++i) { LAS float* d = scr + (4 * i + r4) * 65 + c4; d[0] = v[i][0]; d[1] = v[i][1]; d[2] = v[i][2]; d[3] = v[i][3]; } }
    const int c = lane & 7;
    f32x4 s0 = (f32x4){1.f, 1.f, 1.f, 1.f}, s1 = s0;
    if (it.ks) { s0 = *(const f32x4*)(it.ks + it.k0 + 8 * c); s1 = *(const f32x4*)(it.ks + it.k0 + 8 * c + 4); }
    asm volatile("s_waitcnt lgkmcnt(0)" ::: "memory");
#pragma unroll
    for (int j = 0; j < 8; ++j) { const int n = (lane >> 3) + 8 * j; const LAS float* s = scr + (8 * c) * 65 + n;
        u32x4 o; o.x = cvt_pk_bf16(s[0 * 65] * s0[0], s[1 * 65] * s0[1]); o.y = cvt_pk_bf16(s[2 * 65] * s0[2], s[3 * 65] * s0[3]);
        o.z = cvt_pk_bf16(s[4 * 65] * s1[0], s[5 * 65] * s1[1]); o.w = cvt_pk_bf16(s[6 * 65] * s1[2], s[7 * 65] * s1[3]);
        __builtin_nontemporal_store(o, (u32x4*)(it.WT + (size_t)(it.nd + n) * it.ldk + it.kd + 8 * c)); }
    asm volatile("s_waitcnt lgkmcnt(0)" ::: "memory");
}
constexpr int NIT_EXP = 8192 + 4096;
__device__ __forceinline__ TrItem exp_item(const Params& p, int r) {
    TrItem it;
    if (r < 8192) { const int up = r >> 12, qq = r & 4095, e = qq >> 8, kb = (qq & 255) >> 3, nb = qq & 7;
        it.W = p.in[up ? 17 : 16] + (size_t)e * D * DE; it.N = DE; it.WT = (bf16_t*)(p.ws + WS_W1T) + (size_t)e * 1024 * D; it.ldk = D;
        it.nd = 256 * (nb >> 1) + (nb & 1) * 64 + (up ? 128 : 0); it.kd = kb * 64; it.k0 = kb * 64; it.ns = nb * 64; it.ks = p.in[11]; }
    else { const int q = r - 8192, e = q >> 8, kb = (q & 255) >> 5, nb = q & 31;
        it.W = p.in[18] + (size_t)e * DE * D; it.N = D; it.WT = (bf16_t*)(p.ws + WS_W2T) + (size_t)e * D * DE; it.ldk = DE; it.nd = nb * 64; it.kd = kb * 64; it.k0 = kb * 64; it.ns = nb * 64; it.ks = nullptr; }
    return it;
}
__device__ __forceinline__ void convert_tail(const Params& p, LAS unsigned char* lds, int nunits) {
    const int tid = opaque_tid(), wave = __builtin_amdgcn_readfirstlane(tid >> 6), lane = tid & 63;
    const int G = gridDim.x, rounds = (nunits + G - 1) / G, nfull = nunits - (rounds - 1) * G;
    int idle_idx, n_idle;
    if (nfull >= G || nunits == 0) { idle_idx = blockIdx.x; n_idle = G; } else { idle_idx = (int)blockIdx.x - nfull; n_idle = G - nfull; }
    if (idle_idx < 0) return;
    LAS float* scr = (LAS float*)(lds + wave * TRS);
    const int stride = n_idle * NWAVES; int r = idle_idx * NWAVES + wave;
    if (r >= NIT_EXP) return;
    f32x4 va[16], vb[16];
    TrItem ia = exp_item(p, r), ib = ia;
    tr_load(va, ia, lane);
    for (;;) {
        const bool hb = (r + stride) < NIT_EXP;
        if (hb) { ib = exp_item(p, r + stride); tr_load(vb, ib, lane); }
        tr_store(va, ia, scr, lane);
        if (!hb) break;
        r += stride;
        const bool ha = (r + stride) < NIT_EXP;
        if (ha) { ia = exp_item(p, r + stride); tr_load(va, ia, lane); }
        tr_store(vb, ib, scr, lane);
        if (!ha) break;
        r += stride;
    }
}
__device__ __forceinline__ int win_src_col(int nd) {
    if (nd < 1024) return nd;
    if (nd < 3072) { const int q = (nd - 1024) >> 8, r = (nd - 1024) & 255; return r < 128 ? (1024 + 128 * q + r) : (2048 + 128 * q + r - 128); }
    if (nd < 5120) return nd;
    { const int q = (nd - 5120) >> 8, r = (nd - 5120) & 255; return r < 128 ? (5120 + 128 * q + r) : (7168 + 128 * q + r - 128); }
}
__device__ __forceinline__ void phase0(const Params& p, LAS unsigned char* lds) {
    const int tid = opaque_tid(), wave = __builtin_amdgcn_readfirstlane(tid >> 6), lane = tid & 63;
    LAS float* scr = (LAS float*)(lds + wave * TRS);
    const int gw = blockIdx.x * NWAVES + wave, NGW = gridDim.x * NWAVES;
    unsigned char* ws = p.ws;
    constexpr int I_IN = 32 * 144, I_UP = 16 * 32, I_OUT = 32 * 32;
    constexpr int NITEMS = I_IN + 2 * I_UP + I_OUT;
    for (int it = gw; it < NITEMS; it += NGW) {
        int r = it;
        if (r < I_IN) { const int kb = r / 144, nb = r % 144; tr_item64(p.in[2], NIN, kb * 64, win_src_col(nb * 64), (bf16_t*)(ws + WS_WINT), D, nb * 64, kb * 64, scr, lane, nullptr); continue; } r -= I_IN;
        if (r < I_UP) { const int kb = r / 32, nb = r % 32; tr_item64(p.in[8], D, kb * 64, nb * 64, (bf16_t*)(ws + WS_WUPT), 2048, nb * 64, kb * 64, scr, lane, nullptr); continue; } r -= I_UP;
        if (r < I_UP) { const int kb = r / 32, nb = r % 32; tr_item64(p.in[9], D, kb * 64, nb * 64, (bf16_t*)(ws + WS_WUPT), 2048, nb * 64, 1024 + kb * 64, scr, lane, nullptr); continue; } r -= I_UP;
        { const int kb = r / 32, nb = r % 32; tr_item64(p.in[10], D, kb * 64, nb * 64, (bf16_t*)(ws + WS_WOUTT), D, nb * 64, kb * 64, scr, lane, nullptr); }
    }
    const float* x = p.in[0]; const float* g = p.in[1]; bf16_t* xn = (bf16_t*)(ws + WS_X);
    for (int m = gw; m < T; m += NGW) {
        const f32x4* xr = (const f32x4*)(x + (size_t)m * D) + lane; f32x4 v[8]; float s = 0.f;
#pragma unroll
        for (int j = 0; j < 8; ++j) { v[j] = __builtin_nontemporal_load(xr + 64 * j); s += (v[j][0] * v[j][0] + v[j][1] * v[j][1]) + (v[j][2] * v[j][2] + v[j][3] * v[j][3]); }
        const float rs = 1.0f / sqrtf(wave_sum(s) * (1.0f / D) + EPS);
        u32x2* o = (u32x2*)(xn + (size_t)m * D) + lane;
#pragma unroll
        for (int j = 0; j < 8; ++j) { const f32x4 gg = *((const f32x4*)g + lane + 64 * j); u32x2 w; w.x = cvt_pk_bf16(v[j][0] * rs * gg[0], v[j][1] * rs * gg[1]); w.y = cvt_pk_bf16(v[j][2] * rs * gg[2], v[j][3] * rs * gg[3]); o[64 * j] = w; }
    }
    { bf16_t* wr = (bf16_t*)(ws + WS_WR); const float* gf = p.in[11];
      for (int i = blockIdx.x * NTHREADS + tid; i < 32 * D; i += gridDim.x * NTHREADS) { const int j = i / D, d = i % D; unsigned hi = 0, lo = 0;
          if (j < 20) { const float v = gf[d] * (j < 4 ? p.in[12][d * 4 + j] : p.in[14][d * 16 + (j - 4)]); hi = cvt_pk_bf16(v, 0.f) & 0xffffu; lo = cvt_pk_bf16(v - __uint_as_float(hi << 16), 0.f) & 0xffffu; }
          wr[(size_t)j * D + d] = (bf16_t)hi; wr[(size_t)(32 + j) * D + d] = (bf16_t)lo; } }
    { bf16_t* wmb = (bf16_t*)(ws + WS_WMB); const float* wsrc = p.in[6];
      for (int i = blockIdx.x * NTHREADS + tid; i < 8 * 128 * 128 / 2; i += gridDim.x * NTHREADS) { const int e0 = 2 * i, r = (e0 >> 7) & 127, c = e0 & 127; const bool ok = (r >= 64) || (c < 64);
          ((unsigned*)wmb)[i] = ok ? cvt_pk_bf16(wsrc[e0], wsrc[e0 + 1]) : 0u; } }
    if (blockIdx.x == 0 && tid < 64) ((int*)(ws + WS_CTL))[tid] = 0;
}

__device__ __forceinline__ void phase2_conv(const Params& p) {
    const bf16_t* Bc = (const bf16_t*)(p.ws + WS_P + P_BC); const bf16_t* P = (const bf16_t*)(p.ws + WS_P + P_P); bf16_t* Y = (bf16_t*)(p.ws + WS_X);
    const float* cw = p.in[3];
    for (int i = blockIdx.x * NTHREADS + opaque_tid(); i < T * (CW / 8); i += gridDim.x * NTHREADS) {
        const int t = i >> 7, c = (i & 127) * 8;
        f32x4 p0a, p0b, p1a, p1b, p2a, p2b, ba, bb;
        unpack8(*(const u32x4*)(P + (size_t)t * CW + c), p2a, p2b); unpack8(*(const u32x4*)(Bc + (size_t)t * CW + c), ba, bb);
        if (t >= 1) unpack8(*(const u32x4*)(P + (size_t)(t - 1) * CW + c), p1a, p1b); else { p1a = (f32x4){0, 0, 0, 0}; p1b = p1a; }
        if (t >= 2) unpack8(*(const u32x4*)(P + (size_t)(t - 2) * CW + c), p0a, p0b); else { p0a = (f32x4){0, 0, 0, 0}; p0b = p0a; }
        const f32x4 w0a = *(const f32x4*)(cw + c), w0b = *(const f32x4*)(cw + c + 4), w1a = *(const f32x4*)(cw + CW + c), w1b = *(const f32x4*)(cw + CW + c + 4),
                    w2a = *(const f32x4*)(cw + 2 * CW + c), w2b = *(const f32x4*)(cw + 2 * CW + c + 4);
        const f32x4 ya = ba * (w0a * p0a + w1a * p1a + w2a * p2a), yb = bb * (w0b * p0b + w1b * p1b + w2b * p2b);
        *(u32x4*)(Y + (size_t)t * 2048 + c) = pack8(ya, yb);
    }
}
__device__ __forceinline__ void phase2_sgu(const Params& p, LAS unsigned char* lds) {
    const int tid = opaque_tid(), wave = __builtin_amdgcn_readfirstlane(tid >> 6), lane = tid & 63, fr = lane & 15, fq = lane >> 4;
    const bf16_t* U = (const bf16_t*)(p.ws + WS_P + P_U); const bf16_t* V = (const bf16_t*)(p.ws + WS_P + P_V); bf16_t* Y = (bf16_t*)(p.ws + WS_X);
    const bf16_t* WmB = (const bf16_t*)(p.ws + WS_WMB); const f32x2* VST = (const f32x2*)(p.ws + WS_SMALL + SM_VST);
    const float* lng = p.in[4]; const float* lnb = p.in[5]; const float* bs = p.in[7];
    LAS f32x2* st = (LAS f32x2*)lds;
    LAS unsigned char* vT = lds + 1024;
    constexpr int VP = 272;
    for (int unit = blockIdx.x; unit < 64 * 8; unit += gridDim.x) {
        const int nb = unit >> 3, h = unit & 7, t0 = nb * 128, c0 = h * 128;
        __syncthreads();
        if (tid < 128) { const f32x4* ps = (const f32x4*)(VST + (size_t)(t0 + tid) * 16); float s = 0.f, q = 0.f;
#pragma unroll
            for (int i = 0; i < 8; ++i) { const f32x4 v = ps[i]; s += v[0] + v[2]; q += v[1] + v[3]; }
            const float mu = s * (1.0f / SW); const float var = fmaxf(q * (1.0f / SW) - mu * mu, 0.f);
            st[tid] = (f32x2){mu, 1.0f / sqrtf(var + EPS)}; }
        __syncthreads();
        if (tid < 256) {
            const int jb = tid >> 4, cb = tid & 15, j0 = jb * 8, cc0 = cb * 8;
            const f32x4 g0 = *(const f32x4*)(lng + c0 + cc0), g1 = *(const f32x4*)(lng + c0 + cc0 + 4), b0 = *(const f32x4*)(lnb + c0 + cc0), b1 = *(const f32x4*)(lnb + c0 + cc0 + 4);
            f32x4 lo[8], hi[8];
#pragma unroll
            for (int r = 0; r < 8; ++r) { const f32x2 s = st[j0 + r]; f32x4 a, b; unpack8(*(const u32x4*)(V + (size_t)(t0 + j0 + r) * SW + c0 + cc0), a, b);
                lo[r] = (a - s.x) * s.y * g0 + b0; hi[r] = (b - s.x) * s.y * g1 + b1; }
#pragma unroll
            for (int cc = 0; cc < 4; ++cc) { u32x4 o;
                o.x = cvt_pk_bf16(lo[0][cc], lo[1][cc]); o.y = cvt_pk_bf16(lo[2][cc], lo[3][cc]); o.z = cvt_pk_bf16(lo[4][cc], lo[5][cc]); o.w = cvt_pk_bf16(lo[6][cc], lo[7][cc]);
                *(LAS u32x4*)(vT + (cc0 + cc) * VP + j0 * 2) = o;
                o.x = cvt_pk_bf16(hi[0][cc], hi[1][cc]); o.y = cvt_pk_bf16(hi[2][cc], hi[3][cc]); o.z = cvt_pk_bf16(hi[4][cc], hi[5][cc]); o.w = cvt_pk_bf16(hi[6][cc], hi[7][cc]);
                *(LAS u32x4*)(vT + (cc0 + 4 + cc) * VP + j0 * 2) = o; }
        }
        __syncthreads();
        bf16x8 wf[4];
#pragma unroll
        for (int ks = 0; ks < 4; ++ks) wf[ks] = *(const bf16x8*)(WmB + ((size_t)h * 128 + wave * 16 + fr) * 128 + ks * 32 + fq * 8);
        f32x4 acc[8];
#pragma unroll
        for (int nk = 0; nk < 8; ++nk) { acc[nk] = (f32x4){0.f, 0.f, 0.f, 0.f};
#pragma unroll
            for (int ks = 0; ks < 4; ++ks) { const bf16x8 vf = *(const LAS bf16x8*)(vT + (nk * 16 + fr) * VP + (ks * 32 + fq * 8) * 2);
                acc[nk] = __builtin_amdgcn_mfma_f32_16x16x32_bf16(vf, wf[ks], acc[nk], 0, 0, 0); } }
        { const int i = wave * 16 + fr; const float bb = bs[h * 128 + i]; const size_t t = (size_t)(t0 + i);
#pragma unroll
          for (int nk = 0; nk < 8; ++nk) { const int c = c0 + nk * 16 + 4 * fq; const u32x2 uu = *(const u32x2*)(U + t * SW + c);
              u32x2 o; o.x = cvt_pk_bf16(bf_lo(uu.x) * (acc[nk][0] + bb), bf_hi(uu.x) * (acc[nk][1] + bb)); o.y = cvt_pk_bf16(bf_lo(uu.y) * (acc[nk][2] + bb), bf_hi(uu.y) * (acc[nk][3] + bb));
              *(u32x2*)(Y + t * 2048 + 1024 + c) = o; } }
    }
}

__device__ __forceinline__ void phase5_router(const Params& p, LAS unsigned char* lds) {
    const int tid = opaque_tid(), wave = __builtin_amdgcn_readfirstlane(tid >> 6), lane = tid & 63, fr = lane & 15, fq = lane >> 4;
    const bf16_t* A2 = (const bf16_t*)(p.ws + WS_A2); const bf16_t* wr = (const bf16_t*)(p.ws + WS_WR);
    float* rstd = (float*)(p.ws + WS_SMALL + SM_RSTD); int* ent = (int*)(p.ws + WS_SMALL + SM_ENT); float* lw = (float*)(p.ws + WS_SMALL + SM_W); int* cnt = (int*)(p.ws + WS_CTL);
    const float* brg = p.in[13]; const float* bre = p.in[15];
    LAS float* part = (LAS float*)lds;
    LAS float* pss  = (LAS float*)(lds + 65536);
    LAS float* lg   = (LAS float*)(lds + 65536 + 1024);
    LAS float* lss  = (LAS float*)(lds + 65536 + 1024 + 2560);
    LAS int* lcnt  = (LAS int*)(lds + 70000);
    LAS int* lbase = (LAS int*)(lds + 70000 + 64);
    LAS int* le    = (LAS int*)(lds + 70000 + 128);
    LAS int* lp    = (LAS int*)(lds + 70000 + 128 + 256);
    LAS float* lwt = (LAS float*)(lds + 70000 + 128 + 512);
    for (int tile = blockIdx.x; tile < T / 32; tile += gridDim.x) {
        const int tok0 = tile * 32;
        __syncthreads();
        if (tid < 16) lcnt[tid] = 0;
        f32x4 acc[2][4]; float ss[2] = {0.f, 0.f};
#pragma unroll
        for (int m = 0; m < 2; ++m)
#pragma unroll
            for (int n = 0; n < 4; ++n) acc[m][n] = (f32x4){0.f, 0.f, 0.f, 0.f};
#pragma unroll 2
        for (int ks = 0; ks < 8; ++ks) {
            const int k = wave * 256 + ks * 32 + fq * 8;
            bf16x8 af[2], bfr[4];
#pragma unroll
            for (int m = 0; m < 2; ++m) af[m] = *(const bf16x8*)(A2 + (size_t)(tok0 + 16 * m + fr) * D + k);
#pragma unroll
            for (int n = 0; n < 4; ++n) bfr[n] = *(const bf16x8*)(wr + (size_t)(16 * n + fr) * D + k);
#pragma unroll
            for (int m = 0; m < 2; ++m) {
#pragma unroll
                for (int j = 0; j < 8; ++j) { const float v = bf1((bf16_t)af[m][j]); ss[m] += v * v; }
#pragma unroll
                for (int n = 0; n < 4; ++n) acc[m][n] = __builtin_amdgcn_mfma_f32_16x16x32_bf16(bfr[n], af[m], acc[m][n], 0, 0, 0);
            }
        }
#pragma unroll
        for (int m = 0; m < 2; ++m) { ss[m] += __shfl_xor(ss[m], 16); ss[m] += __shfl_xor(ss[m], 32);
            if (fq == 0) pss[wave * 32 + 16 * m + fr] = ss[m];
#pragma unroll
            for (int n = 0; n < 4; ++n) *(LAS f32x4*)(part + (wave * 32 + 16 * m + fr) * 64 + 16 * n + 4 * fq) = acc[m][n]; }
        __syncthreads();
        for (int i = tid; i < 32 * 20; i += NTHREADS) { const int t = i / 20, j = i % 20; float s = 0.f;
#pragma unroll
            for (int w = 0; w < 8; ++w) s += part[(w * 32 + t) * 64 + j] + part[(w * 32 + t) * 64 + 32 + j];
            lg[t * 20 + j] = s; }
        if (tid < 32) { float s = 0.f;
#pragma unroll
            for (int w = 0; w < 8; ++w) s += pss[w * 32 + tid];
            lss[tid] = s; }
        __syncthreads();
        if (tid < 32) {
            const int t = tid; const float rs = 1.0f / sqrtf(lss[t] * (1.0f / D) + EPS);
            float g4[4];
#pragma unroll
            for (int j = 0; j < 4; ++j) g4[j] = lg[t * 20 + j] * rs + brg[j];
            int gi = 0; float gm = g4[0];
#pragma unroll
            for (int j = 1; j < 4; ++j) if (g4[j] > gm) { gm = g4[j]; gi = j; }
            float den = 0.f;
#pragma unroll
            for (int j = 0; j < 4; ++j) den += __expf(g4[j] - gm);
            const float pg = 1.0f / den;
            float le4[4];
#pragma unroll
            for (int j = 0; j < 4; ++j) le4[j] = lg[t * 20 + 4 + gi * 4 + j] * rs + bre[gi * 4 + j];
            int i1 = 0; float m1 = le4[0];
#pragma unroll
            for (int j = 1; j < 4; ++j) if (le4[j] > m1) { m1 = le4[j]; i1 = j; }
            int i2 = -1; float m2 = -3.0e38f;
#pragma unroll
            for (int j = 0; j < 4; ++j) if (j != i1 && le4[j] > m2) { m2 = le4[j]; i2 = j; }
            const float ex = __expf(m2 - m1); const float w1 = pg / (1.0f + ex), w2 = pg * ex / (1.0f + ex);
            rstd[tok0 + t] = rs;
            const int e1 = gi * 4 + i1, e2 = gi * 4 + i2;
            le[2 * t] = e1; le[2 * t + 1] = e2; lwt[2 * t] = w1; lwt[2 * t + 1] = w2;
            lp[2 * t] = atomicAdd((int*)&lcnt[e1], 1); lp[2 * t + 1] = atomicAdd((int*)&lcnt[e2], 1);
        }
        __syncthreads();
        if (tid < 16) { const int n = lcnt[tid]; lbase[tid] = n ? atomicAdd(&cnt[tid], n) : 0; }
        __syncthreads();
        if (tid < 64) { const int e = le[tid]; const int pos = lbase[e] + lp[tid]; ent[e * T + pos] = (tok0 + (tid >> 1)) | ((tid & 1) << 16); lw[e * T + pos] = lwt[tid]; }
    }
}

__device__ __forceinline__ void phase8_final(const Params& p) {
    const int tid = opaque_tid(), wave = __builtin_amdgcn_readfirstlane(tid >> 6), lane = tid & 63;
    const bf16_t* A2 = (const bf16_t*)(p.ws + WS_A2); const bf16_t* Y0 = (const bf16_t*)(p.ws + WS_YK0); const bf16_t* Y1 = (const bf16_t*)(p.ws + WS_YK1); const float* g = p.in[19];
    const int gw = blockIdx.x * NWAVES + wave, NGW = gridDim.x * NWAVES;
    for (int m = gw; m < T; m += NGW) {
        f32x4 v[8]; float s = 0.f;
#pragma unroll
        for (int j = 0; j < 8; ++j) { const size_t o = (size_t)m * D + 4 * lane + 256 * j;
            const u32x2 hh = *(const u32x2*)(A2 + o), a = *(const u32x2*)(Y0 + o), b = *(const u32x2*)(Y1 + o);
            v[j][0] = bf_lo(hh.x) + (bf_lo(a.x) + bf_lo(b.x)); v[j][1] = bf_hi(hh.x) + (bf_hi(a.x) + bf_hi(b.x)); v[j][2] = bf_lo(hh.y) + (bf_lo(a.y) + bf_lo(b.y)); v[j][3] = bf_hi(hh.y) + (bf_hi(a.y) + bf_hi(b.y));
            s += (v[j][0] * v[j][0] + v[j][1] * v[j][1]) + (v[j][2] * v[j][2] + v[j][3] * v[j][3]); }
        const float rs = 1.0f / sqrtf(wave_sum(s) * (1.0f / D) + EPS);
#pragma unroll
        for (int j = 0; j < 8; ++j) { const int c = 4 * lane + 256 * j; const f32x4 gg = *(const f32x4*)(g + c); __builtin_nontemporal_store(v[j] * rs * gg, (f32x4*)(p.out + (size_t)m * D + c)); }
    }
}

#define XB_TMO      128
#define XB_XCNT(j)  (256  + 64 * (j))
#define XB_XSUB(j)  (1280 + 64 * (j))
#define XB_XGEN(j)  (2304 + 64 * (j))
#define XB_TOP      3328
#define XB_TOPGEN   3392
#define XCD_BAR_WORDS 3456
#define XB_SPIN_CAP (1u << 18)
__device__ __forceinline__ unsigned xb_ld(unsigned* p)              { return __hip_atomic_load(p, __ATOMIC_RELAXED, __HIP_MEMORY_SCOPE_AGENT); }
__device__ __forceinline__ unsigned xb_add(unsigned* p, unsigned v) { return __hip_atomic_fetch_add(p, v, __ATOMIC_RELAXED, __HIP_MEMORY_SCOPE_AGENT); }
__device__ __forceinline__ unsigned xb_xcc_id() { return (unsigned)__builtin_amdgcn_s_getreg((3 << 11) | 20) & 0xFu; }
#define XB_SPIN(cond, bar) do { unsigned _sp = 0; while (cond) { __builtin_amdgcn_s_sleep(1); \
    if ((++_sp & 255u) == 0u) { if (xb_ld(&(bar)[XB_TMO])) break; if (_sp > XB_SPIN_CAP) { atomicAdd(&(bar)[XB_TMO], 1u); break; } } } } while (0)
struct XcdBarrier { unsigned* bar; unsigned x; volatile LAS unsigned* st; };
__device__ __forceinline__ XcdBarrier xcd_barrier_post(unsigned* bar, volatile LAS unsigned* st) {
    XcdBarrier b; b.bar = bar; b.x = xb_xcc_id(); b.st = st;
    if (threadIdx.x == 0) (void)xb_add(&bar[XB_XCNT(b.x)], 1u);
    return b;
}
__device__ __forceinline__ void xcd_barrier_complete(unsigned* bar, unsigned x, unsigned& nloc, unsigned& nx) {
    const unsigned G = gridDim.x * gridDim.y * gridDim.z;
    unsigned sum, cnt, mine, sp = 0u;
    for (;;) {
        sum = 0u; cnt = 0u; mine = 0u;
#pragma unroll
        for (unsigned j = 0; j < 16; ++j) { const unsigned c = xb_ld(&bar[XB_XCNT(j)]); sum += c; cnt += (c > 0u) ? 1u : 0u; mine = (j == x) ? c : mine; }
        if (sum == G) break;
        __builtin_amdgcn_s_sleep(1);
        if ((++sp & 255u) == 0u) { if (xb_ld(&bar[XB_TMO])) break; if (sp > XB_SPIN_CAP) { atomicAdd(&bar[XB_TMO], 1u); break; } }
    }
    nloc = mine > 0u ? mine : 1u; nx = cnt > 0u ? cnt : 1u;
}
__device__ __forceinline__ void xcd_barrier(const XcdBarrier& b) {
    asm volatile("s_waitcnt vmcnt(0)" ::: "memory");
    __syncthreads();
    if (threadIdx.x == 0) {
        unsigned* bar = b.bar;
        __builtin_amdgcn_s_waitcnt(0);
        unsigned nloc = b.st[0], nx = b.st[1];
        if (nloc == 0u) { xcd_barrier_complete(bar, b.x, nloc, nx); b.st[0] = nloc; b.st[1] = nx; }
        const unsigned old = xb_add(&bar[XB_XSUB(b.x)], 1u);
        const unsigned gen = old / nloc;
        if (old + 1u == (gen + 1u) * nloc) {
            __builtin_amdgcn_fence(__ATOMIC_RELEASE, "agent");
            asm volatile("s_waitcnt vmcnt(0)" ::: "memory");
            const unsigned og = xb_add(&bar[XB_TOP], 1u);
            const unsigned tg = og / nx;
            if (og + 1u == (tg + 1u) * nx) xb_add(&bar[XB_TOPGEN], 1u);
            else XB_SPIN(xb_ld(&bar[XB_TOPGEN]) == tg, bar);
            __builtin_amdgcn_fence(__ATOMIC_ACQUIRE, "agent");
            xb_add(&bar[XB_XGEN(b.x)], 1u);
            asm volatile("s_waitcnt vmcnt(0)" ::: "memory");
        } else {
            XB_SPIN(xb_ld(&bar[XB_XGEN(b.x)]) == gen, bar);
            __builtin_amdgcn_fence(__ATOMIC_ACQUIRE, "agent");
            asm volatile("s_waitcnt vmcnt(0)" ::: "memory");
        }
    }
    __syncthreads();
}

template <int PH> __device__ __forceinline__ void run_phase(const Params& p, LAS unsigned char* lds) {
    unsigned char* ws = p.ws;
    if constexpr (PH == 0) phase0(p, lds);
    if constexpr (PH == 1) { DenseSched S; S.init((const bf16_t*)(ws + WS_X), (const bf16_t*)(ws + WS_WINT), T, NIN, D);
        EpiProj E{(bf16_t*)(ws + WS_P + P_BC), (bf16_t*)(ws + WS_P + P_P), (bf16_t*)(ws + WS_P + P_U), (bf16_t*)(ws + WS_P + P_V), (bf16_t*)(ws + WS_P + P_R), (bf16_t*)(ws + WS_P + P_S), (f32x2*)(ws + WS_SMALL + SM_VST)};
        gemm_run<0>(lds, S, E, D); convert_tail(p, lds, (T / 256) * (NIN / 256)); }
    if constexpr (PH == 2) { phase2_conv(p); phase2_sgu(p, lds); }
    if constexpr (PH == 3) { DenseSched S; S.init((const bf16_t*)(ws + WS_X), (const bf16_t*)(ws + WS_WUPT), T, D, 2048);
        EpiUp E{(const bf16_t*)(ws + WS_P + P_R), (const bf16_t*)(ws + WS_P + P_S), (bf16_t*)(ws + WS_MM)}; gemm_run<1>(lds, S, E, 2048); }
    if constexpr (PH == 4) { DenseSched S; S.init((const bf16_t*)(ws + WS_MM), (const bf16_t*)(ws + WS_WOUTT), T, D, D);
        EpiOut E{p.in[0], (bf16_t*)(ws + WS_A2)}; gemm_run<2>(lds, S, E, D); }
    if constexpr (PH == 5) phase5_router(p, lds);
    if constexpr (PH == 6 || PH == 7) {
        const int* cnt = (const int*)(ws + WS_CTL); const int* ent = (const int*)(ws + WS_SMALL + SM_ENT); const int G = gridDim.x, c = blockIdx.x;
        EpiMoe1 E1{ent, (const float*)(ws + WS_SMALL + SM_W), (const float*)(ws + WS_SMALL + SM_RSTD), (bf16_t*)(ws + WS_HID), false};
        EpiMoe2 E2{ent, (bf16_t*)(ws + WS_YK0), (bf16_t*)(ws + WS_YK1)};
        typedef MoeSched<true, 4, D, 1024> S1T; typedef MoeSched<false, 8, DE, D> S2T;
        constexpr int BIG = 1 << 20;
        unsigned* flags = (unsigned*)(ws + WS_FLAGS);
        int UA = 0, UH = 0; for (int e = 0; e < NE; ++e) { const int nt = (__builtin_amdgcn_readfirstlane(cnt[e]) + 255) >> 8; UA += min(nt, MOE_REG) * 4; UH += max(nt - MOE_REG, 0) * 4; }
        const bool fancy = (UA <= G) && (UH <= G / 4);
        if constexpr (PH == 6) {
            if (fancy) {
                E1.wt = true;
                { S1T S{(const bf16_t*)(ws + WS_A2), (const bf16_t*)(ws + WS_W1T), cnt, ent, 3, (c < UA) ? c : -1, 0, 1, (c < UH) ? UA + c : -1, flags, 1}; gemm_run<3>(lds, S, E1, D); }
                { S2T S{(const bf16_t*)(ws + WS_HID), (const bf16_t*)(ws + WS_W2T), cnt, ent, 3, (c >= UH) ? c - UH : -1, G - UH, BIG, -1, flags, 2}; gemm_run<4>(lds, S, E2, DE); }
            } else { S1T S{(const bf16_t*)(ws + WS_A2), (const bf16_t*)(ws + WS_W1T), cnt, ent, 2, c, G, BIG, -1, flags, 0}; gemm_run<3>(lds, S, E1, D); }
        }
        if constexpr (PH == 7) { S2T S{(const bf16_t*)(ws + WS_HID), (const bf16_t*)(ws + WS_W2T), cnt, ent, 2, c, G, BIG, -1, flags, 0}; gemm_run<4>(lds, S, E2, DE); }
    }
    if constexpr (PH == 8) phase8_final(p);
}

template <int PH> __global__ void __launch_bounds__(NTHREADS, 2) k_phase(Params p) {
    extern __shared__ __attribute__((aligned(16))) unsigned char lds_raw[];
    run_phase<PH>(p, (LAS unsigned char*)lds_raw);
}

#ifndef PROBE_DUP
#define PROBE_DUP 0
#endif
#ifndef PROBE_SYNCS
#define PROBE_SYNCS 0
#endif
#define DUP(k) ((PROBE_DUP >> (k)) & 1)
#ifndef PROBE_T
#define PROBE_T (-1)
#endif
#ifndef PROBE_MULT
#define PROBE_MULT 4
#endif
typedef const __attribute__((address_space(4))) Params* KParamsPtr;
__device__ __forceinline__ Params load_params() {
    Params r{};
#if defined(__HIP_DEVICE_COMPILE__)
    unsigned long long v = (unsigned long long)__builtin_amdgcn_kernarg_segment_ptr(); asm volatile("" : "+s"(v));
    const __attribute__((address_space(4))) unsigned long long* q = (const __attribute__((address_space(4))) unsigned long long*)v;
#pragma unroll
    for (int i = 0; i < 20; ++i) r.in[i] = (const float*)(const __attribute__((address_space(1))) float*)q[i];
    r.out = (float*)(__attribute__((address_space(1))) float*)q[20]; r.ws = (unsigned char*)(__attribute__((address_space(1))) unsigned char*)q[21];
#endif
    return r;
}
#define RUN(k) do { const Params pk = load_params(); run_phase<k>(pk, lds); } while (0)
__global__ void __launch_bounds__(NTHREADS, 2) k_mega(Params p) {
    extern __shared__ __attribute__((aligned(16))) unsigned char lds_raw[];
    LAS unsigned char* lds = (LAS unsigned char*)lds_raw;
    cg::grid_group grid = cg::this_grid();
    volatile LAS unsigned* xbst = (volatile LAS unsigned*)(lds + LDS_BYTES - 64);
    if (threadIdx.x < 4) xbst[threadIdx.x] = 0u;
    __syncthreads();
    const XcdBarrier bar = xcd_barrier_post((unsigned*)(p.ws + WS_BAR), xbst);
    volatile LAS unsigned long long* stamps = (volatile LAS unsigned long long*)(lds + LDS_BYTES - 256);
    int nstamp = 0;
#define STAMP() do { if (PROBE_T >= 0 && blockIdx.x == 0 && threadIdx.x == 0) stamps[nstamp] = __builtin_amdgcn_s_memrealtime(); ++nstamp; } while (0)
#define GSYNC() do { xcd_barrier(bar); STAMP(); } while (0)
    STAMP();
    if (p.ws == nullptr) grid.sync();
    RUN(0); GSYNC();
    if (DUP(0)) { RUN(0); GSYNC(); }
    RUN(1); GSYNC();
    if (DUP(1)) { RUN(1); GSYNC(); }
    RUN(2); GSYNC();
    if (DUP(2)) { RUN(2); GSYNC(); }
    RUN(3); GSYNC();
    if (DUP(3)) { RUN(3); GSYNC(); }
    RUN(4); GSYNC();
    if (DUP(4)) { RUN(4); GSYNC(); }
    RUN(5); GSYNC();
    if (DUP(5)) { if (blockIdx.x == 0 && threadIdx.x < 16) ((int*)(load_params().ws + WS_CTL))[threadIdx.x] = 0; GSYNC(); RUN(5); GSYNC(); }
    RUN(6); GSYNC();
    if (DUP(6)) { RUN(6); GSYNC(); }
    { const int* cnt = (const int*)(load_params().ws + WS_CTL); int UA = 0, UH = 0;
      for (int e = 0; e < NE; ++e) { const int nt = (__builtin_amdgcn_readfirstlane(cnt[e]) + 255) >> 8; UA += min(nt, MOE_REG) * 4; UH += max(nt - MOE_REG, 0) * 4; }
      if (!((UA <= (int)gridDim.x) && (UH <= (int)gridDim.x / 4))) { RUN(7); GSYNC(); } }
    for (int i = 0; i < PROBE_SYNCS; ++i) GSYNC();
    RUN(8);
    if (DUP(8)) { GSYNC(); RUN(8); }
    if (PROBE_T >= 0) { __syncthreads(); STAMP();
        if (blockIdx.x == 0 && threadIdx.x == 0) { const unsigned long long d = (stamps[PROBE_T + 1] - stamps[PROBE_T]) * PROBE_MULT; const unsigned long long t0 = __builtin_amdgcn_s_memrealtime();
            while (__builtin_amdgcn_s_memrealtime() - t0 < d) __builtin_amdgcn_s_sleep(8); } }
}

template <int PH> static void launch_phase(const Params& p, int grid, hipStream_t stream) {
    static bool attr = false;
    if (!attr) { (void)hipFuncSetAttribute((const void*)k_phase<PH>, hipFuncAttributeMaxDynamicSharedMemorySize, LDS_BYTES); attr = true; }
    hipLaunchKernelGGL(k_phase<PH>, dim3(grid), dim3(NTHREADS), LDS_BYTES, stream, p);
}

extern "C" void kernel_launch(void* const* d_in, const int* in_sizes, int n_in, void* d_out, int out_size, void* d_ws, size_t ws_size, hipStream_t stream) {
    static int grid = 0;
    if (grid == 0) {
        if (n_in != 20 || out_size != T * D || ws_size < WS_END) { fprintf(stderr, "kernel_launch: unexpected shapes n_in %d out %d ws %zu (need %zu)\n", n_in, out_size, ws_size, (size_t)WS_END); grid = -1; return; }
        int dev = 0, cus = 0, per_cu = 0;
        (void)hipGetDevice(&dev); (void)hipDeviceGetAttribute(&cus, hipDeviceAttributeMultiprocessorCount, dev);
        (void)hipFuncSetAttribute((const void*)k_mega, hipFuncAttributeMaxDynamicSharedMemorySize, LDS_BYTES);
        (void)hipOccupancyMaxActiveBlocksPerMultiprocessor(&per_cu, (const void*)k_mega, NTHREADS, LDS_BYTES);
        if (per_cu < 1) { fprintf(stderr, "kernel_launch: occupancy query says %d blocks per CU\n", per_cu); per_cu = 1; }
        grid = cus * 1;
        (void)hipGetLastError();
    }
    if (grid < 0) return;
    Params p{};
    for (int i = 0; i < 20; ++i) p.in[i] = (const float*)d_in[i];
    p.out = (float*)d_out; p.ws = (unsigned char*)d_ws;
    (void)hipMemsetAsync((char*)d_ws + WS_CTL, 0, 64 * 1024, stream);
#if ONE_LAUNCH
    void* args[] = {&p};
    hipError_t e = hipLaunchCooperativeKernel((const void*)k_mega, dim3(grid), dim3(NTHREADS), args, LDS_BYTES, stream);
    if (e != hipSuccess) fprintf(stderr, "cooperative launch failed: %s (grid %d)\n", hipGetErrorString(e), grid);
#else
    launch_phase<0>(p, grid, stream); launch_phase<1>(p, grid, stream); launch_phase<2>(p, grid, stream); launch_phase<3>(p, grid, stream); launch_phase<4>(p, grid, stream);
    launch_phase<5>(p, grid, stream); launch_phase<6>(p, grid, stream); launch_phase<7>(p, grid, stream); launch_phase<8>(p, grid, stream);
#endif
}
```

```cpp
#include <hip/hip_runtime.h>
#include <hip/hip_cooperative_groups.h>
#include <cstdio>
#include <cstdint>
namespace cg = cooperative_groups;

#ifndef ONE_LAUNCH
#define ONE_LAUNCH 1
#endif

#define LAS __attribute__((address_space(3)))
typedef unsigned short bf16_t;
typedef short bf16x8 __attribute__((ext_vector_type(8)));
typedef float f32x4 __attribute__((ext_vector_type(4)));
typedef float f32x2 __attribute__((ext_vector_type(2)));
typedef unsigned u32x4 __attribute__((ext_vector_type(4)));
typedef unsigned u32x2 __attribute__((ext_vector_type(2)));

constexpr int T = 8192, D = 2048, CW = 1024, SW = 1024, NIN = 9216, NE = 16, DE = 512;
constexpr float EPS = 1e-6f;
constexpr int NTHREADS = 512, NWAVES = 8;
constexpr int LDS_BYTES = 140 * 1024;
constexpr int HID_ROWS = 2 * T + NE * 256;

constexpr size_t MiB = 1024 * 1024;
constexpr size_t WS_CTL   = 0;
constexpr size_t WS_BAR   = 4096;
constexpr size_t WS_FLAGS = 32768;
constexpr size_t WS_SMALL = 64 * 1024;
constexpr size_t SM_RSTD = 0, SM_ENT = 32 * 1024, SM_W = SM_ENT + (size_t)NE * T * 4, SM_VST = SM_W + (size_t)NE * T * 4, SM_END = SM_VST + (size_t)T * 16 * 8;
constexpr size_t WS_WR    = WS_SMALL + 4 * MiB;
constexpr size_t WS_WMB   = WS_WR + 256 * 1024;
constexpr size_t WS_WINT  = WS_WMB + 256 * 1024;
constexpr size_t WS_WUPT  = WS_WINT + (size_t)NIN * D * 2;
constexpr size_t WS_WOUTT = WS_WUPT + (size_t)D * D * 2;
constexpr size_t WS_W1T   = WS_WOUTT + (size_t)D * D * 2;
constexpr size_t WS_W2T   = WS_W1T + (size_t)NE * 1024 * D * 2;
constexpr size_t WS_X     = WS_W2T + (size_t)NE * D * DE * 2;
constexpr size_t WS_P     = WS_X + (size_t)T * D * 2;
constexpr size_t P_BC = 0, P_P = P_BC + (size_t)T * CW * 2, P_U = P_P + (size_t)T * CW * 2, P_V = P_U + (size_t)T * SW * 2,
                 P_R = P_V + (size_t)T * SW * 2, P_S = P_R + (size_t)T * D * 2, P_END = P_S + (size_t)T * D * 2;
constexpr size_t WS_END   = WS_P + P_END;
constexpr size_t WS_MM  = WS_WINT;
constexpr size_t WS_H   = WS_P + P_BC;
constexpr size_t WS_A2  = WS_P + P_R;
constexpr size_t WS_HID = WS_P + P_S;
constexpr size_t WS_YK0 = WS_X;
constexpr size_t WS_YK1 = WS_WINT;
static_assert(SM_END <= 4 * MiB, "small region");
static_assert((size_t)HID_ROWS * DE * 2 <= (size_t)T * D * 2, "hid overlay");
static_assert((size_t)T * D * 4 <= P_R, "H overlay");

struct Params { const float* in[20]; float* out; unsigned char* ws; };

__device__ __forceinline__ unsigned cvt_pk_bf16(float lo, float hi) { unsigned r; asm("v_cvt_pk_bf16_f32 %0, %1, %2" : "=v"(r) : "v"(lo), "v"(hi)); return r; }
__device__ __forceinline__ float bf_lo(unsigned w) { return __uint_as_float(w << 16); }
__device__ __forceinline__ float bf_hi(unsigned w) { return __uint_as_float(w & 0xffff0000u); }
__device__ __forceinline__ float bf1(bf16_t b) { return __uint_as_float(((unsigned)b) << 16); }
__device__ __forceinline__ float wave_sum(float v) {
#pragma unroll
    for (int o = 1; o < 64; o <<= 1) v += __shfl_xor(v, o);
    return v;
}
__device__ __forceinline__ float fast_rcp(float x) { return __builtin_amdgcn_rcpf(x); }
__device__ __forceinline__ float fast_exp2(float x) { return __builtin_amdgcn_exp2f(x); }
__device__ __forceinline__ float sigmoid_f(float x) { return fast_rcp(1.0f + fast_exp2(-1.44269504f * x)); }
__device__ __forceinline__ float gelu_tanh(float x) {
    const float u = x + 0.044715f * x * x * x;
    return x * fast_rcp(1.0f + fast_exp2(-2.30220819f * u));
}
__device__ __forceinline__ int opaque_tid() { int t = threadIdx.x; asm volatile("" : "+v"(t)); return t; }
__device__ __forceinline__ void st16_wt(void* p, u32x4 v) { asm volatile("global_store_dwordx4 %0, %1, off sc1\n\ts_nop 1" :: "v"(p), "v"(v) : "memory"); }
__host__ __device__ __forceinline__ int perm32(int rho) { const int n = rho >> 4, i = rho & 15; return 8 * (i >> 2) + 4 * n + (i & 3); }

struct Unit { int pm, pn, e, row0, nvalid; };
constexpr int NXCD = 8, WGM = 2;
struct DenseSched {
    static constexpr bool DYN_HALF = false;
    __device__ __forceinline__ void a_ready(const Unit&) const {}
    __device__ __forceinline__ void done(const Unit&) const {}
    const bf16_t* A; const bf16_t* Bt; int K; int nM, nN, nwg, G, c;
    __device__ __forceinline__ void init(const bf16_t* A_, const bf16_t* Bt_, int M, int N, int K_) { A = A_; Bt = Bt_; K = K_; nM = M / 256; nN = N / 256; nwg = nM * nN; G = gridDim.x; c = blockIdx.x; }
    __device__ __forceinline__ bool next(int i, Unit& u) const {
        const long L = (long)i * G + c; if (L >= nwg) return false;
        int wgid = (int)L; { const int q = nwg / NXCD, r = nwg % NXCD, xcd = wgid % NXCD, off = wgid / NXCD; wgid = (xcd < r ? xcd * (q + 1) : r * (q + 1) + (xcd - r) * q) + off; }
        const int nig = WGM * nN, gid = wgid / nig, fm = gid * WGM, gsz = (nM - fm) < WGM ? (nM - fm) : WGM;
        u.pm = fm + ((wgid % nig) % gsz); u.pn = (wgid % nig) / gsz; u.e = 0; u.row0 = u.pm * 256; u.nvalid = 256; return true;
    }
    __device__ __forceinline__ const char* a_base() const { return (const char*)A; }
    __device__ __forceinline__ unsigned a_off(const Unit& u, int r) const { return (unsigned)(u.row0 + r) * (unsigned)K * 2u; }
    __device__ __forceinline__ const char* b_base(const Unit& u) const { return (const char*)Bt + (size_t)u.pn * 256 * K * 2; }
};
constexpr int MOE_REG = 4;
template <bool GATHER, int NPN, int KK, int NROWS_E  >
struct MoeSched {
    static constexpr bool DYN_HALF = true;
    const bf16_t* A; const bf16_t* Bt; const int* cnt; const int* ent;
    int mode;
    int idx, stride, maxi;
    int idx1;
    unsigned* flags; int role;
    __device__ __forceinline__ bool lookup(int L, int md, Unit& u) const {
        int hb = 0;
        for (int e = 0; e < NE; ++e) {
            const int n = __builtin_amdgcn_readfirstlane(cnt[e]); const int nt = (n + 255) >> 8;
            const int lo = (md == 1) ? min(nt, MOE_REG) : 0, hi = (md == 0) ? min(nt, MOE_REG) : nt;
            const int nsel = (hi - lo) * NPN;
            if (L < nsel) { u.e = e; u.pm = lo + L / NPN; u.pn = L % NPN; u.row0 = hb + u.pm * 256; u.nvalid = min(256, n - u.pm * 256); return true; }
            L -= nsel; hb += nt * 256;
        }
        return false;
    }
    __device__ __forceinline__ bool next(int i, Unit& u) const {
        int L;
        const int n0 = (idx >= 0) ? maxi : 0;
        if (i < n0) L = idx + i * stride; else if (i == n0 && idx1 >= 0) L = idx1; else return false;
        if (mode != 3) return lookup(L, mode, u);
        int nreg = 0; for (int e = 0; e < NE; ++e) nreg += min((__builtin_amdgcn_readfirstlane(cnt[e]) + 255) >> 8, MOE_REG) * NPN;
        return (L < nreg) ? lookup(L, 0, u) : lookup(L - nreg, 1, u);
    }
    __device__ __forceinline__ const char* a_base() const { return (const char*)A; }
    __device__ __forceinline__ unsigned a_off(const Unit& u, int r) const {
        if (GATHER) { const int tok = (r < u.nvalid) ? (ent[u.e * T + u.pm * 256 + r] & 0xffff) : 0; return (unsigned)tok * (unsigned)KK * 2u; }
        return (unsigned)(u.row0 + r) * (unsigned)KK * 2u;
    }
    __device__ __forceinline__ const char* b_base(const Unit& u) const { return (const char*)Bt + ((size_t)u.e * NROWS_E + (size_t)u.pn * 256) * KK * 2; }
    __device__ __forceinline__ void a_ready(const Unit& u) const {
        if (role != 2) return;
        if (threadIdx.x < 64) {
            unsigned* f = flags + (u.row0 >> 8) * 64; unsigned spins = 0;
            while ((unsigned)__builtin_amdgcn_readfirstlane(__hip_atomic_load(f, __ATOMIC_RELAXED, __HIP_MEMORY_SCOPE_AGENT)) < 32u) { __builtin_amdgcn_s_sleep(2); if (++spins > (1u << 22)) break; }
            __builtin_amdgcn_fence(__ATOMIC_ACQUIRE, "agent");
            asm volatile("s_waitcnt vmcnt(0)" ::: "memory");
        }
        asm volatile("" ::: "memory"); __builtin_amdgcn_s_barrier(); asm volatile("" ::: "memory");
    }
    __device__ __forceinline__ void done(const Unit& u) const {
        if (role != 1) return;
        asm volatile("s_waitcnt vmcnt(0)" ::: "memory");
        if ((threadIdx.x & 63) == 0) __hip_atomic_fetch_add(flags + (u.row0 >> 8) * 64, 1u, __ATOMIC_RELAXED, __HIP_MEMORY_SCOPE_AGENT);
    }
};
__device__ __forceinline__ int moe_overflow_tiles(const int* cnt) { int t = 0; for (int e = 0; e < NE; ++e) { const int nt = (__builtin_amdgcn_readfirstlane(cnt[e]) + 255) >> 8; t += max(nt - MOE_REG, 0); } return t; }

typedef f32x4 Acc[2][2][4][2];
__device__ __forceinline__ u32x4 pack8(f32x4 a, f32x4 b) { u32x4 w; w.x = cvt_pk_bf16(a[0], a[1]); w.y = cvt_pk_bf16(a[2], a[3]); w.z = cvt_pk_bf16(b[0], b[1]); w.w = cvt_pk_bf16(b[2], b[3]); return w; }
__device__ __forceinline__ void unpack8(u32x4 w, f32x4& a, f32x4& b) { a = (f32x4){bf_lo(w.x), bf_hi(w.x), bf_lo(w.y), bf_hi(w.y)}; b = (f32x4){bf_lo(w.z), bf_hi(w.z), bf_lo(w.w), bf_hi(w.w)}; }

struct EpiProj {
    static constexpr bool PERM = true; static constexpr int MIDK = 0;
    bf16_t *Bc, *P, *U, *V, *R, *S; f32x2* VST;
    __device__ __forceinline__ void mid(Acc&, const Unit&, int, int, int, int) const {}
    __device__ __forceinline__ void operator()(const Acc& acc, const Unit& u, int wr, int wc, int fr, int fq) const {
        const int pn = u.pn; const int rowb = u.row0 + wr * 64 + fr; const int cl = wc * 32 + 8 * fq;
#pragma unroll
        for (int ai = 0; ai < 2; ++ai)
#pragma unroll
            for (int m = 0; m < 4; ++m) {
                const size_t row = (size_t)(rowb + ai * 128 + m * 16);
                if (pn < 4) {
#pragma unroll
                    for (int bj = 0; bj < 2; ++bj) *(u32x4*)(Bc + row * CW + pn * 256 + bj * 128 + cl) = pack8(acc[ai][bj][m][0], acc[ai][bj][m][1]);
                } else if (pn < 12) {
                    *(u32x4*)(P + row * CW + (pn - 4) * 128 + cl) = pack8(acc[ai][0][m][0] * acc[ai][1][m][0], acc[ai][0][m][1] * acc[ai][1][m][1]);
                } else if (pn < 20) {
                    bf16_t* O = (pn < 16) ? (U + row * SW + (pn - 12) * 256) : (V + row * SW + (pn - 16) * 256);
                    float ssum = 0.f, ssq = 0.f;
#pragma unroll
                    for (int bj = 0; bj < 2; ++bj) { f32x4 a = acc[ai][bj][m][0], b = acc[ai][bj][m][1];
#pragma unroll
                        for (int j = 0; j < 4; ++j) { a[j] = gelu_tanh(a[j]); b[j] = gelu_tanh(b[j]); ssum += a[j] + b[j]; ssq += a[j] * a[j] + b[j] * b[j]; }
                        *(u32x4*)(O + bj * 128 + cl) = pack8(a, b); }
                    if (pn >= 16) {
                        ssum += __shfl_xor(ssum, 16); ssum += __shfl_xor(ssum, 32); ssq += __shfl_xor(ssq, 16); ssq += __shfl_xor(ssq, 32);
                        if (fq == 0) VST[row * 16 + (pn - 16) * 4 + wc] = (f32x2){ssum, ssq}; }
                } else {
                    f32x4 r0, r1, s0, s1;
#pragma unroll
                    for (int j = 0; j < 4; ++j) {
                        const float ec0 = fast_exp2(-1.44269504f * acc[ai][0][m][0][j]), es0 = fast_exp2(-1.44269504f * acc[ai][1][m][0][j]);
                        const float ec1 = fast_exp2(-1.44269504f * acc[ai][0][m][1][j]), es1 = fast_exp2(-1.44269504f * acc[ai][1][m][1][j]);
                        r0[j] = (1.0f + es0) * fast_rcp(1.0f + ec0); s0[j] = fast_rcp(1.0f + es0);
                        r1[j] = (1.0f + es1) * fast_rcp(1.0f + ec1); s1[j] = fast_rcp(1.0f + es1);
                    }
                    const size_t o = row * D + (pn - 20) * 128 + cl;
                    *(u32x4*)(R + o) = pack8(r0, r1); *(u32x4*)(S + o) = pack8(s0, s1);
                }
            }
    }
};
struct EpiUp {
    static constexpr bool PERM = true; static constexpr int MIDK = 1024;
    const bf16_t *R, *S; bf16_t* Mm;
    __device__ __forceinline__ void mid(Acc& acc, const Unit& u, int wr, int wc, int fr, int fq) const {
        int rowb = u.row0 + wr * 64 + fr; const int cb = u.pn * 256 + wc * 32 + 8 * fq;
        asm volatile("" : "+v"(rowb));
#pragma unroll
        for (int ai = 0; ai < 2; ++ai)
#pragma unroll
            for (int m = 0; m < 4; ++m)
#pragma unroll
                for (int bj = 0; bj < 2; ++bj) { f32x4 a, b; unpack8(*(const u32x4*)(R + (size_t)(rowb + ai * 128 + m * 16) * D + cb + bj * 128), a, b);
                    acc[ai][bj][m][0] *= a; acc[ai][bj][m][1] *= b; }
    }
    __device__ __forceinline__ void operator()(const Acc& acc, const Unit& u, int wr, int wc, int fr, int fq) const {
        const int rowb = u.row0 + wr * 64 + fr; const int cb = u.pn * 256 + wc * 32 + 8 * fq;
#pragma unroll
        for (int ai = 0; ai < 2; ++ai)
#pragma unroll
            for (int m = 0; m < 4; ++m)
#pragma unroll
                for (int bj = 0; bj < 2; ++bj) { const size_t o = (size_t)(rowb + ai * 128 + m * 16) * D + cb + bj * 128; f32x4 a, b; unpack8(*(const u32x4*)(S + o), a, b);
                    *(u32x4*)(Mm + o) = pack8(acc[ai][bj][m][0] * a, acc[ai][bj][m][1] * b); }
    }
};
struct EpiOut {
    static constexpr bool PERM = true; static constexpr int MIDK = 0;
    const float* x; bf16_t* A2;
    __device__ __forceinline__ void mid(Acc&, const Unit&, int, int, int, int) const {}
    __device__ __forceinline__ void operator()(const Acc& acc, const Unit& u, int wr, int wc, int fr, int fq) const {
        const int rowb = u.row0 + wr * 64 + fr; const int cb = u.pn * 256 + wc * 32 + 8 * fq;
#pragma unroll
        for (int ai = 0; ai < 2; ++ai)
#pragma unroll
            for (int m = 0; m < 4; ++m)
#pragma unroll
                for (int bj = 0; bj < 2; ++bj) { const size_t o = (size_t)(rowb + ai * 128 + m * 16) * D + cb + bj * 128;
                    const f32x4 h0 = *(const f32x4*)(x + o) + acc[ai][bj][m][0], h1 = *(const f32x4*)(x + o + 4) + acc[ai][bj][m][1];
                    *(u32x4*)(A2 + o) = pack8(h0, h1); }
    }
};
struct EpiMoe1 {
    static constexpr bool PERM = true; static constexpr int MIDK = 0;
    const int* ent; const float* lw; const float* rstd; bf16_t* Hid; bool wt;
    __device__ __forceinline__ void mid(Acc&, const Unit&, int, int, int, int) const {}
    __device__ __forceinline__ void operator()(const Acc& acc, const Unit& u, int wr, int wc, int fr, int fq) const {
        const int cl = u.pn * 128 + wc * 32 + 8 * fq;
#pragma unroll
        for (int ai = 0; ai < 2; ++ai)
#pragma unroll
            for (int m = 0; m < 4; ++m) {
                const int r = ai * 128 + wr * 64 + m * 16 + fr;
                if (r < u.nvalid) {
                    const int li = u.e * T + u.pm * 256 + r; const int tok = ent[li] & 0xffff; const float rs = rstd[tok], w = lw[li];
                    f32x4 o[2];
#pragma unroll
                    for (int n = 0; n < 2; ++n)
#pragma unroll
                        for (int j = 0; j < 4; ++j) { const float gt = acc[ai][0][m][n][j] * rs, up = acc[ai][1][m][n][j] * rs; o[n][j] = gt * sigmoid_f(gt) * up * w; }
                    bf16_t* dst = Hid + (size_t)(u.row0 + r) * DE + cl; if (wt) st16_wt(dst, pack8(o[0], o[1])); else *(u32x4*)dst = pack8(o[0], o[1]);
                }
            }
    }
};
struct EpiMoe2 {
    static constexpr bool PERM = true; static constexpr int MIDK = 0;
    const int* ent; bf16_t* Yk0; bf16_t* Yk1;
    __device__ __forceinline__ void mid(Acc&, const Unit&, int, int, int, int) const {}
    __device__ __forceinline__ void operator()(const Acc& acc, const Unit& u, int wr, int wc, int fr, int fq) const {
        const int cb = u.pn * 256 + wc * 32 + 8 * fq;
#pragma unroll
        for (int ai = 0; ai < 2; ++ai)
#pragma unroll
            for (int m = 0; m < 4; ++m) {
                const int r = ai * 128 + wr * 64 + m * 16 + fr;
                if (r < u.nvalid) {
                    const int en = ent[u.e * T + u.pm * 256 + r]; const int tok = en & 0xffff; bf16_t* Y = (en >> 16) ? Yk1 : Yk0;
#pragma unroll
                    for (int bj = 0; bj < 2; ++bj) *(u32x4*)(Y + (size_t)tok * D + cb + bj * 128) = pack8(acc[ai][bj][m][0], acc[ai][bj][m][1]);
                }
            }
    }
};

template <class Epi, class Sched>
__device__ __forceinline__ void gemm_simple(const Sched& S, const Epi& E, const int K) {
    const int tid = opaque_tid(), wid = __builtin_amdgcn_readfirstlane(tid >> 6), lane = tid & 63, wr = wid >> 2, wc = wid & 3, fr = lane & 15, fq = lane >> 4;
    Unit u;
    for (int ui = 0; S.next(ui, u); ++ui) {
        Acc acc;
#pragma unroll
        for (int a = 0; a < 2; ++a)
#pragma unroll
            for (int b = 0; b < 2; ++b)
#pragma unroll
                for (int m = 0; m < 4; ++m)
#pragma unroll
                    for (int n = 0; n < 2; ++n) acc[a][b][m][n] = (f32x4){0.f, 0.f, 0.f, 0.f};
        S.a_ready(u);
        const char* ab = S.a_base(); const char* bb = S.b_base(u);
        unsigned aoff[2][4], boff[2][2];
#pragma unroll
        for (int ai = 0; ai < 2; ++ai)
#pragma unroll
            for (int m = 0; m < 4; ++m) aoff[ai][m] = S.a_off(u, ai * 128 + wr * 64 + m * 16 + fr) + fq * 16;
#pragma unroll
        for (int bj = 0; bj < 2; ++bj)
#pragma unroll
            for (int n = 0; n < 2; ++n) { const int rr = Epi::PERM ? perm32(n * 16 + fr) : (n * 16 + fr); boff[bj][n] = (unsigned)(bj * 128 + wc * 32 + rr) * (unsigned)K * 2u + fq * 16; }
        for (int k0 = 0; k0 < K; k0 += 32) {
            if (Epi::MIDK != 0 && k0 == Epi::MIDK) E.mid(acc, u, wr, wc, fr, fq);
            bf16x8 a[2][4], b[2][2];
#pragma unroll
            for (int ai = 0; ai < 2; ++ai)
#pragma unroll
                for (int m = 0; m < 4; ++m) a[ai][m] = *(const bf16x8*)(ab + aoff[ai][m] + k0 * 2);
#pragma unroll
            for (int bj = 0; bj < 2; ++bj)
#pragma unroll
                for (int n = 0; n < 2; ++n) b[bj][n] = *(const bf16x8*)(bb + boff[bj][n] + k0 * 2);
#pragma unroll
            for (int ai = 0; ai < 2; ++ai)
#pragma unroll
                for (int bj = 0; bj < 2; ++bj)
#pragma unroll
                    for (int m = 0; m < 4; ++m)
#pragma unroll
                        for (int n = 0; n < 2; ++n) acc[ai][bj][m][n] = __builtin_amdgcn_mfma_f32_16x16x32_bf16(b[bj][n], a[ai][m], acc[ai][bj][m][n], 0, 0, 0);
        }
        E(acc, u, wr, wc, fr, fq); S.done(u);
    }
}

constexpr int BK = 64, HALF = 128, HTB = HALF * BK * 2, STAGE_BYTES = 8 * HTB;
__host__ __device__ __forceinline__ int lds_byte(int r, int c) { const int st = (r >> 4) * 2 + (c >> 5), rr = r & 15, cc = c & 31, ob = rr * 64 + cc * 2; return st * 1024 + (ob ^ (((ob >> 9) & 1) << 5)); }
__host__ __device__ __forceinline__ void stage_rc(int b, int& R, int& C) { const int st = b / 1024, sb = b % 1024, swz = sb ^ (((sb >> 9) & 1) << 5); R = (st >> 1) * 16 + swz / 64; C = (st & 1) * 32 + (swz % 64) / 2; }

template <class Epi, class Sched>
__device__ __forceinline__ void gemm_fast(LAS unsigned char* lds, const Sched& S, const Epi& E, const int K) {
    const int tid = opaque_tid(), wid = __builtin_amdgcn_readfirstlane(tid >> 6), lane = tid & 63, wr = wid >> 2, wc = wid & 3, fr = lane & 15, fq = lane >> 4;
    const int nt = K / BK;
    int sR[2], sC[2]; unsigned voffB[2];
#pragma unroll
    for (int i = 0; i < 2; ++i) { stage_rc(tid * 16 + i * 8192, sR[i], sC[i]); const int Rb = Epi::PERM ? ((sR[i] & ~31) + perm32(sR[i] & 31)) : sR[i]; voffB[i] = (unsigned)(Rb * K + sC[i]) * 2u; }
    const size_t kstep = (size_t)(BK * 2);
    const size_t hstepB = (size_t)HALF * K * 2;
    const unsigned ldsw = (unsigned)wid * 1024u;
    const int aoff = lds_byte(wr * 64 + fr, fq * 8), boff = lds_byte(wc * 32 + fr, fq * 8);
#define PG8_SA(b, h) (((b) * 2 + (h)) * HTB)
#define PG8_SB(b, h) ((4 + (b) * 2 + (h)) * HTB)
#define PG8_STAGE(bufoff, gbase, voff) do { _Pragma("unroll") for (int _i = 0; _i < 2; ++_i) \
        __builtin_amdgcn_global_load_lds((const unsigned*)((const char*)(gbase) + (voff)[_i]), (LAS unsigned*)(lds + (bufoff) + ldsw + _i * 8192), 16, 0, 0); } while (0)
#define PG8_LDA(dst, b, h) do { _Pragma("unroll") for (int m = 0; m < 4; ++m) _Pragma("unroll") for (int k = 0; k < 2; ++k) dst[m][k] = *(const LAS bf16x8*)(lds + PG8_SA(b, h) + aoff + m * 2048 + k * 1024); } while (0)
#define PG8_LDB(dst, b, h) do { _Pragma("unroll") for (int n = 0; n < 2; ++n) _Pragma("unroll") for (int k = 0; k < 2; ++k) dst[n][k] = *(const LAS bf16x8*)(lds + PG8_SB(b, h) + boff + n * 2048 + k * 1024); } while (0)
#define PG8_MMA(ai, bj, At, Bt) do { __builtin_amdgcn_s_setprio(1); _Pragma("unroll") for (int m = 0; m < 4; ++m) _Pragma("unroll") for (int n = 0; n < 2; ++n) _Pragma("unroll") for (int k = 0; k < 2; ++k) \
        acc[ai][bj][m][n] = __builtin_amdgcn_mfma_f32_16x16x32_bf16(Bt[n][k], At[m][k], acc[ai][bj][m][n], 0, 0, 0); __builtin_amdgcn_s_setprio(0); } while (0)
#define PG8_WAIT_V(n) asm volatile("s_waitcnt vmcnt(" #n ")" ::: "memory")
#define PG8_WAIT_L(n) asm volatile("s_waitcnt lgkmcnt(" #n ")" ::: "memory")
#define PG8_BAR __builtin_amdgcn_s_barrier()
#define PG8_SCHED __builtin_amdgcn_sched_barrier(0)
    Unit cur, nxt; int ui = 0;
    if (!S.next(0, cur)) return;
    Acc acc;
#pragma unroll
    for (int a = 0; a < 2; ++a)
#pragma unroll
        for (int b = 0; b < 2; ++b)
#pragma unroll
            for (int m = 0; m < 4; ++m)
#pragma unroll
                for (int n = 0; n < 2; ++n) acc[a][b][m][n] = (f32x4){0.f, 0.f, 0.f, 0.f};
    bf16x8 At[4][2], B0[2][2], B1[2][2];
    unsigned va[2][2], vn[2][2];
#pragma unroll
    for (int h = 0; h < 2; ++h)
#pragma unroll
        for (int i = 0; i < 2; ++i) va[h][i] = S.a_off(cur, h * 128 + sR[i]) + (unsigned)sC[i] * 2u;
    const char* const A0 = S.a_base(); const char* cB = S.b_base(cur);
    S.a_ready(cur);
    PG8_STAGE(PG8_SB(0, 0), cB, voffB); PG8_STAGE(PG8_SB(0, 1), cB + hstepB, voffB); PG8_STAGE(PG8_SA(0, 0), A0, va[0]); PG8_STAGE(PG8_SA(0, 1), A0, va[1]);
    if (wr == 1) PG8_BAR;
    PG8_WAIT_V(2); PG8_BAR;
    PG8_STAGE(PG8_SB(1, 0), cB + kstep, voffB); PG8_STAGE(PG8_SA(1, 0), A0 + kstep, va[0]); PG8_STAGE(PG8_SB(1, 1), cB + hstepB + kstep, voffB);
    PG8_WAIT_V(6); PG8_BAR;
    for (;;) {
        const bool has_next = S.next(ui + 1, nxt);
        const char* nB = has_next ? S.b_base(nxt) : cB;
#pragma unroll
        for (int h = 0; h < 2; ++h)
#pragma unroll
            for (int i = 0; i < 2; ++i) vn[h][i] = has_next ? (S.a_off(nxt, h * 128 + sR[i]) + (unsigned)sC[i] * 2u) : va[h][i];
        for (int t = 0; t < nt; t += 2) {
            const bool last = (t == nt - 2);
            if (Epi::MIDK != 0 && t * BK == Epi::MIDK) { PG8_SCHED; E.mid(acc, cur, wr, wc, fr, fq); PG8_SCHED; }
            if (last && has_next) S.a_ready(nxt);
            const char* a1 = A0 + (size_t)(t + 1) * kstep;
            const char* a2 = last ? A0 : A0 + (size_t)(t + 2) * kstep; const char* b2 = last ? nB : cB + (size_t)(t + 2) * kstep;
            const char* a3 = a2 + kstep; const char* b3 = b2 + kstep;
            unsigned v2[2][2];
#pragma unroll
            for (int h = 0; h < 2; ++h)
#pragma unroll
                for (int i = 0; i < 2; ++i) v2[h][i] = last ? vn[h][i] : va[h][i];
            const bool full = !Sched::DYN_HALF || cur.nvalid > 128;
            PG8_LDB(B0, 0, 0); PG8_LDB(B1, 0, 1); PG8_SCHED; PG8_LDA(At, 0, 0); PG8_STAGE(PG8_SA(1, 1), a1, va[1]);
            PG8_WAIT_V(8); PG8_WAIT_L(0); PG8_BAR; PG8_MMA(0, 0, At, B0); PG8_MMA(0, 1, At, B1); PG8_BAR; PG8_SCHED;
            if (full) { PG8_LDA(At, 0, 1); } PG8_STAGE(PG8_SB(0, 0), b2, voffB); PG8_STAGE(PG8_SB(0, 1), b2 + hstepB, voffB); PG8_STAGE(PG8_SA(0, 0), a2, v2[0]);
            PG8_WAIT_V(8); PG8_WAIT_L(0); PG8_BAR; if (full) { PG8_MMA(1, 0, At, B0); PG8_MMA(1, 1, At, B1); } PG8_BAR; PG8_SCHED;
            PG8_LDB(B0, 1, 0); PG8_LDB(B1, 1, 1); PG8_SCHED; PG8_LDA(At, 1, 0); PG8_STAGE(PG8_SA(0, 1), a2, v2[1]);
            PG8_WAIT_V(8); PG8_WAIT_L(0); PG8_BAR; PG8_MMA(0, 0, At, B0); PG8_MMA(0, 1, At, B1); PG8_BAR; PG8_SCHED;
            if (full) { PG8_LDA(At, 1, 1); } PG8_STAGE(PG8_SB(1, 0), b3, voffB); PG8_STAGE(PG8_SB(1, 1), b3 + hstepB, voffB); PG8_STAGE(PG8_SA(1, 0), a3, v2[0]);
            PG8_WAIT_V(8); PG8_WAIT_L(0); PG8_BAR; if (full) { PG8_MMA(1, 0, At, B0); PG8_MMA(1, 1, At, B1); } PG8_BAR; PG8_SCHED;
        }
        if (wr == 0) PG8_BAR;
        E(acc, cur, wr, wc, fr, fq); S.done(cur);
        if (!has_next) break;
#pragma unroll
        for (int a = 0; a < 2; ++a)
#pragma unroll
            for (int b = 0; b < 2; ++b)
#pragma unroll
                for (int m = 0; m < 4; ++m)
#pragma unroll
                    for (int n = 0; n < 2; ++n) acc[a][b][m][n] = (f32x4){0.f, 0.f, 0.f, 0.f};
        cur = nxt; cB = nB; ++ui;
#pragma unroll
        for (int h = 0; h < 2; ++h)
#pragma unroll
            for (int i = 0; i < 2; ++i) va[h][i] = vn[h][i];
        if (wr == 1) PG8_BAR;
    }
    PG8_WAIT_V(0);
    PG8_BAR;
#undef PG8_SA
#undef PG8_SB
#undef PG8_STAGE
#undef PG8_LDA
#undef PG8_LDB
#undef PG8_MMA
#undef PG8_WAIT_V
#undef PG8_WAIT_L
#undef PG8_BAR
#undef PG8_SCHED
}
#ifndef FAST_MASK
#define FAST_MASK 0x1f
#endif
template <int BIT, class Epi, class Sched>
__device__ __forceinline__ void gemm_run(LAS unsigned char* lds, const Sched& S, const Epi& E, const int K) {
    if constexpr ((FAST_MASK >> BIT) & 1) gemm_fast(lds, S, E, K); else gemm_simple(S, E, K);
}

__device__ __forceinline__ void tr_item64(const float* W, int N, int k0, int ns, bf16_t* WT, int ldk, int nd, int kd, LAS float* scr, int lane, const float* kscale) {
    { const int r4 = lane >> 4, c4 = (lane & 15) * 4; f32x4 v[16];
#pragma unroll
      for (int i = 0; i < 16; ++i) v[i] = __builtin_nontemporal_load((const f32x4*)(W + (size_t)(k0 + 4 * i + r4) * N + ns + c4));
#pragma unroll
      for (int i = 0; i < 16; ++i) { LAS float* d = scr + (4 * i + r4) * 65 + c4; d[0] = v[i][0]; d[1] = v[i][1]; d[2] = v[i][2]; d[3] = v[i][3]; } }
    const int c = lane & 7;
    f32x4 s0 = (f32x4){1.f, 1.f, 1.f, 1.f}, s1 = s0;
    if (kscale) { s0 = *(const f32x4*)(kscale + k0 + 8 * c); s1 = *(const f32x4*)(kscale + k0 + 8 * c + 4); }
    asm volatile("s_waitcnt lgkmcnt(0)" ::: "memory");
#pragma unroll
    for (int j = 0; j < 8; ++j) { const int n = (lane >> 3) + 8 * j; const LAS float* s = scr + (8 * c) * 65 + n;
        u32x4 o; o.x = cvt_pk_bf16(s[0 * 65] * s0[0], s[1 * 65] * s0[1]); o.y = cvt_pk_bf16(s[2 * 65] * s0[2], s[3 * 65] * s0[3]);
        o.z = cvt_pk_bf16(s[4 * 65] * s1[0], s[5 * 65] * s1[1]); o.w = cvt_pk_bf16(s[6 * 65] * s1[2], s[7 * 65] * s1[3]);
        *(u32x4*)(WT + (size_t)(nd + n) * ldk + kd + 8 * c) = o; }
    asm volatile("s_waitcnt lgkmcnt(0)" ::: "memory");
}
constexpr int TRS = 64 * 65 * 4;
static_assert(8 * TRS <= LDS_BYTES - 64, "transpose scratch vs barrier words");
struct TrItem { const float* W; int N; bf16_t* WT; int ldk, nd, kd, k0, ns; const float* ks; };
__device__ __forceinline__ void tr_load(f32x4 (&v)[16], const TrItem& it, int lane) {
    const int r4 = lane >> 4, c4 = (lane & 15) * 4;
#pragma unroll
    for (int i = 0; i < 16; ++i) v[i] = __builtin_nontemporal_load((const f32x4*)(it.W + (size_t)(it.k0 + 4 * i + r4) * it.N + it.ns + c4));
}
__device__ __forceinline__ void tr_store(const f32x4 (&v)[16], const TrItem& it, LAS float* scr, int lane) {
    { const int r4 = lane >> 4, c4 = (lane & 15) * 4;
#pragma unroll
      for (int i = 0; i < 16; ++i) { LAS float* d = scr + (4 * i + r4) * 65 + c4; d[0] = v[i][0]; d[1] = v[i][1]; d[2] = v[i][2]; d[3] = v[i][3]; } }
    const int c = lane & 7;
    f32x4 s0 = (f32x4){1.f, 1.f, 1.f, 1.f}, s1 = s0;
    if (it.ks) { s0 = *(const f32x4*)(it.ks + it.k0 + 8 * c); s1 = *(const f32x4*)(it.ks + it.k0 + 8 * c + 4); }
    asm volatile("s_waitcnt lgkmcnt(0)" ::: "memory");
#pragma unroll
    for (int j = 0; j < 8; ++j) { const int n = (lane >> 3) + 8 * j; const LAS float* s = scr + (8 * c) * 65 + n;
        u32x4 o; o.x = cvt_pk_bf16(s[0 * 65] * s0[0], s[1 * 65] * s0[1]); o.y = cvt_pk_bf16(s[2 * 65] * s0[2], s[3 * 65] * s0[3]);
        o.z = cvt_pk_bf16(s[4 * 65] * s1[0], s[5 * 65] * s1[1]); o.w = cvt_pk_bf16(s[6 * 65] * s1[2], s[7 * 65] * s1[3]);
        __builtin_nontemporal_store(o, (u32x4*)(it.WT + (size_t)(it.nd + n) * it.ldk + it.kd + 8 * c)); }
    asm volatile("s_waitcnt lgkmcnt(0)" ::: "memory");
}
constexpr int NIT_EXP = 8192 + 4096;
__device__ __forceinline__ TrItem exp_item(const Params& p, int r) {
    TrItem it;
    if (r < 8192) { const int up = r >> 12, qq = r & 4095, e = qq >> 8, kb = (qq & 255) >> 3, nb = qq & 7;
        it.W = p.in[up ? 17 : 16] + (size_t)e * D * DE; it.N = DE; it.WT = (bf16_t*)(p.ws + WS_W1T) + (size_t)e * 1024 * D; it.ldk = D;
        it.nd = 256 * (nb >> 1) + (nb & 1) * 64 + (up ? 128 : 0); it.kd = kb * 64; it.k0 = kb * 64; it.ns = nb * 64; it.ks = p.in[11]; }
    else { const int q = r - 8192, e = q >> 8, kb = (q & 255) >> 5, nb = q & 31;
        it.W = p.in[18] + (size_t)e * DE * D; it.N = D; it.WT = (bf16_t*)(p.ws + WS_W2T) + (size_t)e * D * DE; it.ldk = DE; it.nd = nb * 64; it.kd = kb * 64; it.k0 = kb * 64; it.ns = nb * 64; it.ks = nullptr; }
    return it;
}
__device__ __forceinline__ void convert_tail(const Params& p, LAS unsigned char* lds, int nunits) {
    const int tid = opaque_tid(), wave = __builtin_amdgcn_readfirstlane(tid >> 6), lane = tid & 63;
    const int G = gridDim.x, rounds = (nunits + G - 1) / G, nfull = nunits - (rounds - 1) * G;
    int idle_idx, n_idle;
    if (nfull >= G || nunits == 0) { idle_idx = blockIdx.x; n_idle = G; } else { idle_idx = (int)blockIdx.x - nfull; n_idle = G - nfull; }
    if (idle_idx < 0) return;
    LAS float* scr = (LAS float*)(lds + wave * TRS);
    const int stride = n_idle * NWAVES; int r = idle_idx * NWAVES + wave;
    if (r >= NIT_EXP) return;
    f32x4 va[16], vb[16];
    TrItem ia = exp_item(p, r), ib = ia;
    tr_load(va, ia, lane);
    for (;;) {
        const bool hb = (r + stride) < NIT_EXP;
        if (hb) { ib = exp_item(p, r + stride); tr_load(vb, ib, lane); }
        tr_store(va, ia, scr, lane);
        if (!hb) break;
        r += stride;
        const bool ha = (r + stride) < NIT_EXP;
        if (ha) { ia = exp_item(p, r + stride); tr_load(va, ia, lane); }
        tr_store(vb, ib, scr, lane);
        if (!ha) break;
        r += stride;
    }
}
__device__ __forceinline__ int win_src_col(int nd) {
    if (nd < 1024) return nd;
    if (nd < 3072) { const int q = (nd - 1024) >> 8, r = (nd - 1024) & 255; return r < 128 ? (1024 + 128 * q + r) : (2048 + 128 * q + r - 128); }
    if (nd < 5120) return nd;
    { const int q = (nd - 5120) >> 8, r = (nd - 5120) & 255; return r < 128 ? (5120 + 128 * q + r) : (7168 + 128 * q + r - 128); }
}
__device__ __forceinline__ void phase0(const Params& p, LAS unsigned char* lds) {
    const int tid = opaque_tid(), wave = __builtin_amdgcn_readfirstlane(tid >> 6), lane = tid & 63;
    LAS float* scr = (LAS float*)(lds + wave * TRS);
    const int gw = blockIdx.x * NWAVES + wave, NGW = gridDim.x * NWAVES;
    unsigned char* ws = p.ws;
    constexpr int I_IN = 32 * 144, I_UP = 16 * 32, I_OUT = 32 * 32;
    constexpr int NITEMS = I_IN + 2 * I_UP + I_OUT;
    for (int it = gw; it < NITEMS; it += NGW) {
        int r = it;
        if (r < I_IN) { const int kb = r / 144, nb = r % 144; tr_item64(p.in[2], NIN, kb * 64, win_src_col(nb * 64), (bf16_t*)(ws + WS_WINT), D, nb * 64, kb * 64, scr, lane, nullptr); continue; } r -= I_IN;
        if (r < I_UP) { const int kb = r / 32, nb = r % 32; tr_item64(p.in[8], D, kb * 64, nb * 64, (bf16_t*)(ws + WS_WUPT), 2048, nb * 64, kb * 64, scr, lane, nullptr); continue; } r -= I_UP;
        if (r < I_UP) { const int kb = r / 32, nb = r % 32; tr_item64(p.in[9], D, kb * 64, nb * 64, (bf16_t*)(ws + WS_WUPT), 2048, nb * 64, 1024 + kb * 64, scr, lane, nullptr); continue; } r -= I_UP;
        { const int kb = r / 32, nb = r % 32; tr_item64(p.in[10], D, kb * 64, nb * 64, (bf16_t*)(ws + WS_WOUTT), D, nb * 64, kb * 64, scr, lane, nullptr); }
    }
    const float* x = p.in[0]; const float* g = p.in[1]; bf16_t* xn = (bf16_t*)(ws + WS_X);
    for (int m = gw; m < T; m += NGW) {
        const f32x4* xr = (const f32x4*)(x + (size_t)m * D) + lane; f32x4 v[8]; float s = 0.f;
#pragma unroll
        for (int j = 0; j < 8; ++j) { v[j] = __builtin_nontemporal_load(xr + 64 * j); s += (v[j][0] * v[j][0] + v[j][1] * v[j][1]) + (v[j][2] * v[j][2] + v[j][3] * v[j][3]); }
        const float rs = 1.0f / sqrtf(wave_sum(s) * (1.0f / D) + EPS);
        u32x2* o = (u32x2*)(xn + (size_t)m * D) + lane;
#pragma unroll
        for (int j = 0; j < 8; ++j) { const f32x4 gg = *((const f32x4*)g + lane + 64 * j); u32x2 w; w.x = cvt_pk_bf16(v[j][0] * rs * gg[0], v[j][1] * rs * gg[1]); w.y = cvt_pk_bf16(v[j][2] * rs * gg[2], v[j][3] * rs * gg[3]); o[64 * j] = w; }
    }
    { bf16_t* wr = (bf16_t*)(ws + WS_WR); const float* gf = p.in[11];
      for (int i = blockIdx.x * NTHREADS + tid; i < 32 * D; i += gridDim.x * NTHREADS) { const int j = i / D, d = i % D; unsigned hi = 0, lo = 0;
          if (j < 20) { const float v = gf[d] * (j < 4 ? p.in[12][d * 4 + j] : p.in[14][d * 16 + (j - 4)]); hi = cvt_pk_bf16(v, 0.f) & 0xffffu; lo = cvt_pk_bf16(v - __uint_as_float(hi << 16), 0.f) & 0xffffu; }
          wr[(size_t)j * D + d] = (bf16_t)hi; wr[(size_t)(32 + j) * D + d] = (bf16_t)lo; } }
    { bf16_t* wmb = (bf16_t*)(ws + WS_WMB); const float* wsrc = p.in[6];
      for (int i = blockIdx.x * NTHREADS + tid; i < 8 * 128 * 128 / 2; i += gridDim.x * NTHREADS) { const int e0 = 2 * i, r = (e0 >> 7) & 127, c = e0 & 127; const bool ok = (r >= 64) || (c < 64);
          ((unsigned*)wmb)[i] = ok ? cvt_pk_bf16(wsrc[e0], wsrc[e0 + 1]) : 0u; } }
    if (blockIdx.x == 0 && tid < 64) ((int*)(ws + WS_CTL))[tid] = 0;
}

__device__ __forceinline__ void phase2_conv(const Params& p) {
    const bf16_t* Bc = (const bf16_t*)(p.ws + WS_P + P_BC); const bf16_t* P = (const bf16_t*)(p.ws + WS_P + P_P); bf16_t* Y = (bf16_t*)(p.ws + WS_X);
    const float* cw = p.in[3];
    for (int i = blockIdx.x * NTHREADS + opaque_tid(); i < (T / 8) * (CW / 8); i += gridDim.x * NTHREADS) {
        const int t0 = (i >> 7) * 8, c = (i & 127) * 8;
        u32x4 pr[10], br[8];
#pragma unroll
        for (int r = 0; r < 10; ++r) { const int t = t0 - 2 + r; pr[r] = (t >= 0) ? *(const u32x4*)(P + (size_t)t * CW + c) : (u32x4){0u, 0u, 0u, 0u}; }
#pragma unroll
        for (int r = 0; r < 8; ++r) br[r] = *(const u32x4*)(Bc + (size_t)(t0 + r) * CW + c);
        const f32x4 w0a = *(const f32x4*)(cw + c), w0b = *(const f32x4*)(cw + c + 4), w1a = *(const f32x4*)(cw + CW + c), w1b = *(const f32x4*)(cw + CW + c + 4),
                    w2a = *(const f32x4*)(cw + 2 * CW + c), w2b = *(const f32x4*)(cw + 2 * CW + c + 4);
#pragma unroll
        for (int r = 0; r < 8; ++r) {
            f32x4 p0a, p0b, p1a, p1b, p2a, p2b, ba, bb;
            unpack8(pr[r], p0a, p0b); unpack8(pr[r + 1], p1a, p1b); unpack8(pr[r + 2], p2a, p2b); unpack8(br[r], ba, bb);
            const f32x4 ya = ba * (w0a * p0a + w1a * p1a + w2a * p2a), yb = bb * (w0b * p0b + w1b * p1b + w2b * p2b);
            *(u32x4*)(Y + (size_t)(t0 + r) * 2048 + c) = pack8(ya, yb);
        }
    }
}
__device__ __forceinline__ void phase2_sgu(const Params& p, LAS unsigned char* lds) {
    const int tid = opaque_tid(), wave = __builtin_amdgcn_readfirstlane(tid >> 6), lane = tid & 63, fr = lane & 15, fq = lane >> 4;
    const bf16_t* U = (const bf16_t*)(p.ws + WS_P + P_U); const bf16_t* V = (const bf16_t*)(p.ws + WS_P + P_V); bf16_t* Y = (bf16_t*)(p.ws + WS_X);
    const bf16_t* WmB = (const bf16_t*)(p.ws + WS_WMB); const f32x2* VST = (const f32x2*)(p.ws + WS_SMALL + SM_VST);
    const float* lng = p.in[4]; const float* lnb = p.in[5]; const float* bs = p.in[7];
    LAS f32x2* st = (LAS f32x2*)lds;
    constexpr int VP = 272, VTB = 128 * VP;
    LAS unsigned char* vT = lds + 2048;
    const int G = gridDim.x;
    for (int u0 = blockIdx.x; u0 < 64 * 8; u0 += 2 * G) {
        const int u1 = u0 + G; const bool two = u1 < 64 * 8;
        __syncthreads();
        if (tid < 256 && (tid < 128 || two)) { const int uu = (tid < 128) ? u0 : u1; const int tk = (uu >> 3) * 128 + (tid & 127);
            const f32x4* ps = (const f32x4*)(VST + (size_t)tk * 16); float s = 0.f, q = 0.f;
#pragma unroll
            for (int i = 0; i < 8; ++i) { const f32x4 v = ps[i]; s += v[0] + v[2]; q += v[1] + v[3]; }
            const float mu = s * (1.0f / SW); const float var = fmaxf(q * (1.0f / SW) - mu * mu, 0.f);
            st[tid] = (f32x2){mu, 1.0f / sqrtf(var + EPS)}; }
        const int su = tid >> 8, sl = tid & 255, jb = sl >> 4, cb = sl & 15, j0 = jb * 8, cc0 = cb * 8;
        const int uu = su ? u1 : u0; const bool act = (su == 0) || two;
        const int t0 = (uu >> 3) * 128, c0 = (uu & 7) * 128;
        u32x4 raw[8];
        if (act) {
#pragma unroll
            for (int r = 0; r < 8; ++r) raw[r] = *(const u32x4*)(V + (size_t)(t0 + j0 + r) * SW + c0 + cc0); }
        __syncthreads();
        if (act) {
            const f32x4 g0 = *(const f32x4*)(lng + c0 + cc0), g1 = *(const f32x4*)(lng + c0 + cc0 + 4), b0 = *(const f32x4*)(lnb + c0 + cc0), b1 = *(const f32x4*)(lnb + c0 + cc0 + 4);
            f32x4 lo[8], hi[8];
#pragma unroll
            for (int r = 0; r < 8; ++r) { const f32x2 s = st[su * 128 + j0 + r]; f32x4 a, b; unpack8(raw[r], a, b);
                lo[r] = (a - s.x) * s.y * g0 + b0; hi[r] = (b - s.x) * s.y * g1 + b1; }
            LAS unsigned char* vt = vT + su * VTB;
#pragma unroll
            for (int cc = 0; cc < 4; ++cc) { u32x4 o;
                o.x = cvt_pk_bf16(lo[0][cc], lo[1][cc]); o.y = cvt_pk_bf16(lo[2][cc], lo[3][cc]); o.z = cvt_pk_bf16(lo[4][cc], lo[5][cc]); o.w = cvt_pk_bf16(lo[6][cc], lo[7][cc]);
                *(LAS u32x4*)(vt + (cc0 + cc) * VP + j0 * 2) = o;
                o.x = cvt_pk_bf16(hi[0][cc], hi[1][cc]); o.y = cvt_pk_bf16(hi[2][cc], hi[3][cc]); o.z = cvt_pk_bf16(hi[4][cc], hi[5][cc]); o.w = cvt_pk_bf16(hi[6][cc], hi[7][cc]);
                *(LAS u32x4*)(vt + (cc0 + 4 + cc) * VP + j0 * 2) = o; }
        }
        __syncthreads();
#pragma unroll
        for (int s2 = 0; s2 < 2; ++s2) {
            if (s2 == 1 && !two) break;
            const int ux = s2 ? u1 : u0; const int h = ux & 7, tt0 = (ux >> 3) * 128, cc = h * 128;
            LAS unsigned char* vt = vT + s2 * VTB;
            bf16x8 wf[4];
#pragma unroll
            for (int ks = 0; ks < 4; ++ks) wf[ks] = *(const bf16x8*)(WmB + ((size_t)h * 128 + wave * 16 + fr) * 128 + ks * 32 + fq * 8);
            const int i = wave * 16 + fr; const float bb = bs[h * 128 + i]; const size_t t = (size_t)(tt0 + i);
            u32x2 uv[8];
#pragma unroll
            for (int nk = 0; nk < 8; ++nk) uv[nk] = *(const u32x2*)(U + t * SW + cc + nk * 16 + 4 * fq);
            f32x4 acc[8];
#pragma unroll
            for (int nk = 0; nk < 8; ++nk) { acc[nk] = (f32x4){0.f, 0.f, 0.f, 0.f};
#pragma unroll
                for (int ks = 0; ks < 4; ++ks) { const bf16x8 vf = *(const LAS bf16x8*)(vt + (nk * 16 + fr) * VP + (ks * 32 + fq * 8) * 2);
                    acc[nk] = __builtin_amdgcn_mfma_f32_16x16x32_bf16(vf, wf[ks], acc[nk], 0, 0, 0); } }
#pragma unroll
            for (int nk = 0; nk < 8; ++nk) { const int c = cc + nk * 16 + 4 * fq; const u32x2 u2 = uv[nk];
                u32x2 o; o.x = cvt_pk_bf16(bf_lo(u2.x) * (acc[nk][0] + bb), bf_hi(u2.x) * (acc[nk][1] + bb)); o.y = cvt_pk_bf16(bf_lo(u2.y) * (acc[nk][2] + bb), bf_hi(u2.y) * (acc[nk][3] + bb));
                *(u32x2*)(Y + t * 2048 + 1024 + c) = o; }
        }
    }
}

__device__ __forceinline__ void phase5_router(const Params& p, LAS unsigned char* lds) {
    const int tid = opaque_tid(), wave = __builtin_amdgcn_readfirstlane(tid >> 6), lane = tid & 63, fr = lane & 15, fq = lane >> 4;
    const bf16_t* A2 = (const bf16_t*)(p.ws + WS_A2); const bf16_t* wr = (const bf16_t*)(p.ws + WS_WR);
    float* rstd = (float*)(p.ws + WS_SMALL + SM_RSTD); int* ent = (int*)(p.ws + WS_SMALL + SM_ENT); float* lw = (float*)(p.ws + WS_SMALL + SM_W); int* cnt = (int*)(p.ws + WS_CTL);
    const float* brg = p.in[13]; const float* bre = p.in[15];
    LAS float* part = (LAS float*)lds;
    LAS float* pss  = (LAS float*)(lds + 65536);
    LAS float* lg   = (LAS float*)(lds + 65536 + 1024);
    LAS float* lss  = (LAS float*)(lds + 65536 + 1024 + 2560);
    LAS int* lcnt  = (LAS int*)(lds + 70000);
    LAS int* lbase = (LAS int*)(lds + 70000 + 64);
    LAS int* le    = (LAS int*)(lds + 70000 + 128);
    LAS int* lp    = (LAS int*)(lds + 70000 + 128 + 256);
    LAS float* lwt = (LAS float*)(lds + 70000 + 128 + 512);
    for (int tile = blockIdx.x; tile < T / 32; tile += gridDim.x) {
        const int tok0 = tile * 32;
        __syncthreads();
        if (tid < 16) lcnt[tid] = 0;
        f32x4 acc[2][4]; float ss[2] = {0.f, 0.f};
#pragma unroll
        for (int m = 0; m < 2; ++m)
#pragma unroll
            for (int n = 0; n < 4; ++n) acc[m][n] = (f32x4){0.f, 0.f, 0.f, 0.f};
#pragma unroll 2
        for (int ks = 0; ks < 8; ++ks) {
            const int k = wave * 256 + ks * 32 + fq * 8;
            bf16x8 af[2], bfr[4];
#pragma unroll
            for (int m = 0; m < 2; ++m) af[m] = *(const bf16x8*)(A2 + (size_t)(tok0 + 16 * m + fr) * D + k);
#pragma unroll
            for (int n = 0; n < 4; ++n) bfr[n] = *(const bf16x8*)(wr + (size_t)(16 * n + fr) * D + k);
#pragma unroll
            for (int m = 0; m < 2; ++m) {
#pragma unroll
                for (int j = 0; j < 8; ++j) { const float v = bf1((bf16_t)af[m][j]); ss[m] += v * v; }
#pragma unroll
                for (int n = 0; n < 4; ++n) acc[m][n] = __builtin_amdgcn_mfma_f32_16x16x32_bf16(bfr[n], af[m], acc[m][n], 0, 0, 0);
            }
        }
#pragma unroll
        for (int m = 0; m < 2; ++m) { ss[m] += __shfl_xor(ss[m], 16); ss[m] += __shfl_xor(ss[m], 32);
            if (fq == 0) pss[wave * 32 + 16 * m + fr] = ss[m];
#pragma unroll
            for (int n = 0; n < 4; ++n) *(LAS f32x4*)(part + (wave * 32 + 16 * m + fr) * 64 + 16 * n + 4 * fq) = acc[m][n]; }
        __syncthreads();
        for (int i = tid; i < 32 * 20; i += NTHREADS) { const int t = i / 20, j = i % 20; float s = 0.f;
#pragma unroll
            for (int w = 0; w < 8; ++w) s += part[(w * 32 + t) * 64 + j] + part[(w * 32 + t) * 64 + 32 + j];
            lg[t * 20 + j] = s; }
        if (tid < 32) { float s = 0.f;
#pragma unroll
            for (int w = 0; w < 8; ++w) s += pss[w * 32 + tid];
            lss[tid] = s; }
        __syncthreads();
        if (tid < 32) {
            const int t = tid; const float rs = 1.0f / sqrtf(lss[t] * (1.0f / D) + EPS);
            float g4[4];
#pragma unroll
            for (int j = 0; j < 4; ++j) g4[j] = lg[t * 20 + j] * rs + brg[j];
            int gi = 0; float gm = g4[0];
#pragma unroll
            for (int j = 1; j < 4; ++j) if (g4[j] > gm) { gm = g4[j]; gi = j; }
            float den = 0.f;
#pragma unroll
            for (int j = 0; j < 4; ++j) den += __expf(g4[j] - gm);
            const float pg = 1.0f / den;
            float le4[4];
#pragma unroll
            for (int j = 0; j < 4; ++j) le4[j] = lg[t * 20 + 4 + gi * 4 + j] * rs + bre[gi * 4 + j];
            int i1 = 0; float m1 = le4[0];
#pragma unroll
            for (int j = 1; j < 4; ++j) if (le4[j] > m1) { m1 = le4[j]; i1 = j; }
            int i2 = -1; float m2 = -3.0e38f;
#pragma unroll
            for (int j = 0; j < 4; ++j) if (j != i1 && le4[j] > m2) { m2 = le4[j]; i2 = j; }
            const float ex = __expf(m2 - m1); const float w1 = pg / (1.0f + ex), w2 = pg * ex / (1.0f + ex);
            rstd[tok0 + t] = rs;
            const int e1 = gi * 4 + i1, e2 = gi * 4 + i2;
            le[2 * t] = e1; le[2 * t + 1] = e2; lwt[2 * t] = w1; lwt[2 * t + 1] = w2;
            lp[2 * t] = atomicAdd((int*)&lcnt[e1], 1); lp[2 * t + 1] = atomicAdd((int*)&lcnt[e2], 1);
        }
        __syncthreads();
        if (tid < 16) { const int n = lcnt[tid]; lbase[tid] = n ? atomicAdd(&cnt[tid], n) : 0; }
        __syncthreads();
        if (tid < 64) { const int e = le[tid]; const int pos = lbase[e] + lp[tid]; ent[e * T + pos] = (tok0 + (tid >> 1)) | ((tid & 1) << 16); lw[e * T + pos] = lwt[tid]; }
    }
}

__device__ __forceinline__ void phase8_final(const Params& p) {
    const int tid = opaque_tid(), wave = __builtin_amdgcn_readfirstlane(tid >> 6), lane = tid & 63;
    const bf16_t* A2 = (const bf16_t*)(p.ws + WS_A2); const bf16_t* Y0 = (const bf16_t*)(p.ws + WS_YK0); const bf16_t* Y1 = (const bf16_t*)(p.ws + WS_YK1); const float* g = p.in[19];
    const int gw = blockIdx.x * NWAVES + wave, NGW = gridDim.x * NWAVES;
    for (int m = gw; m < T; m += NGW) {
        f32x4 v[8]; float s = 0.f;
#pragma unroll
        for (int j = 0; j < 8; ++j) { const size_t o = (size_t)m * D + 4 * lane + 256 * j;
            const u32x2 hh = *(const u32x2*)(A2 + o), a = *(const u32x2*)(Y0 + o), b = *(const u32x2*)(Y1 + o);
            v[j][0] = bf_lo(hh.x) + (bf_lo(a.x) + bf_lo(b.x)); v[j][1] = bf_hi(hh.x) + (bf_hi(a.x) + bf_hi(b.x)); v[j][2] = bf_lo(hh.y) + (bf_lo(a.y) + bf_lo(b.y)); v[j][3] = bf_hi(hh.y) + (bf_hi(a.y) + bf_hi(b.y));
            s += (v[j][0] * v[j][0] + v[j][1] * v[j][1]) + (v[j][2] * v[j][2] + v[j][3] * v[j][3]); }
        const float rs = 1.0f / sqrtf(wave_sum(s) * (1.0f / D) + EPS);
#pragma unroll
        for (int j = 0; j < 8; ++j) { const int c = 4 * lane + 256 * j; const f32x4 gg = *(const f32x4*)(g + c); __builtin_nontemporal_store(v[j] * rs * gg, (f32x4*)(p.out + (size_t)m * D + c)); }
    }
}

#define XB_TMO      128
#define XB_XCNT(j)  (256  + 64 * (j))
#define XB_XSUB(j)  (1280 + 64 * (j))
#define XB_XGEN(j)  (2304 + 64 * (j))
#define XB_TOP      3328
#define XB_TOPGEN   3392
#define XCD_BAR_WORDS 3456
#define XB_SPIN_CAP (1u << 18)
__device__ __forceinline__ unsigned xb_ld(unsigned* p)              { return __hip_atomic_load(p, __ATOMIC_RELAXED, __HIP_MEMORY_SCOPE_AGENT); }
__device__ __forceinline__ unsigned xb_add(unsigned* p, unsigned v) { return __hip_atomic_fetch_add(p, v, __ATOMIC_RELAXED, __HIP_MEMORY_SCOPE_AGENT); }
__device__ __forceinline__ unsigned xb_xcc_id() { return (unsigned)__builtin_amdgcn_s_getreg((3 << 11) | 20) & 0xFu; }
#define XB_SPIN(cond, bar) do { unsigned _sp = 0; while (cond) { __builtin_amdgcn_s_sleep(1); \
    if ((++_sp & 255u) == 0u) { if (xb_ld(&(bar)[XB_TMO])) break; if (_sp > XB_SPIN_CAP) { atomicAdd(&(bar)[XB_TMO], 1u); break; } } } } while (0)
struct XcdBarrier { unsigned* bar; unsigned x; volatile LAS unsigned* st; };
__device__ __forceinline__ XcdBarrier xcd_barrier_post(unsigned* bar, volatile LAS unsigned* st) {
    XcdBarrier b; b.bar = bar; b.x = xb_xcc_id(); b.st = st;
    if (threadIdx.x == 0) (void)xb_add(&bar[XB_XCNT(b.x)], 1u);
    return b;
}
__device__ __forceinline__ void xcd_barrier_complete(unsigned* bar, unsigned x, unsigned& nloc, unsigned& nx) {
    const unsigned G = gridDim.x * gridDim.y * gridDim.z;
    unsigned sum, cnt, mine, sp = 0u;
    for (;;) {
        sum = 0u; cnt = 0u; mine = 0u;
#pragma unroll
        for (unsigned j = 0; j < 16; ++j) { const unsigned c = xb_ld(&bar[XB_XCNT(j)]); sum += c; cnt += (c > 0u) ? 1u : 0u; mine = (j == x) ? c : mine; }
        if (sum == G) break;
        __builtin_amdgcn_s_sleep(1);
        if ((++sp & 255u) == 0u) { if (xb_ld(&bar[XB_TMO])) break; if (sp > XB_SPIN_CAP) { atomicAdd(&bar[XB_TMO], 1u); break; } }
    }
    nloc = mine > 0u ? mine : 1u; nx = cnt > 0u ? cnt : 1u;
}
__device__ __forceinline__ void xcd_barrier(const XcdBarrier& b) {
    asm volatile("s_waitcnt vmcnt(0)" ::: "memory");
    __syncthreads();
    if (threadIdx.x == 0) {
        unsigned* bar = b.bar;
        __builtin_amdgcn_s_waitcnt(0);
        unsigned nloc = b.st[0], nx = b.st[1];
        if (nloc == 0u) { xcd_barrier_complete(bar, b.x, nloc, nx); b.st[0] = nloc; b.st[1] = nx; }
        const unsigned old = xb_add(&bar[XB_XSUB(b.x)], 1u);
        const unsigned gen = old / nloc;
        if (old + 1u == (gen + 1u) * nloc) {
            __builtin_amdgcn_fence(__ATOMIC_RELEASE, "agent");
            asm volatile("s_waitcnt vmcnt(0)" ::: "memory");
            const unsigned og = xb_add(&bar[XB_TOP], 1u);
            const unsigned tg = og / nx;
            if (og + 1u == (tg + 1u) * nx) xb_add(&bar[XB_TOPGEN], 1u);
            else XB_SPIN(xb_ld(&bar[XB_TOPGEN]) == tg, bar);
            __builtin_amdgcn_fence(__ATOMIC_ACQUIRE, "agent");
            xb_add(&bar[XB_XGEN(b.x)], 1u);
            asm volatile("s_waitcnt vmcnt(0)" ::: "memory");
        } else {
            XB_SPIN(xb_ld(&bar[XB_XGEN(b.x)]) == gen, bar);
            __builtin_amdgcn_fence(__ATOMIC_ACQUIRE, "agent");
            asm volatile("s_waitcnt vmcnt(0)" ::: "memory");
        }
    }
    __syncthreads();
}

template <int PH> __device__ __forceinline__ void run_phase(const Params& p, LAS unsigned char* lds) {
    unsigned char* ws = p.ws;
    if constexpr (PH == 0) phase0(p, lds);
    if constexpr (PH == 1) { DenseSched S; S.init((const bf16_t*)(ws + WS_X), (const bf16_t*)(ws + WS_WINT), T, NIN, D);
        EpiProj E{(bf16_t*)(ws + WS_P + P_BC), (bf16_t*)(ws + WS_P + P_P), (bf16_t*)(ws + WS_P + P_U), (bf16_t*)(ws + WS_P + P_V), (bf16_t*)(ws + WS_P + P_R), (bf16_t*)(ws + WS_P + P_S), (f32x2*)(ws + WS_SMALL + SM_VST)};
        gemm_run<0>(lds, S, E, D); convert_tail(p, lds, (T / 256) * (NIN / 256)); }
    if constexpr (PH == 2) { phase2_conv(p); phase2_sgu(p, lds); }
    if constexpr (PH == 3) { DenseSched S; S.init((const bf16_t*)(ws + WS_X), (const bf16_t*)(ws + WS_WUPT), T, D, 2048);
        EpiUp E{(const bf16_t*)(ws + WS_P + P_R), (const bf16_t*)(ws + WS_P + P_S), (bf16_t*)(ws + WS_MM)}; gemm_run<1>(lds, S, E, 2048); }
    if constexpr (PH == 4) { DenseSched S; S.init((const bf16_t*)(ws + WS_MM), (const bf16_t*)(ws + WS_WOUTT), T, D, D);
        EpiOut E{p.in[0], (bf16_t*)(ws + WS_A2)}; gemm_run<2>(lds, S, E, D); }
    if constexpr (PH == 5) phase5_router(p, lds);
    if constexpr (PH == 6 || PH == 7) {
        const int* cnt = (const int*)(ws + WS_CTL); const int* ent = (const int*)(ws + WS_SMALL + SM_ENT); const int G = gridDim.x, c = blockIdx.x;
        EpiMoe1 E1{ent, (const float*)(ws + WS_SMALL + SM_W), (const float*)(ws + WS_SMALL + SM_RSTD), (bf16_t*)(ws + WS_HID), false};
        EpiMoe2 E2{ent, (bf16_t*)(ws + WS_YK0), (bf16_t*)(ws + WS_YK1)};
        typedef MoeSched<true, 4, D, 1024> S1T; typedef MoeSched<false, 8, DE, D> S2T;
        constexpr int BIG = 1 << 20;
        unsigned* flags = (unsigned*)(ws + WS_FLAGS);
        int UA = 0, UH = 0; for (int e = 0; e < NE; ++e) { const int nt = (__builtin_amdgcn_readfirstlane(cnt[e]) + 255) >> 8; UA += min(nt, MOE_REG) * 4; UH += max(nt - MOE_REG, 0) * 4; }
        const bool fancy = (UA <= G) && (UH <= G / 4);
        if constexpr (PH == 6) {
            if (fancy) {
                E1.wt = true;
                { S1T S{(const bf16_t*)(ws + WS_A2), (const bf16_t*)(ws + WS_W1T), cnt, ent, 3, (c < UA) ? c : -1, 0, 1, (c < UH) ? UA + c : -1, flags, 1}; gemm_run<3>(lds, S, E1, D); }
                { S2T S{(const bf16_t*)(ws + WS_HID), (const bf16_t*)(ws + WS_W2T), cnt, ent, 3, (c >= UH) ? c - UH : -1, G - UH, BIG, -1, flags, 2}; gemm_run<4>(lds, S, E2, DE); }
            } else { S1T S{(const bf16_t*)(ws + WS_A2), (const bf16_t*)(ws + WS_W1T), cnt, ent, 2, c, G, BIG, -1, flags, 0}; gemm_run<3>(lds, S, E1, D); }
        }
        if constexpr (PH == 7) { S2T S{(const bf16_t*)(ws + WS_HID), (const bf16_t*)(ws + WS_W2T), cnt, ent, 2, c, G, BIG, -1, flags, 0}; gemm_run<4>(lds, S, E2, DE); }
    }
    if constexpr (PH == 8) phase8_final(p);
}

template <int PH> __global__ void __launch_bounds__(NTHREADS, 2) k_phase(Params p) {
    extern __shared__ __attribute__((aligned(16))) unsigned char lds_raw[];
    run_phase<PH>(p, (LAS unsigned char*)lds_raw);
}

#ifndef PROBE_DUP
#define PROBE_DUP 0
#endif
#ifndef PROBE_SYNCS
#define PROBE_SYNCS 0
#endif
#define DUP(k) ((PROBE_DUP >> (k)) & 1)
#ifndef PROBE_T
#define PROBE_T (-1)
#endif
#ifndef PROBE_MULT
#define PROBE_MULT 4
#endif
typedef const __attribute__((address_space(4))) Params* KParamsPtr;
__device__ __forceinline__ Params load_params() {
    Params r{};
#if defined(__HIP_DEVICE_COMPILE__)
    unsigned long long v = (unsigned long long)__builtin_amdgcn_kernarg_segment_ptr(); asm volatile("" : "+s"(v));
    const __attribute__((address_space(4))) unsigned long long* q = (const __attribute__((address_space(4))) unsigned long long*)v;
#pragma unroll
    for (int i = 0; i < 20; ++i) r.in[i] = (const float*)(const __attribute__((address_space(1))) float*)q[i];
    r.out = (float*)(__attribute__((address_space(1))) float*)q[20]; r.ws = (unsigned char*)(__attribute__((address_space(1))) unsigned char*)q[21];
#endif
    return r;
}
#define RUN(k) do { const Params pk = load_params(); run_phase<k>(pk, lds); } while (0)
__global__ void __launch_bounds__(NTHREADS, 2) k_mega(Params p) {
    extern __shared__ __attribute__((aligned(16))) unsigned char lds_raw[];
    LAS unsigned char* lds = (LAS unsigned char*)lds_raw;
    cg::grid_group grid = cg::this_grid();
    volatile LAS unsigned* xbst = (volatile LAS unsigned*)(lds + LDS_BYTES - 64);
    if (threadIdx.x < 4) xbst[threadIdx.x] = 0u;
    __syncthreads();
    const XcdBarrier bar = xcd_barrier_post((unsigned*)(p.ws + WS_BAR), xbst);
    volatile LAS unsigned long long* stamps = (volatile LAS unsigned long long*)(lds + LDS_BYTES - 256);
    int nstamp = 0;
#define STAMP() do { if (PROBE_T >= 0 && blockIdx.x == 0 && threadIdx.x == 0) stamps[nstamp] = __builtin_amdgcn_s_memrealtime(); ++nstamp; } while (0)
#define GSYNC() do { xcd_barrier(bar); STAMP(); } while (0)
    STAMP();
    if (p.ws == nullptr) grid.sync();
    RUN(0); GSYNC();
    if (DUP(0)) { RUN(0); GSYNC(); }
    RUN(1); GSYNC();
    if (DUP(1)) { RUN(1); GSYNC(); }
    RUN(2); GSYNC();
    if (DUP(2)) { RUN(2); GSYNC(); }
    RUN(3); GSYNC();
    if (DUP(3)) { RUN(3); GSYNC(); }
    RUN(4); GSYNC();
    if (DUP(4)) { RUN(4); GSYNC(); }
    RUN(5); GSYNC();
    if (DUP(5)) { if (blockIdx.x == 0 && threadIdx.x < 16) ((int*)(load_params().ws + WS_CTL))[threadIdx.x] = 0; GSYNC(); RUN(5); GSYNC(); }
    RUN(6); GSYNC();
    if (DUP(6)) { RUN(6); GSYNC(); }
    { const int* cnt = (const int*)(load_params().ws + WS_CTL); int UA = 0, UH = 0;
      for (int e = 0; e < NE; ++e) { const int nt = (__builtin_amdgcn_readfirstlane(cnt[e]) + 255) >> 8; UA += min(nt, MOE_REG) * 4; UH += max(nt - MOE_REG, 0) * 4; }
      if (!((UA <= (int)gridDim.x) && (UH <= (int)gridDim.x / 4))) { RUN(7); GSYNC(); } }
    for (int i = 0; i < PROBE_SYNCS; ++i) GSYNC();
    RUN(8);
    if (DUP(8)) { GSYNC(); RUN(8); }
    if (PROBE_T >= 0) { __syncthreads(); STAMP();
        if (blockIdx.x == 0 && threadIdx.x == 0) { const unsigned long long d = (stamps[PROBE_T + 1] - stamps[PROBE_T]) * PROBE_MULT; const unsigned long long t0 = __builtin_amdgcn_s_memrealtime();
            while (__builtin_amdgcn_s_memrealtime() - t0 < d) __builtin_amdgcn_s_sleep(8); } }
}

template <int PH> static void launch_phase(const Params& p, int grid, hipStream_t stream) {
    static bool attr = false;
    if (!attr) { (void)hipFuncSetAttribute((const void*)k_phase<PH>, hipFuncAttributeMaxDynamicSharedMemorySize, LDS_BYTES); attr = true; }
    hipLaunchKernelGGL(k_phase<PH>, dim3(grid), dim3(NTHREADS), LDS_BYTES, stream, p);
}

extern "C" void kernel_launch(void* const* d_in, const int* in_sizes, int n_in, void* d_out, int out_size, void* d_ws, size_t ws_size, hipStream_t stream) {
    static int grid = 0;
    if (grid == 0) {
        if (n_in != 20 || out_size != T * D || ws_size < WS_END) { fprintf(stderr, "kernel_launch: unexpected shapes n_in %d out %d ws %zu (need %zu)\n", n_in, out_size, ws_size, (size_t)WS_END); grid = -1; return; }
        int dev = 0, cus = 0, per_cu = 0;
        (void)hipGetDevice(&dev); (void)hipDeviceGetAttribute(&cus, hipDeviceAttributeMultiprocessorCount, dev);
        (void)hipFuncSetAttribute((const void*)k_mega, hipFuncAttributeMaxDynamicSharedMemorySize, LDS_BYTES);
        (void)hipOccupancyMaxActiveBlocksPerMultiprocessor(&per_cu, (const void*)k_mega, NTHREADS, LDS_BYTES);
        if (per_cu < 1) { fprintf(stderr, "kernel_launch: occupancy query says %d blocks per CU\n", per_cu); per_cu = 1; }
        grid = cus * 1;
        (void)hipGetLastError();
    }
    if (grid < 0) return;
    Params p{};
    for (int i = 0; i < 20; ++i) p.in[i] = (const float*)d_in[i];
    p.out = (float*)d_out; p.ws = (unsigned char*)d_ws;
    (void)hipMemsetAsync((char*)d_ws + WS_CTL, 0, 64 * 1024, stream);
#if ONE_LAUNCH
    void* args[] = {&p};
    hipError_t e = hipLaunchCooperativeKernel((const void*)k_mega, dim3(grid), dim3(NTHREADS), args, LDS_BYTES, stream);
    if (e != hipSuccess) fprintf(stderr, "cooperative launch failed: %s (grid %d)\n", hipGetErrorString(e), grid);
#else
    launch_phase<0>(p, grid, stream); launch_phase<1>(p, grid, stream); launch_phase<2>(p, grid, stream); launch_phase<3>(p, grid, stream); launch_phase<4>(p, grid, stream);
    launch_phase<5>(p, grid, stream); launch_phase<6>(p, grid, stream); launch_phase<7>(p, grid, stream); launch_phase<8>(p, grid, stream);
#endif
}
```

```cpp
#include <hip/hip_runtime.h>
#include <hip/hip_cooperative_groups.h>
#include <cstdio>
#include <cstdint>
namespace cg = cooperative_groups;

#ifndef ONE_LAUNCH
#define ONE_LAUNCH 1
#endif

#define LAS __attribute__((address_space(3)))
typedef unsigned short bf16_t;
typedef short bf16x8 __attribute__((ext_vector_type(8)));
typedef float f32x4 __attribute__((ext_vector_type(4)));
typedef float f32x2 __attribute__((ext_vector_type(2)));
typedef unsigned u32x4 __attribute__((ext_vector_type(4)));
typedef unsigned u32x2 __attribute__((ext_vector_type(2)));

constexpr int T = 8192, D = 2048, CW = 1024, SW = 1024, NIN = 9216, NE = 16, DE = 512;
constexpr float EPS = 1e-6f;
constexpr int NTHREADS = 512, NWAVES = 8;
constexpr int LDS_BYTES = 140 * 1024;
constexpr int HID_ROWS = 2 * T + NE * 256;

constexpr size_t MiB = 1024 * 1024;
constexpr size_t WS_CTL   = 0;
constexpr size_t WS_BAR   = 4096;
constexpr size_t WS_FLAGS = 32768;
constexpr size_t WS_SMALL = 64 * 1024;
constexpr size_t SM_RSTD = 0, SM_ENT = 32 * 1024, SM_W = SM_ENT + (size_t)NE * T * 4, SM_VST = SM_W + (size_t)NE * T * 4, SM_END = SM_VST + (size_t)T * 16 * 8;
constexpr size_t WS_WR    = WS_SMALL + 4 * MiB;
constexpr size_t WS_WMB   = WS_WR + 256 * 1024;
constexpr size_t WS_WINT  = WS_WMB + 256 * 1024;
constexpr size_t WS_WUPT  = WS_WINT + (size_t)NIN * D * 2;
constexpr size_t WS_WOUTT = WS_WUPT + (size_t)D * D * 2;
constexpr size_t WS_W1T   = WS_WOUTT + (size_t)D * D * 2;
constexpr size_t WS_W2T   = WS_W1T + (size_t)NE * 1024 * D * 2;
constexpr size_t WS_X     = WS_W2T + (size_t)NE * D * DE * 2;
constexpr size_t WS_P     = WS_X + (size_t)T * D * 2;
constexpr size_t P_BC = 0, P_P = P_BC + (size_t)T * CW * 2, P_U = P_P + (size_t)T * CW * 2, P_V = P_U + (size_t)T * SW * 2,
                 P_R = P_V + (size_t)T * SW * 2, P_S = P_R + (size_t)T * D * 2, P_END = P_S + (size_t)T * D * 2;
constexpr size_t WS_END   = WS_P + P_END;
constexpr size_t WS_MM  = WS_WINT;
constexpr size_t WS_H   = WS_P + P_BC;
constexpr size_t WS_A2  = WS_P + P_R;
constexpr size_t WS_HID = WS_P + P_S;
constexpr size_t WS_YK0 = WS_X;
constexpr size_t WS_YK1 = WS_WINT;
static_assert(SM_END <= 4 * MiB, "small region");
static_assert((size_t)HID_ROWS * DE * 2 <= (size_t)T * D * 2, "hid overlay");
static_assert((size_t)T * D * 4 <= P_R, "H overlay");

struct Params { const float* in[20]; float* out; unsigned char* ws; };

__device__ __forceinline__ unsigned cvt_pk_bf16(float lo, float hi) { unsigned r; asm("v_cvt_pk_bf16_f32 %0, %1, %2" : "=v"(r) : "v"(lo), "v"(hi)); return r; }
__device__ __forceinline__ float bf_lo(unsigned w) { return __uint_as_float(w << 16); }
__device__ __forceinline__ float bf_hi(unsigned w) { return __uint_as_float(w & 0xffff0000u); }
__device__ __forceinline__ float bf1(bf16_t b) { return __uint_as_float(((unsigned)b) << 16); }
__device__ __forceinline__ float wave_sum(float v) {
#pragma unroll
    for (int o = 1; o < 64; o <<= 1) v += __shfl_xor(v, o);
    return v;
}
__device__ __forceinline__ float fast_rcp(float x) { return __builtin_amdgcn_rcpf(x); }
__device__ __forceinline__ float fast_exp2(float x) { return __builtin_amdgcn_exp2f(x); }
__device__ __forceinline__ float sigmoid_f(float x) { return fast_rcp(1.0f + fast_exp2(-1.44269504f * x)); }
__device__ __forceinline__ float gelu_tanh(float x) {
    const float u = x + 0.044715f * x * x * x;
    return x * fast_rcp(1.0f + fast_exp2(-2.30220819f * u));
}
__device__ __forceinline__ int opaque_tid() { int t = threadIdx.x; asm volatile("" : "+v"(t)); return t; }
__device__ __forceinline__ void st16_wt(void* p, u32x4 v) { asm volatile("global_store_dwordx4 %0, %1, off sc1\n\ts_nop 1" :: "v"(p), "v"(v) : "memory"); }
__host__ __device__ __forceinline__ int perm32(int rho) { const int n = rho >> 4, i = rho & 15; return 8 * (i >> 2) + 4 * n + (i & 3); }

struct Unit { int pm, pn, e, row0, nvalid; };
constexpr int NXCD = 8, WGM = 2;
struct DenseSched {
    static constexpr bool DYN_HALF = false;
    __device__ __forceinline__ void a_ready(const Unit&) const {}
    __device__ __forceinline__ void done(const Unit&) const {}
    const bf16_t* A; const bf16_t* Bt; int K; int nM, nN, nwg, G, c;
    __device__ __forceinline__ void init(const bf16_t* A_, const bf16_t* Bt_, int M, int N, int K_) { A = A_; Bt = Bt_; K = K_; nM = M / 256; nN = N / 256; nwg = nM * nN; G = gridDim.x; c = blockIdx.x; }
    __device__ __forceinline__ bool next(int i, Unit& u) const {
        const long L = (long)i * G + c; if (L >= nwg) return false;
        int wgid = (int)L; { const int q = nwg / NXCD, r = nwg % NXCD, xcd = wgid % NXCD, off = wgid / NXCD; wgid = (xcd < r ? xcd * (q + 1) : r * (q + 1) + (xcd - r) * q) + off; }
        const int nig = WGM * nN, gid = wgid / nig, fm = gid * WGM, gsz = (nM - fm) < WGM ? (nM - fm) : WGM;
        u.pm = fm + ((wgid % nig) % gsz); u.pn = (wgid % nig) / gsz; u.e = 0; u.row0 = u.pm * 256; u.nvalid = 256; return true;
    }
    __device__ __forceinline__ const char* a_base() const { return (const char*)A; }
    __device__ __forceinline__ unsigned a_off(const Unit& u, int r) const { return (unsigned)(u.row0 + r) * (unsigned)K * 2u; }
    __device__ __forceinline__ const char* b_base(const Unit& u) const { return (const char*)Bt + (size_t)u.pn * 256 * K * 2; }
};
constexpr int MOE_REG = 4;
template <bool GATHER, int NPN, int KK, int NROWS_E  >
struct MoeSched {
    static constexpr bool DYN_HALF = true;
    const bf16_t* A; const bf16_t* Bt; const int* cnt; const int* ent;
    int mode;
    int idx, stride, maxi;
    int idx1;
    unsigned* flags; int role;
    __device__ __forceinline__ bool lookup(int L, int md, Unit& u) const {
        int hb = 0;
        for (int e = 0; e < NE; ++e) {
            const int n = __builtin_amdgcn_readfirstlane(cnt[e]); const int nt = (n + 255) >> 8;
            const int lo = (md == 1) ? min(nt, MOE_REG) : 0, hi = (md == 0) ? min(nt, MOE_REG) : nt;
            const int nsel = (hi - lo) * NPN;
            if (L < nsel) { u.e = e; u.pm = lo + L / NPN; u.pn = L % NPN; u.row0 = hb + u.pm * 256; u.nvalid = min(256, n - u.pm * 256); return true; }
            L -= nsel; hb += nt * 256;
        }
        return false;
    }
    __device__ __forceinline__ bool next(int i, Unit& u) const {
        int L;
        const int n0 = (idx >= 0) ? maxi : 0;
        if (i < n0) L = idx + i * stride; else if (i == n0 && idx1 >= 0) L = idx1; else return false;
        if (mode != 3) return lookup(L, mode, u);
        int nreg = 0; for (int e = 0; e < NE; ++e) nreg += min((__builtin_amdgcn_readfirstlane(cnt[e]) + 255) >> 8, MOE_REG) * NPN;
        return (L < nreg) ? lookup(L, 0, u) : lookup(L - nreg, 1, u);
    }
    __device__ __forceinline__ const char* a_base() const { return (const char*)A; }
    __device__ __forceinline__ unsigned a_off(const Unit& u, int r) const {
        if (GATHER) { const int tok = (r < u.nvalid) ? (ent[u.e * T + u.pm * 256 + r] & 0xffff) : 0; return (unsigned)tok * (unsigned)KK * 2u; }
        return (unsigned)(u.row0 + r) * (unsigned)KK * 2u;
    }
    __device__ __forceinline__ const char* b_base(const Unit& u) const { return (const char*)Bt + ((size_t)u.e * NROWS_E + (size_t)u.pn * 256) * KK * 2; }
    __device__ __forceinline__ void a_ready(const Unit& u) const {
        if (role != 2) return;
        if (threadIdx.x < 64) {
            unsigned* f = flags + (u.row0 >> 8) * 64; unsigned spins = 0;
            while ((unsigned)__builtin_amdgcn_readfirstlane(__hip_atomic_load(f, __ATOMIC_RELAXED, __HIP_MEMORY_SCOPE_AGENT)) < 32u) { __builtin_amdgcn_s_sleep(2); if (++spins > (1u << 22)) break; }
            __builtin_amdgcn_fence(__ATOMIC_ACQUIRE, "agent");
            asm volatile("s_waitcnt vmcnt(0)" ::: "memory");
        }
        asm volatile("" ::: "memory"); __builtin_amdgcn_s_barrier(); asm volatile("" ::: "memory");
    }
    __device__ __forceinline__ void done(const Unit& u) const {
        if (role != 1) return;
        asm volatile("s_waitcnt vmcnt(0)" ::: "memory");
        if ((threadIdx.x & 63) == 0) __hip_atomic_fetch_add(flags + (u.row0 >> 8) * 64, 1u, __ATOMIC_RELAXED, __HIP_MEMORY_SCOPE_AGENT);
    }
};
__device__ __forceinline__ int moe_overflow_tiles(const int* cnt) { int t = 0; for (int e = 0; e < NE; ++e) { const int nt = (__builtin_amdgcn_readfirstlane(cnt[e]) + 255) >> 8; t += max(nt - MOE_REG, 0); } return t; }

typedef f32x4 Acc[2][2][4][2];
__device__ __forceinline__ u32x4 pack8(f32x4 a, f32x4 b) { u32x4 w; w.x = cvt_pk_bf16(a[0], a[1]); w.y = cvt_pk_bf16(a[2], a[3]); w.z = cvt_pk_bf16(b[0], b[1]); w.w = cvt_pk_bf16(b[2], b[3]); return w; }
__device__ __forceinline__ void unpack8(u32x4 w, f32x4& a, f32x4& b) { a = (f32x4){bf_lo(w.x), bf_hi(w.x), bf_lo(w.y), bf_hi(w.y)}; b = (f32x4){bf_lo(w.z), bf_hi(w.z), bf_lo(w.w), bf_hi(w.w)}; }

struct EpiProj {
    static constexpr bool PERM = true; static constexpr int MIDK = 0;
    bf16_t *Bc, *P, *U, *V, *R, *S; f32x2* VST;
    __device__ __forceinline__ void mid(Acc&, const Unit&, int, int, int, int) const {}
    __device__ __forceinline__ void operator()(const Acc& acc, const Unit& u, int wr, int wc, int fr, int fq) const {
        const int pn = u.pn; const int rowb = u.row0 + wr * 64 + fr; const int cl = wc * 32 + 8 * fq;
#pragma unroll
        for (int ai = 0; ai < 2; ++ai)
#pragma unroll
            for (int m = 0; m < 4; ++m) {
                const size_t row = (size_t)(rowb + ai * 128 + m * 16);
                if (pn < 4) {
#pragma unroll
                    for (int bj = 0; bj < 2; ++bj) *(u32x4*)(Bc + row * CW + pn * 256 + bj * 128 + cl) = pack8(acc[ai][bj][m][0], acc[ai][bj][m][1]);
                } else if (pn < 12) {
                    *(u32x4*)(P + row * CW + (pn - 4) * 128 + cl) = pack8(acc[ai][0][m][0] * acc[ai][1][m][0], acc[ai][0][m][1] * acc[ai][1][m][1]);
                } else if (pn < 20) {
                    bf16_t* O = (pn < 16) ? (U + row * SW + (pn - 12) * 256) : (V + row * SW + (pn - 16) * 256);
                    float ssum = 0.f, ssq = 0.f;
#pragma unroll
                    for (int bj = 0; bj < 2; ++bj) { f32x4 a = acc[ai][bj][m][0], b = acc[ai][bj][m][1];
#pragma unroll
                        for (int j = 0; j < 4; ++j) { a[j] = gelu_tanh(a[j]); b[j] = gelu_tanh(b[j]); ssum += a[j] + b[j]; ssq += a[j] * a[j] + b[j] * b[j]; }
                        *(u32x4*)(O + bj * 128 + cl) = pack8(a, b); }
                    if (pn >= 16) {
                        ssum += __shfl_xor(ssum, 16); ssum += __shfl_xor(ssum, 32); ssq += __shfl_xor(ssq, 16); ssq += __shfl_xor(ssq, 32);
                        if (fq == 0) VST[row * 16 + (pn - 16) * 4 + wc] = (f32x2){ssum, ssq}; }
                } else {
                    f32x4 r0, r1, s0, s1;
#pragma unroll
                    for (int j = 0; j < 4; ++j) {
                        const float ec0 = fast_exp2(-1.44269504f * acc[ai][0][m][0][j]), es0 = fast_exp2(-1.44269504f * acc[ai][1][m][0][j]);
                        const float ec1 = fast_exp2(-1.44269504f * acc[ai][0][m][1][j]), es1 = fast_exp2(-1.44269504f * acc[ai][1][m][1][j]);
                        r0[j] = (1.0f + es0) * fast_rcp(1.0f + ec0); s0[j] = fast_rcp(1.0f + es0);
                        r1[j] = (1.0f + es1) * fast_rcp(1.0f + ec1); s1[j] = fast_rcp(1.0f + es1);
                    }
                    const size_t o = row * D + (pn - 20) * 128 + cl;
                    *(u32x4*)(R + o) = pack8(r0, r1); *(u32x4*)(S + o) = pack8(s0, s1);
                }
            }
    }
};
struct EpiUp {
    static constexpr bool PERM = true; static constexpr int MIDK = 1024;
    const bf16_t *R, *S; bf16_t* Mm;
    __device__ __forceinline__ void mid(Acc& acc, const Unit& u, int wr, int wc, int fr, int fq) const {
        int rowb = u.row0 + wr * 64 + fr; const int cb = u.pn * 256 + wc * 32 + 8 * fq;
        asm volatile("" : "+v"(rowb));
#pragma unroll
        for (int ai = 0; ai < 2; ++ai)
#pragma unroll
            for (int m = 0; m < 4; ++m)
#pragma unroll
                for (int bj = 0; bj < 2; ++bj) { f32x4 a, b; unpack8(*(const u32x4*)(R + (size_t)(rowb + ai * 128 + m * 16) * D + cb + bj * 128), a, b);
                    acc[ai][bj][m][0] *= a; acc[ai][bj][m][1] *= b; }
    }
    __device__ __forceinline__ void operator()(const Acc& acc, const Unit& u, int wr, int wc, int fr, int fq) const {
        const int rowb = u.row0 + wr * 64 + fr; const int cb = u.pn * 256 + wc * 32 + 8 * fq;
#pragma unroll
        for (int ai = 0; ai < 2; ++ai)
#pragma unroll
            for (int m = 0; m < 4; ++m)
#pragma unroll
                for (int bj = 0; bj < 2; ++bj) { const size_t o = (size_t)(rowb + ai * 128 + m * 16) * D + cb + bj * 128; f32x4 a, b; unpack8(*(const u32x4*)(S + o), a, b);
                    *(u32x4*)(Mm + o) = pack8(acc[ai][bj][m][0] * a, acc[ai][bj][m][1] * b); }
    }
};
struct EpiOut {
    static constexpr bool PERM = true; static constexpr int MIDK = 0;
    const float* x; bf16_t* A2;
    __device__ __forceinline__ void mid(Acc&, const Unit&, int, int, int, int) const {}
    __device__ __forceinline__ void operator()(const Acc& acc, const Unit& u, int wr, int wc, int fr, int fq) const {
        const int rowb = u.row0 + wr * 64 + fr; const int cb = u.pn * 256 + wc * 32 + 8 * fq;
#pragma unroll
        for (int ai = 0; ai < 2; ++ai)
#pragma unroll
            for (int m = 0; m < 4; ++m)
#pragma unroll
                for (int bj = 0; bj < 2; ++bj) { const size_t o = (size_t)(rowb + ai * 128 + m * 16) * D + cb + bj * 128;
                    const f32x4 h0 = *(const f32x4*)(x + o) + acc[ai][bj][m][0], h1 = *(const f32x4*)(x + o + 4) + acc[ai][bj][m][1];
                    *(u32x4*)(A2 + o) = pack8(h0, h1); }
    }
};
struct EpiMoe1 {
    static constexpr bool PERM = true; static constexpr int MIDK = 0;
    const int* ent; const float* lw; const float* rstd; bf16_t* Hid; bool wt;
    __device__ __forceinline__ void mid(Acc&, const Unit&, int, int, int, int) const {}
    __device__ __forceinline__ void operator()(const Acc& acc, const Unit& u, int wr, int wc, int fr, int fq) const {
        const int cl = u.pn * 128 + wc * 32 + 8 * fq;
#pragma unroll
        for (int ai = 0; ai < 2; ++ai)
#pragma unroll
            for (int m = 0; m < 4; ++m) {
                const int r = ai * 128 + wr * 64 + m * 16 + fr;
                if (r < u.nvalid) {
                    const int li = u.e * T + u.pm * 256 + r; const int tok = ent[li] & 0xffff; const float rs = rstd[tok], w = lw[li];
                    f32x4 o[2];
#pragma unroll
                    for (int n = 0; n < 2; ++n)
#pragma unroll
                        for (int j = 0; j < 4; ++j) { const float gt = acc[ai][0][m][n][j] * rs, up = acc[ai][1][m][n][j] * rs; o[n][j] = gt * sigmoid_f(gt) * up * w; }
                    bf16_t* dst = Hid + (size_t)(u.row0 + r) * DE + cl; if (wt) st16_wt(dst, pack8(o[0], o[1])); else *(u32x4*)dst = pack8(o[0], o[1]);
                }
            }
    }
};
struct EpiMoe2 {
    static constexpr bool PERM = true; static constexpr int MIDK = 0;
    const int* ent; bf16_t* Yk0; bf16_t* Yk1;
    __device__ __forceinline__ void mid(Acc&, const Unit&, int, int, int, int) const {}
    __device__ __forceinline__ void operator()(const Acc& acc, const Unit& u, int wr, int wc, int fr, int fq) const {
        const int cb = u.pn * 256 + wc * 32 + 8 * fq;
#pragma unroll
        for (int ai = 0; ai < 2; ++ai)
#pragma unroll
            for (int m = 0; m < 4; ++m) {
                const int r = ai * 128 + wr * 64 + m * 16 + fr;
                if (r < u.nvalid) {
                    const int en = ent[u.e * T + u.pm * 256 + r]; const int tok = en & 0xffff; bf16_t* Y = (en >> 16) ? Yk1 : Yk0;
#pragma unroll
                    for (int bj = 0; bj < 2; ++bj) *(u32x4*)(Y + (size_t)tok * D + cb + bj * 128) = pack8(acc[ai][bj][m][0], acc[ai][bj][m][1]);
                }
            }
    }
};

template <class Epi, class Sched>
__device__ __forceinline__ void gemm_simple(const Sched& S, const Epi& E, const int K) {
    const int tid = opaque_tid(), wid = __builtin_amdgcn_readfirstlane(tid >> 6), lane = tid & 63, wr = wid >> 2, wc = wid & 3, fr = lane & 15, fq = lane >> 4;
    Unit u;
    for (int ui = 0; S.next(ui, u); ++ui) {
        Acc acc;
#pragma unroll
        for (int a = 0; a < 2; ++a)
#pragma unroll
            for (int b = 0; b < 2; ++b)
#pragma unroll
                for (int m = 0; m < 4; ++m)
#pragma unroll
                    for (int n = 0; n < 2; ++n) acc[a][b][m][n] = (f32x4){0.f, 0.f, 0.f, 0.f};
        S.a_ready(u);
        const char* ab = S.a_base(); const char* bb = S.b_base(u);
        unsigned aoff[2][4], boff[2][2];
#pragma unroll
        for (int ai = 0; ai < 2; ++ai)
#pragma unroll
            for (int m = 0; m < 4; ++m) aoff[ai][m] = S.a_off(u, ai * 128 + wr * 64 + m * 16 + fr) + fq * 16;
#pragma unroll
        for (int bj = 0; bj < 2; ++bj)
#pragma unroll
            for (int n = 0; n < 2; ++n) { const int rr = Epi::PERM ? perm32(n * 16 + fr) : (n * 16 + fr); boff[bj][n] = (unsigned)(bj * 128 + wc * 32 + rr) * (unsigned)K * 2u + fq * 16; }
        for (int k0 = 0; k0 < K; k0 += 32) {
            if (Epi::MIDK != 0 && k0 == Epi::MIDK) E.mid(acc, u, wr, wc, fr, fq);
            bf16x8 a[2][4], b[2][2];
#pragma unroll
            for (int ai = 0; ai < 2; ++ai)
#pragma unroll
                for (int m = 0; m < 4; ++m) a[ai][m] = *(const bf16x8*)(ab + aoff[ai][m] + k0 * 2);
#pragma unroll
            for (int bj = 0; bj < 2; ++bj)
#pragma unroll
                for (int n = 0; n < 2; ++n) b[bj][n] = *(const bf16x8*)(bb + boff[bj][n] + k0 * 2);
#pragma unroll
            for (int ai = 0; ai < 2; ++ai)
#pragma unroll
                for (int bj = 0; bj < 2; ++bj)
#pragma unroll
                    for (int m = 0; m < 4; ++m)
#pragma unroll
                        for (int n = 0; n < 2; ++n) acc[ai][bj][m][n] = __builtin_amdgcn_mfma_f32_16x16x32_bf16(b[bj][n], a[ai][m], acc[ai][bj][m][n], 0, 0, 0);
        }
        E(acc, u, wr, wc, fr, fq); S.done(u);
    }
}

constexpr int BK = 64, HALF = 128, HTB = HALF * BK * 2, STAGE_BYTES = 8 * HTB;
__host__ __device__ __forceinline__ int lds_byte(int r, int c) { const int st = (r >> 4) * 2 + (c >> 5), rr = r & 15, cc = c & 31, ob = rr * 64 + cc * 2; return st * 1024 + (ob ^ (((ob >> 9) & 1) << 5)); }
__host__ __device__ __forceinline__ void stage_rc(int b, int& R, int& C) { const int st = b / 1024, sb = b % 1024, swz = sb ^ (((sb >> 9) & 1) << 5); R = (st >> 1) * 16 + swz / 64; C = (st & 1) * 32 + (swz % 64) / 2; }

template <class Epi, class Sched>
__device__ __forceinline__ void gemm_fast(LAS unsigned char* lds, const Sched& S, const Epi& E, const int K) {
    const int tid = opaque_tid(), wid = __builtin_amdgcn_readfirstlane(tid >> 6), lane = tid & 63, wr = wid >> 2, wc = wid & 3, fr = lane & 15, fq = lane >> 4;
    const int nt = K / BK;
    int sR[2], sC[2]; unsigned voffB[2];
#pragma unroll
    for (int i = 0; i < 2; ++i) { stage_rc(tid * 16 + i * 8192, sR[i], sC[i]); const int Rb = Epi::PERM ? ((sR[i] & ~31) + perm32(sR[i] & 31)) : sR[i]; voffB[i] = (unsigned)(Rb * K + sC[i]) * 2u; }
    const size_t kstep = (size_t)(BK * 2);
    const size_t hstepB = (size_t)HALF * K * 2;
    const unsigned ldsw = (unsigned)wid * 1024u;
    const int aoff = lds_byte(wr * 64 + fr, fq * 8), boff = lds_byte(wc * 32 + fr, fq * 8);
#define PG8_SA(b, h) (((b) * 2 + (h)) * HTB)
#define PG8_SB(b, h) ((4 + (b) * 2 + (h)) * HTB)
#define PG8_STAGE(bufoff, gbase, voff) do { _Pragma("unroll") for (int _i = 0; _i < 2; ++_i) \
        __builtin_amdgcn_global_load_lds((const unsigned*)((const char*)(gbase) + (voff)[_i]), (LAS unsigned*)(lds + (bufoff) + ldsw + _i * 8192), 16, 0, 0); } while (0)
#define PG8_LDA(dst, b, h) do { _Pragma("unroll") for (int m = 0; m < 4; ++m) _Pragma("unroll") for (int k = 0; k < 2; ++k) dst[m][k] = *(const LAS bf16x8*)(lds + PG8_SA(b, h) + aoff + m * 2048 + k * 1024); } while (0)
#define PG8_LDB(dst, b, h) do { _Pragma("unroll") for (int n = 0; n < 2; ++n) _Pragma("unroll") for (int k = 0; k < 2; ++k) dst[n][k] = *(const LAS bf16x8*)(lds + PG8_SB(b, h) + boff + n * 2048 + k * 1024); } while (0)
#define PG8_MMA(ai, bj, At, Bt) do { __builtin_amdgcn_s_setprio(1); _Pragma("unroll") for (int m = 0; m < 4; ++m) _Pragma("unroll") for (int n = 0; n < 2; ++n) _Pragma("unroll") for (int k = 0; k < 2; ++k) \
        acc[ai][bj][m][n] = __builtin_amdgcn_mfma_f32_16x16x32_bf16(Bt[n][k], At[m][k], acc[ai][bj][m][n], 0, 0, 0); __builtin_amdgcn_s_setprio(0); } while (0)
#define PG8_WAIT_V(n) asm volatile("s_waitcnt vmcnt(" #n ")" ::: "memory")
#define PG8_WAIT_L(n) asm volatile("s_waitcnt lgkmcnt(" #n ")" ::: "memory")
#define PG8_BAR __builtin_amdgcn_s_barrier()
#define PG8_SCHED __builtin_amdgcn_sched_barrier(0)
    Unit cur, nxt; int ui = 0;
    if (!S.next(0, cur)) return;
    Acc acc;
#pragma unroll
    for (int a = 0; a < 2; ++a)
#pragma unroll
        for (int b = 0; b < 2; ++b)
#pragma unroll
            for (int m = 0; m < 4; ++m)
#pragma unroll
                for (int n = 0; n < 2; ++n) acc[a][b][m][n] = (f32x4){0.f, 0.f, 0.f, 0.f};
    bf16x8 At[4][2], B0[2][2], B1[2][2];
    unsigned va[2][2], vn[2][2];
#pragma unroll
    for (int h = 0; h < 2; ++h)
#pragma unroll
        for (int i = 0; i < 2; ++i) va[h][i] = S.a_off(cur, h * 128 + sR[i]) + (unsigned)sC[i] * 2u;
    const char* const A0 = S.a_base(); const char* cB = S.b_base(cur);
    S.a_ready(cur);
    PG8_STAGE(PG8_SB(0, 0), cB, voffB); PG8_STAGE(PG8_SB(0, 1), cB + hstepB, voffB); PG8_STAGE(PG8_SA(0, 0), A0, va[0]); PG8_STAGE(PG8_SA(0, 1), A0, va[1]);
    if (wr == 1) PG8_BAR;
    PG8_WAIT_V(2); PG8_BAR;
    PG8_STAGE(PG8_SB(1, 0), cB + kstep, voffB); PG8_STAGE(PG8_SA(1, 0), A0 + kstep, va[0]); PG8_STAGE(PG8_SB(1, 1), cB + hstepB + kstep, voffB);
    PG8_WAIT_V(6); PG8_BAR;
    for (;;) {
        const bool has_next = S.next(ui + 1, nxt);
        const char* nB = has_next ? S.b_base(nxt) : cB;
#pragma unroll
        for (int h = 0; h < 2; ++h)
#pragma unroll
            for (int i = 0; i < 2; ++i) vn[h][i] = has_next ? (S.a_off(nxt, h * 128 + sR[i]) + (unsigned)sC[i] * 2u) : va[h][i];
        for (int t = 0; t < nt; t += 2) {
            const bool last = (t == nt - 2);
            if (Epi::MIDK != 0 && t * BK == Epi::MIDK) { PG8_SCHED; E.mid(acc, cur, wr, wc, fr, fq); PG8_SCHED; }
            if (last && has_next) S.a_ready(nxt);
            const char* a1 = A0 + (size_t)(t + 1) * kstep;
            const char* a2 = last ? A0 : A0 + (size_t)(t + 2) * kstep; const char* b2 = last ? nB : cB + (size_t)(t + 2) * kstep;
            const char* a3 = a2 + kstep; const char* b3 = b2 + kstep;
            unsigned v2[2][2];
#pragma unroll
            for (int h = 0; h < 2; ++h)
#pragma unroll
                for (int i = 0; i < 2; ++i) v2[h][i] = last ? vn[h][i] : va[h][i];
            const bool full = !Sched::DYN_HALF || cur.nvalid > 128;
            PG8_LDB(B0, 0, 0); PG8_LDB(B1, 0, 1); PG8_SCHED; PG8_LDA(At, 0, 0); PG8_STAGE(PG8_SA(1, 1), a1, va[1]);
            PG8_WAIT_V(8); PG8_WAIT_L(0); PG8_BAR; PG8_MMA(0, 0, At, B0); PG8_MMA(0, 1, At, B1); PG8_BAR; PG8_SCHED;
            if (full) { PG8_LDA(At, 0, 1); } PG8_STAGE(PG8_SB(0, 0), b2, voffB); PG8_STAGE(PG8_SB(0, 1), b2 + hstepB, voffB); PG8_STAGE(PG8_SA(0, 0), a2, v2[0]);
            PG8_WAIT_V(8); PG8_WAIT_L(0); PG8_BAR; if (full) { PG8_MMA(1, 0, At, B0); PG8_MMA(1, 1, At, B1); } PG8_BAR; PG8_SCHED;
            PG8_LDB(B0, 1, 0); PG8_LDB(B1, 1, 1); PG8_SCHED; PG8_LDA(At, 1, 0); PG8_STAGE(PG8_SA(0, 1), a2, v2[1]);
            PG8_WAIT_V(8); PG8_WAIT_L(0); PG8_BAR; PG8_MMA(0, 0, At, B0); PG8_MMA(0, 1, At, B1); PG8_BAR; PG8_SCHED;
            if (full) { PG8_LDA(At, 1, 1); } PG8_STAGE(PG8_SB(1, 0), b3, voffB); PG8_STAGE(PG8_SB(1, 1), b3 + hstepB, voffB); PG8_STAGE(PG8_SA(1, 0), a3, v2[0]);
            PG8_WAIT_V(8); PG8_WAIT_L(0); PG8_BAR; if (full) { PG8_MMA(1, 0, At, B0); PG8_MMA(1, 1, At, B1); } PG8_BAR; PG8_SCHED;
        }
        if (wr == 0) PG8_BAR;
        E(acc, cur, wr, wc, fr, fq); S.done(cur);
        if (!has_next) break;
#pragma unroll
        for (int a = 0; a < 2; ++a)
#pragma unroll
            for (int b = 0; b < 2; ++b)
#pragma unroll
                for (int m = 0; m < 4; ++m)
#pragma unroll
                    for (int n = 0; n < 2; ++n) acc[a][b][m][n] = (f32x4){0.f, 0.f, 0.f, 0.f};
        cur = nxt; cB = nB; ++ui;
#pragma unroll
        for (int h = 0; h < 2; ++h)
#pragma unroll
            for (int i = 0; i < 2; ++i) va[h][i] = vn[h][i];
        if (wr == 1) PG8_BAR;
    }
    PG8_WAIT_V(0);
    PG8_BAR;
#undef PG8_SA
#undef PG8_SB
#undef PG8_STAGE
#undef PG8_LDA
#undef PG8_LDB
#undef PG8_MMA
#undef PG8_WAIT_V
#undef PG8_WAIT_L
#undef PG8_BAR
#undef PG8_SCHED
}
#ifndef FAST_MASK
#define FAST_MASK 0x1f
#endif
template <int BIT, class Epi, class Sched>
__device__ __forceinline__ void gemm_run(LAS unsigned char* lds, const Sched& S, const Epi& E, const int K) {
    if constexpr ((FAST_MASK >> BIT) & 1) gemm_fast(lds, S, E, K); else gemm_simple(S, E, K);
}

__device__ __forceinline__ void tr_item64(const float* W, int N, int k0, int ns, bf16_t* WT, int ldk, int nd, int kd, LAS float* scr, int lane, const float* kscale) {
    { const int r4 = lane >> 4, c4 = (lane & 15) * 4; f32x4 v[16];
#pragma unroll
      for (int i = 0; i < 16; ++i) v[i] = __builtin_nontemporal_load((const f32x4*)(W + (size_t)(k0 + 4 * i + r4) * N + ns + c4));
#pragma unroll
      for (int i = 0; i < 16; ++i) { LAS float* d = scr + (4 * i + r4) * 65 + c4; d[0] = v[i][0]; d[1] = v[i][1]; d[2] = v[i][2]; d[3] = v[i][3]; } }
    const int c = lane & 7;
    f32x4 s0 = (f32x4){1.f, 1.f, 1.f, 1.f}, s1 = s0;
    if (kscale) { s0 = *(const f32x4*)(kscale + k0 + 8 * c); s1 = *(const f32x4*)(kscale + k0 + 8 * c + 4); }
    asm volatile("s_waitcnt lgkmcnt(0)" ::: "memory");
#pragma unroll
    for (int j = 0; j < 8; ++j) { const int n = (lane >> 3) + 8 * j; const LAS float* s = scr + (8 * c) * 65 + n;
        u32x4 o; o.x = cvt_pk_bf16(s[0 * 65] * s0[0], s[1 * 65] * s0[1]); o.y = cvt_pk_bf16(s[2 * 65] * s0[2], s[3 * 65] * s0[3]);
        o.z = cvt_pk_bf16(s[4 * 65] * s1[0], s[5 * 65] * s1[1]); o.w = cvt_pk_bf16(s[6 * 65] * s1[2], s[7 * 65] * s1[3]);
        *(u32x4*)(WT + (size_t)(nd + n) * ldk + kd + 8 * c) = o; }
    asm volatile("s_waitcnt lgkmcnt(0)" ::: "memory");
}
constexpr int TRS = 64 * 65 * 4;
static_assert(8 * TRS <= LDS_BYTES - 64, "transpose scratch vs barrier words");
struct TrItem { const float* W; int N; bf16_t* WT; int ldk, nd, kd, k0, ns; const float* ks; };
__device__ __forceinline__ void tr_load(f32x4 (&v)[16], const TrItem& it, int lane) {
    const int r4 = lane >> 4, c4 = (lane & 15) * 4;
#pragma unroll
    for (int i = 0; i < 16; ++i) v[i] = __builtin_nontemporal_load((const f32x4*)(it.W + (size_t)(it.k0 + 4 * i + r4) * it.N + it.ns + c4));
}
__device__ __forceinline__ void tr_store(const f32x4 (&v)[16], const TrItem& it, LAS float* scr, int lane) {
    { const int r4 = lane >> 4, c4 = (lane & 15) * 4;
#pragma unroll
      for (int i = 0; i < 16; ++i) { LAS float* d = scr + (4 * i + r4) * 65 + c4; d[0] = v[i][0]; d[1] = v[i][1]; d[2] = v[i][2]; d[3] = v[i][3]; } }
    const int c = lane & 7;
    f32x4 s0 = (f32x4){1.f, 1.f, 1.f, 1.f}, s1 = s0;
    if (it.ks) { s0 = *(const f32x4*)(it.ks + it.k0 + 8 * c); s1 = *(const f32x4*)(it.ks + it.k0 + 8 * c + 4); }
    asm volatile("s_waitcnt lgkmcnt(0)" ::: "memory");
#pragma unroll
    for (int j = 0; j < 8; ++j) { const int n = (lane >> 3) + 8 * j; const LAS float* s = scr + (8 * c) * 65 + n;
        u32x4 o; o.x = cvt_pk_bf16(s[0 * 65] * s0[0], s[1 * 65] * s0[1]); o.y = cvt_pk_bf16(s[2 * 65] * s0[2], s[3 * 65] * s0[3]);
        o.z = cvt_pk_bf16(s[4 * 65] * s1[0], s[5 * 65] * s1[1]); o.w = cvt_pk_bf16(s[6 * 65] * s1[2], s[7 * 65] * s1[3]);
        __builtin_nontemporal_store(o, (u32x4*)(it.WT + (size_t)(it.nd + n) * it.ldk + it.kd + 8 * c)); }
    asm volatile("s_waitcnt lgkmcnt(0)" ::: "memory");
}
constexpr int NIT_EXP = 8192 + 4096;
__device__ __forceinline__ TrItem exp_item(const Params& p, int r) {
    TrItem it;
    if (r < 8192) { const int up = r >> 12, qq = r & 4095, e = qq >> 8, kb = (qq & 255) >> 3, nb = qq & 7;
        it.W = p.in[up ? 17 : 16] + (size_t)e * D * DE; it.N = DE; it.WT = (bf16_t*)(p.ws + WS_W1T) + (size_t)e * 1024 * D; it.ldk = D;
        it.nd = 256 * (nb >> 1) + (nb & 1) * 64 + (up ? 128 : 0); it.kd = kb * 64; it.k0 = kb * 64; it.ns = nb * 64; it.ks = p.in[11]; }
    else { const int q = r - 8192, e = q >> 8, kb = (q & 255) >> 5, nb = q & 31;
        it.W = p.in[18] + (size_t)e * DE * D; it.N = D; it.WT = (bf16_t*)(p.ws + WS_W2T) + (size_t)e * D * DE; it.ldk = DE; it.nd = nb * 64; it.kd = kb * 64; it.k0 = kb * 64; it.ns = nb * 64; it.ks = nullptr; }
    return it;
}
__device__ __forceinline__ void convert_tail(const Params& p, LAS unsigned char* lds, int nunits) {
    const int tid = opaque_tid(), wave = __builtin_amdgcn_readfirstlane(tid >> 6), lane = tid & 63;
    const int G = gridDim.x, rounds = (nunits + G - 1) / G, nfull = nunits - (rounds - 1) * G;
    int idle_idx, n_idle;
    if (nfull >= G || nunits == 0) { idle_idx = blockIdx.x; n_idle = G; } else { idle_idx = (int)blockIdx.x - nfull; n_idle = G - nfull; }
    if (idle_idx < 0) return;
    LAS float* scr = (LAS float*)(lds + wave * TRS);
    const int stride = n_idle * NWAVES; int r = idle_idx * NWAVES + wave;
    if (r >= NIT_EXP) return;
    f32x4 va[16], vb[16];
    TrItem ia = exp_item(p, r), ib = ia;
    tr_load(va, ia, lane);
    for (;;) {
        const bool hb = (r + stride) < NIT_EXP;
        if (hb) { ib = exp_item(p, r + stride); tr_load(vb, ib, lane); }
        tr_store(va, ia, scr, lane);
        if (!hb) break;
        r += stride;
        const bool ha = (r + stride) < NIT_EXP;
        if (ha) { ia = exp_item(p, r + stride); tr_load(va, ia, lane); }
        tr_store(vb, ib, scr, lane);
        if (!ha) break;
        r += stride;
    }
}
__device__ __forceinline__ int win_src_col(int nd) {
    if (nd < 1024) return nd;
    if (nd < 3072) { const int q = (nd - 1024) >> 8, r = (nd - 1024) & 255; return r < 128 ? (1024 + 128 * q + r) : (2048 + 128 * q + r - 128); }
    if (nd < 5120) return nd;
    { const int q = (nd - 5120) >> 8, r = (nd - 5120) & 255; return r < 128 ? (5120 + 128 * q + r) : (7168 + 128 * q + r - 128); }
}
__device__ __forceinline__ void phase0(const Params& p, LAS unsigned char* lds) {
    const int tid = opaque_tid(), wave = __builtin_amdgcn_readfirstlane(tid >> 6), lane = tid & 63;
    LAS float* scr = (LAS float*)(lds + wave * TRS);
    const int gw = blockIdx.x * NWAVES + wave, NGW = gridDim.x * NWAVES;
    unsigned char* ws = p.ws;
    constexpr int I_IN = 32 * 144, I_UP = 16 * 32, I_OUT = 32 * 32;
    constexpr int NITEMS = I_IN + 2 * I_UP + I_OUT;
    for (int it = gw; it < NITEMS; it += NGW) {
        int r = it;
        if (r < I_IN) { const int kb = r / 144, nb = r % 144; tr_item64(p.in[2], NIN, kb * 64, win_src_col(nb * 64), (bf16_t*)(ws + WS_WINT), D, nb * 64, kb * 64, scr, lane, nullptr); continue; } r -= I_IN;
        if (r < I_UP) { const int kb = r / 32, nb = r % 32; tr_item64(p.in[8], D, kb * 64, nb * 64, (bf16_t*)(ws + WS_WUPT), 2048, nb * 64, kb * 64, scr, lane, nullptr); continue; } r -= I_UP;
        if (r < I_UP) { const int kb = r / 32, nb = r % 32; tr_item64(p.in[9], D, kb * 64, nb * 64, (bf16_t*)(ws + WS_WUPT), 2048, nb * 64, 1024 + kb * 64, scr, lane, nullptr); continue; } r -= I_UP;
        { const int kb = r / 32, nb = r % 32; tr_item64(p.in[10], D, kb * 64, nb * 64, (bf16_t*)(ws + WS_WOUTT), D, nb * 64, kb * 64, scr, lane, nullptr); }
    }
    const float* x = p.in[0]; const float* g = p.in[1]; bf16_t* xn = (bf16_t*)(ws + WS_X);
    for (int m = gw; m < T; m += NGW) {
        const f32x4* xr = (const f32x4*)(x + (size_t)m * D) + lane; f32x4 v[8]; float s = 0.f;
#pragma unroll
        for (int j = 0; j < 8; ++j) { v[j] = __builtin_nontemporal_load(xr + 64 * j); s += (v[j][0] * v[j][0] + v[j][1] * v[j][1]) + (v[j][2] * v[j][2] + v[j][3] * v[j][3]); }
        const float rs = 1.0f / sqrtf(wave_sum(s) * (1.0f / D) + EPS);
        u32x2* o = (u32x2*)(xn + (size_t)m * D) + lane;
#pragma unroll
        for (int j = 0; j < 8; ++j) { const f32x4 gg = *((const f32x4*)g + lane + 64 * j); u32x2 w; w.x = cvt_pk_bf16(v[j][0] * rs * gg[0], v[j][1] * rs * gg[1]); w.y = cvt_pk_bf16(v[j][2] * rs * gg[2], v[j][3] * rs * gg[3]); o[64 * j] = w; }
    }
    { bf16_t* wr = (bf16_t*)(ws + WS_WR); const float* gf = p.in[11];
      for (int i = blockIdx.x * NTHREADS + tid; i < 32 * D; i += gridDim.x * NTHREADS) { const int j = i / D, d = i % D; unsigned hi = 0, lo = 0;
          if (j < 20) { const float v = gf[d] * (j < 4 ? p.in[12][d * 4 + j] : p.in[14][d * 16 + (j - 4)]); hi = cvt_pk_bf16(v, 0.f) & 0xffffu; lo = cvt_pk_bf16(v - __uint_as_float(hi << 16), 0.f) & 0xffffu; }
          wr[(size_t)j * D + d] = (bf16_t)hi; wr[(size_t)(32 + j) * D + d] = (bf16_t)lo; } }
    { bf16_t* wmb = (bf16_t*)(ws + WS_WMB); const float* wsrc = p.in[6];
      for (int i = blockIdx.x * NTHREADS + tid; i < 8 * 128 * 128 / 2; i += gridDim.x * NTHREADS) { const int e0 = 2 * i, r = (e0 >> 7) & 127, c = e0 & 127; const bool ok = (r >= 64) || (c < 64);
          ((unsigned*)wmb)[i] = ok ? cvt_pk_bf16(wsrc[e0], wsrc[e0 + 1]) : 0u; } }
    if (blockIdx.x == 0 && tid < 64) ((int*)(ws + WS_CTL))[tid] = 0;
}

__device__ __forceinline__ void phase2_conv(const Params& p) {
    const bf16_t* Bc = (const bf16_t*)(p.ws + WS_P + P_BC); const bf16_t* P = (const bf16_t*)(p.ws + WS_P + P_P); bf16_t* Y = (bf16_t*)(p.ws + WS_X);
    const float* cw = p.in[3];
    for (int i = blockIdx.x * NTHREADS + opaque_tid(); i < (T / 8) * (CW / 8); i += gridDim.x * NTHREADS) {
        const int t0 = (i >> 7) * 8, c = (i & 127) * 8;
        u32x4 pr[10], br[8];
#pragma unroll
        for (int r = 0; r < 10; ++r) { const int t = t0 - 2 + r; pr[r] = (t >= 0) ? *(const u32x4*)(P + (size_t)t * CW + c) : (u32x4){0u, 0u, 0u, 0u}; }
#pragma unroll
        for (int r = 0; r < 8; ++r) br[r] = *(const u32x4*)(Bc + (size_t)(t0 + r) * CW + c);
        const f32x4 w0a = *(const f32x4*)(cw + c), w0b = *(const f32x4*)(cw + c + 4), w1a = *(const f32x4*)(cw + CW + c), w1b = *(const f32x4*)(cw + CW + c + 4),
                    w2a = *(const f32x4*)(cw + 2 * CW + c), w2b = *(const f32x4*)(cw + 2 * CW + c + 4);
#pragma unroll
        for (int r = 0; r < 8; ++r) {
            f32x4 p0a, p0b, p1a, p1b, p2a, p2b, ba, bb;
            unpack8(pr[r], p0a, p0b); unpack8(pr[r + 1], p1a, p1b); unpack8(pr[r + 2], p2a, p2b); unpack8(br[r], ba, bb);
            const f32x4 ya = ba * (w0a * p0a + w1a * p1a + w2a * p2a), yb = bb * (w0b * p0b + w1b * p1b + w2b * p2b);
            *(u32x4*)(Y + (size_t)(t0 + r) * 2048 + c) = pack8(ya, yb);
        }
    }
}
__device__ __forceinline__ void phase2_sgu(const Params& p, LAS unsigned char* lds) {
    const int tid = opaque_tid(), wave = __builtin_amdgcn_readfirstlane(tid >> 6), lane = tid & 63, fr = lane & 15, fq = lane >> 4;
    const bf16_t* U = (const bf16_t*)(p.ws + WS_P + P_U); const bf16_t* V = (const bf16_t*)(p.ws + WS_P + P_V); bf16_t* Y = (bf16_t*)(p.ws + WS_X);
    const bf16_t* WmB = (const bf16_t*)(p.ws + WS_WMB); const f32x2* VST = (const f32x2*)(p.ws + WS_SMALL + SM_VST);
    const float* lng = p.in[4]; const float* lnb = p.in[5]; const float* bs = p.in[7];
    LAS f32x2* st = (LAS f32x2*)lds;
    constexpr int VP = 272, VTB = 128 * VP;
    LAS unsigned char* vT = lds + 2048;
    const int G = gridDim.x;
    for (int u0 = blockIdx.x; u0 < 64 * 8; u0 += 2 * G) {
        const int u1 = u0 + G; const bool two = u1 < 64 * 8;
        __syncthreads();
        if (tid < 256 && (tid < 128 || two)) { const int uu = (tid < 128) ? u0 : u1; const int tk = (uu >> 3) * 128 + (tid & 127);
            const f32x4* ps = (const f32x4*)(VST + (size_t)tk * 16); float s = 0.f, q = 0.f;
#pragma unroll
            for (int i = 0; i < 8; ++i) { const f32x4 v = ps[i]; s += v[0] + v[2]; q += v[1] + v[3]; }
            const float mu = s * (1.0f / SW); const float var = fmaxf(q * (1.0f / SW) - mu * mu, 0.f);
            st[tid] = (f32x2){mu, 1.0f / sqrtf(var + EPS)}; }
        const int su = tid >> 8, sl = tid & 255, jb = sl >> 4, cb = sl & 15, j0 = jb * 8, cc0 = cb * 8;
        const int uu = su ? u1 : u0; const bool act = (su == 0) || two;
        const int t0 = (uu >> 3) * 128, c0 = (uu & 7) * 128;
        u32x4 raw[8];
        if (act) {
#pragma unroll
            for (int r = 0; r < 8; ++r) raw[r] = *(const u32x4*)(V + (size_t)(t0 + j0 + r) * SW + c0 + cc0); }
        __syncthreads();
        if (act) {
            const f32x4 g0 = *(const f32x4*)(lng + c0 + cc0), g1 = *(const f32x4*)(lng + c0 + cc0 + 4), b0 = *(const f32x4*)(lnb + c0 + cc0), b1 = *(const f32x4*)(lnb + c0 + cc0 + 4);
            f32x4 lo[8], hi[8];
#pragma unroll
            for (int r = 0; r < 8; ++r) { const f32x2 s = st[su * 128 + j0 + r]; f32x4 a, b; unpack8(raw[r], a, b);
                lo[r] = (a - s.x) * s.y * g0 + b0; hi[r] = (b - s.x) * s.y * g1 + b1; }
            LAS unsigned char* vt = vT + su * VTB;
#pragma unroll
            for (int cc = 0; cc < 4; ++cc) { u32x4 o;
                o.x = cvt_pk_bf16(lo[0][cc], lo[1][cc]); o.y = cvt_pk_bf16(lo[2][cc], lo[3][cc]); o.z = cvt_pk_bf16(lo[4][cc], lo[5][cc]); o.w = cvt_pk_bf16(lo[6][cc], lo[7][cc]);
                *(LAS u32x4*)(vt + (cc0 + cc) * VP + j0 * 2) = o;
                o.x = cvt_pk_bf16(hi[0][cc], hi[1][cc]); o.y = cvt_pk_bf16(hi[2][cc], hi[3][cc]); o.z = cvt_pk_bf16(hi[4][cc], hi[5][cc]); o.w = cvt_pk_bf16(hi[6][cc], hi[7][cc]);
                *(LAS u32x4*)(vt + (cc0 + 4 + cc) * VP + j0 * 2) = o; }
        }
        __syncthreads();
#pragma unroll
        for (int s2 = 0; s2 < 2; ++s2) {
            if (s2 == 1 && !two) break;
            const int ux = s2 ? u1 : u0; const int h = ux & 7, tt0 = (ux >> 3) * 128, cc = h * 128;
            LAS unsigned char* vt = vT + s2 * VTB;
            bf16x8 wf[4];
#pragma unroll
            for (int ks = 0; ks < 4; ++ks) wf[ks] = *(const bf16x8*)(WmB + ((size_t)h * 128 + wave * 16 + fr) * 128 + ks * 32 + fq * 8);
            const int i = wave * 16 + fr; const float bb = bs[h * 128 + i]; const size_t t = (size_t)(tt0 + i);
            u32x2 uv[8];
#pragma unroll
            for (int nk = 0; nk < 8; ++nk) uv[nk] = *(const u32x2*)(U + t * SW + cc + nk * 16 + 4 * fq);
            f32x4 acc[8];
#pragma unroll
            for (int nk = 0; nk < 8; ++nk) { acc[nk] = (f32x4){0.f, 0.f, 0.f, 0.f};
#pragma unroll
                for (int ks = 0; ks < 4; ++ks) { const bf16x8 vf = *(const LAS bf16x8*)(vt + (nk * 16 + fr) * VP + (ks * 32 + fq * 8) * 2);
                    acc[nk] = __builtin_amdgcn_mfma_f32_16x16x32_bf16(vf, wf[ks], acc[nk], 0, 0, 0); } }
#pragma unroll
            for (int nk = 0; nk < 8; ++nk) { const int c = cc + nk * 16 + 4 * fq; const u32x2 u2 = uv[nk];
                u32x2 o; o.x = cvt_pk_bf16(bf_lo(u2.x) * (acc[nk][0] + bb), bf_hi(u2.x) * (acc[nk][1] + bb)); o.y = cvt_pk_bf16(bf_lo(u2.y) * (acc[nk][2] + bb), bf_hi(u2.y) * (acc[nk][3] + bb));
                *(u32x2*)(Y + t * 2048 + 1024 + c) = o; }
        }
    }
}

__device__ __forceinline__ void phase5_router(const Params& p, LAS unsigned char* lds) {
    const int tid = opaque_tid(), wave = __builtin_amdgcn_readfirstlane(tid >> 6), lane = tid & 63, fr = lane & 15, fq = lane >> 4;
    const bf16_t* A2 = (const bf16_t*)(p.ws + WS_A2); const bf16_t* wr = (const bf16_t*)(p.ws + WS_WR);
    float* rstd = (float*)(p.ws + WS_SMALL + SM_RSTD); int* ent = (int*)(p.ws + WS_SMALL + SM_ENT); float* lw = (float*)(p.ws + WS_SMALL + SM_W); int* cnt = (int*)(p.ws + WS_CTL);
    const float* brg = p.in[13]; const float* bre = p.in[15];
    LAS float* part = (LAS float*)lds;
    LAS float* pss  = (LAS float*)(lds + 65536);
    LAS float* lg   = (LAS float*)(lds + 65536 + 1024);
    LAS float* lss  = (LAS float*)(lds + 65536 + 1024 + 2560);
    LAS int* lcnt  = (LAS int*)(lds + 70000);
    LAS int* lbase = (LAS int*)(lds + 70000 + 64);
    LAS int* le    = (LAS int*)(lds + 70000 + 128);
    LAS int* lp    = (LAS int*)(lds + 70000 + 128 + 256);
    LAS float* lwt = (LAS float*)(lds + 70000 + 128 + 512);
    for (int tile = blockIdx.x; tile < T / 32; tile += gridDim.x) {
        const int tok0 = tile * 32;
        __syncthreads();
        if (tid < 16) lcnt[tid] = 0;
        f32x4 acc[2][4]; float ss[2] = {0.f, 0.f};
#pragma unroll
        for (int m = 0; m < 2; ++m)
#pragma unroll
            for (int n = 0; n < 4; ++n) acc[m][n] = (f32x4){0.f, 0.f, 0.f, 0.f};
#pragma unroll 2
        for (int ks = 0; ks < 8; ++ks) {
            const int k = wave * 256 + ks * 32 + fq * 8;
            bf16x8 af[2], bfr[4];
#pragma unroll
            for (int m = 0; m < 2; ++m) af[m] = *(const bf16x8*)(A2 + (size_t)(tok0 + 16 * m + fr) * D + k);
#pragma unroll
            for (int n = 0; n < 4; ++n) bfr[n] = *(const bf16x8*)(wr + (size_t)(16 * n + fr) * D + k);
#pragma unroll
            for (int m = 0; m < 2; ++m) {
#pragma unroll
                for (int j = 0; j < 8; ++j) { const float v = bf1((bf16_t)af[m][j]); ss[m] += v * v; }
#pragma unroll
                for (int n = 0; n < 4; ++n) acc[m][n] = __builtin_amdgcn_mfma_f32_16x16x32_bf16(bfr[n], af[m], acc[m][n], 0, 0, 0);
            }
        }
#pragma unroll
        for (int m = 0; m < 2; ++m) { ss[m] += __shfl_xor(ss[m], 16); ss[m] += __shfl_xor(ss[m], 32);
            if (fq == 0) pss[wave * 32 + 16 * m + fr] = ss[m];
#pragma unroll
            for (int n = 0; n < 4; ++n) *(LAS f32x4*)(part + (wave * 32 + 16 * m + fr) * 64 + 16 * n + 4 * fq) = acc[m][n]; }
        __syncthreads();
        for (int i = tid; i < 32 * 20; i += NTHREADS) { const int t = i / 20, j = i % 20; float s = 0.f;
#pragma unroll
            for (int w = 0; w < 8; ++w) s += part[(w * 32 + t) * 64 + j] + part[(w * 32 + t) * 64 + 32 + j];
            lg[t * 20 + j] = s; }
        if (tid < 32) { float s = 0.f;
#pragma unroll
            for (int w = 0; w < 8; ++w) s += pss[w * 32 + tid];
            lss[tid] = s; }
        __syncthreads();
        if (tid < 32) {
            const int t = tid; const float rs = 1.0f / sqrtf(lss[t] * (1.0f / D) + EPS);
            float g4[4];
#pragma unroll
            for (int j = 0; j < 4; ++j) g4[j] = lg[t * 20 + j] * rs + brg[j];
            int gi = 0; float gm = g4[0];
#pragma unroll
            for (int j = 1; j < 4; ++j) if (g4[j] > gm) { gm = g4[j]; gi = j; }
            float den = 0.f;
#pragma unroll
            for (int j = 0; j < 4; ++j) den += __expf(g4[j] - gm);
            const float pg = 1.0f / den;
            float le4[4];
#pragma unroll
            for (int j = 0; j < 4; ++j) le4[j] = lg[t * 20 + 4 + gi * 4 + j] * rs + bre[gi * 4 + j];
            int i1 = 0; float m1 = le4[0];
#pragma unroll
            for (int j = 1; j < 4; ++j) if (le4[j] > m1) { m1 = le4[j]; i1 = j; }
            int i2 = -1; float m2 = -3.0e38f;
#pragma unroll
            for (int j = 0; j < 4; ++j) if (j != i1 && le4[j] > m2) { m2 = le4[j]; i2 = j; }
            const float ex = __expf(m2 - m1); const float w1 = pg / (1.0f + ex), w2 = pg * ex / (1.0f + ex);
            rstd[tok0 + t] = rs;
            const int e1 = gi * 4 + i1, e2 = gi * 4 + i2;
            le[2 * t] = e1; le[2 * t + 1] = e2; lwt[2 * t] = w1; lwt[2 * t + 1] = w2;
            lp[2 * t] = atomicAdd((int*)&lcnt[e1], 1); lp[2 * t + 1] = atomicAdd((int*)&lcnt[e2], 1);
        }
        __syncthreads();
        if (tid < 16) { const int n = lcnt[tid]; lbase[tid] = n ? atomicAdd(&cnt[tid], n) : 0; }
        __syncthreads();
        if (tid < 64) { const int e = le[tid]; const int pos = lbase[e] + lp[tid]; ent[e * T + pos] = (tok0 + (tid >> 1)) | ((tid & 1) << 16); lw[e * T + pos] = lwt[tid]; }
    }
}

__device__ __forceinline__ void phase8_final(const Params& p) {
    const int tid = opaque_tid(), wave = __builtin_amdgcn_readfirstlane(tid >> 6), lane = tid & 63;
    const bf16_t* A2 = (const bf16_t*)(p.ws + WS_A2); const bf16_t* Y0 = (const bf16_t*)(p.ws + WS_YK0); const bf16_t* Y1 = (const bf16_t*)(p.ws + WS_YK1); const float* g = p.in[19];
    const int gw = blockIdx.x * NWAVES + wave, NGW = gridDim.x * NWAVES;
    for (int m = gw; m < T; m += NGW) {
        f32x4 v[8]; float s = 0.f;
#pragma unroll
        for (int j = 0; j < 8; ++j) { const size_t o = (size_t)m * D + 4 * lane + 256 * j;
            const u32x2 hh = *(const u32x2*)(A2 + o), a = *(const u32x2*)(Y0 + o), b = *(const u32x2*)(Y1 + o);
            v[j][0] = bf_lo(hh.x) + (bf_lo(a.x) + bf_lo(b.x)); v[j][1] = bf_hi(hh.x) + (bf_hi(a.x) + bf_hi(b.x)); v[j][2] = bf_lo(hh.y) + (bf_lo(a.y) + bf_lo(b.y)); v[j][3] = bf_hi(hh.y) + (bf_hi(a.y) + bf_hi(b.y));
            s += (v[j][0] * v[j][0] + v[j][1] * v[j][1]) + (v[j][2] * v[j][2] + v[j][3] * v[j][3]); }
        const float rs = 1.0f / sqrtf(wave_sum(s) * (1.0f / D) + EPS);
#pragma unroll
        for (int j = 0; j < 8; ++j) { const int c = 4 * lane + 256 * j; const f32x4 gg = *(const f32x4*)(g + c); __builtin_nontemporal_store(v[j] * rs * gg, (f32x4*)(p.out + (size_t)m * D + c)); }
    }
}

#define XB_TMO      128
#define XB_XCNT(j)  (256  + 64 * (j))
#define XB_XSUB(j)  (1280 + 64 * (j))
#define XB_XGEN(j)  (2304 + 64 * (j))
#define XB_TOP      3328
#define XB_TOPGEN   3392
#define XCD_BAR_WORDS 3456
#define XB_SPIN_CAP (1u << 18)
__device__ __forceinline__ unsigned xb_ld(unsigned* p)              { return __hip_atomic_load(p, __ATOMIC_RELAXED, __HIP_MEMORY_SCOPE_AGENT); }
__device__ __forceinline__ unsigned xb_add(unsigned* p, unsigned v) { return __hip_atomic_fetch_add(p, v, __ATOMIC_RELAXED, __HIP_MEMORY_SCOPE_AGENT); }
__device__ __forceinline__ unsigned xb_xcc_id() { return (unsigned)__builtin_amdgcn_s_getreg((3 << 11) | 20) & 0xFu; }
#define XB_SPIN(cond, bar) do { unsigned _sp = 0; while (cond) { __builtin_amdgcn_s_sleep(1); \
    if ((++_sp & 255u) == 0u) { if (xb_ld(&(bar)[XB_TMO])) break; if (_sp > XB_SPIN_CAP) { atomicAdd(&(bar)[XB_TMO], 1u); break; } } } } while (0)
struct XcdBarrier { unsigned* bar; unsigned x; volatile LAS unsigned* st; };
__device__ __forceinline__ XcdBarrier xcd_barrier_post(unsigned* bar, volatile LAS unsigned* st) {
    XcdBarrier b; b.bar = bar; b.x = xb_xcc_id(); b.st = st;
    if (threadIdx.x == 0) (void)xb_add(&bar[XB_XCNT(b.x)], 1u);
    return b;
}
__device__ __forceinline__ void xcd_barrier_complete(unsigned* bar, unsigned x, unsigned& nloc, unsigned& nx) {
    const unsigned G = gridDim.x * gridDim.y * gridDim.z;
    unsigned sum, cnt, mine, sp = 0u;
    for (;;) {
        sum = 0u; cnt = 0u; mine = 0u;
#pragma unroll
        for (unsigned j = 0; j < 16; ++j) { const unsigned c = xb_ld(&bar[XB_XCNT(j)]); sum += c; cnt += (c > 0u) ? 1u : 0u; mine = (j == x) ? c : mine; }
        if (sum == G) break;
        __builtin_amdgcn_s_sleep(1);
        if ((++sp & 255u) == 0u) { if (xb_ld(&bar[XB_TMO])) break; if (sp > XB_SPIN_CAP) { atomicAdd(&bar[XB_TMO], 1u); break; } }
    }
    nloc = mine > 0u ? mine : 1u; nx = cnt > 0u ? cnt : 1u;
}
__device__ __forceinline__ void xcd_barrier(const XcdBarrier& b) {
    asm volatile("s_waitcnt vmcnt(0)" ::: "memory");
    __syncthreads();
    if (threadIdx.x == 0) {
        unsigned* bar = b.bar;
        __builtin_amdgcn_s_waitcnt(0);
        unsigned nloc = b.st[0], nx = b.st[1];
        if (nloc == 0u) { xcd_barrier_complete(bar, b.x, nloc, nx); b.st[0] = nloc; b.st[1] = nx; }
        const unsigned old = xb_add(&bar[XB_XSUB(b.x)], 1u);
        const unsigned gen = old / nloc;
        if (old + 1u == (gen + 1u) * nloc) {
            __builtin_amdgcn_fence(__ATOMIC_RELEASE, "agent");
            asm volatile("s_waitcnt vmcnt(0)" ::: "memory");
            const unsigned og = xb_add(&bar[XB_TOP], 1u);
            const unsigned tg = og / nx;
            if (og + 1u == (tg + 1u) * nx) xb_add(&bar[XB_TOPGEN], 1u);
            else XB_SPIN(xb_ld(&bar[XB_TOPGEN]) == tg, bar);
            __builtin_amdgcn_fence(__ATOMIC_ACQUIRE, "agent");
            xb_add(&bar[XB_XGEN(b.x)], 1u);
            asm volatile("s_waitcnt vmcnt(0)" ::: "memory");
        } else {
            XB_SPIN(xb_ld(&bar[XB_XGEN(b.x)]) == gen, bar);
            __builtin_amdgcn_fence(__ATOMIC_ACQUIRE, "agent");
            asm volatile("s_waitcnt vmcnt(0)" ::: "memory");
        }
    }
    __syncthreads();
}

template <int PH> __device__ __forceinline__ void run_phase(const Params& p, LAS unsigned char* lds) {
    unsigned char* ws = p.ws;
    if constexpr (PH == 0) phase0(p, lds);
    if constexpr (PH == 1) { DenseSched S; S.init((const bf16_t*)(ws + WS_X), (const bf16_t*)(ws + WS_WINT), T, NIN, D);
        EpiProj E{(bf16_t*)(ws + WS_P + P_BC), (bf16_t*)(ws + WS_P + P_P), (bf16_t*)(ws + WS_P + P_U), (bf16_t*)(ws + WS_P + P_V), (bf16_t*)(ws + WS_P + P_R), (bf16_t*)(ws + WS_P + P_S), (f32x2*)(ws + WS_SMALL + SM_VST)};
        gemm_run<0>(lds, S, E, D); convert_tail(p, lds, (T / 256) * (NIN / 256)); }
    if constexpr (PH == 2) { phase2_conv(p); phase2_sgu(p, lds); }
    if constexpr (PH == 3) { DenseSched S; S.init((const bf16_t*)(ws + WS_X), (const bf16_t*)(ws + WS_WUPT), T, D, 2048);
        EpiUp E{(const bf16_t*)(ws + WS_P + P_R), (const bf16_t*)(ws + WS_P + P_S), (bf16_t*)(ws + WS_MM)}; gemm_run<1>(lds, S, E, 2048); }
    if constexpr (PH == 4) { DenseSched S; S.init((const bf16_t*)(ws + WS_MM), (const bf16_t*)(ws + WS_WOUTT), T, D, D);
        EpiOut E{p.in[0], (bf16_t*)(ws + WS_A2)}; gemm_run<2>(lds, S, E, D); }
    if constexpr (PH == 5) phase5_router(p, lds);
    if constexpr (PH == 6 || PH == 7) {
        const int* cnt = (const int*)(ws + WS_CTL); const int* ent = (const int*)(ws + WS_SMALL + SM_ENT); const int G = gridDim.x, c = blockIdx.x;
        EpiMoe1 E1{ent, (const float*)(ws + WS_SMALL + SM_W), (const float*)(ws + WS_SMALL + SM_RSTD), (bf16_t*)(ws + WS_HID), false};
        EpiMoe2 E2{ent, (bf16_t*)(ws + WS_YK0), (bf16_t*)(ws + WS_YK1)};
        typedef MoeSched<true, 4, D, 1024> S1T; typedef MoeSched<false, 8, DE, D> S2T;
        constexpr int BIG = 1 << 20;
        unsigned* flags = (unsigned*)(ws + WS_FLAGS);
        int UA = 0, UH = 0; for (int e = 0; e < NE; ++e) { const int nt = (__builtin_amdgcn_readfirstlane(cnt[e]) + 255) >> 8; UA += min(nt, MOE_REG) * 4; UH += max(nt - MOE_REG, 0) * 4; }
        const bool fancy = (UA <= G) && (UH <= G / 2);
        if constexpr (PH == 6) {
            if (fancy) {
                E1.wt = true;
                { S1T S{(const bf16_t*)(ws + WS_A2), (const bf16_t*)(ws + WS_W1T), cnt, ent, 3, (c < UA) ? c : -1, 0, 1, (c < UH) ? UA + c : -1, flags, 1}; gemm_run<3>(lds, S, E1, D); }
                { S2T S{(const bf16_t*)(ws + WS_HID), (const bf16_t*)(ws + WS_W2T), cnt, ent, 3, (c >= UH) ? c - UH : -1, G - UH, BIG, -1, flags, 2}; gemm_run<4>(lds, S, E2, DE); }
            } else { S1T S{(const bf16_t*)(ws + WS_A2), (const bf16_t*)(ws + WS_W1T), cnt, ent, 2, c, G, BIG, -1, flags, 0}; gemm_run<3>(lds, S, E1, D); }
        }
        if constexpr (PH == 7) { S2T S{(const bf16_t*)(ws + WS_HID), (const bf16_t*)(ws + WS_W2T), cnt, ent, 2, c, G, BIG, -1, flags, 0}; gemm_run<4>(lds, S, E2, DE); }
    }
    if constexpr (PH == 8) phase8_final(p);
}

template <int PH> __global__ void __launch_bounds__(NTHREADS, 2) k_phase(Params p) {
    extern __shared__ __attribute__((aligned(16))) unsigned char lds_raw[];
    run_phase<PH>(p, (LAS unsigned char*)lds_raw);
}

#ifndef PROBE_DUP
#define PROBE_DUP 0
#endif
#ifndef PROBE_SYNCS
#define PROBE_SYNCS 0
#endif
#define DUP(k) ((PROBE_DUP >> (k)) & 1)
#ifndef PROBE_T
#define PROBE_T (-1)
#endif
#ifndef PROBE_MULT
#define PROBE_MULT 4
#endif
typedef const __attribute__((address_space(4))) Params* KParamsPtr;
__device__ __forceinline__ Params load_params() {
    Params r{};
#if defined(__HIP_DEVICE_COMPILE__)
    unsigned long long v = (unsigned long long)__builtin_amdgcn_kernarg_segment_ptr(); asm volatile("" : "+s"(v));
    const __attribute__((address_space(4))) unsigned long long* q = (const __attribute__((address_space(4))) unsigned long long*)v;
#pragma unroll
    for (int i = 0; i < 20; ++i) r.in[i] = (const float*)(const __attribute__((address_space(1))) float*)q[i];
    r.out = (float*)(__attribute__((address_space(1))) float*)q[20]; r.ws = (unsigned char*)(__attribute__((address_space(1))) unsigned char*)q[21];
#endif
    return r;
}
#define RUN(k) do { const Params pk = load_params(); run_phase<k>(pk, lds); } while (0)
__global__ void __launch_bounds__(NTHREADS, 2) k_mega(Params p) {
    extern __shared__ __attribute__((aligned(16))) unsigned char lds_raw[];
    LAS unsigned char* lds = (LAS unsigned char*)lds_raw;
    cg::grid_group grid = cg::this_grid();
    volatile LAS unsigned* xbst = (volatile LAS unsigned*)(lds + LDS_BYTES - 64);
    if (threadIdx.x < 4) xbst[threadIdx.x] = 0u;
    __syncthreads();
    const XcdBarrier bar = xcd_barrier_post((unsigned*)(p.ws + WS_BAR), xbst);
    volatile LAS unsigned long long* stamps = (volatile LAS unsigned long long*)(lds + LDS_BYTES - 256);
    int nstamp = 0;
#define STAMP() do { if (PROBE_T >= 0 && blockIdx.x == 0 && threadIdx.x == 0) stamps[nstamp] = __builtin_amdgcn_s_memrealtime(); ++nstamp; } while (0)
#define GSYNC() do { xcd_barrier(bar); STAMP(); } while (0)
    STAMP();
    if (p.ws == nullptr) grid.sync();
    RUN(0); GSYNC();
    if (DUP(0)) { RUN(0); GSYNC(); }
    RUN(1); GSYNC();
    if (DUP(1)) { RUN(1); GSYNC(); }
    RUN(2); GSYNC();
    if (DUP(2)) { RUN(2); GSYNC(); }
    RUN(3); GSYNC();
    if (DUP(3)) { RUN(3); GSYNC(); }
    RUN(4); GSYNC();
    if (DUP(4)) { RUN(4); GSYNC(); }
    RUN(5); GSYNC();
    if (DUP(5)) { if (blockIdx.x == 0 && threadIdx.x < 16) ((int*)(load_params().ws + WS_CTL))[threadIdx.x] = 0; GSYNC(); RUN(5); GSYNC(); }
    RUN(6); GSYNC();
    if (DUP(6)) { RUN(6); GSYNC(); }
    { const int* cnt = (const int*)(load_params().ws + WS_CTL); int UA = 0, UH = 0;
      for (int e = 0; e < NE; ++e) { const int nt = (__builtin_amdgcn_readfirstlane(cnt[e]) + 255) >> 8; UA += min(nt, MOE_REG) * 4; UH += max(nt - MOE_REG, 0) * 4; }
      if (!((UA <= (int)gridDim.x) && (UH <= (int)gridDim.x / 2))) { RUN(7); GSYNC(); } }
    for (int i = 0; i < PROBE_SYNCS; ++i) GSYNC();
    RUN(8);
    if (DUP(8)) { GSYNC(); RUN(8); }
    if (PROBE_T >= 0) { __syncthreads(); STAMP();
        if (blockIdx.x == 0 && threadIdx.x == 0) { const unsigned long long d = (stamps[PROBE_T + 1] - stamps[PROBE_T]) * PROBE_MULT; const unsigned long long t0 = __builtin_amdgcn_s_memrealtime();
            while (__builtin_amdgcn_s_memrealtime() - t0 < d) __builtin_amdgcn_s_sleep(8); } }
}

template <int PH> static void launch_phase(const Params& p, int grid, hipStream_t stream) {
    static bool attr = false;
    if (!attr) { (void)hipFuncSetAttribute((const void*)k_phase<PH>, hipFuncAttributeMaxDynamicSharedMemorySize, LDS_BYTES); attr = true; }
    hipLaunchKernelGGL(k_phase<PH>, dim3(grid), dim3(NTHREADS), LDS_BYTES, stream, p);
}

extern "C" void kernel_launch(void* const* d_in, const int* in_sizes, int n_in, void* d_out, int out_size, void* d_ws, size_t ws_size, hipStream_t stream) {
    static int grid = 0;
    if (grid == 0) {
        if (n_in != 20 || out_size != T * D || ws_size < WS_END) { fprintf(stderr, "kernel_launch: unexpected shapes n_in %d out %d ws %zu (need %zu)\n", n_in, out_size, ws_size, (size_t)WS_END); grid = -1; return; }
        int dev = 0, cus = 0, per_cu = 0;
        (void)hipGetDevice(&dev); (void)hipDeviceGetAttribute(&cus, hipDeviceAttributeMultiprocessorCount, dev);
        (void)hipFuncSetAttribute((const void*)k_mega, hipFuncAttributeMaxDynamicSharedMemorySize, LDS_BYTES);
        (void)hipOccupancyMaxActiveBlocksPerMultiprocessor(&per_cu, (const void*)k_mega, NTHREADS, LDS_BYTES);
        if (per_cu < 1) { fprintf(stderr, "kernel_launch: occupancy query says %d blocks per CU\n", per_cu); per_cu = 1; }
        grid = cus * 1;
        (void)hipGetLastError();
    }
    if (grid < 0) return;
    Params p{};
    for (int i = 0; i < 20; ++i) p.in[i] = (const float*)d_in[i];
    p.out = (float*)d_out; p.ws = (unsigned char*)d_ws;
    (void)hipMemsetAsync((char*)d_ws + WS_CTL, 0, 64 * 1024, stream);
#if ONE_LAUNCH
    void* args[] = {&p};
    hipError_t e = hipLaunchCooperativeKernel((const void*)k_mega, dim3(grid), dim3(NTHREADS), args, LDS_BYTES, stream);
    if (e != hipSuccess) fprintf(stderr, "cooperative launch failed: %s (grid %d)\n", hipGetErrorString(e), grid);
#else
    launch_phase<0>(p, grid, stream); launch_phase<1>(p, grid, stream); launch_phase<2>(p, grid, stream); launch_phase<3>(p, grid, stream); launch_phase<4>(p, grid, stream);
    launch_phase<5>(p, grid, stream); launch_phase<6>(p, grid, stream); launch_phase<7>(p, grid, stream); launch_phase<8>(p, grid, stream);
#endif
}
```

```cpp
#include <hip/hip_runtime.h>
#include <hip/hip_cooperative_groups.h>
#include <cstdio>
#include <cstdint>
namespace cg = cooperative_groups;

#ifndef ONE_LAUNCH
#define ONE_LAUNCH 1
#endif

#define LAS __attribute__((address_space(3)))
#ifndef MOE_FP8
#define MOE_FP8 1
#endif
typedef unsigned short bf16_t;
typedef short bf16x8 __attribute__((ext_vector_type(8)));
typedef float f32x4 __attribute__((ext_vector_type(4)));
typedef float f32x2 __attribute__((ext_vector_type(2)));
typedef unsigned u32x4 __attribute__((ext_vector_type(4)));
typedef unsigned u32x2 __attribute__((ext_vector_type(2)));
typedef int i32x8 __attribute__((ext_vector_type(8)));
typedef int i32x4_t __attribute__((ext_vector_type(4)));
constexpr int EBM = MOE_FP8 ? 1 : 2;
constexpr float FSX = 32.f, FSW = 128.f;
constexpr float FS1 = 64.f, FS2 = 32.f, FSH = 16.f;

constexpr int T = 8192, D = 2048, CW = 1024, SW = 1024, NIN = 9216, NE = 16, DE = 512;
constexpr float EPS = 1e-6f;
constexpr int NTHREADS = 512, NWAVES = 8;
constexpr int LDS_BYTES = 140 * 1024;
constexpr int HID_ROWS = 2 * T + NE * 256;

constexpr size_t MiB = 1024 * 1024;
constexpr size_t WS_CTL   = 0;
constexpr size_t WS_BAR   = 4096;
constexpr size_t WS_FLAGS = 32768;
constexpr size_t WS_SMALL = 64 * 1024;
constexpr size_t SM_RSTD = 0, SM_ENT = 32 * 1024, SM_W = SM_ENT + (size_t)NE * T * 4, SM_VST = SM_W + (size_t)NE * T * 4, SM_RS1 = SM_VST + (size_t)T * 16 * 8, SM_END = SM_RS1 + (size_t)T * 4;
constexpr size_t WS_WR    = WS_SMALL + 4 * MiB;
constexpr size_t WS_WMB   = WS_WR + 256 * 1024;
constexpr size_t WS_WINT  = WS_WMB + 256 * 1024;
constexpr size_t WS_WUPT  = WS_WINT + (size_t)NIN * D * 2;
constexpr size_t WS_WOUTT = WS_WUPT + (size_t)D * D * 2;
constexpr size_t WS_W1T   = WS_WOUTT + (size_t)D * D * 2;
constexpr size_t WS_W2T   = WS_W1T + (size_t)NE * 1024 * D * 2;
constexpr size_t WS_X     = WS_W2T + (size_t)NE * D * DE * 2;
constexpr size_t WS_P     = WS_X + (size_t)T * D * 2;
constexpr size_t P_BC = 0, P_P = P_BC + (size_t)T * CW * 2, P_U = P_P + (size_t)T * CW * 2, P_V = P_U + (size_t)T * SW * 2,
                 P_R = P_V + (size_t)T * SW * 2, P_S = P_R + (size_t)T * D * 2, P_END = P_S + (size_t)T * D * 2;
constexpr size_t WS_Y     = WS_P + P_END;
constexpr size_t WS_END   = WS_Y + (size_t)T * 2048 * 2;
constexpr size_t WS_WIN8 = WS_WINT + (size_t)5120 * D * 2;
constexpr size_t WS_XN8  = WS_Y;
constexpr size_t WS_MM  = WS_WINT;
constexpr size_t WS_H   = WS_P + P_BC;
constexpr size_t WS_A2  = WS_P + P_R;
constexpr size_t WS_HID = WS_P + P_S;
constexpr size_t WS_YK0 = WS_X;
constexpr size_t WS_A8  = WS_Y;
constexpr size_t WS_YK1 = WS_WINT;
static_assert(SM_END <= 4 * MiB, "small region");
static_assert((size_t)HID_ROWS * DE * 2 <= (size_t)T * D * 2, "hid overlay");
static_assert((size_t)T * D * 4 <= P_R, "H overlay");

struct Params { const float* in[20]; float* out; unsigned char* ws; };

__device__ __forceinline__ unsigned cvt_pk_bf16(float lo, float hi) { unsigned r; asm("v_cvt_pk_bf16_f32 %0, %1, %2" : "=v"(r) : "v"(lo), "v"(hi)); return r; }
__device__ __forceinline__ unsigned pk4_fp8(f32x4 v) { int w = 0; w = __builtin_amdgcn_cvt_pk_fp8_f32(v[0], v[1], w, false); w = __builtin_amdgcn_cvt_pk_fp8_f32(v[2], v[3], w, true); return (unsigned)w; }
__device__ __forceinline__ f32x4 clamp_fp8(f32x4 v) { f32x4 r; for (int j = 0; j < 4; ++j) r[j] = fminf(fmaxf(v[j], -448.f), 448.f); return r; }
__device__ __forceinline__ float bf_lo(unsigned w) { return __uint_as_float(w << 16); }
__device__ __forceinline__ float bf_hi(unsigned w) { return __uint_as_float(w & 0xffff0000u); }
__device__ __forceinline__ float bf1(bf16_t b) { return __uint_as_float(((unsigned)b) << 16); }
__device__ __forceinline__ float wave_sum(float v) {
#pragma unroll
    for (int o = 1; o < 64; o <<= 1) v += __shfl_xor(v, o);
    return v;
}
__device__ __forceinline__ float fast_rcp(float x) { return __builtin_amdgcn_rcpf(x); }
__device__ __forceinline__ float fast_exp2(float x) { return __builtin_amdgcn_exp2f(x); }
__device__ __forceinline__ float sigmoid_f(float x) { return fast_rcp(1.0f + fast_exp2(-1.44269504f * x)); }
__device__ __forceinline__ float gelu_tanh(float x) {
    const float u = x + 0.044715f * x * x * x;
    return x * fast_rcp(1.0f + fast_exp2(-2.30220819f * u));
}
__device__ __forceinline__ int opaque_tid() { int t = threadIdx.x; asm volatile("" : "+v"(t)); return t; }
__device__ __forceinline__ void st16_wt(void* p, u32x4 v) { asm volatile("global_store_dwordx4 %0, %1, off sc1\n\ts_nop 1" :: "v"(p), "v"(v) : "memory"); }
__device__ __forceinline__ void st8_wt(void* p, u32x2 v) { asm volatile("global_store_dwordx2 %0, %1, off sc1\n\ts_nop 1" :: "v"(p), "v"(v) : "memory"); }
__host__ __device__ __forceinline__ int perm32(int rho) { const int n = rho >> 4, i = rho & 15; return 8 * (i >> 2) + 4 * n + (i & 3); }

struct Unit { int pm, pn, e, row0, nvalid; };
constexpr int NXCD = 8, WGM = 2;
template <int EB_> struct DenseSchedT {
    static constexpr bool DYN_HALF = false; static constexpr int EB = EB_; static constexpr int A_AUX = 0;
    __device__ __forceinline__ void a_ready(const Unit&) const {}
    __device__ __forceinline__ void done(const Unit&) const {}
    const bf16_t* A; const bf16_t* Bt; int K; int nM, nN, nwg, G, c;
    __device__ __forceinline__ void init(const bf16_t* A_, const bf16_t* Bt_, int M, int N, int K_) { A = A_; Bt = Bt_; K = K_; nM = M / 256; nN = N / 256; nwg = nM * nN; G = gridDim.x; c = blockIdx.x; }
    __device__ __forceinline__ bool next(int i, Unit& u) const {
        const long L = (long)i * G + c; if (L >= nwg) return false;
        int wgid = (int)L; { const int q = nwg / NXCD, r = nwg % NXCD, xcd = wgid % NXCD, off = wgid / NXCD; wgid = (xcd < r ? xcd * (q + 1) : r * (q + 1) + (xcd - r) * q) + off; }
        const int nig = WGM * nN, gid = wgid / nig, fm = gid * WGM, gsz = (nM - fm) < WGM ? (nM - fm) : WGM;
        u.pm = fm + ((wgid % nig) % gsz); u.pn = (wgid % nig) / gsz; u.e = 0; u.row0 = u.pm * 256; u.nvalid = 256; return true;
    }
    __device__ __forceinline__ const char* a_base() const { return (const char*)A; }
    __device__ __forceinline__ unsigned a_off(const Unit& u, int r) const { return (unsigned)(u.row0 + r) * (unsigned)K * (unsigned)EB_; }
    __device__ __forceinline__ const char* b_base(const Unit& u) const { return (const char*)Bt + (size_t)u.pn * 256 * K * EB_; }
};
typedef DenseSchedT<2> DenseSched;
constexpr int MOE_REG = 4;
template <bool GATHER, int NPN, int KK, int NROWS_E  , int EB_  >
struct MoeSched {
    static constexpr bool DYN_HALF = true; static constexpr int EB = EB_;
    static constexpr int A_AUX = GATHER ? 0 : 16;
    const bf16_t* A; const bf16_t* Bt; const int* cnt; const int* ent;
    int mode;
    int idx, stride, maxi;
    int idx1;
    unsigned* flags; int role;
    __device__ __forceinline__ bool lookup(int L, int md, Unit& u) const {
        int hb = 0;
        for (int e = 0; e < NE; ++e) {
            const int n = __builtin_amdgcn_readfirstlane(cnt[e]); const int nt = (n + 255) >> 8;
            const int lo = (md == 1) ? min(nt, MOE_REG) : 0, hi = (md == 0) ? min(nt, MOE_REG) : nt;
            const int nsel = (hi - lo) * NPN;
            if (L < nsel) { u.e = e; u.pm = lo + L / NPN; u.pn = L % NPN; u.row0 = hb + u.pm * 256; u.nvalid = min(256, n - u.pm * 256); return true; }
            L -= nsel; hb += nt * 256;
        }
        return false;
    }
    __device__ __forceinline__ bool next(int i, Unit& u) const {
        int L;
        const int n0 = (idx >= 0) ? maxi : 0;
        if (i < n0) L = idx + i * stride; else if (i == n0 && idx1 >= 0) L = idx1; else return false;
        if (mode != 3) return lookup(L, mode, u);
        int nreg = 0; for (int e = 0; e < NE; ++e) nreg += min((__builtin_amdgcn_readfirstlane(cnt[e]) + 255) >> 8, MOE_REG) * NPN;
        return (L < nreg) ? lookup(L, 0, u) : lookup(L - nreg, 1, u);
    }
    __device__ __forceinline__ const char* a_base() const { return (const char*)A; }
    __device__ __forceinline__ unsigned a_off(const Unit& u, int r) const {
        if (GATHER) { const int tok = (r < u.nvalid) ? (ent[u.e * T + u.pm * 256 + r] & 0xffff) : 0; return (unsigned)tok * (unsigned)(KK * EB_); }
        return (unsigned)(u.row0 + r) * (unsigned)(KK * EB_);
    }
    __device__ __forceinline__ const char* b_base(const Unit& u) const { return (const char*)Bt + ((size_t)u.e * NROWS_E + (size_t)u.pn * 256) * KK * EB_; }
    __device__ __forceinline__ void a_ready(const Unit& u) const {
        if (role != 2) return;
        if (threadIdx.x < 64) {
            unsigned* f = flags + (u.row0 >> 8) * 64; unsigned spins = 0;
            while ((unsigned)__builtin_amdgcn_readfirstlane(__hip_atomic_load(f, __ATOMIC_RELAXED, __HIP_MEMORY_SCOPE_AGENT)) < 32u) { __builtin_amdgcn_s_sleep(2); if (++spins > (1u << 22)) break; }
        }
        asm volatile("" ::: "memory"); __builtin_amdgcn_s_barrier(); asm volatile("" ::: "memory");
    }
    __device__ __forceinline__ void done(const Unit& u) const {
        if (role != 1) return;
        asm volatile("s_waitcnt vmcnt(0)" ::: "memory");
        if ((threadIdx.x & 63) == 0) __hip_atomic_fetch_add(flags + (u.row0 >> 8) * 64, 1u, __ATOMIC_RELAXED, __HIP_MEMORY_SCOPE_AGENT);
    }
};
__device__ __forceinline__ int moe_overflow_tiles(const int* cnt) { int t = 0; for (int e = 0; e < NE; ++e) { const int nt = (__builtin_amdgcn_readfirstlane(cnt[e]) + 255) >> 8; t += max(nt - MOE_REG, 0); } return t; }

typedef f32x4 Acc[2][2][4][2];
__device__ __forceinline__ u32x4 pack8(f32x4 a, f32x4 b) { u32x4 w; w.x = cvt_pk_bf16(a[0], a[1]); w.y = cvt_pk_bf16(a[2], a[3]); w.z = cvt_pk_bf16(b[0], b[1]); w.w = cvt_pk_bf16(b[2], b[3]); return w; }
__device__ __forceinline__ void unpack8(u32x4 w, f32x4& a, f32x4& b) { a = (f32x4){bf_lo(w.x), bf_hi(w.x), bf_lo(w.y), bf_hi(w.y)}; b = (f32x4){bf_lo(w.z), bf_hi(w.z), bf_lo(w.w), bf_hi(w.w)}; }

struct EpiProj {
    static constexpr bool PERM = true; static constexpr int MIDK = 0;
    bf16_t *Bc, *P, *U, *V, *R, *S; f32x2* VST; int pn0; float nls;
    __device__ __forceinline__ void mid(Acc&, const Unit&, int, int, int, int) const {}
    __device__ __forceinline__ void operator()(const Acc& acc, const Unit& u, int wr, int wc, int fr, int fq) const {
        const int pn = u.pn + pn0; const int rowb = u.row0 + wr * 64 + fr; const int cl = wc * 32 + 8 * fq;
#pragma unroll
        for (int ai = 0; ai < 2; ++ai)
#pragma unroll
            for (int m = 0; m < 4; ++m) {
                const size_t row = (size_t)(rowb + ai * 128 + m * 16);
                if (pn < 4) {
#pragma unroll
                    for (int bj = 0; bj < 2; ++bj) *(u32x4*)(Bc + row * CW + pn * 256 + bj * 128 + cl) = pack8(acc[ai][bj][m][0], acc[ai][bj][m][1]);
                } else if (pn < 12) {
                    *(u32x4*)(P + row * CW + (pn - 4) * 128 + cl) = pack8(acc[ai][0][m][0] * acc[ai][1][m][0], acc[ai][0][m][1] * acc[ai][1][m][1]);
                } else if (pn < 20) {
                    bf16_t* O = (pn < 16) ? (U + row * SW + (pn - 12) * 256) : (V + row * SW + (pn - 16) * 256);
                    float ssum = 0.f, ssq = 0.f;
#pragma unroll
                    for (int bj = 0; bj < 2; ++bj) { f32x4 a = acc[ai][bj][m][0], b = acc[ai][bj][m][1];
#pragma unroll
                        for (int j = 0; j < 4; ++j) { a[j] = gelu_tanh(a[j]); b[j] = gelu_tanh(b[j]); ssum += a[j] + b[j]; ssq += a[j] * a[j] + b[j] * b[j]; }
                        *(u32x4*)(O + bj * 128 + cl) = pack8(a, b); }
                    if (pn >= 16) {
                        ssum += __shfl_xor(ssum, 16); ssum += __shfl_xor(ssum, 32); ssq += __shfl_xor(ssq, 16); ssq += __shfl_xor(ssq, 32);
                        if (fq == 0) VST[row * 16 + (pn - 16) * 4 + wc] = (f32x2){ssum, ssq}; }
                } else {
                    f32x4 r0, r1, s0, s1;
#pragma unroll
                    for (int j = 0; j < 4; ++j) {
                        const float ec0 = fast_exp2(fminf(nls * acc[ai][0][m][0][j], 80.f)), es0 = fast_exp2(fminf(nls * acc[ai][1][m][0][j], 80.f));
                        const float ec1 = fast_exp2(fminf(nls * acc[ai][0][m][1][j], 80.f)), es1 = fast_exp2(fminf(nls * acc[ai][1][m][1][j], 80.f));
                        r0[j] = (1.0f + es0) * fast_rcp(1.0f + ec0); s0[j] = fast_rcp(1.0f + es0);
                        r1[j] = (1.0f + es1) * fast_rcp(1.0f + ec1); s1[j] = fast_rcp(1.0f + es1);
                    }
                    const size_t o = row * D + (pn - 20) * 128 + cl;
                    *(u32x4*)(R + o) = pack8(r0, r1); *(u32x4*)(S + o) = pack8(s0, s1);
                }
            }
    }
};
struct EpiUp {
    static constexpr bool PERM = true; static constexpr int MIDK = 1024;
    const bf16_t *R, *S; bf16_t* Mm;
    __device__ __forceinline__ void mid(Acc& acc, const Unit& u, int wr, int wc, int fr, int fq) const {
        int rowb = u.row0 + wr * 64 + fr; const int cb = u.pn * 256 + wc * 32 + 8 * fq;
        asm volatile("" : "+v"(rowb));
#pragma unroll
        for (int ai = 0; ai < 2; ++ai)
#pragma unroll
            for (int m = 0; m < 4; ++m)
#pragma unroll
                for (int bj = 0; bj < 2; ++bj) { f32x4 a, b; unpack8(*(const u32x4*)(R + (size_t)(rowb + ai * 128 + m * 16) * D + cb + bj * 128), a, b);
                    acc[ai][bj][m][0] *= a; acc[ai][bj][m][1] *= b; }
    }
    __device__ __forceinline__ void operator()(const Acc& acc, const Unit& u, int wr, int wc, int fr, int fq) const {
        const int rowb = u.row0 + wr * 64 + fr; const int cb = u.pn * 256 + wc * 32 + 8 * fq;
#pragma unroll
        for (int ai = 0; ai < 2; ++ai)
#pragma unroll
            for (int m = 0; m < 4; ++m)
#pragma unroll
                for (int bj = 0; bj < 2; ++bj) { const size_t o = (size_t)(rowb + ai * 128 + m * 16) * D + cb + bj * 128; f32x4 a, b; unpack8(*(const u32x4*)(S + o), a, b);
                    *(u32x4*)(Mm + o) = pack8(acc[ai][bj][m][0] * a, acc[ai][bj][m][1] * b); }
    }
};
struct EpiOut {
    static constexpr bool PERM = true; static constexpr int MIDK = 0;
    const bf16_t* xn; const float* g; const float* irs; bf16_t* A2; unsigned char* A8;
    __device__ __forceinline__ void mid(Acc&, const Unit&, int, int, int, int) const {}
    __device__ __forceinline__ void operator()(const Acc& acc, const Unit& u, int wr, int wc, int fr, int fq) const {
        const int rowb = u.row0 + wr * 64 + fr; const int cb = u.pn * 256 + wc * 32 + 8 * fq;
        f32x4 ig[2][2];
#pragma unroll
        for (int bj = 0; bj < 2; ++bj)
#pragma unroll
            for (int n = 0; n < 2; ++n) { const f32x4 gg = *(const f32x4*)(g + cb + bj * 128 + 4 * n);
#pragma unroll
                for (int j = 0; j < 4; ++j) ig[bj][n][j] = fast_rcp(gg[j]); }
#pragma unroll
        for (int ai = 0; ai < 2; ++ai)
#pragma unroll
            for (int m = 0; m < 4; ++m) { const int row = rowb + ai * 128 + m * 16; const float ir = irs[row];
#pragma unroll
                for (int bj = 0; bj < 2; ++bj) { const size_t o = (size_t)row * D + cb + bj * 128;
                    f32x4 x0, x1; unpack8(*(const u32x4*)(xn + o), x0, x1);
                    const f32x4 h0 = x0 * ir * ig[bj][0] + acc[ai][bj][m][0], h1 = x1 * ir * ig[bj][1] + acc[ai][bj][m][1];
                    *(u32x4*)(A2 + o) = pack8(h0, h1); } }
    }
};
struct EpiMoe1 {
    static constexpr bool PERM = true; static constexpr int MIDK = 0;
    const int* ent; const float* lw; const float* rstd; bf16_t* Hid; bool wt;
    __device__ __forceinline__ void mid(Acc&, const Unit&, int, int, int, int) const {}
    __device__ __forceinline__ void operator()(const Acc& acc, const Unit& u, int wr, int wc, int fr, int fq) const {
        const int cl = u.pn * 128 + wc * 32 + 8 * fq;
#pragma unroll
        for (int ai = 0; ai < 2; ++ai)
#pragma unroll
            for (int m = 0; m < 4; ++m) {
                const int r = ai * 128 + wr * 64 + m * 16 + fr;
                if (r < u.nvalid) {
                    const int li = u.e * T + u.pm * 256 + r; const int tok = ent[li] & 0xffff; const float rs = rstd[tok] * (MOE_FP8 ? 1.0f / FS1 : 1.0f), w = lw[li] * (MOE_FP8 ? FSH : 1.0f);
                    f32x4 o[2];
#pragma unroll
                    for (int n = 0; n < 2; ++n)
#pragma unroll
                        for (int j = 0; j < 4; ++j) { const float gt = acc[ai][0][m][n][j] * rs, up = acc[ai][1][m][n][j] * rs; o[n][j] = gt * sigmoid_f(gt) * up * w; }
                    if (MOE_FP8) { u32x2 q; q.x = pk4_fp8(clamp_fp8(o[0])); q.y = pk4_fp8(clamp_fp8(o[1])); unsigned char* d8 = (unsigned char*)Hid + (size_t)(u.row0 + r) * DE + cl; if (wt) st8_wt(d8, q); else *(u32x2*)d8 = q; } else {
                    bf16_t* dst = Hid + (size_t)(u.row0 + r) * DE + cl; if (wt) st16_wt(dst, pack8(o[0], o[1])); else *(u32x4*)dst = pack8(o[0], o[1]); }
                }
            }
    }
};
struct EpiMoe2 {
    static constexpr bool PERM = true; static constexpr int MIDK = 0;
    const int* ent; bf16_t* Yk0; bf16_t* Yk1;
    __device__ __forceinline__ void mid(Acc&, const Unit&, int, int, int, int) const {}
    __device__ __forceinline__ void operator()(const Acc& acc, const Unit& u, int wr, int wc, int fr, int fq) const {
        const int cb = u.pn * 256 + wc * 32 + 8 * fq;
#pragma unroll
        for (int ai = 0; ai < 2; ++ai)
#pragma unroll
            for (int m = 0; m < 4; ++m) {
                const int r = ai * 128 + wr * 64 + m * 16 + fr;
                if (r < u.nvalid) {
                    const int en = ent[u.e * T + u.pm * 256 + r]; const int tok = en & 0xffff; bf16_t* Y = (en >> 16) ? Yk1 : Yk0;
#pragma unroll
                    for (int bj = 0; bj < 2; ++bj) { constexpr float us = MOE_FP8 ? 1.0f / (FSH * FS2) : 1.0f; *(u32x4*)(Y + (size_t)tok * D + cb + bj * 128) = pack8(acc[ai][bj][m][0] * us, acc[ai][bj][m][1] * us); }
                }
            }
    }
};

template <class Epi, class Sched>
__device__ __forceinline__ void gemm_simple(const Sched& S, const Epi& E, const int K) {
    const int tid = opaque_tid(), wid = __builtin_amdgcn_readfirstlane(tid >> 6), lane = tid & 63, wr = wid >> 2, wc = wid & 3, fr = lane & 15, fq = lane >> 4;
    Unit u;
    for (int ui = 0; S.next(ui, u); ++ui) {
        Acc acc;
#pragma unroll
        for (int a = 0; a < 2; ++a)
#pragma unroll
            for (int b = 0; b < 2; ++b)
#pragma unroll
                for (int m = 0; m < 4; ++m)
#pragma unroll
                    for (int n = 0; n < 2; ++n) acc[a][b][m][n] = (f32x4){0.f, 0.f, 0.f, 0.f};
        S.a_ready(u);
        const char* ab = S.a_base(); const char* bb = S.b_base(u);
        unsigned aoff[2][4], boff[2][2];
#pragma unroll
        for (int ai = 0; ai < 2; ++ai)
#pragma unroll
            for (int m = 0; m < 4; ++m) aoff[ai][m] = S.a_off(u, ai * 128 + wr * 64 + m * 16 + fr) + fq * 16;
#pragma unroll
        for (int bj = 0; bj < 2; ++bj)
#pragma unroll
            for (int n = 0; n < 2; ++n) { const int rr = Epi::PERM ? perm32(n * 16 + fr) : (n * 16 + fr); boff[bj][n] = (unsigned)(bj * 128 + wc * 32 + rr) * (unsigned)K * 2u + fq * 16; }
        for (int k0 = 0; k0 < K; k0 += 32) {
            if (Epi::MIDK != 0 && k0 == Epi::MIDK) E.mid(acc, u, wr, wc, fr, fq);
            bf16x8 a[2][4], b[2][2];
#pragma unroll
            for (int ai = 0; ai < 2; ++ai)
#pragma unroll
                for (int m = 0; m < 4; ++m) a[ai][m] = *(const bf16x8*)(ab + aoff[ai][m] + k0 * 2);
#pragma unroll
            for (int bj = 0; bj < 2; ++bj)
#pragma unroll
                for (int n = 0; n < 2; ++n) b[bj][n] = *(const bf16x8*)(bb + boff[bj][n] + k0 * 2);
#pragma unroll
            for (int ai = 0; ai < 2; ++ai)
#pragma unroll
                for (int bj = 0; bj < 2; ++bj)
#pragma unroll
                    for (int m = 0; m < 4; ++m)
#pragma unroll
                        for (int n = 0; n < 2; ++n) acc[ai][bj][m][n] = __builtin_amdgcn_mfma_f32_16x16x32_bf16(b[bj][n], a[ai][m], acc[ai][bj][m][n], 0, 0, 0);
        }
        E(acc, u, wr, wc, fr, fq); S.done(u);
    }
}

constexpr int BK = 64, HALF = 128, HTB = HALF * BK * 2, STAGE_BYTES = 8 * HTB;
__host__ __device__ __forceinline__ int lds_byte(int r, int c) { const int st = (r >> 4) * 2 + (c >> 5), rr = r & 15, cc = c & 31, ob = rr * 64 + cc * 2; return st * 1024 + (ob ^ (((ob >> 9) & 1) << 5)); }
__host__ __device__ __forceinline__ void stage_rc(int b, int& R, int& C) { const int st = b / 1024, sb = b % 1024, swz = sb ^ (((sb >> 9) & 1) << 5); R = (st >> 1) * 16 + swz / 64; C = (st & 1) * 32 + (swz % 64) / 2; }

template <class Epi, class Sched>
__device__ __forceinline__ void gemm_fast(LAS unsigned char* lds, const Sched& S, const Epi& E, const int K) {
    const int tid = opaque_tid(), wid = __builtin_amdgcn_readfirstlane(tid >> 6), lane = tid & 63, wr = wid >> 2, wc = wid & 3, fr = lane & 15, fq = lane >> 4;
    constexpr int EB = Sched::EB; const int Kb = K * EB, nt = Kb / (BK * 2);
    struct VoffB { int tid, Kb; __device__ __forceinline__ unsigned operator[](int i) const { int t2 = tid; asm volatile("" : "+v"(t2)); int sR, sC; stage_rc(t2 * 16 + i * 8192, sR, sC);
        const int Rb = Epi::PERM ? ((sR & ~31) + perm32(sR & 31)) : sR; return (unsigned)(Rb * Kb) + (unsigned)sC * 2u; } };
    struct VoffBReg { unsigned v[2]; __device__ __forceinline__ unsigned operator[](int i) const { return v[i]; } };
    constexpr bool LEAN = (EB == 1);
    const VoffB voffB_lean{tid, Kb}; VoffBReg voffB_reg; voffB_reg.v[0] = voffB_lean[0]; voffB_reg.v[1] = voffB_lean[1];
    volatile LAS unsigned* vslot = (volatile LAS unsigned*)(lds + STAGE_BYTES + 2048 + tid * 8);
    if constexpr (LEAN) { vslot[0] = voffB_reg.v[0]; vslot[1] = voffB_reg.v[1]; }

#define PG8_AOFF(dst, unit) do { int t2_ = tid; asm volatile("" : "+v"(t2_)); _Pragma("unroll") for (int i_ = 0; i_ < 2; ++i_) { int sR_, sC_; stage_rc(t2_ * 16 + i_ * 8192, sR_, sC_); \
        _Pragma("unroll") for (int h_ = 0; h_ < 2; ++h_) dst[h_][i_] = S.a_off(unit, h_ * 128 + sR_) + (unsigned)sC_ * 2u; } } while (0)
    const size_t kstep = (size_t)(BK * 2);
    const size_t hstepB = (size_t)HALF * Kb;
    const unsigned ldsw = (unsigned)wid * 1024u;
    const int aoff = lds_byte(wr * 64 + fr, fq * 8), boff = lds_byte(wc * 32 + fr, fq * 8);
#define PG8_SA(b, h) (((b) * 2 + (h)) * HTB)
#define PG8_SB(b, h) ((4 + (b) * 2 + (h)) * HTB)
#define PG8_STAGE(bufoff, gbase, voff) do { _Pragma("unroll") for (int _i = 0; _i < 2; ++_i) \
        __builtin_amdgcn_global_load_lds((const unsigned*)((const char*)(gbase) + (voff)[_i]), (LAS unsigned*)(lds + (bufoff) + ldsw + _i * 8192), 16, 0, Sched::A_AUX); } while (0)
#define PG8_STAGEB(bufoff, gbase) do { unsigned vo_[2]; if constexpr (LEAN) { const u32x2 t_ = *(volatile LAS u32x2*)vslot; vo_[0] = t_.x; vo_[1] = t_.y; } else { vo_[0] = voffB_reg.v[0]; vo_[1] = voffB_reg.v[1]; } \
        _Pragma("unroll") for (int _i = 0; _i < 2; ++_i) \
        __builtin_amdgcn_global_load_lds((const unsigned*)((const char*)(gbase) + vo_[_i]), (LAS unsigned*)(lds + (bufoff) + ldsw + _i * 8192), 16, 0, 0); } while (0)
#define PG8_LDA(dst, b, h) do { _Pragma("unroll") for (int m = 0; m < 4; ++m) _Pragma("unroll") for (int k = 0; k < 2; ++k) dst[m][k] = *(const LAS bf16x8*)(lds + PG8_SA(b, h) + aoff + m * 2048 + k * 1024); } while (0)
#define PG8_LDB(dst, b, h) do { _Pragma("unroll") for (int n = 0; n < 2; ++n) _Pragma("unroll") for (int k = 0; k < 2; ++k) dst[n][k] = *(const LAS bf16x8*)(lds + PG8_SB(b, h) + boff + n * 2048 + k * 1024); } while (0)
#define PG8_V8(f) __builtin_shufflevector(__builtin_bit_cast(i32x4_t, (f)[0]), __builtin_bit_cast(i32x4_t, (f)[1]), 0, 1, 2, 3, 4, 5, 6, 7)
#define PG8_MMA(ai, bj, At, Bt) do { __builtin_amdgcn_s_setprio(1); _Pragma("unroll") for (int m = 0; m < 4; ++m) _Pragma("unroll") for (int n = 0; n < 2; ++n) { \
        if constexpr (EB == 2) { _Pragma("unroll") for (int k = 0; k < 2; ++k) acc[ai][bj][m][n] = __builtin_amdgcn_mfma_f32_16x16x32_bf16(Bt[n][k], At[m][k], acc[ai][bj][m][n], 0, 0, 0); } \
        else acc[ai][bj][m][n] = __builtin_amdgcn_mfma_scale_f32_16x16x128_f8f6f4(PG8_V8(Bt[n]), PG8_V8(At[m]), acc[ai][bj][m][n], 0, 0, 0, 0, 0, 0); } \
        __builtin_amdgcn_s_setprio(0); } while (0)
#define PG8_WAIT_V(n) asm volatile("s_waitcnt vmcnt(" #n ")" ::: "memory")
#define PG8_WAIT_L(n) asm volatile("s_waitcnt lgkmcnt(" #n ")" ::: "memory")
#define PG8_BAR __builtin_amdgcn_s_barrier()
#define PG8_SCHED __builtin_amdgcn_sched_barrier(0)
    Unit cur, nxt; int ui = 0;
    if (!S.next(0, cur)) return;
    Acc acc;
#pragma unroll
    for (int a = 0; a < 2; ++a)
#pragma unroll
        for (int b = 0; b < 2; ++b)
#pragma unroll
            for (int m = 0; m < 4; ++m)
#pragma unroll
                for (int n = 0; n < 2; ++n) acc[a][b][m][n] = (f32x4){0.f, 0.f, 0.f, 0.f};
    bf16x8 At[4][2], B0[2][2], B1[2][2];
    unsigned va[2][2], vn[2][2];
    PG8_AOFF(va, cur);
    const char* const A0 = S.a_base(); const char* cB = S.b_base(cur);
    S.a_ready(cur);
    PG8_STAGEB(PG8_SB(0, 0), cB); PG8_STAGEB(PG8_SB(0, 1), cB + hstepB); PG8_STAGE(PG8_SA(0, 0), A0, va[0]); PG8_STAGE(PG8_SA(0, 1), A0, va[1]);
    if (wr == 1) PG8_BAR;
    PG8_WAIT_V(2); PG8_BAR;
    PG8_STAGEB(PG8_SB(1, 0), cB + kstep); PG8_STAGE(PG8_SA(1, 0), A0 + kstep, va[0]); PG8_STAGEB(PG8_SB(1, 1), cB + hstepB + kstep);
    PG8_WAIT_V(6); PG8_BAR;
    for (;;) {
        const bool has_next = S.next(ui + 1, nxt);
        const char* nB = has_next ? S.b_base(nxt) : cB;
        if constexpr (!LEAN) { if (has_next) PG8_AOFF(vn, nxt); else { _Pragma("unroll") for (int h = 0; h < 2; ++h) _Pragma("unroll") for (int i = 0; i < 2; ++i) vn[h][i] = va[h][i]; } }
        for (int t = 0; t < nt; t += 2) {
            const bool last = (t == nt - 2);
            if (Epi::MIDK != 0 && EB == 2 && t * BK == Epi::MIDK) { PG8_SCHED; if (wr == 0) PG8_BAR; E.mid(acc, cur, wr, wc, fr, fq); if (wr == 1) PG8_BAR; PG8_SCHED; }
            if (last && has_next) S.a_ready(nxt);
            const char* a1 = A0 + (size_t)(t + 1) * kstep;
            const char* a2 = last ? A0 : A0 + (size_t)(t + 2) * kstep; const char* b2 = last ? nB : cB + (size_t)(t + 2) * kstep;
            const char* a3 = a2 + kstep; const char* b3 = b2 + kstep;
            const bool full = !Sched::DYN_HALF || cur.nvalid > 128;
            PG8_LDB(B0, 0, 0); PG8_LDB(B1, 0, 1); PG8_SCHED; PG8_LDA(At, 0, 0); PG8_STAGE(PG8_SA(1, 1), a1, va[1]);
            if constexpr (LEAN) { if (last && has_next) PG8_AOFF(va, nxt); }
            else { if (last) { _Pragma("unroll") for (int h = 0; h < 2; ++h) _Pragma("unroll") for (int i = 0; i < 2; ++i) va[h][i] = vn[h][i]; } }
            PG8_WAIT_V(8); PG8_WAIT_L(0); PG8_BAR; PG8_MMA(0, 0, At, B0); PG8_MMA(0, 1, At, B1); PG8_BAR; PG8_SCHED;
            if (full) { PG8_LDA(At, 0, 1); } PG8_STAGEB(PG8_SB(0, 0), b2); PG8_STAGEB(PG8_SB(0, 1), b2 + hstepB); PG8_STAGE(PG8_SA(0, 0), a2, va[0]);
            PG8_WAIT_V(8); PG8_WAIT_L(0); PG8_BAR; if (full) { PG8_MMA(1, 0, At, B0); PG8_MMA(1, 1, At, B1); } PG8_BAR; PG8_SCHED;
            PG8_LDB(B0, 1, 0); PG8_LDB(B1, 1, 1); PG8_SCHED; PG8_LDA(At, 1, 0); PG8_STAGE(PG8_SA(0, 1), a2, va[1]);
            PG8_WAIT_V(8); PG8_WAIT_L(0); PG8_BAR; PG8_MMA(0, 0, At, B0); PG8_MMA(0, 1, At, B1); PG8_BAR; PG8_SCHED;
            if (full) { PG8_LDA(At, 1, 1); } PG8_STAGEB(PG8_SB(1, 0), b3); PG8_STAGEB(PG8_SB(1, 1), b3 + hstepB); PG8_STAGE(PG8_SA(1, 0), a3, va[0]);
            PG8_WAIT_V(8); PG8_WAIT_L(0); PG8_BAR; if (full) { PG8_MMA(1, 0, At, B0); PG8_MMA(1, 1, At, B1); } PG8_BAR; PG8_SCHED;
        }
        if (wr == 0) PG8_BAR;
        E(acc, cur, wr, wc, fr, fq); S.done(cur);
        if (!has_next) break;
#pragma unroll
        for (int a = 0; a < 2; ++a)
#pragma unroll
            for (int b = 0; b < 2; ++b)
#pragma unroll
                for (int m = 0; m < 4; ++m)
#pragma unroll
                    for (int n = 0; n < 2; ++n) acc[a][b][m][n] = (f32x4){0.f, 0.f, 0.f, 0.f};
        cur = nxt; cB = nB; ++ui;
        if (wr == 1) PG8_BAR;
    }
    PG8_WAIT_V(0);
    PG8_BAR;
#undef PG8_SA
#undef PG8_SB
#undef PG8_STAGE
#undef PG8_STAGEB
#undef PG8_LDA
#undef PG8_LDB
#undef PG8_MMA
#undef PG8_V8
#undef PG8_AOFF
#undef PG8_WAIT_V
#undef PG8_WAIT_L
#undef PG8_BAR
#undef PG8_SCHED
}
#ifndef FAST_MASK
#define FAST_MASK 0x1f
#endif
template <int BIT, class Epi, class Sched>
__device__ __forceinline__ void gemm_run(LAS unsigned char* lds, const Sched& S, const Epi& E, const int K) {
    if constexpr ((FAST_MASK >> BIT) & 1) gemm_fast(lds, S, E, K); else gemm_simple(S, E, K);
}

__device__ __forceinline__ void tr_item64(const float* W, int N, int k0, int ns, bf16_t* WT, int ldk, int nd, int kd, LAS float* scr, int lane, const float* kscale, float sc = 0.f) {
    { const int r4 = lane >> 4, c4 = (lane & 15) * 4; f32x4 v[16];
#pragma unroll
      for (int i = 0; i < 16; ++i) v[i] = __builtin_nontemporal_load((const f32x4*)(W + (size_t)(k0 + 4 * i + r4) * N + ns + c4));
#pragma unroll
      for (int i = 0; i < 16; ++i) { LAS float* d = scr + (4 * i + r4) * 65 + c4; d[0] = v[i][0]; d[1] = v[i][1]; d[2] = v[i][2]; d[3] = v[i][3]; } }
    const int c = lane & 7;
    f32x4 s0 = (f32x4){1.f, 1.f, 1.f, 1.f}, s1 = s0;
    if (kscale) { s0 = *(const f32x4*)(kscale + k0 + 8 * c); s1 = *(const f32x4*)(kscale + k0 + 8 * c + 4); }
    asm volatile("s_waitcnt lgkmcnt(0)" ::: "memory");
#pragma unroll
    for (int j = 0; j < 8; ++j) { const int n = (lane >> 3) + 8 * j; const LAS float* s = scr + (8 * c) * 65 + n;
        if (sc != 0.f) { const f32x4 lo4 = (f32x4){s[0 * 65], s[1 * 65], s[2 * 65], s[3 * 65]} * s0 * sc, hi4 = (f32x4){s[4 * 65], s[5 * 65], s[6 * 65], s[7 * 65]} * s1 * sc;
            u32x2 q; q.x = pk4_fp8(clamp_fp8(lo4)); q.y = pk4_fp8(clamp_fp8(hi4)); *(u32x2*)((unsigned char*)WT + (size_t)(nd + n) * ldk + kd + 8 * c) = q; continue; }
        u32x4 o; o.x = cvt_pk_bf16(s[0 * 65] * s0[0], s[1 * 65] * s0[1]); o.y = cvt_pk_bf16(s[2 * 65] * s0[2], s[3 * 65] * s0[3]);
        o.z = cvt_pk_bf16(s[4 * 65] * s1[0], s[5 * 65] * s1[1]); o.w = cvt_pk_bf16(s[6 * 65] * s1[2], s[7 * 65] * s1[3]);
        *(u32x4*)(WT + (size_t)(nd + n) * ldk + kd + 8 * c) = o; }
    asm volatile("s_waitcnt lgkmcnt(0)" ::: "memory");
}
constexpr int TRS = 64 * 65 * 4;
static_assert(8 * TRS <= LDS_BYTES - 64, "transpose scratch vs barrier words");
struct TrItem { const float* W; int N; bf16_t* WT; int ldk, nd, kd, k0, ns; const float* ks; float sc; };
__device__ __forceinline__ void tr_load(f32x4 (&v)[16], const TrItem& it, int lane) {
    const int r4 = lane >> 4, c4 = (lane & 15) * 4;
#pragma unroll
    for (int i = 0; i < 16; ++i) v[i] = __builtin_nontemporal_load((const f32x4*)(it.W + (size_t)(it.k0 + 4 * i + r4) * it.N + it.ns + c4));
}
__device__ __forceinline__ void tr_store(const f32x4 (&v)[16], const TrItem& it, LAS float* scr, int lane) {
    { const int r4 = lane >> 4, c4 = (lane & 15) * 4;
#pragma unroll
      for (int i = 0; i < 16; ++i) { LAS float* d = scr + (4 * i + r4) * 65 + c4; d[0] = v[i][0]; d[1] = v[i][1]; d[2] = v[i][2]; d[3] = v[i][3]; } }
    const int c = lane & 7;
    f32x4 s0 = (f32x4){1.f, 1.f, 1.f, 1.f}, s1 = s0;
    if (it.ks) { s0 = *(const f32x4*)(it.ks + it.k0 + 8 * c); s1 = *(const f32x4*)(it.ks + it.k0 + 8 * c + 4); }
    asm volatile("s_waitcnt lgkmcnt(0)" ::: "memory");
#pragma unroll
    for (int j = 0; j < 8; ++j) { const int n = (lane >> 3) + 8 * j; const LAS float* s = scr + (8 * c) * 65 + n;
        if (it.sc != 0.f) { const f32x4 lo4 = (f32x4){s[0 * 65] * s0[0], s[1 * 65] * s0[1], s[2 * 65] * s0[2], s[3 * 65] * s0[3]} * it.sc, hi4 = (f32x4){s[4 * 65] * s1[0], s[5 * 65] * s1[1], s[6 * 65] * s1[2], s[7 * 65] * s1[3]} * it.sc;
            u32x2 q; q.x = pk4_fp8(clamp_fp8(lo4)); q.y = pk4_fp8(clamp_fp8(hi4)); __builtin_nontemporal_store(q, (u32x2*)((unsigned char*)it.WT + (size_t)(it.nd + n) * it.ldk + it.kd + 8 * c)); }
        else { u32x4 o; o.x = cvt_pk_bf16(s[0 * 65] * s0[0], s[1 * 65] * s0[1]); o.y = cvt_pk_bf16(s[2 * 65] * s0[2], s[3 * 65] * s0[3]);
            o.z = cvt_pk_bf16(s[4 * 65] * s1[0], s[5 * 65] * s1[1]); o.w = cvt_pk_bf16(s[6 * 65] * s1[2], s[7 * 65] * s1[3]);
            __builtin_nontemporal_store(o, (u32x4*)(it.WT + (size_t)(it.nd + n) * it.ldk + it.kd + 8 * c)); } }
    asm volatile("s_waitcnt lgkmcnt(0)" ::: "memory");
}
constexpr int NIT_EXP = 8192 + 4096;
__device__ __forceinline__ TrItem exp_item(const Params& p, int r) {
    TrItem it;
    if (r < 8192) { const int up = r >> 12, qq = r & 4095, e = qq >> 8, kb = (qq & 255) >> 3, nb = qq & 7;
        it.W = p.in[up ? 17 : 16] + (size_t)e * D * DE; it.N = DE; it.WT = (bf16_t*)(p.ws + WS_W1T + (size_t)e * 1024 * D * EBM); it.ldk = D; it.sc = MOE_FP8 ? FS1 : 0.f;
        it.nd = 256 * (nb >> 1) + (nb & 1) * 64 + (up ? 128 : 0); it.kd = kb * 64; it.k0 = kb * 64; it.ns = nb * 64; it.ks = p.in[11]; }
    else { const int q = r - 8192, e = q >> 8, kb = (q & 255) >> 5, nb = q & 31;
        it.W = p.in[18] + (size_t)e * DE * D; it.N = D; it.WT = (bf16_t*)(p.ws + WS_W2T + (size_t)e * D * DE * EBM); it.ldk = DE; it.sc = MOE_FP8 ? FS2 : 0.f; it.nd = nb * 64; it.kd = kb * 64; it.k0 = kb * 64; it.ns = nb * 64; it.ks = nullptr; }
    return it;
}
__device__ __forceinline__ int pair_item(int pr, int j) {
    if (pr < 4096) { const int nb = pr & 7, kbh = (pr >> 3) & 15, e = (pr >> 7) & 15, up = pr >> 11; return (up << 12) | (e << 8) | ((2 * kbh + j) << 3) | nb; }
    const int q = pr - 4096, nb = q & 31, kbh = (q >> 5) & 3, e = q >> 7; return 8192 + ((e << 8) | ((2 * kbh + j) << 5) | nb);
}
__device__ __forceinline__ void convert_tail(const Params& p, LAS unsigned char* lds, int nunits) {
    const int tid = opaque_tid(), wave = __builtin_amdgcn_readfirstlane(tid >> 6), lane = tid & 63;
    const int G = gridDim.x, rounds = (nunits + G - 1) / G, nfull = nunits - (rounds - 1) * G;
    int idle_idx, n_idle;
    if (nfull >= G || nunits == 0) { idle_idx = blockIdx.x; n_idle = G; } else { idle_idx = (int)blockIdx.x - nfull; n_idle = G - nfull; }
    if (idle_idx < 0) return;
    LAS float* scr = (LAS float*)(lds + wave * TRS);
    constexpr int NPAIR = NIT_EXP / 2;
    const int stride = n_idle * NWAVES; int pr = idle_idx * NWAVES + wave;
    if (pr >= NPAIR) return;
    f32x4 va[16], vb[16];
    TrItem ia = exp_item(p, pair_item(pr, 0)), ib = ia;
    tr_load(va, ia, lane);
    for (;;) {
        ib = exp_item(p, pair_item(pr, 1)); tr_load(vb, ib, lane);
        tr_store(va, ia, scr, lane);
        const bool hn = (pr + stride) < NPAIR;
        if (hn) { ia = exp_item(p, pair_item(pr + stride, 0)); tr_load(va, ia, lane); }
        tr_store(vb, ib, scr, lane);
        if (!hn) break;
        pr += stride;
    }
}
__device__ __forceinline__ int win_src_col(int nd) {
    if (nd < 1024) return nd;
    if (nd < 3072) { const int q = (nd - 1024) >> 8, r = (nd - 1024) & 255; return r < 128 ? (1024 + 128 * q + r) : (2048 + 128 * q + r - 128); }
    if (nd < 5120) return nd;
    { const int q = (nd - 5120) >> 8, r = (nd - 5120) & 255; return r < 128 ? (5120 + 128 * q + r) : (7168 + 128 * q + r - 128); }
}
__device__ __forceinline__ void phase0(const Params& p, LAS unsigned char* lds) {
    const int tid = opaque_tid(), wave = __builtin_amdgcn_readfirstlane(tid >> 6), lane = tid & 63;
    LAS float* scr = (LAS float*)(lds + wave * TRS);
    const int gw = blockIdx.x * NWAVES + wave, NGW = gridDim.x * NWAVES;
    unsigned char* ws = p.ws;
    constexpr int I_IN = 32 * 144, I_UP = 16 * 32, I_OUT = 32 * 32;
    constexpr int NITEMS = I_IN + 2 * I_UP + I_OUT;
    for (int it = gw; it < NITEMS; it += NGW) {
        int r = it;
        if (r < I_IN) { const int kb = r / 144, nb = r % 144;
            if (nb < 80) tr_item64(p.in[2], NIN, kb * 64, win_src_col(nb * 64), (bf16_t*)(ws + WS_WINT), D, nb * 64, kb * 64, scr, lane, nullptr);
            else tr_item64(p.in[2], NIN, kb * 64, win_src_col(nb * 64), (bf16_t*)(ws + WS_WIN8), D, (nb - 80) * 64, kb * 64, scr, lane, nullptr, FSW);
            continue; } r -= I_IN;
        if (r < I_UP) { const int kb = r / 32, nb = r % 32; tr_item64(p.in[8], D, kb * 64, nb * 64, (bf16_t*)(ws + WS_WUPT), 2048, nb * 64, kb * 64, scr, lane, nullptr); continue; } r -= I_UP;
        if (r < I_UP) { const int kb = r / 32, nb = r % 32; tr_item64(p.in[9], D, kb * 64, nb * 64, (bf16_t*)(ws + WS_WUPT), 2048, nb * 64, 1024 + kb * 64, scr, lane, nullptr); continue; } r -= I_UP;
        { const int kb = r / 32, nb = r % 32; tr_item64(p.in[10], D, kb * 64, nb * 64, (bf16_t*)(ws + WS_WOUTT), D, nb * 64, kb * 64, scr, lane, nullptr); }
    }
    const float* x = p.in[0]; const float* g = p.in[1]; bf16_t* xn = (bf16_t*)(ws + WS_X);
    for (int m = gw; m < T; m += NGW) {
        const f32x4* xr = (const f32x4*)(x + (size_t)m * D) + lane; f32x4 v[8]; float s = 0.f;
#pragma unroll
        for (int j = 0; j < 8; ++j) { v[j] = __builtin_nontemporal_load(xr + 64 * j); s += (v[j][0] * v[j][0] + v[j][1] * v[j][1]) + (v[j][2] * v[j][2] + v[j][3] * v[j][3]); }
        const float ms = wave_sum(s) * (1.0f / D) + EPS; const float rs = 1.0f / sqrtf(ms);
        if (lane == 0) ((float*)(ws + WS_SMALL + SM_RS1))[m] = sqrtf(ms);
        u32x2* o = (u32x2*)(xn + (size_t)m * D) + lane; unsigned* o8 = (unsigned*)(ws + WS_XN8 + (size_t)m * D) + lane;
#pragma unroll
        for (int j = 0; j < 8; ++j) { const f32x4 gg = *((const f32x4*)g + lane + 64 * j); const f32x4 y = v[j] * rs * gg; u32x2 w; w.x = cvt_pk_bf16(y[0], y[1]); w.y = cvt_pk_bf16(y[2], y[3]); o[64 * j] = w;
            o8[64 * j] = pk4_fp8(clamp_fp8(y * FSX)); }
    }
    { bf16_t* wr = (bf16_t*)(ws + WS_WR); const float* gf = p.in[11];
      for (int i = blockIdx.x * NTHREADS + tid; i < 32 * D; i += gridDim.x * NTHREADS) { const int j = i / D, d = i % D; unsigned hi = 0, lo = 0;
          if (j < 20) { const float v = gf[d] * (j < 4 ? p.in[12][d * 4 + j] : p.in[14][d * 16 + (j - 4)]); hi = cvt_pk_bf16(v, 0.f) & 0xffffu; lo = cvt_pk_bf16(v - __uint_as_float(hi << 16), 0.f) & 0xffffu; }
          wr[(size_t)j * D + d] = (bf16_t)hi; wr[(size_t)(32 + j) * D + d] = (bf16_t)lo; } }
    { bf16_t* wmb = (bf16_t*)(ws + WS_WMB); const float* wsrc = p.in[6];
      for (int i = blockIdx.x * NTHREADS + tid; i < 8 * 128 * 128 / 2; i += gridDim.x * NTHREADS) { const int e0 = 2 * i, r = (e0 >> 7) & 127, c = e0 & 127; const bool ok = (r >= 64) || (c < 64);
          ((unsigned*)wmb)[i] = ok ? cvt_pk_bf16(wsrc[e0], wsrc[e0 + 1]) : 0u; } }
    if (blockIdx.x == 0 && tid < 64) ((int*)(ws + WS_CTL))[tid] = 0;
}

__device__ __forceinline__ void phase2_conv(const Params& p) {
    const bf16_t* Bc = (const bf16_t*)(p.ws + WS_P + P_BC); const bf16_t* P = (const bf16_t*)(p.ws + WS_P + P_P); bf16_t* Y = (bf16_t*)(p.ws + WS_Y);
    const float* cw = p.in[3];
    for (int i = blockIdx.x * NTHREADS + opaque_tid(); i < (T / 8) * (CW / 8); i += gridDim.x * NTHREADS) {
        const int t0 = (i >> 7) * 8, c = (i & 127) * 8;
        u32x4 pr[10], br[8];
#pragma unroll
        for (int r = 0; r < 10; ++r) { const int t = t0 - 2 + r; pr[r] = (t >= 0) ? *(const u32x4*)(P + (size_t)t * CW + c) : (u32x4){0u, 0u, 0u, 0u}; }
#pragma unroll
        for (int r = 0; r < 8; ++r) br[r] = *(const u32x4*)(Bc + (size_t)(t0 + r) * CW + c);
        const f32x4 w0a = *(const f32x4*)(cw + c), w0b = *(const f32x4*)(cw + c + 4), w1a = *(const f32x4*)(cw + CW + c), w1b = *(const f32x4*)(cw + CW + c + 4),
                    w2a = *(const f32x4*)(cw + 2 * CW + c), w2b = *(const f32x4*)(cw + 2 * CW + c + 4);
#pragma unroll
        for (int r = 0; r < 8; ++r) {
            f32x4 p0a, p0b, p1a, p1b, p2a, p2b, ba, bb;
            unpack8(pr[r], p0a, p0b); unpack8(pr[r + 1], p1a, p1b); unpack8(pr[r + 2], p2a, p2b); unpack8(br[r], ba, bb);
            const f32x4 ya = ba * (w0a * p0a + w1a * p1a + w2a * p2a), yb = bb * (w0b * p0b + w1b * p1b + w2b * p2b);
            *(u32x4*)(Y + (size_t)(t0 + r) * 2048 + c) = pack8(ya, yb);
        }
    }
}
__device__ __forceinline__ void phase2_sgu(const Params& p, LAS unsigned char* lds) {
    const int tid = opaque_tid(), wave = __builtin_amdgcn_readfirstlane(tid >> 6), lane = tid & 63, fr = lane & 15, fq = lane >> 4;
    const bf16_t* U = (const bf16_t*)(p.ws + WS_P + P_U); const bf16_t* V = (const bf16_t*)(p.ws + WS_P + P_V); bf16_t* Y = (bf16_t*)(p.ws + WS_Y);
    const bf16_t* WmB = (const bf16_t*)(p.ws + WS_WMB); const f32x2* VST = (const f32x2*)(p.ws + WS_SMALL + SM_VST);
    const float* lng = p.in[4]; const float* lnb = p.in[5]; const float* bs = p.in[7];
    LAS f32x2* st = (LAS f32x2*)lds;
    constexpr int VP = 272, VTB = 128 * VP;
    LAS unsigned char* vT = lds + 2048;
    const int G = gridDim.x;
    for (int u0 = blockIdx.x; u0 < 64 * 8; u0 += 2 * G) {
        const int u1 = u0 + G; const bool two = u1 < 64 * 8;
        __syncthreads();
        if (tid < 256 && (tid < 128 || two)) { const int uu = (tid < 128) ? u0 : u1; const int tk = (uu >> 3) * 128 + (tid & 127);
            const f32x4* ps = (const f32x4*)(VST + (size_t)tk * 16); float s = 0.f, q = 0.f;
#pragma unroll
            for (int i = 0; i < 8; ++i) { const f32x4 v = ps[i]; s += v[0] + v[2]; q += v[1] + v[3]; }
            const float mu = s * (1.0f / SW); const float var = fmaxf(q * (1.0f / SW) - mu * mu, 0.f);
            st[tid] = (f32x2){mu, 1.0f / sqrtf(var + EPS)}; }
        const int su = tid >> 8, sl = tid & 255, jb = sl >> 4, cb = sl & 15, j0 = jb * 8, cc0 = cb * 8;
        const int uu = su ? u1 : u0; const bool act = (su == 0) || two;
        const int t0 = (uu >> 3) * 128, c0 = (uu & 7) * 128;
        u32x4 raw[8];
        if (act) {
#pragma unroll
            for (int r = 0; r < 8; ++r) raw[r] = *(const u32x4*)(V + (size_t)(t0 + j0 + r) * SW + c0 + cc0); }
        __syncthreads();
        if (act) {
            const f32x4 g0 = *(const f32x4*)(lng + c0 + cc0), g1 = *(const f32x4*)(lng + c0 + cc0 + 4), b0 = *(const f32x4*)(lnb + c0 + cc0), b1 = *(const f32x4*)(lnb + c0 + cc0 + 4);
            f32x4 lo[8], hi[8];
#pragma unroll
            for (int r = 0; r < 8; ++r) { const f32x2 s = st[su * 128 + j0 + r]; f32x4 a, b; unpack8(raw[r], a, b);
                lo[r] = (a - s.x) * s.y * g0 + b0; hi[r] = (b - s.x) * s.y * g1 + b1; }
            LAS unsigned char* vt = vT + su * VTB;
#pragma unroll
            for (int cc = 0; cc < 4; ++cc) { u32x4 o;
                o.x = cvt_pk_bf16(lo[0][cc], lo[1][cc]); o.y = cvt_pk_bf16(lo[2][cc], lo[3][cc]); o.z = cvt_pk_bf16(lo[4][cc], lo[5][cc]); o.w = cvt_pk_bf16(lo[6][cc], lo[7][cc]);
                *(LAS u32x4*)(vt + (cc0 + cc) * VP + j0 * 2) = o;
                o.x = cvt_pk_bf16(hi[0][cc], hi[1][cc]); o.y = cvt_pk_bf16(hi[2][cc], hi[3][cc]); o.z = cvt_pk_bf16(hi[4][cc], hi[5][cc]); o.w = cvt_pk_bf16(hi[6][cc], hi[7][cc]);
                *(LAS u32x4*)(vt + (cc0 + 4 + cc) * VP + j0 * 2) = o; }
        }
        __syncthreads();
#pragma unroll
        for (int s2 = 0; s2 < 2; ++s2) {
            if (s2 == 1 && !two) break;
            const int ux = s2 ? u1 : u0; const int h = ux & 7, tt0 = (ux >> 3) * 128, cc = h * 128;
            LAS unsigned char* vt = vT + s2 * VTB;
            bf16x8 wf[4];
#pragma unroll
            for (int ks = 0; ks < 4; ++ks) wf[ks] = *(const bf16x8*)(WmB + ((size_t)h * 128 + wave * 16 + fr) * 128 + ks * 32 + fq * 8);
            const int i = wave * 16 + fr; const float bb = bs[h * 128 + i]; const size_t t = (size_t)(tt0 + i);
            u32x2 uv[8];
#pragma unroll
            for (int nk = 0; nk < 8; ++nk) uv[nk] = *(const u32x2*)(U + t * SW + cc + nk * 16 + 4 * fq);
            f32x4 acc[8];
#pragma unroll
            for (int nk = 0; nk < 8; ++nk) { acc[nk] = (f32x4){0.f, 0.f, 0.f, 0.f};
#pragma unroll
                for (int ks = 0; ks < 4; ++ks) { const bf16x8 vf = *(const LAS bf16x8*)(vt + (nk * 16 + fr) * VP + (ks * 32 + fq * 8) * 2);
                    acc[nk] = __builtin_amdgcn_mfma_f32_16x16x32_bf16(vf, wf[ks], acc[nk], 0, 0, 0); } }
#pragma unroll
            for (int nk = 0; nk < 8; ++nk) { const int c = cc + nk * 16 + 4 * fq; const u32x2 u2 = uv[nk];
                u32x2 o; o.x = cvt_pk_bf16(bf_lo(u2.x) * (acc[nk][0] + bb), bf_hi(u2.x) * (acc[nk][1] + bb)); o.y = cvt_pk_bf16(bf_lo(u2.y) * (acc[nk][2] + bb), bf_hi(u2.y) * (acc[nk][3] + bb));
                *(u32x2*)(Y + t * 2048 + 1024 + c) = o; }
        }
    }
}

__device__ __forceinline__ void phase5_router(const Params& p, LAS unsigned char* lds) {
    const int tid = opaque_tid(), wave = __builtin_amdgcn_readfirstlane(tid >> 6), lane = tid & 63, fr = lane & 15, fq = lane >> 4;
    const bf16_t* A2 = (const bf16_t*)(p.ws + WS_A2); const bf16_t* wr = (const bf16_t*)(p.ws + WS_WR);
    float* rstd = (float*)(p.ws + WS_SMALL + SM_RSTD); int* ent = (int*)(p.ws + WS_SMALL + SM_ENT); float* lw = (float*)(p.ws + WS_SMALL + SM_W); int* cnt = (int*)(p.ws + WS_CTL);
    const float* brg = p.in[13]; const float* bre = p.in[15];
    LAS float* part = (LAS float*)lds;
    LAS float* pss  = (LAS float*)(lds + 65536);
    LAS float* lg   = (LAS float*)(lds + 65536 + 1024);
    LAS float* lss  = (LAS float*)(lds + 65536 + 1024 + 2560);
    LAS int* lcnt  = (LAS int*)(lds + 70000);
    LAS int* lbase = (LAS int*)(lds + 70000 + 64);
    LAS int* le    = (LAS int*)(lds + 70000 + 128);
    LAS int* lp    = (LAS int*)(lds + 70000 + 128 + 256);
    LAS float* lwt = (LAS float*)(lds + 70000 + 128 + 512);
    for (int tile = blockIdx.x; tile < T / 32; tile += gridDim.x) {
        const int tok0 = tile * 32;
        __syncthreads();
        if (tid < 16) lcnt[tid] = 0;
        f32x4 acc[2][4]; float ss[2] = {0.f, 0.f};
#pragma unroll
        for (int m = 0; m < 2; ++m)
#pragma unroll
            for (int n = 0; n < 4; ++n) acc[m][n] = (f32x4){0.f, 0.f, 0.f, 0.f};
#pragma unroll 2
        for (int ks = 0; ks < 8; ++ks) {
            const int k = wave * 256 + ks * 32 + fq * 8;
            bf16x8 af[2], bfr[4];
#pragma unroll
            for (int m = 0; m < 2; ++m) { af[m] = *(const bf16x8*)(A2 + (size_t)(tok0 + 16 * m + fr) * D + k);
                if (MOE_FP8) { const u32x4 w = __builtin_bit_cast(u32x4, af[m]); f32x4 a, b; unpack8(w, a, b); u32x2 q; q.x = pk4_fp8(clamp_fp8(a)); q.y = pk4_fp8(clamp_fp8(b));
                    *(u32x2*)(p.ws + WS_A8 + (size_t)(tok0 + 16 * m + fr) * D + k) = q; } }
#pragma unroll
            for (int n = 0; n < 4; ++n) bfr[n] = *(const bf16x8*)(wr + (size_t)(16 * n + fr) * D + k);
#pragma unroll
            for (int m = 0; m < 2; ++m) {
#pragma unroll
                for (int j = 0; j < 8; ++j) { const float v = bf1((bf16_t)af[m][j]); ss[m] += v * v; }
#pragma unroll
                for (int n = 0; n < 4; ++n) acc[m][n] = __builtin_amdgcn_mfma_f32_16x16x32_bf16(bfr[n], af[m], acc[m][n], 0, 0, 0);
            }
        }
#pragma unroll
        for (int m = 0; m < 2; ++m) { ss[m] += __shfl_xor(ss[m], 16); ss[m] += __shfl_xor(ss[m], 32);
            if (fq == 0) pss[wave * 32 + 16 * m + fr] = ss[m];
#pragma unroll
            for (int n = 0; n < 4; ++n) *(LAS f32x4*)(part + (wave * 32 + 16 * m + fr) * 64 + 16 * n + 4 * fq) = acc[m][n]; }
        __syncthreads();
        for (int i = tid; i < 32 * 20; i += NTHREADS) { const int t = i / 20, j = i % 20; float s = 0.f;
#pragma unroll
            for (int w = 0; w < 8; ++w) s += part[(w * 32 + t) * 64 + j] + part[(w * 32 + t) * 64 + 32 + j];
            lg[t * 20 + j] = s; }
        if (tid < 32) { float s = 0.f;
#pragma unroll
            for (int w = 0; w < 8; ++w) s += pss[w * 32 + tid];
            lss[tid] = s; }
        __syncthreads();
        if (tid < 32) {
            const int t = tid; const float rs = 1.0f / sqrtf(lss[t] * (1.0f / D) + EPS);
            float g4[4];
#pragma unroll
            for (int j = 0; j < 4; ++j) g4[j] = lg[t * 20 + j] * rs + brg[j];
            int gi = 0; float gm = g4[0];
#pragma unroll
            for (int j = 1; j < 4; ++j) if (g4[j] > gm) { gm = g4[j]; gi = j; }
            float den = 0.f;
#pragma unroll
            for (int j = 0; j < 4; ++j) den += __expf(g4[j] - gm);
            const float pg = 1.0f / den;
            float le4[4];
#pragma unroll
            for (int j = 0; j < 4; ++j) le4[j] = lg[t * 20 + 4 + gi * 4 + j] * rs + bre[gi * 4 + j];
            int i1 = 0; float m1 = le4[0];
#pragma unroll
            for (int j = 1; j < 4; ++j) if (le4[j] > m1) { m1 = le4[j]; i1 = j; }
            int i2 = -1; float m2 = -3.0e38f;
#pragma unroll
            for (int j = 0; j < 4; ++j) if (j != i1 && le4[j] > m2) { m2 = le4[j]; i2 = j; }
            const float ex = __expf(m2 - m1); const float w1 = pg / (1.0f + ex), w2 = pg * ex / (1.0f + ex);
            rstd[tok0 + t] = rs;
            const int e1 = gi * 4 + i1, e2 = gi * 4 + i2;
            le[2 * t] = e1; le[2 * t + 1] = e2; lwt[2 * t] = w1; lwt[2 * t + 1] = w2;
            lp[2 * t] = atomicAdd((int*)&lcnt[e1], 1); lp[2 * t + 1] = atomicAdd((int*)&lcnt[e2], 1);
        }
        __syncthreads();
        if (tid < 16) { const int n = lcnt[tid]; lbase[tid] = n ? atomicAdd(&cnt[tid], n) : 0; }
        __syncthreads();
        if (tid < 64) { const int e = le[tid]; const int pos = lbase[e] + lp[tid]; ent[e * T + pos] = (tok0 + (tid >> 1)) | ((tid & 1) << 16); lw[e * T + pos] = lwt[tid]; }
    }
}

__device__ __forceinline__ void phase8_final(const Params& p) {
    const int tid = opaque_tid(), wave = __builtin_amdgcn_readfirstlane(tid >> 6), lane = tid & 63;
    const bf16_t* A2 = (const bf16_t*)(p.ws + WS_A2); const bf16_t* Y0 = (const bf16_t*)(p.ws + WS_YK0); const bf16_t* Y1 = (const bf16_t*)(p.ws + WS_YK1); const float* g = p.in[19];
    const int gw = blockIdx.x * NWAVES + wave, NGW = gridDim.x * NWAVES;
    for (int m = gw; m < T; m += NGW) {
        f32x4 v[8]; float s = 0.f;
#pragma unroll
        for (int j = 0; j < 8; ++j) { const size_t o = (size_t)m * D + 4 * lane + 256 * j;
            const u32x2 hh = *(const u32x2*)(A2 + o), a = *(const u32x2*)(Y0 + o), b = *(const u32x2*)(Y1 + o);
            v[j][0] = bf_lo(hh.x) + (bf_lo(a.x) + bf_lo(b.x)); v[j][1] = bf_hi(hh.x) + (bf_hi(a.x) + bf_hi(b.x)); v[j][2] = bf_lo(hh.y) + (bf_lo(a.y) + bf_lo(b.y)); v[j][3] = bf_hi(hh.y) + (bf_hi(a.y) + bf_hi(b.y));
            s += (v[j][0] * v[j][0] + v[j][1] * v[j][1]) + (v[j][2] * v[j][2] + v[j][3] * v[j][3]); }
        const float rs = 1.0f / sqrtf(wave_sum(s) * (1.0f / D) + EPS);
#pragma unroll
        for (int j = 0; j < 8; ++j) { const int c = 4 * lane + 256 * j; const f32x4 gg = *(const f32x4*)(g + c); __builtin_nontemporal_store(v[j] * rs * gg, (f32x4*)(p.out + (size_t)m * D + c)); }
    }
}

#define XB_TMO      128
#define XB_XCNT(j)  (256  + 64 * (j))
#define XB_XSUB(j)  (1280 + 64 * (j))
#define XB_XGEN(j)  (2304 + 64 * (j))
#define XB_TOP      3328
#define XB_TOPGEN   3392
#define XCD_BAR_WORDS 3456
#define XB_SPIN_CAP (1u << 18)
__device__ __forceinline__ unsigned xb_ld(unsigned* p)              { return __hip_atomic_load(p, __ATOMIC_RELAXED, __HIP_MEMORY_SCOPE_AGENT); }
__device__ __forceinline__ unsigned xb_add(unsigned* p, unsigned v) { return __hip_atomic_fetch_add(p, v, __ATOMIC_RELAXED, __HIP_MEMORY_SCOPE_AGENT); }
__device__ __forceinline__ unsigned xb_xcc_id() { return (unsigned)__builtin_amdgcn_s_getreg((3 << 11) | 20) & 0xFu; }
#define XB_SPIN(cond, bar) do { unsigned _sp = 0; while (cond) { __builtin_amdgcn_s_sleep(1); \
    if ((++_sp & 255u) == 0u) { if (xb_ld(&(bar)[XB_TMO])) break; if (_sp > XB_SPIN_CAP) { atomicAdd(&(bar)[XB_TMO], 1u); break; } } } } while (0)
struct XcdBarrier { unsigned* bar; unsigned x; volatile LAS unsigned* st; };
__device__ __forceinline__ XcdBarrier xcd_barrier_post(unsigned* bar, volatile LAS unsigned* st) {
    XcdBarrier b; b.bar = bar; b.x = xb_xcc_id(); b.st = st;
    if (threadIdx.x == 0) (void)xb_add(&bar[XB_XCNT(b.x)], 1u);
    return b;
}
__device__ __forceinline__ void xcd_barrier_complete(unsigned* bar, unsigned x, unsigned& nloc, unsigned& nx) {
    const unsigned G = gridDim.x * gridDim.y * gridDim.z;
    unsigned sum, cnt, mine, sp = 0u;
    for (;;) {
        sum = 0u; cnt = 0u; mine = 0u;
#pragma unroll
        for (unsigned j = 0; j < 16; ++j) { const unsigned c = xb_ld(&bar[XB_XCNT(j)]); sum += c; cnt += (c > 0u) ? 1u : 0u; mine = (j == x) ? c : mine; }
        if (sum == G) break;
        __builtin_amdgcn_s_sleep(1);
        if ((++sp & 255u) == 0u) { if (xb_ld(&bar[XB_TMO])) break; if (sp > XB_SPIN_CAP) { atomicAdd(&bar[XB_TMO], 1u); break; } }
    }
    nloc = mine > 0u ? mine : 1u; nx = cnt > 0u ? cnt : 1u;
}
__device__ __forceinline__ void xcd_barrier(const XcdBarrier& b) {
    asm volatile("s_waitcnt vmcnt(0)" ::: "memory");
    __syncthreads();
    if (threadIdx.x == 0) {
        unsigned* bar = b.bar;
        __builtin_amdgcn_s_waitcnt(0);
        unsigned nloc = b.st[0], nx = b.st[1];
        if (nloc == 0u) { xcd_barrier_complete(bar, b.x, nloc, nx); b.st[0] = nloc; b.st[1] = nx; }
        const unsigned old = xb_add(&bar[XB_XSUB(b.x)], 1u);
        const unsigned gen = old / nloc;
        if (old + 1u == (gen + 1u) * nloc) {
            __builtin_amdgcn_fence(__ATOMIC_RELEASE, "agent");
            asm volatile("s_waitcnt vmcnt(0)" ::: "memory");
            const unsigned og = xb_add(&bar[XB_TOP], 1u);
            const unsigned tg = og / nx;
            if (og + 1u == (tg + 1u) * nx) xb_add(&bar[XB_TOPGEN], 1u);
            else XB_SPIN(xb_ld(&bar[XB_TOPGEN]) == tg, bar);
            __builtin_amdgcn_fence(__ATOMIC_ACQUIRE, "agent");
            xb_add(&bar[XB_XGEN(b.x)], 1u);
            asm volatile("s_waitcnt vmcnt(0)" ::: "memory");
        } else {
            XB_SPIN(xb_ld(&bar[XB_XGEN(b.x)]) == gen, bar);
            __builtin_amdgcn_fence(__ATOMIC_ACQUIRE, "agent");
            asm volatile("s_waitcnt vmcnt(0)" ::: "memory");
        }
    }
    __syncthreads();
}

template <int PH> __device__ __forceinline__ void run_phase(const Params& p, LAS unsigned char* lds) {
    unsigned char* ws = p.ws;
    if constexpr (PH == 0) phase0(p, lds);
    if constexpr (PH == 1) {
        EpiProj E{(bf16_t*)(ws + WS_P + P_BC), (bf16_t*)(ws + WS_P + P_P), (bf16_t*)(ws + WS_P + P_U), (bf16_t*)(ws + WS_P + P_V), (bf16_t*)(ws + WS_P + P_R), (bf16_t*)(ws + WS_P + P_S), (f32x2*)(ws + WS_SMALL + SM_VST), 20, -1.44269504f / (FSX * FSW)};
        { EpiProj Eb = E; Eb.pn0 = 0; Eb.nls = -1.44269504f; DenseSched S; S.init((const bf16_t*)(ws + WS_X), (const bf16_t*)(ws + WS_WINT), T, 5120, D); gemm_run<0>(lds, S, Eb, D); }
        { DenseSchedT<1> S8; S8.init((const bf16_t*)(ws + WS_XN8), (const bf16_t*)(ws + WS_WIN8), T, 4096, D); gemm_fast(lds, S8, E, D); }
        convert_tail(p, lds, (T / 256) * (5120 / 256)); }
    if constexpr (PH == 2) { phase2_conv(p); phase2_sgu(p, lds); }
    if constexpr (PH == 3) { DenseSched S; S.init((const bf16_t*)(ws + WS_Y), (const bf16_t*)(ws + WS_WUPT), T, D, 2048);
        EpiUp E{(const bf16_t*)(ws + WS_P + P_R), (const bf16_t*)(ws + WS_P + P_S), (bf16_t*)(ws + WS_MM)}; gemm_run<1>(lds, S, E, 2048); }
    if constexpr (PH == 4) { DenseSched S; S.init((const bf16_t*)(ws + WS_MM), (const bf16_t*)(ws + WS_WOUTT), T, D, D);
        EpiOut E{(const bf16_t*)(ws + WS_X), p.in[1], (const float*)(ws + WS_SMALL + SM_RS1), (bf16_t*)(ws + WS_A2), ws + WS_A8}; gemm_run<2>(lds, S, E, D); }
    if constexpr (PH == 5) phase5_router(p, lds);
    if constexpr (PH == 6 || PH == 7) {
        const int* cnt = (const int*)(ws + WS_CTL); const int* ent = (const int*)(ws + WS_SMALL + SM_ENT); const int G = gridDim.x, c = blockIdx.x;
        EpiMoe1 E1{ent, (const float*)(ws + WS_SMALL + SM_W), (const float*)(ws + WS_SMALL + SM_RSTD), (bf16_t*)(ws + WS_HID), false};
        EpiMoe2 E2{ent, (bf16_t*)(ws + WS_YK0), (bf16_t*)(ws + WS_YK1)};
        typedef MoeSched<true, 4, D, 1024, EBM> S1T; typedef MoeSched<false, 8, DE, D, EBM> S2T;
        const bf16_t* A2m = (const bf16_t*)(ws + (MOE_FP8 ? WS_A8 : WS_A2));
        constexpr int BIG = 1 << 20;
        unsigned* flags = (unsigned*)(ws + WS_FLAGS);
        int UA = 0, UH = 0; for (int e = 0; e < NE; ++e) { const int nt = (__builtin_amdgcn_readfirstlane(cnt[e]) + 255) >> 8; UA += min(nt, MOE_REG) * 4; UH += max(nt - MOE_REG, 0) * 4; }
        const bool fancy = (UA <= G) && (UH <= G / 2);
        if constexpr (PH == 6) {
            if (fancy) {
                E1.wt = true;
                { S1T S{A2m, (const bf16_t*)(ws + WS_W1T), cnt, ent, 3, (c < UA) ? c : -1, 0, 1, (c < UH) ? UA + c : -1, flags, 1}; gemm_run<3>(lds, S, E1, D); }
                { S2T S{(const bf16_t*)(ws + WS_HID), (const bf16_t*)(ws + WS_W2T), cnt, ent, 3, (c >= UH) ? c - UH : -1, G - UH, BIG, -1, flags, 2}; gemm_run<4>(lds, S, E2, DE); }
            } else { S1T S{A2m, (const bf16_t*)(ws + WS_W1T), cnt, ent, 2, c, G, BIG, -1, flags, 0}; gemm_run<3>(lds, S, E1, D); }
        }
        if constexpr (PH == 7) { S2T S{(const bf16_t*)(ws + WS_HID), (const bf16_t*)(ws + WS_W2T), cnt, ent, 2, c, G, BIG, -1, flags, 0}; gemm_run<4>(lds, S, E2, DE); }
    }
    if constexpr (PH == 8) phase8_final(p);
}

template <int PH> __global__ void __launch_bounds__(NTHREADS, 2) k_phase(Params p) {
    extern __shared__ __attribute__((aligned(16))) unsigned char lds_raw[];
    run_phase<PH>(p, (LAS unsigned char*)lds_raw);
}

#ifndef PROBE_DUP
#define PROBE_DUP 0
#endif
#ifndef PROBE_SYNCS
#define PROBE_SYNCS 0
#endif
#define DUP(k) ((PROBE_DUP >> (k)) & 1)
#ifndef PROBE_T
#define PROBE_T (-1)
#endif
#ifndef PROBE_MULT
#define PROBE_MULT 4
#endif
typedef const __attribute__((address_space(4))) Params* KParamsPtr;
__device__ __forceinline__ Params load_params() {
    Params r{};
#if defined(__HIP_DEVICE_COMPILE__)
    unsigned long long v = (unsigned long long)__builtin_amdgcn_kernarg_segment_ptr(); asm volatile("" : "+s"(v));
    const __attribute__((address_space(4))) unsigned long long* q = (const __attribute__((address_space(4))) unsigned long long*)v;
#pragma unroll
    for (int i = 0; i < 20; ++i) r.in[i] = (const float*)(const __attribute__((address_space(1))) float*)q[i];
    r.out = (float*)(__attribute__((address_space(1))) float*)q[20]; r.ws = (unsigned char*)(__attribute__((address_space(1))) unsigned char*)q[21];
#endif
    return r;
}
#define RUN(k) do { const Params pk = load_params(); run_phase<k>(pk, lds); } while (0)
__global__ void __launch_bounds__(NTHREADS, 2) k_mega(Params p) {
    extern __shared__ __attribute__((aligned(16))) unsigned char lds_raw[];
    LAS unsigned char* lds = (LAS unsigned char*)lds_raw;
    cg::grid_group grid = cg::this_grid();
    volatile LAS unsigned* xbst = (volatile LAS unsigned*)(lds + LDS_BYTES - 64);
    if (threadIdx.x < 4) xbst[threadIdx.x] = 0u;
    __syncthreads();
    (void)xcd_barrier_post((unsigned*)(p.ws + WS_BAR), xbst);
    volatile LAS unsigned long long* stamps = (volatile LAS unsigned long long*)(lds + LDS_BYTES - 256);
    int nstamp = 0;
#define STAMP() do { if (PROBE_T >= 0 && blockIdx.x == 0 && threadIdx.x == 0) stamps[nstamp] = __builtin_amdgcn_s_memrealtime(); ++nstamp; } while (0)
#define GSYNC() do { XcdBarrier b_; b_.bar = (unsigned*)(load_params().ws + WS_BAR); b_.x = xb_xcc_id(); b_.st = (volatile LAS unsigned*)(lds + LDS_BYTES - 64); xcd_barrier(b_); STAMP(); } while (0)
    STAMP();
    if (p.ws == nullptr) grid.sync();
    RUN(0); GSYNC();
    if (DUP(0)) { RUN(0); GSYNC(); }
    RUN(1); GSYNC();
    if (DUP(1)) { RUN(1); GSYNC(); }
    RUN(2); GSYNC();
    if (DUP(2)) { RUN(2); GSYNC(); }
    RUN(3); GSYNC();
    if (DUP(3)) { RUN(3); GSYNC(); }
    RUN(4); GSYNC();
    if (DUP(4)) { RUN(4); GSYNC(); }
    RUN(5); GSYNC();
    if (DUP(5)) { if (blockIdx.x == 0 && threadIdx.x < 16) ((int*)(load_params().ws + WS_CTL))[threadIdx.x] = 0; GSYNC(); RUN(5); GSYNC(); }
    RUN(6); GSYNC();
    if (DUP(6)) { RUN(6); GSYNC(); }
    { const int* cnt = (const int*)(load_params().ws + WS_CTL); int UA = 0, UH = 0;
      for (int e = 0; e < NE; ++e) { const int nt = (__builtin_amdgcn_readfirstlane(cnt[e]) + 255) >> 8; UA += min(nt, MOE_REG) * 4; UH += max(nt - MOE_REG, 0) * 4; }
      if (!((UA <= (int)gridDim.x) && (UH <= (int)gridDim.x / 2))) { RUN(7); GSYNC(); } }
    for (int i = 0; i < PROBE_SYNCS; ++i) GSYNC();
    RUN(8);
    if (DUP(8)) { GSYNC(); RUN(8); }
    if (PROBE_T >= 0) { __syncthreads(); STAMP();
        if (blockIdx.x == 0 && threadIdx.x == 0) { const unsigned long long d = (stamps[PROBE_T + 1] - stamps[PROBE_T]) * PROBE_MULT; const unsigned long long t0 = __builtin_amdgcn_s_memrealtime();
            while (__builtin_amdgcn_s_memrealtime() - t0 < d) __builtin_amdgcn_s_sleep(8); } }
}

template <int PH> static void launch_phase(const Params& p, int grid, hipStream_t stream) {
    static bool attr = false;
    if (!attr) { (void)hipFuncSetAttribute((const void*)k_phase<PH>, hipFuncAttributeMaxDynamicSharedMemorySize, LDS_BYTES); attr = true; }
    hipLaunchKernelGGL(k_phase<PH>, dim3(grid), dim3(NTHREADS), LDS_BYTES, stream, p);
}

extern "C" void kernel_launch(void* const* d_in, const int* in_sizes, int n_in, void* d_out, int out_size, void* d_ws, size_t ws_size, hipStream_t stream) {
    static int grid = 0;
    if (grid == 0) {
        if (n_in != 20 || out_size != T * D || ws_size < WS_END) { fprintf(stderr, "kernel_launch: unexpected shapes n_in %d out %d ws %zu (need %zu)\n", n_in, out_size, ws_size, (size_t)WS_END); grid = -1; return; }
        int dev = 0, cus = 0, per_cu = 0;
        (void)hipGetDevice(&dev); (void)hipDeviceGetAttribute(&cus, hipDeviceAttributeMultiprocessorCount, dev);
        (void)hipFuncSetAttribute((const void*)k_mega, hipFuncAttributeMaxDynamicSharedMemorySize, LDS_BYTES);
        (void)hipOccupancyMaxActiveBlocksPerMultiprocessor(&per_cu, (const void*)k_mega, NTHREADS, LDS_BYTES);
        if (per_cu < 1) { fprintf(stderr, "kernel_launch: occupancy query says %d blocks per CU\n", per_cu); per_cu = 1; }
        grid = cus * 1;
        (void)hipGetLastError();
    }
    if (grid < 0) return;
    Params p{};
    for (int i = 0; i < 20; ++i) p.in[i] = (const float*)d_in[i];
    p.out = (float*)d_out; p.ws = (unsigned char*)d_ws;
    (void)hipMemsetAsync((char*)d_ws + WS_CTL, 0, 64 * 1024, stream);
#if ONE_LAUNCH
    void* args[] = {&p};
    hipError_t e = hipLaunchCooperativeKernel((const void*)k_mega, dim3(grid), dim3(NTHREADS), args, LDS_BYTES, stream);
    if (e != hipSuccess) fprintf(stderr, "cooperative launch failed: %s (grid %d)\n", hipGetErrorString(e), grid);
#else
    launch_phase<0>(p, grid, stream); launch_phase<1>(p, grid, stream); launch_phase<2>(p, grid, stream); launch_phase<3>(p, grid, stream); launch_phase<4>(p, grid, stream);
    launch_phase<5>(p, grid, stream); launch_phase<6>(p, grid, stream); launch_phase<7>(p, grid, stream); launch_phase<8>(p, grid, stream);
#endif
}
```
